# Optimizing an MI355X kernel written in HIP

```python
import jax, jax.numpy as jnp
from jax import lax
import numpy as np

D_MODEL = 2048
BATCH = 32
SEQ = 256
DEPTH = 2
DEC_BATCH = 8
DEC_SEQ = 1024
PAST_LEN = 512

GRID_W = 64
HEAD_DIM = 128
A_Q_HEADS = 8
A_KV_HEADS = 2
B_HEADS = 8
A_WIDTH = A_Q_HEADS * HEAD_DIM
A_KV_WIDTH = A_KV_HEADS * HEAD_DIM
B_WIDTH = B_HEADS * HEAD_DIM
L0_WIDTH = A_WIDTH + B_WIDTH
L0_IN = A_WIDTH + 2 * A_KV_WIDTH + 3 * B_WIDTH + L0_WIDTH
NA_WIN_H = 8
NA_WIN_W = 16
MLA_HEADS = 16
Q_LORA = 512
KV_LORA = 512
QK_NOPE = 128
QK_ROPE = 64
V_DIM = 128
L1_WIDTH = MLA_HEADS * V_DIM
L1_IN = Q_LORA + KV_LORA + QK_ROPE + L1_WIDTH
Q_BLOCK = 128
ROPE_THETA = 10000.0
EPS = 1e-6
NEG_INF = -1e30

kernel_name = 'hybrid_diffusion_prefix_step'


def rmsnorm(x, g):
    xf = x.astype(jnp.float32)
    y = xf * lax.rsqrt(jnp.mean(xf * xf, axis=-1, keepdims=True) + EPS)
    return (y * g.astype(jnp.float32)).astype(x.dtype)


def adaln(c, w, b):
    m = jax.nn.silu(c) @ w + b
    shift, scale, gate = jnp.split(m, 3, axis=-1)
    return shift[:, None], scale[:, None], gate[:, None]


def rope_half(x, ang):
    m = x.shape[-1] // 2
    cos = jnp.cos(ang)[:, None, :].astype(x.dtype)
    sin = jnp.sin(ang)[:, None, :].astype(x.dtype)
    x1, x2 = x[..., :m], x[..., m:]
    return jnp.concatenate([x1 * cos - x2 * sin, x2 * cos + x1 * sin], axis=-1)


def axial_rope(x):
    S, d = x.shape[1], x.shape[-1]
    a = d // 2
    t = jnp.arange(S)
    row = (t // GRID_W).astype(jnp.float32)
    col = (t % GRID_W).astype(jnp.float32)
    inv = 1.0 / (ROPE_THETA ** (jnp.arange(a // 2, dtype=jnp.float32) * 2.0 / a))
    return jnp.concatenate([rope_half(x[..., :a], row[:, None] * inv),
                            rope_half(x[..., a:], col[:, None] * inv)], axis=-1)


def blocked_attention(q, k, v, scale):
    B, S, Hkv, G, Dq = q.shape
    nb = S // Q_BLOCK
    qb = jnp.moveaxis(q.reshape(B, nb, Q_BLOCK, Hkv, G, Dq), 1, 0)

    def one_block(qblk):
        s = jnp.einsum('bqhgd,bkhd->bhgqk', qblk, k).astype(jnp.float32) * scale
        p = jax.nn.softmax(s, axis=-1).astype(v.dtype)
        return jnp.einsum('bhgqk,bkhd->bqhgd', p, v)

    out = lax.map(one_block, qb)
    return jnp.moveaxis(out, 0, 1).reshape(B, S, Hkv * G, v.shape[-1])


def neighbourhood_attention(q, k, v, k_ctx, v_ctx, rpb, scale):
    B, S, H, D = q.shape
    rows = S // GRID_W
    wh = min(NA_WIN_H, rows)
    ncb = GRID_W // NA_WIN_W
    ksw = 2 * NA_WIN_W
    row_start = jnp.clip(jnp.arange(rows) - wh // 2, 0, rows - wh)
    key_cols = jnp.clip(jnp.arange(ncb) * NA_WIN_W - NA_WIN_W // 2, 0, GRID_W - ksw)[:, None] + jnp.arange(ksw)
    q_cols = jnp.arange(GRID_W).reshape(ncb, NA_WIN_W)
    col_start = jnp.clip(q_cols - NA_WIN_W // 2, 0, GRID_W - NA_WIN_W)
    kc = key_cols[:, None, :]
    col_ok = (kc >= col_start[..., None]) & (kc < col_start[..., None] + NA_WIN_W)
    dx_idx = jnp.clip(kc - q_cols[..., None] + NA_WIN_W - 1, 0, 2 * NA_WIN_W - 2)
    q_g = q.reshape(B, rows, ncb, NA_WIN_W, H, D)
    k_g = k.reshape(B, rows, GRID_W, H, D)
    v_g = v.reshape(B, rows, GRID_W, H, D)
    n_loc = wh * ksw

    def row_block(r):
        q_r = lax.dynamic_index_in_dim(q_g, r, axis=1, keepdims=False)
        rs = row_start[r]
        k_blk = jnp.take(lax.dynamic_slice_in_dim(k_g, rs, wh, axis=1), key_cols, axis=2)
        v_blk = jnp.take(lax.dynamic_slice_in_dim(v_g, rs, wh, axis=1), key_cols, axis=2)
        dy_idx = rs + jnp.arange(wh) - r + NA_WIN_H - 1
        bias = rpb[:, dy_idx[:, None, None, None], dx_idx[None]]
        bias = jnp.where(col_ok[None, None], bias.astype(jnp.float32), NEG_INF)
        bias = jnp.transpose(bias, (0, 2, 3, 1, 4))[None]
        s_loc = jnp.einsum('bjqhd,bajkhd->bhjqak', q_r, k_blk).astype(jnp.float32) * scale + bias
        s_loc = s_loc.reshape(B, H, ncb, NA_WIN_W, n_loc)
        s_ctx = jnp.einsum('bjqhd,blhd->bhjql', q_r, k_ctx).astype(jnp.float32) * scale
        p = jax.nn.softmax(jnp.concatenate([s_loc, s_ctx], axis=-1), axis=-1).astype(v.dtype)
        p_loc = p[..., :n_loc].reshape(B, H, ncb, NA_WIN_W, wh, ksw)
        o = (jnp.einsum('bhjqak,bajkhd->bjqhd', p_loc, v_blk)
             + jnp.einsum('bhjql,blhd->bjqhd', p[..., n_loc:], v_ctx))
        return o.reshape(B, GRID_W, H, D)

    out = lax.map(row_block, jnp.arange(rows))
    return jnp.moveaxis(out, 0, 1).reshape(B, S, H, D)


def l0_split(h, w_in):
    B, S, _ = h.shape
    idx = np.cumsum([A_WIDTH, A_KV_WIDTH, A_KV_WIDTH, B_WIDTH, B_WIDTH, B_WIDTH]).tolist()
    q_a, k_a, v_a, q_b, k_b, v_b, gate = jnp.split(h @ w_in, idx, axis=-1)
    return (q_a.reshape(B, S, A_Q_HEADS, HEAD_DIM), k_a.reshape(B, S, A_KV_HEADS, HEAD_DIM),
            v_a.reshape(B, S, A_KV_HEADS, HEAD_DIM), q_b.reshape(B, S, B_HEADS, HEAD_DIM),
            k_b.reshape(B, S, B_HEADS, HEAD_DIM), v_b.reshape(B, S, B_HEADS, HEAD_DIM), gate)


def l0_merge(o_a, o_b, gate, w_out):
    B, S = gate.shape[:2]
    o = jnp.concatenate([o_a.reshape(B, S, A_WIDTH), o_b.reshape(B, S, B_WIDTH)], axis=-1)
    return (o * jax.nn.silu(gate)) @ w_out


def l0_context(h, w_in, q_norm, k_norm, w_out):
    B, L, _ = h.shape
    q_a, k_a, v_a, q_b, k_b, v_b, gate = l0_split(h, w_in)
    q_a = rmsnorm(q_a, q_norm)
    k_a = rmsnorm(k_a, k_norm)
    sc = HEAD_DIM ** -0.5
    o_a = blocked_attention(q_a.reshape(B, L, A_KV_HEADS, A_Q_HEADS // A_KV_HEADS, HEAD_DIM), k_a, v_a, sc)
    o_b = blocked_attention(q_b[:, :, :, None], k_b, v_b, sc)
    return l0_merge(o_a, o_b, gate, w_out), (k_a, v_a, k_b, v_b)


def l0_latent(h, ck_a, cv_a, ck_b, cv_b, w_in, q_norm, k_norm, rpb, w_out):
    B, S, _ = h.shape
    q_a, k_a, v_a, q_b, k_b, v_b, gate = l0_split(h, w_in)
    q_a = axial_rope(rmsnorm(q_a, q_norm))
    k_a = axial_rope(rmsnorm(k_a, k_norm))
    sc = HEAD_DIM ** -0.5
    o_a = blocked_attention(q_a.reshape(B, S, A_KV_HEADS, A_Q_HEADS // A_KV_HEADS, HEAD_DIM),
                            jnp.concatenate([ck_a, k_a], axis=1), jnp.concatenate([cv_a, v_a], axis=1), sc)
    o_b = neighbourhood_attention(q_b, k_b, v_b, ck_b, cv_b, rpb, sc)
    return l0_merge(o_a, o_b, gate, w_out)


def l1_split(h, w_in, q_a_norm, w_q_b, kv_a_norm):
    B, S, _ = h.shape
    q_lat, kv_lat, k_rope, gate = jnp.split(h @ w_in, np.cumsum([Q_LORA, KV_LORA, QK_ROPE]).tolist(), axis=-1)
    q = (rmsnorm(q_lat, q_a_norm) @ w_q_b).reshape(B, S, MLA_HEADS, QK_NOPE + QK_ROPE)
    ckv = rmsnorm(kv_lat, kv_a_norm)
    return q[..., :QK_NOPE], q[..., QK_NOPE:], ckv, k_rope, gate


def mla_attend(q_nope, q_rope, ckv, k_rope, w_kv_b):
    B, T, _ = ckv.shape
    kv = (ckv @ w_kv_b).reshape(B, T, MLA_HEADS, QK_NOPE + V_DIM)
    k = jnp.concatenate([kv[..., :QK_NOPE],
                         jnp.broadcast_to(k_rope[:, :, None, :], (B, T, MLA_HEADS, QK_ROPE))], axis=-1)
    q = jnp.concatenate([q_nope, q_rope], axis=-1)[:, :, :, None]
    return blocked_attention(q, k, kv[..., QK_NOPE:], (QK_NOPE + QK_ROPE) ** -0.5)


def l1_context(h, w_in, q_a_norm, w_q_b, kv_a_norm, w_kv_b, w_out):
    B, L, _ = h.shape
    q_nope, q_rope, ckv, k_rope, gate = l1_split(h, w_in, q_a_norm, w_q_b, kv_a_norm)
    o = mla_attend(q_nope, q_rope, ckv, k_rope, w_kv_b).reshape(B, L, L1_WIDTH)
    return (o * jax.nn.silu(gate)) @ w_out, (ckv, k_rope)


def l1_latent(h, c_ckv, c_krope, w_in, q_a_norm, w_q_b, kv_a_norm, w_kv_b, w_out):
    B, S, _ = h.shape
    q_nope, q_rope, ckv, k_rope, gate = l1_split(h, w_in, q_a_norm, w_q_b, kv_a_norm)
    q_rope = axial_rope(q_rope)
    k_rope = axial_rope(k_rope[:, :, None, :])[:, :, 0]
    o = mla_attend(q_nope, q_rope, jnp.concatenate([c_ckv, ckv], axis=1),
                   jnp.concatenate([c_krope, k_rope], axis=1), w_kv_b).reshape(B, S, L1_WIDTH)
    return (o * jax.nn.silu(gate)) @ w_out


def setup_inputs(seed: int = 0) -> dict:
    key = jax.random.key(seed)
    ks = jax.random.split(key, 28)
    f32 = jnp.float32

    def nrm(k, shape, scale=1.0):
        return jax.random.normal(k, shape, f32) * scale

    def gain(k, n):
        return 1.0 + 0.05 * jax.random.normal(k, (n,), f32)

    D = D_MODEL
    return {
        'x_prompt': nrm(ks[0], (BATCH, SEQ, D)),
        'x_sample': nrm(ks[1], (DEC_BATCH, DEC_SEQ, D)),
        'cache_l0_a_k': nrm(ks[2], (DEC_BATCH, PAST_LEN, A_KV_HEADS, HEAD_DIM)),
        'cache_l0_a_v': nrm(ks[3], (DEC_BATCH, PAST_LEN, A_KV_HEADS, HEAD_DIM)),
        'cache_l0_b_k': nrm(ks[4], (DEC_BATCH, PAST_LEN, B_HEADS, HEAD_DIM)),
        'cache_l0_b_v': nrm(ks[5], (DEC_BATCH, PAST_LEN, B_HEADS, HEAD_DIM)),
        'cache_l1_ckv': nrm(ks[6], (DEC_BATCH, PAST_LEN, KV_LORA)),
        'cache_l1_krope': nrm(ks[7], (DEC_BATCH, PAST_LEN, QK_ROPE)),
        'c': nrm(ks[8], (DEC_BATCH, D)),
        'c_ctx': nrm(ks[9], (D,)),
        'l0_norm': gain(ks[10], D),
        'l0_ada_w': nrm(ks[11], (D, 3 * D), 0.5 * D ** -0.5),
        'l0_ada_b': nrm(ks[12], (3 * D,), 0.02),
        'l0_w_in': nrm(ks[13], (D, L0_IN), D ** -0.5),
        'l0_q_norm': gain(ks[14], HEAD_DIM),
        'l0_k_norm': gain(ks[15], HEAD_DIM),
        'l0_rpb': nrm(ks[16], (B_HEADS, 2 * NA_WIN_H - 1, 2 * NA_WIN_W - 1), 0.2),
        'l0_w_out': nrm(ks[17], (L0_WIDTH, D), L0_WIDTH ** -0.5),
        'l1_norm': gain(ks[18], D),
        'l1_ada_w': nrm(ks[19], (D, 3 * D), 0.5 * D ** -0.5),
        'l1_ada_b': nrm(ks[20], (3 * D,), 0.02),
        'l1_w_in': nrm(ks[21], (D, L1_IN), D ** -0.5),
        'l1_q_a_norm': gain(ks[22], Q_LORA),
        'l1_w_q_b': nrm(ks[23], (Q_LORA, MLA_HEADS * (QK_NOPE + QK_ROPE)), Q_LORA ** -0.5),
        'l1_kv_a_norm': gain(ks[24], KV_LORA),
        'l1_w_kv_b': nrm(ks[25], (KV_LORA, MLA_HEADS * (QK_NOPE + V_DIM)), KV_LORA ** -0.5),
        'l1_w_out': nrm(ks[26], (L1_WIDTH, D), L1_WIDTH ** -0.5),
        'final_norm': gain(ks[27], D),
    }


def reference(x_prompt, x_sample, cache_l0_a_k, cache_l0_a_v, cache_l0_b_k, cache_l0_b_v,
              cache_l1_ckv, cache_l1_krope, c, c_ctx,
              l0_norm, l0_ada_w, l0_ada_b, l0_w_in, l0_q_norm, l0_k_norm, l0_rpb, l0_w_out,
              l1_norm, l1_ada_w, l1_ada_b, l1_w_in, l1_q_a_norm, l1_w_q_b, l1_kv_a_norm,
              l1_w_kv_b, l1_w_out, final_norm):
    norms = [l0_norm, l1_norm]
    ada_ws = [l0_ada_w, l1_ada_w]
    ada_bs = [l0_ada_b, l1_ada_b]
    caches = [(cache_l0_a_k, cache_l0_a_v, cache_l0_b_k, cache_l0_b_v), (cache_l1_ckv, cache_l1_krope)]

    x = x_prompt
    ctx_states = []
    for i in range(DEPTH):
        shift, scale, gate = adaln(c_ctx[None], ada_ws[i], ada_bs[i])
        h = rmsnorm(x, norms[i]) * (1.0 + scale) + shift
        if i % 2 == 0:
            out, st = l0_context(h, l0_w_in, l0_q_norm, l0_k_norm, l0_w_out)
        else:
            out, st = l1_context(h, l1_w_in, l1_q_a_norm, l1_w_q_b, l1_kv_a_norm, l1_w_kv_b, l1_w_out)
        x = x + gate * out
        ctx_states.append(st)
    y_prompt = rmsnorm(x, final_norm)
    new_l0_a_k, new_l0_a_v, new_l0_b_k, new_l0_b_v = ctx_states[0]
    new_l1_ckv, new_l1_krope = ctx_states[1]

    x = x_sample
    for i in range(DEPTH):
        shift, scale, gate = adaln(c, ada_ws[i], ada_bs[i])
        h = rmsnorm(x, norms[i]) * (1.0 + scale) + shift
        if i % 2 == 0:
            ck_a, cv_a, ck_b, cv_b = caches[i]
            out = l0_latent(h, ck_a, cv_a, ck_b, cv_b, l0_w_in, l0_q_norm, l0_k_norm, l0_rpb, l0_w_out)
        else:
            c_ckv, c_krope = caches[i]
            out = l1_latent(h, c_ckv, c_krope, l1_w_in, l1_q_a_norm, l1_w_q_b, l1_kv_a_norm, l1_w_kv_b, l1_w_out)
        x = x + gate * out
    y_sample = rmsnorm(x, final_norm)

    return (y_prompt, y_sample, new_l0_a_k, new_l0_a_v, new_l0_b_k, new_l0_b_v, new_l1_ckv, new_l1_krope)
```

```cpp
#include <hip/hip_runtime.h>
#include <hip/hip_cooperative_groups.h>
#include <cstdio>
namespace cg = cooperative_groups;

typedef unsigned short u16;
using bf16x8 = __attribute__((ext_vector_type(8))) short;
using s16x4  = __attribute__((ext_vector_type(4))) short;
using f32x16 = __attribute__((ext_vector_type(16))) float;
using u32x4  = __attribute__((ext_vector_type(4))) unsigned;
typedef __bf16 bf16x2_t __attribute__((ext_vector_type(2)));
typedef float f32x2_t __attribute__((ext_vector_type(2)));
#define DI __device__ __forceinline__
#define MFMA32(a, b, c) __builtin_amdgcn_mfma_f32_32x32x16_bf16((a), (b), (c), 0, 0, 0)
#define LDS_AS(T) __attribute__((address_space(3))) T

constexpr int D = 2048;
constexpr int NTOK = 16384;
constexpr int NCTX = 8192;
constexpr int L0_IN = 6656;
constexpr int L1_IN = 3136;
constexpr float EPS = 1e-6f;
constexpr float LOG2E = 1.4426950408889634f;
constexpr float LOG2_THETA = 13.287712379549449f;

constexpr size_t OFF_WT_IN1  = 0;
constexpr size_t OFF_WT_QB   = OFF_WT_IN1 + (size_t)3136 * 2048 * 2;
constexpr size_t OFF_WT_KVB  = OFF_WT_QB + (size_t)3072 * 512 * 2;
constexpr size_t OFF_WT_OUT1 = OFF_WT_KVB + (size_t)4096 * 512 * 2;
constexpr size_t OFF_WL0     = OFF_WT_OUT1 + (size_t)2048 * 2048 * 2;
constexpr size_t OFF_WT_IN0  = OFF_WL0;
constexpr size_t OFF_WT_OUT0 = OFF_WT_IN0 + (size_t)6656 * 2048 * 2;
constexpr size_t OFF_H       = OFF_WT_OUT0 + (size_t)2048 * 2048 * 2;
constexpr size_t OFF_BIG     = OFF_H + (size_t)NTOK * 2048 * 2;
constexpr size_t OFF_C       = OFF_BIG + (size_t)NTOK * 6656 * 2;
constexpr size_t OFF_KA_ALL  = OFF_C;
constexpr size_t OFF_VA_ALL  = OFF_KA_ALL + (size_t)8 * 1536 * 256 * 2;
constexpr size_t OFF_KB_CTX  = OFF_VA_ALL + (size_t)8 * 1536 * 256 * 2;
constexpr size_t OFF_VB_CTX  = OFF_KB_CTX + (size_t)8 * 512 * 1024 * 2;
constexpr size_t OFF_CKV_ALL = OFF_VB_CTX + (size_t)8 * 512 * 1024 * 2;
constexpr size_t OFF_KR_ALL  = OFF_CKV_ALL + (size_t)8 * 1536 * 512 * 2;
constexpr size_t OFF_MOD     = OFF_KR_ALL + (size_t)8 * 1536 * 64 * 2;
constexpr size_t OFF_ROPE    = OFF_MOD + (size_t)2 * 9 * 6144 * 4;
constexpr size_t WS_NEEDED   = OFF_ROPE + (size_t)64 * 16 * 2 * 4;
constexpr size_t OFF_QN      = OFF_WL0;
constexpr size_t OFF_CKV_CTX = OFF_QN + (size_t)NTOK * 512 * 2;
constexpr size_t OFF_KR_CTX  = OFF_CKV_CTX + (size_t)NCTX * 512 * 2;
constexpr size_t OFF_KV_CTX  = OFF_H;
constexpr size_t OFF_KV_LAT  = OFF_WL0;
constexpr size_t OFF_LAT1    = OFF_BIG;
constexpr size_t OFF_Q1      = OFF_BIG + (size_t)NTOK * 3136 * 2;
static_assert(OFF_KR_CTX + (size_t)NCTX * 64 * 2 <= OFF_WT_OUT0, "l1 small bufs overflow");
static_assert(OFF_KV_LAT + (size_t)12288 * 4096 * 2 <= OFF_BIG, "kv_lat overflow");
static_assert(OFF_Q1 + (size_t)NTOK * 3072 * 2 <= OFF_C, "q1 overflow");

constexpr size_t OUT_Y   = 0;
constexpr size_t OUT_NAK = (size_t)NTOK * 2048;
constexpr size_t OUT_NAV = OUT_NAK + (size_t)NCTX * 256;
constexpr size_t OUT_NBK = OUT_NAV + (size_t)NCTX * 256;
constexpr size_t OUT_NBV = OUT_NBK + (size_t)NCTX * 1024;
constexpr size_t OUT_NCKV = OUT_NBV + (size_t)NCTX * 1024;
constexpr size_t OUT_NKR = OUT_NCKV + (size_t)NCTX * 512;

constexpr int SMEM_BYTES = 48 * 1024;

struct Params {
  const float *x_prompt, *x_sample, *ca_k, *ca_v, *cb_k, *cb_v, *c_ckv, *c_kr, *c, *c_ctx;
  const float *l0_norm, *l0_ada_w, *l0_ada_b, *l0_w_in, *l0_qn, *l0_kn, *l0_rpb, *l0_w_out;
  const float *l1_norm, *l1_ada_w, *l1_ada_b, *l1_w_in, *l1_qan, *l1_wqb, *l1_kvan, *l1_wkvb, *l1_w_out, *fnorm;
  float* out;
  char* ws;
};

DI u16 f2bf(float x) { unsigned u = __float_as_uint(x); u += 0x7fffu + ((u >> 16) & 1u); return (u16)(u >> 16); }
DI float bf2f(u16 v) { return __uint_as_float(((unsigned)v) << 16); }
DI unsigned pack2(float a, float b) { f32x2_t f = {a, b}; bf16x2_t r = __builtin_convertvector(f, bf16x2_t); return __builtin_bit_cast(unsigned, r); }
DI float bflo(unsigned u) { return __uint_as_float(u << 16); }
DI float bfhi(unsigned u) { return __uint_as_float(u & 0xffff0000u); }
DI float wave_sum(float v) {
#pragma unroll
  for (int o = 32; o >= 1; o >>= 1) v += __shfl_xor(v, o);
  return v;
}
DI int crow(int i, int h) { return (i & 3) + 8 * (i >> 2) + 4 * h; }
DI float silu(float x) { return x / (1.f + __expf(-x)); }
DI int tok_modrow(int tok) { return tok < NCTX ? 0 : 1 + ((tok - NCTX) >> 10); }

DI void transpose_tile(const float* __restrict__ src, int K, int N, u16* __restrict__ dst, int kt, int nt, float* sm) {
  const int t = threadIdx.x;
#pragma unroll
  for (int i = 0; i < 4; ++i) {
    int id = t + 256 * i, r = id >> 4, c4 = id & 15;
    float4 v = *(const float4*)(src + (size_t)(kt * 64 + r) * N + nt * 64 + c4 * 4);
    float* d = sm + r * 65 + c4 * 4;
    d[0] = v.x; d[1] = v.y; d[2] = v.z; d[3] = v.w;
  }
  __syncthreads();
  {
    int n = t >> 2, kq = t & 3;
    unsigned pk[8];
#pragma unroll
    for (int j = 0; j < 8; ++j) pk[j] = pack2(sm[(kq * 16 + 2 * j) * 65 + n], sm[(kq * 16 + 2 * j + 1) * 65 + n]);
    uint4* dp = (uint4*)(dst + (size_t)(nt * 64 + n) * K + kt * 64 + kq * 16);
    dp[0] = make_uint4(pk[0], pk[1], pk[2], pk[3]);
    dp[1] = make_uint4(pk[4], pk[5], pk[6], pk[7]);
  }
  __syncthreads();
}

DI void adaln_item(const Params& p, int l, int chunk, float* sm) {
  const float* W = l ? p.l1_ada_w : p.l0_ada_w;
  const float* bias = l ? p.l1_ada_b : p.l0_ada_b;
  float* mod = (float*)(p.ws + OFF_MOD) + (size_t)l * 9 * 6144;
  const int t = threadIdx.x, col = chunk * 64 + (t & 63), kg = t >> 6;
  float acc[9];
#pragma unroll
  for (int r = 0; r < 9; ++r) acc[r] = 0.f;
  for (int kh = 0; kh < 2; ++kh) {
    __syncthreads();
    for (int e = t; e < 9 * 1024; e += 256) {
      int r = e >> 10, k = e & 1023;
      float cv = (r == 0) ? p.c_ctx[kh * 1024 + k] : p.c[(r - 1) * 2048 + kh * 1024 + k];
      sm[r * 1024 + k] = silu(cv);
    }
    __syncthreads();
    const float* wp = W + (size_t)(kh * 1024 + kg * 256) * 6144 + col;
    const float* sp = sm + kg * 256;
#pragma unroll 8
    for (int k = 0; k < 256; ++k) {
      float w = wp[(size_t)k * 6144];
#pragma unroll
      for (int r = 0; r < 9; ++r) acc[r] += sp[r * 1024 + k] * w;
    }
  }
  __syncthreads();
#pragma unroll
  for (int r = 0; r < 9; ++r) sm[(kg * 9 + r) * 64 + (t & 63)] = acc[r];
  __syncthreads();
  for (int e = t; e < 9 * 64; e += 256) {
    int r = e >> 6, cc = e & 63;
    float s = sm[(0 * 9 + r) * 64 + cc] + sm[(1 * 9 + r) * 64 + cc] + sm[(2 * 9 + r) * 64 + cc] + sm[(3 * 9 + r) * 64 + cc];
    mod[(size_t)r * 6144 + chunk * 64 + cc] = s + bias[chunk * 64 + cc];
  }
  __syncthreads();
}

DI void convert_item(const float* __restrict__ src, u16* __restrict__ dst, int W, int dstT, int item) {
  size_t e = (size_t)item * 2048 + threadIdx.x * 8;
  size_t per_b = (size_t)512 * W;
  size_t b = e / per_b, r = e % per_b;
  float4 v0 = *(const float4*)(src + e), v1 = *(const float4*)(src + e + 4);
  uint4 o = make_uint4(pack2(v0.x, v0.y), pack2(v0.z, v0.w), pack2(v1.x, v1.y), pack2(v1.z, v1.w));
  *(uint4*)(dst + b * (size_t)dstT * W + r) = o;
}

DI void phase_prep(const Params& p, char* smem) {
  float* sm = (float*)smem;
  char* ws = p.ws;
  constexpr int N_ADA = 192;
  constexpr int T_IN0 = 32 * 104, T_OUT0 = 32 * 32, T_IN1 = 32 * 49, T_QB = 8 * 48, T_KVB = 8 * 64, T_OUT1 = 32 * 32;
  constexpr int C_A = 512, C_B = 2048, C_CKV = 1024, C_KR = 128;
  constexpr int B1 = N_ADA, B2 = B1 + T_IN0, B3 = B2 + T_OUT0, B4 = B3 + T_IN1, B5 = B4 + T_QB, B6 = B5 + T_KVB, B7 = B6 + T_OUT1;
  constexpr int B8 = B7 + C_A, B9 = B8 + C_A, B10 = B9 + C_B, B11 = B10 + C_B, B12 = B11 + C_CKV, B13 = B12 + C_KR;
  if (blockIdx.x == gridDim.x - 1) {
    float* tab = (float*)(ws + OFF_ROPE);
    for (int e = threadIdx.x; e < 64 * 16; e += 256) {
      int pos = e >> 4, i = e & 15;
      float inv = exp2f(-(float)i * (LOG2_THETA / 16.f));
      float sn, cs; sincosf((float)pos * inv, &sn, &cs);
      tab[2 * e] = cs; tab[2 * e + 1] = sn;
    }
  }
  for (int it = blockIdx.x; it < B13; it += gridDim.x) {
    if (it < B1) adaln_item(p, it / 96, it % 96, sm);
    else if (it < B2) { int i = it - B1; transpose_tile(p.l0_w_in, 2048, 6656, (u16*)(ws + OFF_WT_IN0), i / 104, i % 104, sm); }
    else if (it < B3) { int i = it - B2; transpose_tile(p.l0_w_out, 2048, 2048, (u16*)(ws + OFF_WT_OUT0), i / 32, i % 32, sm); }
    else if (it < B4) { int i = it - B3; transpose_tile(p.l1_w_in, 2048, 3136, (u16*)(ws + OFF_WT_IN1), i / 49, i % 49, sm); }
    else if (it < B5) { int i = it - B4; transpose_tile(p.l1_wqb, 512, 3072, (u16*)(ws + OFF_WT_QB), i / 48, i % 48, sm); }
    else if (it < B6) { int i = it - B5; transpose_tile(p.l1_wkvb, 512, 4096, (u16*)(ws + OFF_WT_KVB), i / 64, i % 64, sm); }
    else if (it < B7) { int i = it - B6; transpose_tile(p.l1_w_out, 2048, 2048, (u16*)(ws + OFF_WT_OUT1), i / 32, i % 32, sm); }
    else if (it < B8) convert_item(p.ca_k, (u16*)(ws + OFF_KA_ALL), 256, 1536, it - B7);
    else if (it < B9) convert_item(p.ca_v, (u16*)(ws + OFF_VA_ALL), 256, 1536, it - B8);
    else if (it < B10) convert_item(p.cb_k, (u16*)(ws + OFF_KB_CTX), 1024, 512, it - B9);
    else if (it < B11) convert_item(p.cb_v, (u16*)(ws + OFF_VB_CTX), 1024, 512, it - B10);
    else if (it < B12) convert_item(p.c_ckv, (u16*)(ws + OFF_CKV_ALL), 512, 1536, it - B11);
    else convert_item(p.c_kr, (u16*)(ws + OFF_KR_ALL), 64, 1536, it - B12);
  }
}

DI void phase_normmod(const Params& p, int layer) {
  const int wave = threadIdx.x >> 6, lane = threadIdx.x & 63;
  const float* g = layer ? p.l1_norm : p.l0_norm;
  const float* mod = (const float*)(p.ws + OFF_MOD) + (size_t)layer * 9 * 6144;
  u16* H = (u16*)(p.ws + OFF_H);
  for (int it = blockIdx.x; it < NTOK / 4; it += gridDim.x) {
    int row = it * 4 + wave;
    const float* src;
    if (layer == 0) src = row < NCTX ? p.x_prompt + (size_t)row * D : p.x_sample + (size_t)(row - NCTX) * D;
    else src = p.out + OUT_Y + (size_t)row * D;
    const float* mr = mod + (size_t)tok_modrow(row) * 6144;
    float4 v[8];
    float ss = 0.f;
#pragma unroll
    for (int i = 0; i < 8; ++i) {
      v[i] = *(const float4*)(src + (i * 64 + lane) * 4);
      ss += v[i].x * v[i].x + v[i].y * v[i].y + v[i].z * v[i].z + v[i].w * v[i].w;
    }
    ss = wave_sum(ss);
    float rinv = rsqrtf(ss * (1.f / D) + EPS);
#pragma unroll
    for (int i = 0; i < 8; ++i) {
      int col = (i * 64 + lane) * 4;
      float4 gg = *(const float4*)(g + col);
      float4 sh = *(const float4*)(mr + col);
      float4 sc = *(const float4*)(mr + 2048 + col);
      float h0 = v[i].x * rinv * gg.x * (1.f + sc.x) + sh.x;
      float h1 = v[i].y * rinv * gg.y * (1.f + sc.y) + sh.y;
      float h2 = v[i].z * rinv * gg.z * (1.f + sc.z) + sh.z;
      float h3 = v[i].w * rinv * gg.w * (1.f + sc.w) + sh.w;
      *(uint2*)(H + (size_t)row * D + col) = make_uint2(pack2(h0, h1), pack2(h2, h3));
    }
  }
}

struct EpiBf16 {
  u16* C; int ldc; int N;
  DI void operator()(int m, int n, float v) const { if (n < N) C[(size_t)m * ldc + n] = f2bf(v); }
};
struct EpiResid {
  const float* xa; const float* xb; const float* gate; float* out;
  DI void operator()(int m, int n, float v) const {
    float xv = (m < NCTX) ? xa[(size_t)m * D + n] : xb[(size_t)(m - NCTX) * D + n];
    float gt = gate[(size_t)tok_modrow(m) * 6144 + n];
    out[(size_t)m * D + n] = xv + gt * v;
  }
};

constexpr int GLD = 72;
template <class Epi>
DI void gemm_tile(const u16* __restrict__ A, int lda, const u16* __restrict__ Bt, int ldb, int K, int m0, int n0, int N,
                  char* smem, const Epi& epi) {
  u16* As = (u16*)smem;
  u16* Bs = As + 128 * GLD;
  const int t = threadIdx.x, wave = t >> 6, lane = t & 63, wm = wave >> 1, wn = wave & 1, l31 = lane & 31, h = lane >> 5;
  f32x16 acc[2][2];
#pragma unroll
  for (int i = 0; i < 2; ++i)
#pragma unroll
    for (int j = 0; j < 2; ++j)
#pragma unroll
      for (int r = 0; r < 16; ++r) acc[i][j][r] = 0.f;
  const u16* ap[4]; const u16* bp[4];
#pragma unroll
  for (int i = 0; i < 4; ++i) {
    int id = t + 256 * i, r = id >> 3, kc = id & 7;
    ap[i] = A + (size_t)(m0 + r) * lda + kc * 8;
    int nr = n0 + r; if (nr > N - 1) nr = N - 1;
    bp[i] = Bt + (size_t)nr * ldb + kc * 8;
  }
  u32x4 ra[4], rb[4];
#pragma unroll
  for (int i = 0; i < 4; ++i) { ra[i] = *(const u32x4*)(ap[i]); rb[i] = *(const u32x4*)(bp[i]); }
  const int KT = K >> 6;
  for (int kt = 0; kt < KT; ++kt) {
    __syncthreads();
#pragma unroll
    for (int i = 0; i < 4; ++i) {
      int id = t + 256 * i, r = id >> 3, kc = id & 7;
      *(u32x4*)(As + r * GLD + kc * 8) = ra[i];
      *(u32x4*)(Bs + r * GLD + kc * 8) = rb[i];
    }
    __syncthreads();
    if (kt + 1 < KT) {
#pragma unroll
      for (int i = 0; i < 4; ++i) { ra[i] = *(const u32x4*)(ap[i] + (kt + 1) * 64); rb[i] = *(const u32x4*)(bp[i] + (kt + 1) * 64); }
    }
#pragma unroll
    for (int s = 0; s < 4; ++s) {
      bf16x8 a0 = *(const bf16x8*)(As + (wm * 64 + l31) * GLD + 16 * s + 8 * h);
      bf16x8 a1 = *(const bf16x8*)(As + (wm * 64 + 32 + l31) * GLD + 16 * s + 8 * h);
      bf16x8 b0 = *(const bf16x8*)(Bs + (wn * 64 + l31) * GLD + 16 * s + 8 * h);
      bf16x8 b1 = *(const bf16x8*)(Bs + (wn * 64 + 32 + l31) * GLD + 16 * s + 8 * h);
      acc[0][0] = MFMA32(a0, b0, acc[0][0]);
      acc[0][1] = MFMA32(a0, b1, acc[0][1]);
      acc[1][0] = MFMA32(a1, b0, acc[1][0]);
      acc[1][1] = MFMA32(a1, b1, acc[1][1]);
    }
  }
#pragma unroll
  for (int i = 0; i < 2; ++i)
#pragma unroll
    for (int j = 0; j < 2; ++j)
#pragma unroll
      for (int r = 0; r < 16; ++r) {
        int m = m0 + wm * 64 + i * 32 + crow(r, h);
        int n = n0 + wn * 64 + j * 32 + l31;
        epi(m, n, acc[i][j][r]);
      }
}

template <class Epi>
DI void gemm_phase(const u16* A, int lda, const u16* Bt, int K, int M, int N, char* smem, const Epi& epi, int item_base, int item_total_unused) {
  (void)item_total_unused;
  const int NT = (N + 127) / 128, MT = M / 128;
  for (int it = blockIdx.x; it < NT * MT; it += gridDim.x) {
    int nt = it % NT, mt = it / NT;
    gemm_tile(A, lda, Bt, K, K, mt * 128, nt * 128, N, smem, epi);
  }
  (void)item_base;
}

DI void phase_qknorm0(const Params& p) {
  const int wave = threadIdx.x >> 6, lane = threadIdx.x & 63;
  u16* QKVG = (u16*)(p.ws + OFF_BIG);
  u16* KA = (u16*)(p.ws + OFF_KA_ALL);
  u16* VA = (u16*)(p.ws + OFF_VA_ALL);
  const int i = lane & 31, half = lane >> 5, d1 = half * 64 + i, d2 = d1 + 32;
  const float inv = exp2f(-(float)i * (LOG2_THETA / 32.f));
  const float gq1 = p.l0_qn[d1], gq2 = p.l0_qn[d2], gk1 = p.l0_kn[d1], gk2 = p.l0_kn[d2];
  for (int it = blockIdx.x; it < NTOK / 4; it += gridDim.x) {
    int tk = it * 4 + wave;
    u16* base = QKVG + (size_t)tk * L0_IN;
    const bool lat = tk >= NCTX;
    int lt = tk - NCTX, b = lt >> 10, tt = lt & 1023;
    float sn = 0.f, cs = 1.f;
    if (lat) { float pos = half ? (float)(tt & 63) : (float)(tt >> 6); sincosf(pos * inv, &sn, &cs); }
#pragma unroll 1
    for (int hs = 0; hs < 10; ++hs) {
      int col0 = hs < 8 ? hs * 128 : 1024 + (hs - 8) * 128;
      float x1 = bf2f(base[col0 + d1]), x2 = bf2f(base[col0 + d2]);
      float ss = wave_sum(x1 * x1 + x2 * x2);
      float rinv = rsqrtf(ss * (1.f / 128.f) + EPS);
      float y1 = x1 * rinv * (hs < 8 ? gq1 : gk1), y2 = x2 * rinv * (hs < 8 ? gq2 : gk2);
      float o1 = y1 * cs - y2 * sn, o2 = y2 * cs + y1 * sn;
      if (hs < 8) { base[col0 + d1] = f2bf(o1); base[col0 + d2] = f2bf(o2); }
      else {
        int gh = hs - 8;
        if (!lat) {
          base[col0 + d1] = f2bf(o1); base[col0 + d2] = f2bf(o2);
          float* o = p.out + OUT_NAK + (size_t)tk * 256 + gh * 128;
          o[d1] = o1; o[d2] = o2;
        } else {
          u16* o = KA + ((size_t)b * 1536 + 512 + tt) * 256 + gh * 128;
          o[d1] = f2bf(o1); o[d2] = f2bf(o2);
        }
      }
    }
    {
      uint2 v = *(const uint2*)(base + 1280 + lane * 4);
      if (!lat) {
        *(float4*)(p.out + OUT_NAV + (size_t)tk * 256 + lane * 4) = make_float4(bflo(v.x), bfhi(v.x), bflo(v.y), bfhi(v.y));
      } else {
        *(uint2*)(VA + ((size_t)b * 1536 + 512 + tt) * 256 + lane * 4) = v;
      }
    }
    if (!lat) {
#pragma unroll
      for (int kv = 0; kv < 2; ++kv) {
        const u16* s = base + (kv ? 3584 : 2560);
        float* o = p.out + (kv ? OUT_NBV : OUT_NBK) + (size_t)tk * 1024;
#pragma unroll
        for (int q = 0; q < 2; ++q) {
          uint4 v = *(const uint4*)(s + (q * 64 + lane) * 8);
          *(float4*)(o + (q * 64 + lane) * 8) = make_float4(bflo(v.x), bfhi(v.x), bflo(v.y), bfhi(v.y));
          *(float4*)(o + (q * 64 + lane) * 8 + 4) = make_float4(bflo(v.z), bfhi(v.z), bflo(v.w), bfhi(v.w));
        }
      }
    }
  }
}

DI void phase_norm1(const Params& p) {
  const int wave = threadIdx.x >> 6, lane = threadIdx.x & 63;
  const u16* LAT1 = (const u16*)(p.ws + OFF_LAT1);
  u16* QN = (u16*)(p.ws + OFF_QN);
  u16* CKVC = (u16*)(p.ws + OFF_CKV_CTX);
  u16* KRC = (u16*)(p.ws + OFF_KR_CTX);
  u16* CKVA = (u16*)(p.ws + OFF_CKV_ALL);
  u16* KRA = (u16*)(p.ws + OFF_KR_ALL);
  float gq[8], gk[8];
#pragma unroll
  for (int j = 0; j < 8; ++j) { gq[j] = p.l1_qan[lane * 8 + j]; gk[j] = p.l1_kvan[lane * 8 + j]; }
  const int ri = lane & 15, rhalf = (lane >> 4) & 1;
  const int rd1 = rhalf * 32 + ri, rd2 = rd1 + 16;
  const float inv = exp2f(-(float)ri * (LOG2_THETA / 16.f));
  for (int it = blockIdx.x; it < NTOK / 4; it += gridDim.x) {
    int tk = it * 4 + wave;
    const u16* base = LAT1 + (size_t)tk * L1_IN;
    const bool lat = tk >= NCTX;
    int lt = tk - NCTX, b = lt >> 10, tt = lt & 1023;
    size_t arow = (size_t)b * 1536 + 512 + tt;
#pragma unroll
    for (int part = 0; part < 2; ++part) {
      uint4 v = *(const uint4*)(base + part * 512 + lane * 8);
      float x[8] = {bflo(v.x), bfhi(v.x), bflo(v.y), bfhi(v.y), bflo(v.z), bfhi(v.z), bflo(v.w), bfhi(v.w)};
      float ss = 0.f;
#pragma unroll
      for (int j = 0; j < 8; ++j) ss += x[j] * x[j];
      ss = wave_sum(ss);
      float rinv = rsqrtf(ss * (1.f / 512.f) + EPS);
#pragma unroll
      for (int j = 0; j < 8; ++j) x[j] = x[j] * rinv * (part ? gk[j] : gq[j]);
      uint4 o = make_uint4(pack2(x[0], x[1]), pack2(x[2], x[3]), pack2(x[4], x[5]), pack2(x[6], x[7]));
      if (part == 0) *(uint4*)(QN + (size_t)tk * 512 + lane * 8) = o;
      else if (!lat) {
        *(uint4*)(CKVC + (size_t)tk * 512 + lane * 8) = o;
        float* op = p.out + OUT_NCKV + (size_t)tk * 512 + lane * 8;
        *(float4*)op = make_float4(x[0], x[1], x[2], x[3]);
        *(float4*)(op + 4) = make_float4(x[4], x[5], x[6], x[7]);
      } else *(uint4*)(CKVA + arow * 512 + lane * 8) = o;
    }
    if (lane < 32) {
      float x1 = bf2f(base[1024 + rd1]), x2 = bf2f(base[1024 + rd2]);
      if (!lat) {
        KRC[(size_t)tk * 64 + rd1] = f2bf(x1); KRC[(size_t)tk * 64 + rd2] = f2bf(x2);
        p.out[OUT_NKR + (size_t)tk * 64 + rd1] = x1; p.out[OUT_NKR + (size_t)tk * 64 + rd2] = x2;
      } else {
        float pos = rhalf ? (float)(tt & 63) : (float)(tt >> 6);
        float sn, cs; sincosf(pos * inv, &sn, &cs);
        KRA[arow * 64 + rd1] = f2bf(x1 * cs - x2 * sn);
        KRA[arow * 64 + rd2] = f2bf(x2 * cs + x1 * sn);
      }
    }
  }
}

DI void phase_final(const Params& p) {
  const int wave = threadIdx.x >> 6, lane = threadIdx.x & 63;
  for (int it = blockIdx.x; it < NTOK / 4; it += gridDim.x) {
    int row = it * 4 + wave;
    float* y = p.out + OUT_Y + (size_t)row * D;
    float4 v[8];
    float ss = 0.f;
#pragma unroll
    for (int i = 0; i < 8; ++i) {
      v[i] = *(const float4*)(y + (i * 64 + lane) * 4);
      ss += v[i].x * v[i].x + v[i].y * v[i].y + v[i].z * v[i].z + v[i].w * v[i].w;
    }
    ss = wave_sum(ss);
    float rinv = rsqrtf(ss * (1.f / D) + EPS);
#pragma unroll
    for (int i = 0; i < 8; ++i) {
      int col = (i * 64 + lane) * 4;
      float4 gg = *(const float4*)(p.fnorm + col);
      *(float4*)(y + col) = make_float4(v[i].x * rinv * gg.x, v[i].y * rinv * gg.y, v[i].z * rinv * gg.z, v[i].w * rinv * gg.w);
    }
  }
}

struct KVSeg { const u16* k; const u16* v; const u16* kr; int ks, vs, n; };
struct AttnArgs {
  const u16* q; int qs;
  KVSeg seg[2]; int nseg;
  const u16* gate; int gs;
  u16* out; int os;
  float scale_log2;
  const float* rpb;
  int qtok0;
  int rs0;
  int rope;
  const float* ropetab;
};


template <int DQK, int MODE>
DI void attn_load_tile(const AttnArgs& a, int tile, int nt0, u32x4 (&rk)[DQK / 32], u32x4 (&rv)[4]) {
  const int t = threadIdx.x;
  const int sg = tile >= nt0 ? 1 : 0;
  const int off = (sg ? tile - nt0 : tile) * 64;
  const u16* kp = sg ? a.seg[1].k : a.seg[0].k;
  const u16* vp = sg ? a.seg[1].v : a.seg[0].v;
  const int ks = sg ? a.seg[1].ks : a.seg[0].ks;
  const int vs = sg ? a.seg[1].vs : a.seg[0].vs;
  const int r0 = t >> 4, c0 = (t & 15) * 8;
#pragma unroll
  for (int i = 0; i < 4; ++i) {
    rk[i] = *(const u32x4*)(kp + (unsigned)((off + r0 + 16 * i) * ks + c0));
    rv[i] = *(const u32x4*)(vp + (unsigned)((off + r0 + 16 * i) * vs + c0));
  }
  if constexpr (MODE == 2) {
    const u16* krp = sg ? a.seg[1].kr : a.seg[0].kr;
#pragma unroll
    for (int i = 0; i < 2; ++i) rk[4 + i] = *(const u32x4*)(krp + (unsigned)((off + (t >> 3) + 32 * i) * 64 + (t & 7) * 8));
  }
}

template <int DQK, int MODE>
DI void attn_block(const AttnArgs& a, char* smem) {
  constexpr int KLD = DQK + 8;
  constexpr int VLD = 128 + 16;
  constexpr int KCH = DQK / 32;
  constexpr int NS = DQK / 16;
  u16* Ks = (u16*)smem;
  u16* Vs = Ks + 64 * KLD;
  float* bias_s = (float*)(Vs + 64 * VLD);
  const int t = threadIdx.x, wave = t >> 6, lane = t & 63, l31 = lane & 31, h = lane >> 5;

  __syncthreads();
  if constexpr (MODE == 1) {
    for (int e = t; e < 15 * 31; e += 256) bias_s[e] = a.rpb[e] * LOG2E;
  }
  bf16x8 qf[NS];
  {
    const u16* qp = a.q + (size_t)(wave * 32 + l31) * a.qs + 8 * h;
#pragma unroll
    for (int s = 0; s < NS; ++s) qf[s] = *(const bf16x8*)(qp + 16 * s);
  }
  const int qtok = a.qtok0 + wave * 32 + l31;
  if constexpr (MODE == 2) {
    if (a.rope) {
      const int qr = qtok >> 6, qc = qtok & 63;
#pragma unroll
      for (int pr = 0; pr < 2; ++pr) {
        const float4* tb = (const float4*)(a.ropetab + ((pr ? qc : qr) * 16 + 8 * h) * 2);
#pragma unroll
        for (int j2 = 0; j2 < 4; ++j2) {
          float4 cssn = tb[j2];
#pragma unroll
          for (int e = 0; e < 2; ++e) {
            const int j = 2 * j2 + e;
            float cs = e ? cssn.z : cssn.x, sn = e ? cssn.w : cssn.y;
            float x1 = bf2f((u16)qf[8 + 2 * pr][j]), x2 = bf2f((u16)qf[9 + 2 * pr][j]);
            qf[8 + 2 * pr][j] = (short)f2bf(x1 * cs - x2 * sn);
            qf[9 + 2 * pr][j] = (short)f2bf(x2 * cs + x1 * sn);
          }
        }
      }
    }
  }
  f32x16 acc[4];
#pragma unroll
  for (int c = 0; c < 4; ++c)
#pragma unroll
    for (int r = 0; r < 16; ++r) acc[c][r] = 0.f;
  float m_run = -1e30f, l_run = 0.f;

  int ntiles = 0;
  for (int s = 0; s < a.nseg; ++s) ntiles += a.seg[s].n >> 6;
  const int nt0 = a.seg[0].n >> 6;

  u32x4 rk[KCH], rv[4];
  attn_load_tile<DQK, MODE>(a, 0, nt0, rk, rv);

  const int blk = (lane >> 4) & 1, tq = (lane & 15) >> 2, tp = lane & 3;
  const int qrow = qtok >> 6, qcol = qtok & 63;
  int q_rs = qrow - 4; q_rs = q_rs < 0 ? 0 : (q_rs > 8 ? 8 : q_rs);
  int q_cs = qcol - 8; q_cs = q_cs < 0 ? 0 : (q_cs > 48 ? 48 : q_cs);

  for (int tile = 0; tile < ntiles; ++tile) {
    __syncthreads();
#pragma unroll
    for (int i = 0; i < 4; ++i) {
      *(u32x4*)(Ks + ((t >> 4) + 16 * i) * KLD + (t & 15) * 8) = rk[i];
      *(u32x4*)(Vs + ((t >> 4) + 16 * i) * VLD + (t & 15) * 8) = rv[i];
    }
    if constexpr (MODE == 2) {
#pragma unroll
      for (int i = 0; i < 2; ++i) *(u32x4*)(Ks + ((t >> 3) + 32 * i) * KLD + 128 + (t & 7) * 8) = rk[4 + i];
    }
    __syncthreads();
    if (tile + 1 < ntiles) attn_load_tile<DQK, MODE>(a, tile + 1, nt0, rk, rv);

    const bool local = (MODE == 1) && (tile >= nt0);
    const int krow = a.rs0 + (tile - nt0);
#pragma unroll 1
    for (int mt = 0; mt < 2; ++mt) {
      f32x16 S;
#pragma unroll
      for (int r = 0; r < 16; ++r) S[r] = 0.f;
      const u16* kbase = Ks + (mt * 32 + l31) * KLD + 8 * h;
#pragma unroll
      for (int s = 0; s < NS; ++s) {
        bf16x8 kf = *(const bf16x8*)(kbase + 16 * s);
        S = MFMA32(kf, qf[s], S);
        if ((s & 3) == 3) __builtin_amdgcn_sched_barrier(0);
      }
      float mx = -1e30f;
#pragma unroll
      for (int r = 0; r < 16; ++r) {
        float sv = S[r] * a.scale_log2;
        if (MODE == 1) {
          if (local) {
            int kcol = mt * 32 + crow(r, h);
            bool ok = (krow >= q_rs) && (krow < q_rs + 8) && (kcol >= q_cs) && (kcol < q_cs + 16);
            int dy = krow - qrow + 7, dx = kcol - qcol + 15;
            dy = dy < 0 ? 0 : (dy > 14 ? 14 : dy);
            dx = dx < 0 ? 0 : (dx > 30 ? 30 : dx);
            sv = ok ? sv + bias_s[dy * 31 + dx] : -1e30f;
          }
        }
        S[r] = sv;
        mx = fmaxf(mx, sv);
      }
      mx = fmaxf(mx, __shfl_xor(mx, 32));
      const float m_new = fmaxf(m_run, mx);
      const float alpha = exp2f(m_run - m_new);
      m_run = m_new;
      float ps = 0.f;
#pragma unroll
      for (int r = 0; r < 16; ++r) {
        float pv = exp2f(S[r] - m_new);
        if (MODE == 1) { if (S[r] <= -1e29f) pv = 0.f; }
        S[r] = pv;
        ps += pv;
      }
      l_run = l_run * alpha + ps;
#pragma unroll
      for (int c = 0; c < 4; ++c)
#pragma unroll
        for (int r = 0; r < 16; ++r) acc[c][r] *= alpha;
      bf16x8 pf[2];
#pragma unroll
      for (int s2 = 0; s2 < 2; ++s2) {
        u32x4 u;
        u[0] = pack2(S[8 * s2 + 0], S[8 * s2 + 1]);
        u[1] = pack2(S[8 * s2 + 2], S[8 * s2 + 3]);
        u[2] = pack2(S[8 * s2 + 4], S[8 * s2 + 5]);
        u[3] = pack2(S[8 * s2 + 6], S[8 * s2 + 7]);
        pf[s2] = __builtin_bit_cast(bf16x8, u);
      }
      const u16* vbase = Vs + (mt * 32 + 4 * h + tq) * VLD + 16 * blk + 4 * tp;
#pragma unroll
      for (int c = 0; c < 4; ++c)
#pragma unroll
        for (int s2 = 0; s2 < 2; ++s2) {
          const u16* vp = vbase + (16 * s2) * VLD + 32 * c;
          s16x4 lo = __builtin_amdgcn_ds_read_tr16_b64_v4i16((LDS_AS(s16x4)*)(vp));
          s16x4 hi = __builtin_amdgcn_ds_read_tr16_b64_v4i16((LDS_AS(s16x4)*)(vp + 8 * VLD));
          bf16x8 vf = __builtin_shufflevector(lo, hi, 0, 1, 2, 3, 4, 5, 6, 7);
          acc[c] = MFMA32(vf, pf[s2], acc[c]);
          if (s2 == 1 && (c & 1)) __builtin_amdgcn_sched_barrier(0);
        }
    }
  }
  float l_tot = l_run + __shfl_xor(l_run, 32);
  float linv = 1.f / l_tot;
  const size_t qrow_i = (size_t)(wave * 32 + l31);
#pragma unroll
  for (int c = 0; c < 4; ++c)
#pragma unroll
    for (int g4 = 0; g4 < 4; ++g4) {
      int dv0 = 32 * c + 8 * g4 + 4 * h;
      uint2 gt = *(const uint2*)(a.gate + qrow_i * a.gs + dv0);
      float o0 = acc[c][4 * g4 + 0] * linv * silu(bflo(gt.x));
      float o1 = acc[c][4 * g4 + 1] * linv * silu(bfhi(gt.x));
      float o2 = acc[c][4 * g4 + 2] * linv * silu(bflo(gt.y));
      float o3 = acc[c][4 * g4 + 3] * linv * silu(bfhi(gt.y));
      *(uint2*)(a.out + qrow_i * a.os + dv0) = make_uint2(pack2(o0, o1), pack2(o2, o3));
    }
}

DI void phase_attn0(const Params& p, char* smem) {
  const u16* QKVG = (const u16*)(p.ws + OFF_BIG);
  u16* OG = (u16*)(p.ws + OFF_H);
  const u16* KA = (const u16*)(p.ws + OFF_KA_ALL);
  const u16* VA = (const u16*)(p.ws + OFF_VA_ALL);
  const u16* KBC = (const u16*)(p.ws + OFF_KB_CTX);
  const u16* VBC = (const u16*)(p.ws + OFF_VB_CTX);
  const float sc = 0.08838834764831845f * LOG2E;
  for (int it = blockIdx.x; it < 2048; it += gridDim.x) {
    AttnArgs a;
    a.qs = L0_IN; a.gs = L0_IN; a.os = D; a.scale_log2 = sc; a.rpb = nullptr; a.qtok0 = 0; a.rs0 = 0; a.rope = 0; a.ropetab = nullptr;
    a.seg[1].k = nullptr; a.seg[1].v = nullptr; a.seg[1].kr = nullptr; a.seg[1].ks = 0; a.seg[1].vs = 0; a.seg[1].n = 0;
    a.seg[0].kr = nullptr;
    if (it < 512) {
      int b = it >> 6, hq = (it >> 3) & 7, qb = it & 7;
      size_t tok = (size_t)NCTX + b * 1024 + qb * 128;
      a.q = QKVG + tok * L0_IN + hq * 128;
      a.gate = QKVG + tok * L0_IN + 4608 + hq * 128;
      a.out = OG + tok * D + hq * 128;
      a.nseg = 1;
      a.seg[0].k = KA + (size_t)b * 1536 * 256 + (hq >> 2) * 128; a.seg[0].ks = 256;
      a.seg[0].v = VA + (size_t)b * 1536 * 256 + (hq >> 2) * 128; a.seg[0].vs = 256;
      a.seg[0].n = 1536;
      attn_block<128, 0>(a, smem);
    } else if (it < 1024) {
      int i = it - 512;
      int b = i >> 6, hh = (i >> 3) & 7, qb = i & 7;
      size_t tok = (size_t)NCTX + b * 1024 + qb * 128;
      a.q = QKVG + tok * L0_IN + 1536 + hh * 128;
      a.gate = QKVG + tok * L0_IN + 4608 + 1024 + hh * 128;
      a.out = OG + tok * D + 1024 + hh * 128;
      a.nseg = 2;
      a.seg[0].k = KBC + (size_t)b * 512 * 1024 + hh * 128; a.seg[0].ks = 1024;
      a.seg[0].v = VBC + (size_t)b * 512 * 1024 + hh * 128; a.seg[0].vs = 1024;
      a.seg[0].n = 512;
      int r0 = 2 * qb;
      int rs0 = r0 - 4; rs0 = rs0 < 0 ? 0 : (rs0 > 8 ? 8 : rs0);
      int nrows = 16 - rs0; nrows = nrows > 9 ? 9 : nrows;
      size_t ktok = (size_t)NCTX + b * 1024 + rs0 * 64;
      a.seg[1].k = QKVG + ktok * L0_IN + 2560 + hh * 128; a.seg[1].ks = L0_IN;
      a.seg[1].v = QKVG + ktok * L0_IN + 3584 + hh * 128; a.seg[1].vs = L0_IN;
      a.seg[1].n = nrows * 64;
      a.rpb = p.l0_rpb + hh * 15 * 31;
      a.qtok0 = qb * 128; a.rs0 = rs0;
      attn_block<128, 1>(a, smem);
    } else {
      int i = it - 1024;
      bool isB = i >= 512; i &= 511;
      int b = i >> 4, hh = (i >> 1) & 7, qb = i & 1;
      size_t tok = (size_t)b * 256 + qb * 128;
      size_t ktok = (size_t)b * 256;
      a.nseg = 1; a.seg[0].n = 256; a.seg[0].ks = L0_IN; a.seg[0].vs = L0_IN;
      if (!isB) {
        a.q = QKVG + tok * L0_IN + hh * 128;
        a.gate = QKVG + tok * L0_IN + 4608 + hh * 128;
        a.out = OG + tok * D + hh * 128;
        a.seg[0].k = QKVG + ktok * L0_IN + 1024 + (hh >> 2) * 128;
        a.seg[0].v = QKVG + ktok * L0_IN + 1280 + (hh >> 2) * 128;
      } else {
        a.q = QKVG + tok * L0_IN + 1536 + hh * 128;
        a.gate = QKVG + tok * L0_IN + 4608 + 1024 + hh * 128;
        a.out = OG + tok * D + 1024 + hh * 128;
        a.seg[0].k = QKVG + ktok * L0_IN + 2560 + hh * 128;
        a.seg[0].v = QKVG + ktok * L0_IN + 3584 + hh * 128;
      }
      attn_block<128, 0>(a, smem);
    }
  }
}

DI void phase_attn1(const Params& p, char* smem, int round) {
  const u16* Q1 = (const u16*)(p.ws + OFF_Q1);
  u16* LAT1 = (u16*)(p.ws + OFF_LAT1);
  const float sc = 0.07216878364870322f * LOG2E;
  for (int it = blockIdx.x; it < 1024; it += gridDim.x) {
    AttnArgs a;
    a.qs = 3072; a.gs = L1_IN; a.os = L1_IN; a.scale_log2 = sc; a.rpb = nullptr; a.rs0 = 0; a.ropetab = (const float*)(p.ws + OFF_ROPE);
    a.seg[1].k = nullptr; a.seg[1].v = nullptr; a.seg[1].kr = nullptr; a.seg[1].ks = 0; a.seg[1].vs = 0; a.seg[1].n = 0;
    a.nseg = 1;
    a.seg[0].ks = 4096; a.seg[0].vs = 4096;
    size_t tok;
    int hh;
    if (round == 0) {
      int b = it >> 5, qb = it & 1; hh = (it >> 1) & 15;
      tok = (size_t)b * 256 + qb * 128;
      const u16* KV = (const u16*)(p.ws + OFF_KV_CTX) + (size_t)b * 256 * 4096 + hh * 256;
      a.seg[0].k = KV; a.seg[0].v = KV + 128;
      a.seg[0].kr = (const u16*)(p.ws + OFF_KR_CTX) + (size_t)b * 256 * 64;
      a.seg[0].n = 256;
      a.rope = 0; a.qtok0 = 0;
    } else {
      int b = it >> 7, qb = it & 7; hh = (it >> 3) & 15;
      tok = (size_t)NCTX + b * 1024 + qb * 128;
      const u16* KV = (const u16*)(p.ws + OFF_KV_LAT) + (size_t)b * 1536 * 4096 + hh * 256;
      a.seg[0].k = KV; a.seg[0].v = KV + 128;
      a.seg[0].kr = (const u16*)(p.ws + OFF_KR_ALL) + (size_t)b * 1536 * 64;
      a.seg[0].n = 1536;
      a.rope = 1; a.qtok0 = qb * 128;
    }
    a.q = Q1 + tok * 3072 + hh * 192;
    a.gate = LAT1 + tok * L1_IN + 1088 + hh * 128;
    a.out = LAT1 + tok * L1_IN + 1088 + hh * 128;
    attn_block<192, 2>(a, smem);
  }
}

__global__ void __launch_bounds__(256, 2) fwd_megakernel(Params p) {
  cg::grid_group grid = cg::this_grid();
  __shared__ __attribute__((aligned(16))) char smem[SMEM_BYTES];
  char* ws = p.ws;
  const float* mod0 = (const float*)(ws + OFF_MOD);
  const float* mod1 = mod0 + 9 * 6144;

  phase_prep(p, smem);
  grid.sync();
  phase_normmod(p, 0);
  grid.sync();
  { EpiBf16 e{(u16*)(ws + OFF_BIG), L0_IN, L0_IN};
    gemm_phase((const u16*)(ws + OFF_H), D, (const u16*)(ws + OFF_WT_IN0), 2048, NTOK, L0_IN, smem, e, 0, 0); }
  grid.sync();
  phase_qknorm0(p);
  grid.sync();
  phase_attn0(p, smem);
  grid.sync();
  { EpiResid e{p.x_prompt, p.x_sample, mod0 + 4096, p.out + OUT_Y};
    gemm_phase((const u16*)(ws + OFF_H), D, (const u16*)(ws + OFF_WT_OUT0), 2048, NTOK, D, smem, e, 0, 0); }
  grid.sync();
  phase_normmod(p, 1);
  grid.sync();
  { EpiBf16 e{(u16*)(ws + OFF_LAT1), L1_IN, L1_IN};
    gemm_phase((const u16*)(ws + OFF_H), D, (const u16*)(ws + OFF_WT_IN1), 2048, NTOK, L1_IN, smem, e, 0, 0); }
  grid.sync();
  phase_norm1(p);
  grid.sync();
  { EpiBf16 e{(u16*)(ws + OFF_Q1), 3072, 3072};
    gemm_phase((const u16*)(ws + OFF_QN), 512, (const u16*)(ws + OFF_WT_QB), 512, NTOK, 3072, smem, e, 0, 0); }
  { EpiBf16 e{(u16*)(ws + OFF_KV_CTX), 4096, 4096};
    gemm_phase((const u16*)(ws + OFF_CKV_CTX), 512, (const u16*)(ws + OFF_WT_KVB), 512, NCTX, 4096, smem, e, 0, 0); }
  grid.sync();
  phase_attn1(p, smem, 0);
  grid.sync();
  { EpiBf16 e{(u16*)(ws + OFF_KV_LAT), 4096, 4096};
    gemm_phase((const u16*)(ws + OFF_CKV_ALL), 512, (const u16*)(ws + OFF_WT_KVB), 512, 12288, 4096, smem, e, 0, 0); }
  grid.sync();
  phase_attn1(p, smem, 1);
  grid.sync();
  { EpiResid e{p.out + OUT_Y, p.out + OUT_Y + (size_t)NCTX * D, mod1 + 4096, p.out + OUT_Y};
    gemm_phase((const u16*)(ws + OFF_LAT1) + 1088, L1_IN, (const u16*)(ws + OFF_WT_OUT1), 2048, NTOK, D, smem, e, 0, 0); }
  grid.sync();
  phase_final(p);
}

extern "C" void kernel_launch(void* const* d_in, const int* in_sizes, int n_in, void* d_out, int out_size, void* d_ws,
                              size_t ws_size, hipStream_t stream) {
  (void)in_sizes; (void)n_in; (void)out_size;
  if (ws_size < WS_NEEDED) { fprintf(stderr, "workspace too small: %zu < %zu\n", ws_size, (size_t)WS_NEEDED); return; }
  static int grid_blocks = 0;
  if (!grid_blocks) {
    int dev = 0, cus = 0, per_cu = 0;
    hipGetDevice(&dev);
    hipDeviceGetAttribute(&cus, hipDeviceAttributeMultiprocessorCount, dev);
    hipOccupancyMaxActiveBlocksPerMultiprocessor(&per_cu, fwd_megakernel, 256, 0);
    if (per_cu > 2) per_cu = 2;
    if (per_cu < 1) per_cu = 1;
    grid_blocks = cus * per_cu;
  }
  Params p{};
  const float** pf = (const float**)&p;
  for (int i = 0; i < 28; ++i) pf[i] = (const float*)d_in[i];
  p.out = (float*)d_out;
  p.ws = (char*)d_ws;
  void* args[] = {&p};
  hipError_t e = hipLaunchCooperativeKernel((void*)fwd_megakernel, dim3(grid_blocks), dim3(256), args, 0, stream);
  if (e != hipSuccess) fprintf(stderr, "cooperative launch failed: %s (grid %d)\n", hipGetErrorString(e), grid_blocks);
}
```

```cpp
#include <hip/hip_runtime.h>
#include <hip/hip_cooperative_groups.h>
#include <cstdio>
namespace cg = cooperative_groups;

typedef unsigned short u16;
using bf16x8 = __attribute__((ext_vector_type(8))) short;
using s16x4  = __attribute__((ext_vector_type(4))) short;
using f32x16 = __attribute__((ext_vector_type(16))) float;
using f32x4  = __attribute__((ext_vector_type(4))) float;
using u32x4  = __attribute__((ext_vector_type(4))) unsigned;
typedef __bf16 bf16x2_t __attribute__((ext_vector_type(2)));
typedef float f32x2_t __attribute__((ext_vector_type(2)));
#define DI __device__ __forceinline__
#define MFMA32(a, b, c) __builtin_amdgcn_mfma_f32_32x32x16_bf16((a), (b), (c), 0, 0, 0)
#define LDS_AS(T) __attribute__((address_space(3))) T

constexpr int D = 2048;
constexpr int NTOK = 16384;
constexpr int NCTX = 8192;
constexpr int L0_IN = 6656;
constexpr int L1_IN = 3136;
constexpr int L1_LD = 3328;
constexpr float EPS = 1e-6f;
constexpr float LOG2E = 1.4426950408889634f;
constexpr float LOG2_THETA = 13.287712379549449f;
constexpr int NT = 512;
constexpr int NW = 8;

constexpr size_t OFF_WT_IN1  = 0;
constexpr size_t OFF_WT_QB   = OFF_WT_IN1 + (size_t)3328 * 2048 * 2;
constexpr size_t OFF_WT_KVB  = OFF_WT_QB + (size_t)3072 * 512 * 2;
constexpr size_t OFF_WT_OUT1 = OFF_WT_KVB + (size_t)4096 * 512 * 2;
constexpr size_t OFF_WL0     = OFF_WT_OUT1 + (size_t)2048 * 2048 * 2;
constexpr size_t OFF_WT_IN0  = OFF_WL0;
constexpr size_t OFF_WT_OUT0 = OFF_WT_IN0 + (size_t)6656 * 2048 * 2;
constexpr size_t OFF_H       = OFF_WT_OUT0 + (size_t)2048 * 2048 * 2;
constexpr size_t OFF_BIG     = OFF_H + (size_t)NTOK * 2048 * 2;
constexpr size_t OFF_C       = OFF_BIG + (size_t)NTOK * 6656 * 2;
constexpr size_t OFF_KA_ALL  = OFF_C;
constexpr size_t OFF_VA_ALL  = OFF_KA_ALL + (size_t)8 * 1536 * 256 * 2;
constexpr size_t OFF_KB_CTX  = OFF_VA_ALL + (size_t)8 * 1536 * 256 * 2;
constexpr size_t OFF_VB_CTX  = OFF_KB_CTX + (size_t)8 * 512 * 1024 * 2;
constexpr size_t OFF_CKV_ALL = OFF_VB_CTX + (size_t)8 * 512 * 1024 * 2;
constexpr size_t OFF_KR_ALL  = OFF_CKV_ALL + (size_t)8 * 1536 * 512 * 2;
constexpr size_t OFF_MOD     = OFF_KR_ALL + (size_t)8 * 1536 * 64 * 2;
constexpr size_t OFF_ROPE    = OFF_MOD + (size_t)2 * 9 * 6144 * 4;
constexpr size_t WS_NEEDED   = OFF_ROPE + (size_t)64 * 16 * 2 * 4;
constexpr size_t OFF_QN      = OFF_WL0;
constexpr size_t OFF_CKV_CTX = OFF_QN + (size_t)NTOK * 512 * 2;
constexpr size_t OFF_KR_CTX  = OFF_CKV_CTX + (size_t)NCTX * 512 * 2;
constexpr size_t OFF_KV_CTX  = OFF_H;
constexpr size_t OFF_KV_LAT  = OFF_WL0;
constexpr size_t OFF_LAT1    = OFF_BIG;
constexpr size_t OFF_Q1      = OFF_BIG + (size_t)NTOK * L1_LD * 2;
static_assert(OFF_KR_CTX + (size_t)NCTX * 64 * 2 <= OFF_WT_OUT0, "l1 small bufs overflow");
static_assert(OFF_KV_LAT + (size_t)12288 * 4096 * 2 <= OFF_BIG, "kv_lat overflow");
static_assert(OFF_Q1 + (size_t)NTOK * 3072 * 2 <= OFF_C, "q1 overflow");

constexpr size_t OUT_Y   = 0;
constexpr size_t OUT_NAK = (size_t)NTOK * 2048;
constexpr size_t OUT_NAV = OUT_NAK + (size_t)NCTX * 256;
constexpr size_t OUT_NBK = OUT_NAV + (size_t)NCTX * 256;
constexpr size_t OUT_NBV = OUT_NBK + (size_t)NCTX * 1024;
constexpr size_t OUT_NCKV = OUT_NBV + (size_t)NCTX * 1024;
constexpr size_t OUT_NKR = OUT_NCKV + (size_t)NCTX * 512;

constexpr int SMEM_BYTES = 128 * 1024;

struct Params {
  const float *x_prompt, *x_sample, *ca_k, *ca_v, *cb_k, *cb_v, *c_ckv, *c_kr, *c, *c_ctx;
  const float *l0_norm, *l0_ada_w, *l0_ada_b, *l0_w_in, *l0_qn, *l0_kn, *l0_rpb, *l0_w_out;
  const float *l1_norm, *l1_ada_w, *l1_ada_b, *l1_w_in, *l1_qan, *l1_wqb, *l1_kvan, *l1_wkvb, *l1_w_out, *fnorm;
  float* out;
  char* ws;
};

DI int threadIdx_x_raw() { return (int)__builtin_amdgcn_workitem_id_x(); }
DI u16 f2bf(float x) { unsigned u = __float_as_uint(x); u += 0x7fffu + ((u >> 16) & 1u); return (u16)(u >> 16); }
DI float bf2f(u16 v) { return __uint_as_float(((unsigned)v) << 16); }
DI unsigned pack2(float a, float b) { f32x2_t f = {a, b}; bf16x2_t r = __builtin_convertvector(f, bf16x2_t); return __builtin_bit_cast(unsigned, r); }
DI float bflo(unsigned u) { return __uint_as_float(u << 16); }
DI float bfhi(unsigned u) { return __uint_as_float(u & 0xffff0000u); }
DI float wave_sum(float v) {
#pragma unroll
  for (int o = 32; o >= 1; o >>= 1) v += __shfl_xor(v, o);
  return v;
}
DI int TID() { int t = threadIdx_x_raw(); asm volatile("" : "+v"(t)); return t; }
DI int crow(int i, int h) { return (i & 3) + 8 * (i >> 2) + 4 * h; }
DI float silu(float x) { return x / (1.f + __expf(-x)); }
DI int tok_modrow(int tok) { return tok < NCTX ? 0 : 1 + ((tok - NCTX) >> 10); }

DI void transpose_tile(const float* __restrict__ src, int K, int N, u16* __restrict__ dst, int kt, int nt, float* sm) {
  const int t = TID();
#pragma unroll
  for (int i = 0; i < 2; ++i) {
    int id = t + NT * i, r = id >> 4, c4 = id & 15;
    float4 v = *(const float4*)(src + (size_t)(kt * 64 + r) * N + nt * 64 + c4 * 4);
    float* d = sm + r * 65 + c4 * 4;
    d[0] = v.x; d[1] = v.y; d[2] = v.z; d[3] = v.w;
  }
  __syncthreads();
  {
    int n = t >> 3, kq = t & 7;
    u32x4 o;
#pragma unroll
    for (int j = 0; j < 4; ++j) o[j] = pack2(sm[(kq * 8 + 2 * j) * 65 + n], sm[(kq * 8 + 2 * j + 1) * 65 + n]);
    *(u32x4*)(dst + (size_t)(nt * 64 + n) * K + kt * 64 + kq * 8) = o;
  }
  __syncthreads();
}

DI void adaln_item(const Params& p, int l, int chunk, float* sm) {
  const float* W = l ? p.l1_ada_w : p.l0_ada_w;
  const float* bias = l ? p.l1_ada_b : p.l0_ada_b;
  float* mod = (float*)(p.ws + OFF_MOD) + (size_t)l * 9 * 6144;
  const int t = TID(), col = chunk * 64 + (t & 63), kg = t >> 6;
  float acc[9];
#pragma unroll
  for (int r = 0; r < 9; ++r) acc[r] = 0.f;
  for (int kh = 0; kh < 2; ++kh) {
    __syncthreads();
    for (int e = t; e < 9 * 1024; e += NT) {
      int r = e >> 10, k = e & 1023;
      float cv = (r == 0) ? p.c_ctx[kh * 1024 + k] : p.c[(r - 1) * 2048 + kh * 1024 + k];
      sm[r * 1024 + k] = silu(cv);
    }
    __syncthreads();
    const float* wp = W + (size_t)(kh * 1024 + kg * 128) * 6144 + col;
    const float* sp = sm + kg * 128;
#pragma unroll 8
    for (int k = 0; k < 128; ++k) {
      float w = wp[(size_t)k * 6144];
#pragma unroll
      for (int r = 0; r < 9; ++r) acc[r] += sp[r * 1024 + k] * w;
    }
  }
  __syncthreads();
#pragma unroll
  for (int r = 0; r < 9; ++r) sm[(kg * 9 + r) * 64 + (t & 63)] = acc[r];
  __syncthreads();
  for (int e = t; e < 9 * 64; e += NT) {
    int r = e >> 6, cc = e & 63;
    float s = 0.f;
#pragma unroll
    for (int g = 0; g < NW; ++g) s += sm[(g * 9 + r) * 64 + cc];
    mod[(size_t)r * 6144 + chunk * 64 + cc] = s + bias[chunk * 64 + cc];
  }
  __syncthreads();
}

DI void convert_item(const float* __restrict__ src, u16* __restrict__ dst, int W, int dstT, int item) {
  size_t e = (size_t)item * 4096 + TID() * 8;
  size_t per_b = (size_t)512 * W;
  size_t b = e / per_b, r = e % per_b;
  float4 v0 = *(const float4*)(src + e), v1 = *(const float4*)(src + e + 4);
  u32x4 o = {pack2(v0.x, v0.y), pack2(v0.z, v0.w), pack2(v1.x, v1.y), pack2(v1.z, v1.w)};
  *(u32x4*)(dst + b * (size_t)dstT * W + r) = o;
}

DI void phase_prep(const Params& p, char* smem) {
  float* sm = (float*)smem;
  char* ws = p.ws;
  constexpr int N_ADA = 192;
  constexpr int T_IN0 = 32 * 104, T_OUT0 = 32 * 32, T_IN1 = 32 * 49, T_QB = 8 * 48, T_KVB = 8 * 64, T_OUT1 = 32 * 32;
  constexpr int C_A = 256, C_B = 1024, C_CKV = 512, C_KR = 64;
  constexpr int B1 = N_ADA, B2 = B1 + T_IN0, B3 = B2 + T_OUT0, B4 = B3 + T_IN1, B5 = B4 + T_QB, B6 = B5 + T_KVB, B7 = B6 + T_OUT1;
  constexpr int B8 = B7 + C_A, B9 = B8 + C_A, B10 = B9 + C_B, B11 = B10 + C_B, B12 = B11 + C_CKV, B13 = B12 + C_KR;
  if (blockIdx.x == gridDim.x - 1) {
    float* tab = (float*)(ws + OFF_ROPE);
    for (int e = TID(); e < 64 * 16; e += NT) {
      int pos = e >> 4, i = e & 15;
      float inv = exp2f(-(float)i * (LOG2_THETA / 16.f));
      float sn, cs; sincosf((float)pos * inv, &sn, &cs);
      tab[2 * e] = cs; tab[2 * e + 1] = sn;
    }
  }
  for (int it = blockIdx.x; it < B13; it += gridDim.x) {
    if (it < B1) adaln_item(p, it / 96, it % 96, sm);
    else if (it < B2) { int i = it - B1; transpose_tile(p.l0_w_in, 2048, 6656, (u16*)(ws + OFF_WT_IN0), i / 104, i % 104, sm); }
    else if (it < B3) { int i = it - B2; transpose_tile(p.l0_w_out, 2048, 2048, (u16*)(ws + OFF_WT_OUT0), i / 32, i % 32, sm); }
    else if (it < B4) { int i = it - B3; transpose_tile(p.l1_w_in, 2048, 3136, (u16*)(ws + OFF_WT_IN1), i / 49, i % 49, sm); }
    else if (it < B5) { int i = it - B4; transpose_tile(p.l1_wqb, 512, 3072, (u16*)(ws + OFF_WT_QB), i / 48, i % 48, sm); }
    else if (it < B6) { int i = it - B5; transpose_tile(p.l1_wkvb, 512, 4096, (u16*)(ws + OFF_WT_KVB), i / 64, i % 64, sm); }
    else if (it < B7) { int i = it - B6; transpose_tile(p.l1_w_out, 2048, 2048, (u16*)(ws + OFF_WT_OUT1), i / 32, i % 32, sm); }
    else if (it < B8) convert_item(p.ca_k, (u16*)(ws + OFF_KA_ALL), 256, 1536, it - B7);
    else if (it < B9) convert_item(p.ca_v, (u16*)(ws + OFF_VA_ALL), 256, 1536, it - B8);
    else if (it < B10) convert_item(p.cb_k, (u16*)(ws + OFF_KB_CTX), 1024, 512, it - B9);
    else if (it < B11) convert_item(p.cb_v, (u16*)(ws + OFF_VB_CTX), 1024, 512, it - B10);
    else if (it < B12) convert_item(p.c_ckv, (u16*)(ws + OFF_CKV_ALL), 512, 1536, it - B11);
    else convert_item(p.c_kr, (u16*)(ws + OFF_KR_ALL), 64, 1536, it - B12);
  }
}

DI void phase_normmod(const Params& p, int layer) {
  const int wave = TID() >> 6, lane = TID() & 63;
  const float* g = layer ? p.l1_norm : p.l0_norm;
  const float* mod = (const float*)(p.ws + OFF_MOD) + (size_t)layer * 9 * 6144;
  u16* H = (u16*)(p.ws + OFF_H);
  for (int it = blockIdx.x; it < NTOK / NW; it += gridDim.x) {
    int row = it * NW + wave;
    const float* src;
    if (layer == 0) src = row < NCTX ? p.x_prompt + (size_t)row * D : p.x_sample + (size_t)(row - NCTX) * D;
    else src = p.out + OUT_Y + (size_t)row * D;
    const float* mr = mod + (size_t)tok_modrow(row) * 6144;
    float4 v[8];
    float ss = 0.f;
#pragma unroll
    for (int i = 0; i < 8; ++i) {
      v[i] = *(const float4*)(src + (i * 64 + lane) * 4);
      ss += v[i].x * v[i].x + v[i].y * v[i].y + v[i].z * v[i].z + v[i].w * v[i].w;
    }
    ss = wave_sum(ss);
    float rinv = rsqrtf(ss * (1.f / D) + EPS);
#pragma unroll
    for (int i = 0; i < 8; ++i) {
      int col = (i * 64 + lane) * 4;
      float4 gg = *(const float4*)(g + col);
      float4 sh = *(const float4*)(mr + col);
      float4 sc = *(const float4*)(mr + 2048 + col);
      float h0 = v[i].x * rinv * gg.x * (1.f + sc.x) + sh.x;
      float h1 = v[i].y * rinv * gg.y * (1.f + sc.y) + sh.y;
      float h2 = v[i].z * rinv * gg.z * (1.f + sc.z) + sh.z;
      float h3 = v[i].w * rinv * gg.w * (1.f + sc.w) + sh.w;
      *(uint2*)(H + (size_t)row * D + col) = make_uint2(pack2(h0, h1), pack2(h2, h3));
    }
  }
}

namespace pg8 {
#define PG8_LAS __attribute__((address_space(3)))
typedef unsigned short bf16_t;
typedef short bf16x8 __attribute__((ext_vector_type(8)));
typedef float f32x4 __attribute__((ext_vector_type(4)));
typedef unsigned u32x4 __attribute__((ext_vector_type(4)));
constexpr int BM = 256, BK = 64, HALF = 128, HTB = HALF * BK * 2  , STAGE_BYTES = 8 * HTB, NXCD = 8, WGM = 8;

__host__ __device__ __forceinline__ int lds_byte(int r, int c) { const int st = (r >> 4) * 2 + (c >> 5), rr = r & 15, cc = c & 31, ob = rr * 64 + cc * 2; return st * 1024 + (ob ^ (((ob >> 9) & 1) << 5)); }
__host__ __device__ __forceinline__ void stage_rc(int b, int& R, int& C) { const int st = b / 1024, sb = b % 1024, swz = sb ^ (((sb >> 9) & 1) << 5); R = (st >> 1) * 16 + swz / 64; C = (st & 1) * 32 + (swz % 64) / 2; }
__host__ __device__ __forceinline__ int perm32(int rho) { const int n = rho >> 4, i = rho & 15; return 8 * (i >> 2) + 4 * n + (i & 3); }

struct Unit { int pm, pn; };
struct Gemm { const bf16_t* A; const bf16_t* Bt; int M, N, K, lda; };
struct StaticOrder {
    int nM, nN, nwg, G, c;
    __host__ __device__ void init(int M, int N, int G_, int c_) { nM = M / BM; nN = N / BM; nwg = nM * nN; G = G_; c = c_; }
    __host__ __device__ bool next(int i, Unit& u) const {
        const long L = (long)i * G + c; if (L >= nwg) return false;
        int wgid = (int)L; { const int q = nwg / NXCD, r = nwg % NXCD, xcd = wgid % NXCD, off = wgid / NXCD; wgid = (xcd < r ? xcd * (q + 1) : r * (q + 1) + (xcd - r) * q) + off; }
        const int nig = WGM * nN, gid = wgid / nig, fm = gid * WGM, gsz = (nM - fm) < WGM ? (nM - fm) : WGM;
        u.pm = fm + ((wgid % nig) % gsz); u.pn = (wgid % nig) / gsz; return true;
    }
    __device__ __forceinline__ void a_ready(const Unit&) const {}
    __device__ __forceinline__ void done(const Unit&) const {}
};
template <class Epi, class Sched, bool STAMP = false>
__device__ __forceinline__ void gemm_phase(PG8_LAS unsigned char* lds, const Gemm g, const Sched& S, const Epi& E, unsigned long long* stamps) {
    const int tid = TID(), wid = __builtin_amdgcn_readfirstlane(tid >> 6), lane = tid & 63, wr = wid >> 2, wc = wid & 3, fr = lane & 15, fq = lane >> 4;
    const int K = g.K, nt = K / BK;
    int ts_lo = 0, ts_hi = 0, nts = 0; const unsigned long long rt_entry = STAMP ? (unsigned long long)wall_clock64() : 0ull;
#define PG8_STAMP() do { if (STAMP && wid == 0 && nts < 64) { const unsigned long long _c = (unsigned long long)clock64(); \
        ts_lo = (lane == nts) ? (int)(unsigned)_c : ts_lo; ts_hi = (lane == nts) ? (int)(unsigned)(_c >> 32) : ts_hi; ++nts; } } while (0)
    PG8_STAMP();
    unsigned voffA[2], voffB[2];
#pragma unroll
    for (int i = 0; i < 2; ++i) { int R, C; stage_rc(tid * 16 + i * 8192, R, C); const int Rb = Epi::PERM ? ((R & ~31) + perm32(R & 31)) : R;
        voffA[i] = (unsigned)(R * g.lda + C) * 2u; voffB[i] = (unsigned)(Rb * K + C) * 2u; }
    const size_t kstep = (size_t)(BK * 2);
    const size_t hstepB = (size_t)HALF * K * 2, hstepA = (size_t)HALF * g.lda * 2;
    const size_t tstepB = 2 * hstepB, tstepA = 2 * hstepA;
    const unsigned ldsw = (unsigned)wid * 1024u;
    const int aoff = lds_byte(wr * 64 + fr, fq * 8), boff = lds_byte(wc * 32 + fr, fq * 8);
#define PG8_SA(b, h) (((b) * 2 + (h)) * HTB)
#define PG8_SB(b, h) ((4 + (b) * 2 + (h)) * HTB)
#define PG8_STAGE(bufoff, gbase, voff) do { _Pragma("unroll") for (int _i = 0; _i < 2; ++_i) \
        __builtin_amdgcn_global_load_lds((const unsigned*)((const char*)(gbase) + (voff)[_i]), (PG8_LAS unsigned*)(lds + (bufoff) + ldsw + _i * 8192), 16, 0, 0); } while (0)
#define PG8_LDA(dst, b, h) do { _Pragma("unroll") for (int m = 0; m < 4; ++m) _Pragma("unroll") for (int k = 0; k < 2; ++k) dst[m][k] = *(const PG8_LAS bf16x8*)(lds + PG8_SA(b, h) + aoff + m * 2048 + k * 1024); } while (0)
#define PG8_LDB(dst, b, h) do { _Pragma("unroll") for (int n = 0; n < 2; ++n) _Pragma("unroll") for (int k = 0; k < 2; ++k) dst[n][k] = *(const PG8_LAS bf16x8*)(lds + PG8_SB(b, h) + boff + n * 2048 + k * 1024); } while (0)
#define PG8_MMA(ai, bj, At, Bt) do { __builtin_amdgcn_s_setprio(1); _Pragma("unroll") for (int m = 0; m < 4; ++m) _Pragma("unroll") for (int n = 0; n < 2; ++n) _Pragma("unroll") for (int k = 0; k < 2; ++k) \
        acc[ai][bj][m][n] = __builtin_amdgcn_mfma_f32_16x16x32_bf16(Bt[n][k], At[m][k], acc[ai][bj][m][n], 0, 0, 0); __builtin_amdgcn_s_setprio(0); } while (0)
#define PG8_WAIT_V(n) asm volatile("s_waitcnt vmcnt(" #n ")" ::: "memory")
#define PG8_WAIT_L(n) asm volatile("s_waitcnt lgkmcnt(" #n ")" ::: "memory")
#define PG8_BAR __builtin_amdgcn_s_barrier()
#define PG8_SCHED __builtin_amdgcn_sched_barrier(0)
    Unit cur, nxt; int ui = 0;
    if (!S.next(0, cur)) return;
    f32x4 acc[2][2][4][2];
#pragma unroll
    for (int a = 0; a < 2; ++a)
#pragma unroll
        for (int b = 0; b < 2; ++b)
#pragma unroll
            for (int m = 0; m < 4; ++m)
#pragma unroll
                for (int n = 0; n < 2; ++n) acc[a][b][m][n] = (f32x4){0.f, 0.f, 0.f, 0.f};
    bf16x8 At[4][2], B0[2][2], B1[2][2];
    const char* cA = (const char*)g.A + (size_t)cur.pm * tstepA; const char* cB = (const char*)g.Bt + (size_t)cur.pn * tstepB;
    S.a_ready(cur);
    PG8_STAGE(PG8_SB(0, 0), cB, voffB); PG8_STAGE(PG8_SA(0, 0), cA, voffA); PG8_STAGE(PG8_SB(0, 1), cB + hstepB, voffB); PG8_STAGE(PG8_SA(0, 1), cA + hstepA, voffA);
    if (wr == 1) PG8_BAR;
    PG8_WAIT_V(4); PG8_BAR;
    PG8_STAGE(PG8_SB(1, 0), cB + kstep, voffB); PG8_STAGE(PG8_SA(1, 0), cA + kstep, voffA); PG8_STAGE(PG8_SB(1, 1), cB + hstepB + kstep, voffB);
    PG8_WAIT_V(6); PG8_BAR;
    PG8_STAMP();
    for (;;) {
        const bool has_next = S.next(ui + 1, nxt);
        const char* nA = has_next ? (const char*)g.A + (size_t)nxt.pm * tstepA : cA; const char* nB = has_next ? (const char*)g.Bt + (size_t)nxt.pn * tstepB : cB;
        for (int t = 0; t < nt; t += 2) {
            const bool last = (t == nt - 2);
            const char* a1 = cA + (size_t)(t + 1) * kstep;
            const char* a2 = last ? nA : cA + (size_t)(t + 2) * kstep; const char* b2 = last ? nB : cB + (size_t)(t + 2) * kstep;
            const char* a3 = a2 + kstep; const char* b3 = b2 + kstep;
            if (last && has_next) S.a_ready(nxt);
            PG8_LDB(B0, 0, 0); PG8_SCHED; PG8_LDA(At, 0, 0); PG8_STAGE(PG8_SA(1, 1), a1 + hstepA, voffA);
            PG8_WAIT_L(8); PG8_BAR; PG8_WAIT_L(0); PG8_MMA(0, 0, At, B0); PG8_BAR; PG8_SCHED;
            PG8_LDB(B1, 0, 1); PG8_STAGE(PG8_SB(0, 0), b2, voffB);
            PG8_BAR; PG8_WAIT_L(0); PG8_MMA(0, 1, At, B1); PG8_BAR;
            PG8_LDA(At, 0, 1); PG8_STAGE(PG8_SA(0, 0), a2, voffA);
            PG8_BAR; PG8_WAIT_L(0); PG8_MMA(1, 0, At, B0); PG8_BAR; PG8_SCHED;
            PG8_STAGE(PG8_SB(0, 1), b2 + hstepB, voffB);
            PG8_WAIT_V(6); PG8_BAR; PG8_MMA(1, 1, At, B1); PG8_BAR;
            PG8_LDB(B0, 1, 0); PG8_SCHED; PG8_LDA(At, 1, 0); PG8_STAGE(PG8_SA(0, 1), a2 + hstepA, voffA);
            PG8_WAIT_L(8); PG8_BAR; PG8_WAIT_L(0); PG8_MMA(0, 0, At, B0); PG8_BAR; PG8_SCHED;
            PG8_LDB(B1, 1, 1); PG8_STAGE(PG8_SB(1, 0), b3, voffB);
            PG8_BAR; PG8_WAIT_L(0); PG8_MMA(0, 1, At, B1); PG8_BAR;
            PG8_LDA(At, 1, 1); PG8_STAGE(PG8_SA(1, 0), a3, voffA);
            PG8_BAR; PG8_WAIT_L(0); PG8_MMA(1, 0, At, B0); PG8_BAR; PG8_SCHED;
            PG8_STAGE(PG8_SB(1, 1), b3 + hstepB, voffB);
            PG8_WAIT_V(6); PG8_BAR; PG8_MMA(1, 1, At, B1); PG8_BAR;
        }
        PG8_STAMP();
        if constexpr (!Epi::AFTER_DRAIN) { E(acc, cur, wr, wc, fr, fq); S.done(cur); }
        PG8_STAMP();
        if (!has_next) break;
#pragma unroll
        for (int a = 0; a < 2; ++a)
#pragma unroll
            for (int b = 0; b < 2; ++b)
#pragma unroll
                for (int m = 0; m < 4; ++m)
#pragma unroll
                    for (int n = 0; n < 2; ++n) acc[a][b][m][n] = (f32x4){0.f, 0.f, 0.f, 0.f};
        cur = nxt; cA = nA; cB = nB; ++ui;
    }
    PG8_WAIT_V(0);
    if (wr == 0) PG8_BAR;
    PG8_BAR;
    if constexpr (Epi::AFTER_DRAIN) { E.fused(acc, cur, wr, wc, fr, fq, lds, wid, lane); S.done(cur); }
    PG8_STAMP();
    if (STAMP && wid == 0) { stamps[lane] = lane < nts ? (((unsigned long long)(unsigned)ts_hi << 32) | (unsigned)ts_lo) : 0ull;
        if (lane == 62) stamps[62] = rt_entry; if (lane == 63) stamps[63] = (unsigned long long)wall_clock64(); }
#undef PG8_STAMP
#undef PG8_SA
#undef PG8_SB
#undef PG8_STAGE
#undef PG8_LDA
#undef PG8_LDB
#undef PG8_MMA
#undef PG8_WAIT_V
#undef PG8_WAIT_L
#undef PG8_BAR
#undef PG8_SCHED
}
}


struct EpiBf16 {
  static constexpr bool PERM = true, AFTER_DRAIN = false;
  u16* O; int ldc;
  DI void operator()(const f32x4 (&acc)[2][2][4][2], const pg8::Unit& u, int wr, int wc, int fr, int fq) const {
    const int row0 = u.pm * 256 + wr * 64 + fr, col0 = u.pn * 256 + wc * 32 + 8 * fq;
#pragma unroll
    for (int ai = 0; ai < 2; ++ai)
#pragma unroll
      for (int m = 0; m < 4; ++m) {
        u16* rowp = O + (size_t)(row0 + ai * 128 + m * 16) * ldc + col0;
#pragma unroll
        for (int bj = 0; bj < 2; ++bj) {
          f32x4 v0 = acc[ai][bj][m][0], v1 = acc[ai][bj][m][1];
          u32x4 w = {pack2(v0[0], v0[1]), pack2(v0[2], v0[3]), pack2(v1[0], v1[1]), pack2(v1[2], v1[3])};
          *(u32x4*)(rowp + bj * 128) = w;
        }
      }
  }
};
struct EpiResid {
  static constexpr bool PERM = false, AFTER_DRAIN = false;
  const float* xa; const float* xb; const float* gate; float* out;
  DI void operator()(const f32x4 (&acc)[2][2][4][2], const pg8::Unit& u, int wr, int wc, int fr, int fq) const {
    const int row0 = u.pm * 256 + wr * 64 + fr, col0 = u.pn * 256 + wc * 32 + 4 * fq;
#pragma unroll
    for (int ai = 0; ai < 2; ++ai)
#pragma unroll
      for (int m = 0; m < 4; ++m) {
        const int row = row0 + ai * 128 + m * 16;
        const float* xr = (row < NCTX) ? xa + (size_t)row * D : xb + (size_t)(row - NCTX) * D;
        const float* gr = gate + (size_t)tok_modrow(row) * 6144;
        float* orow = out + (size_t)row * D;
#pragma unroll
        for (int bj = 0; bj < 2; ++bj)
#pragma unroll
          for (int n = 0; n < 2; ++n) {
            const int col = col0 + bj * 128 + n * 16;
            f32x4 xv = *(const f32x4*)(xr + col);
            f32x4 gv = *(const f32x4*)(gr + col);
            *(f32x4*)(orow + col) = xv + gv * acc[ai][bj][m][n];
          }
      }
  }
};

template <class Epi>
DI void gemm_run(PG8_LAS unsigned char* lds, const u16* A, int lda, const u16* Bt, int M, int N, int K, const Epi& e) {
  pg8::Gemm g{A, Bt, M, N, K, lda};
  pg8::StaticOrder S; S.init(M, N, (int)gridDim.x, (int)blockIdx.x);
  __syncthreads();
  pg8::gemm_phase<Epi, pg8::StaticOrder, false>(lds, g, S, e, nullptr);
  __syncthreads();
}

DI void phase_qknorm0(const Params& p) {
  const int wave = TID() >> 6, lane = TID() & 63;
  u16* QKVG = (u16*)(p.ws + OFF_BIG);
  u16* KA = (u16*)(p.ws + OFF_KA_ALL);
  u16* VA = (u16*)(p.ws + OFF_VA_ALL);
  const int i = lane & 31, half = lane >> 5, d1 = half * 64 + i, d2 = d1 + 32;
  const float inv = exp2f(-(float)i * (LOG2_THETA / 32.f));
  const float gq1 = p.l0_qn[d1], gq2 = p.l0_qn[d2], gk1 = p.l0_kn[d1], gk2 = p.l0_kn[d2];
  for (int it = blockIdx.x; it < NTOK / NW; it += gridDim.x) {
    int tk = it * NW + wave;
    u16* base = QKVG + (size_t)tk * L0_IN;
    const bool lat = tk >= NCTX;
    int lt = tk - NCTX, b = lt >> 10, tt = lt & 1023;
    float sn = 0.f, cs = 1.f;
    if (lat) { float pos = half ? (float)(tt & 63) : (float)(tt >> 6); sincosf(pos * inv, &sn, &cs); }
#pragma unroll 1
    for (int hs = 0; hs < 10; ++hs) {
      int col0 = hs < 8 ? hs * 128 : 1024 + (hs - 8) * 128;
      float x1 = bf2f(base[col0 + d1]), x2 = bf2f(base[col0 + d2]);
      float ss = wave_sum(x1 * x1 + x2 * x2);
      float rinv = rsqrtf(ss * (1.f / 128.f) + EPS);
      float y1 = x1 * rinv * (hs < 8 ? gq1 : gk1), y2 = x2 * rinv * (hs < 8 ? gq2 : gk2);
      float o1 = y1 * cs - y2 * sn, o2 = y2 * cs + y1 * sn;
      if (hs < 8) { base[col0 + d1] = f2bf(o1); base[col0 + d2] = f2bf(o2); }
      else {
        int gh = hs - 8;
        if (!lat) {
          base[col0 + d1] = f2bf(o1); base[col0 + d2] = f2bf(o2);
          float* o = p.out + OUT_NAK + (size_t)tk * 256 + gh * 128;
          o[d1] = o1; o[d2] = o2;
        } else {
          u16* o = KA + ((size_t)b * 1536 + 512 + tt) * 256 + gh * 128;
          o[d1] = f2bf(o1); o[d2] = f2bf(o2);
        }
      }
    }
    {
      uint2 v = *(const uint2*)(base + 1280 + lane * 4);
      if (!lat) {
        *(float4*)(p.out + OUT_NAV + (size_t)tk * 256 + lane * 4) = make_float4(bflo(v.x), bfhi(v.x), bflo(v.y), bfhi(v.y));
      } else {
        *(uint2*)(VA + ((size_t)b * 1536 + 512 + tt) * 256 + lane * 4) = v;
      }
    }
    if (!lat) {
#pragma unroll
      for (int kv = 0; kv < 2; ++kv) {
        const u16* s = base + (kv ? 3584 : 2560);
        float* o = p.out + (kv ? OUT_NBV : OUT_NBK) + (size_t)tk * 1024;
#pragma unroll
        for (int q = 0; q < 2; ++q) {
          uint4 v = *(const uint4*)(s + (q * 64 + lane) * 8);
          *(float4*)(o + (q * 64 + lane) * 8) = make_float4(bflo(v.x), bfhi(v.x), bflo(v.y), bfhi(v.y));
          *(float4*)(o + (q * 64 + lane) * 8 + 4) = make_float4(bflo(v.z), bfhi(v.z), bflo(v.w), bfhi(v.w));
        }
      }
    }
  }
}

DI void phase_norm1(const Params& p) {
  const int wave = TID() >> 6, lane = TID() & 63;
  const u16* LAT1 = (const u16*)(p.ws + OFF_LAT1);
  u16* QN = (u16*)(p.ws + OFF_QN);
  u16* CKVC = (u16*)(p.ws + OFF_CKV_CTX);
  u16* KRC = (u16*)(p.ws + OFF_KR_CTX);
  u16* CKVA = (u16*)(p.ws + OFF_CKV_ALL);
  u16* KRA = (u16*)(p.ws + OFF_KR_ALL);
  float gq[8], gk[8];
#pragma unroll
  for (int j = 0; j < 8; ++j) { gq[j] = p.l1_qan[lane * 8 + j]; gk[j] = p.l1_kvan[lane * 8 + j]; }
  const int ri = lane & 15, rhalf = (lane >> 4) & 1;
  const int rd1 = rhalf * 32 + ri, rd2 = rd1 + 16;
  const float inv = exp2f(-(float)ri * (LOG2_THETA / 16.f));
  for (int it = blockIdx.x; it < NTOK / NW; it += gridDim.x) {
    int tk = it * NW + wave;
    const u16* base = LAT1 + (size_t)tk * L1_LD;
    const bool lat = tk >= NCTX;
    int lt = tk - NCTX, b = lt >> 10, tt = lt & 1023;
    size_t arow = (size_t)b * 1536 + 512 + tt;
#pragma unroll
    for (int part = 0; part < 2; ++part) {
      uint4 v = *(const uint4*)(base + part * 512 + lane * 8);
      float x[8] = {bflo(v.x), bfhi(v.x), bflo(v.y), bfhi(v.y), bflo(v.z), bfhi(v.z), bflo(v.w), bfhi(v.w)};
      float ss = 0.f;
#pragma unroll
      for (int j = 0; j < 8; ++j) ss += x[j] * x[j];
      ss = wave_sum(ss);
      float rinv = rsqrtf(ss * (1.f / 512.f) + EPS);
#pragma unroll
      for (int j = 0; j < 8; ++j) x[j] = x[j] * rinv * (part ? gk[j] : gq[j]);
      uint4 o = make_uint4(pack2(x[0], x[1]), pack2(x[2], x[3]), pack2(x[4], x[5]), pack2(x[6], x[7]));
      if (part == 0) *(uint4*)(QN + (size_t)tk * 512 + lane * 8) = o;
      else if (!lat) {
        *(uint4*)(CKVC + (size_t)tk * 512 + lane * 8) = o;
        float* op = p.out + OUT_NCKV + (size_t)tk * 512 + lane * 8;
        *(float4*)op = make_float4(x[0], x[1], x[2], x[3]);
        *(float4*)(op + 4) = make_float4(x[4], x[5], x[6], x[7]);
      } else *(uint4*)(CKVA + arow * 512 + lane * 8) = o;
    }
    if (lane < 32) {
      float x1 = bf2f(base[1024 + rd1]), x2 = bf2f(base[1024 + rd2]);
      if (!lat) {
        KRC[(size_t)tk * 64 + rd1] = f2bf(x1); KRC[(size_t)tk * 64 + rd2] = f2bf(x2);
        p.out[OUT_NKR + (size_t)tk * 64 + rd1] = x1; p.out[OUT_NKR + (size_t)tk * 64 + rd2] = x2;
      } else {
        float pos = rhalf ? (float)(tt & 63) : (float)(tt >> 6);
        float sn, cs; sincosf(pos * inv, &sn, &cs);
        KRA[arow * 64 + rd1] = f2bf(x1 * cs - x2 * sn);
        KRA[arow * 64 + rd2] = f2bf(x2 * cs + x1 * sn);
      }
    }
  }
}

DI void phase_final(const Params& p) {
  const int wave = TID() >> 6, lane = TID() & 63;
  for (int it = blockIdx.x; it < NTOK / NW; it += gridDim.x) {
    int row = it * NW + wave;
    float* y = p.out + OUT_Y + (size_t)row * D;
    float4 v[8];
    float ss = 0.f;
#pragma unroll
    for (int i = 0; i < 8; ++i) {
      v[i] = *(const float4*)(y + (i * 64 + lane) * 4);
      ss += v[i].x * v[i].x + v[i].y * v[i].y + v[i].z * v[i].z + v[i].w * v[i].w;
    }
    ss = wave_sum(ss);
    float rinv = rsqrtf(ss * (1.f / D) + EPS);
#pragma unroll
    for (int i = 0; i < 8; ++i) {
      int col = (i * 64 + lane) * 4;
      float4 gg = *(const float4*)(p.fnorm + col);
      *(float4*)(y + col) = make_float4(v[i].x * rinv * gg.x, v[i].y * rinv * gg.y, v[i].z * rinv * gg.z, v[i].w * rinv * gg.w);
    }
  }
}

struct KVSeg { const u16* k; const u16* v; const u16* kr; int ks, vs, n; };
struct AttnArgs {
  const u16* q; int qs;
  KVSeg seg[2]; int nseg;
  const u16* gate; int gs;
  u16* out; int os;
  float scale_log2;
  const float* rpb;
  int qtok0;
  int rs0;
  int rope;
  const float* ropetab;
};

template <int DQK, int MODE>
DI void attn_load_tile(const AttnArgs& a, int tile, int nt0, u32x4 (&rk)[DQK / 64], u32x4 (&rv)[2]) {
  const int t = TID();
  const int sg = tile >= nt0 ? 1 : 0;
  const int off = (sg ? tile - nt0 : tile) * 64;
  const u16* kp = sg ? a.seg[1].k : a.seg[0].k;
  const u16* vp = sg ? a.seg[1].v : a.seg[0].v;
  const int ks = sg ? a.seg[1].ks : a.seg[0].ks;
  const int vs = sg ? a.seg[1].vs : a.seg[0].vs;
  const int r0 = t >> 4, c0 = (t & 15) * 8;
#pragma unroll
  for (int i = 0; i < 2; ++i) {
    rk[i] = *(const u32x4*)(kp + (unsigned)((off + r0 + 32 * i) * ks + c0));
    rv[i] = *(const u32x4*)(vp + (unsigned)((off + r0 + 32 * i) * vs + c0));
  }
  if constexpr (MODE == 2) {
    const u16* krp = sg ? a.seg[1].kr : a.seg[0].kr;
    rk[2] = *(const u32x4*)(krp + (unsigned)((off + (t >> 3)) * 64 + (t & 7) * 8));
  }
}

template <int DQK, int MODE>
DI void attn_block(const AttnArgs& a, char* smem) {
  constexpr int KLD = DQK + 8;
  constexpr int VLD = 128 + 16;
  constexpr int KCH = DQK / 64;
  constexpr int NS = DQK / 16;
  u16* Ks = (u16*)smem;
  u16* Vs = Ks + 64 * KLD;
  float* bias_s = (float*)(Vs + 64 * VLD);
  const int t = TID(), wave = t >> 6, lane = t & 63, l31 = lane & 31, h = lane >> 5;

  __syncthreads();
  if constexpr (MODE == 1) {
    for (int e = t; e < 15 * 31; e += NT) bias_s[e] = a.rpb[e] * LOG2E;
  }
  bf16x8 qf[NS];
  {
    const u16* qp = a.q + (size_t)(wave * 32 + l31) * a.qs + 8 * h;
#pragma unroll
    for (int s = 0; s < NS; ++s) qf[s] = *(const bf16x8*)(qp + 16 * s);
  }
  const int qtok = a.qtok0 + wave * 32 + l31;
  if constexpr (MODE == 2) {
    if (a.rope) {
      const int qr = qtok >> 6, qc = qtok & 63;
#pragma unroll
      for (int pr = 0; pr < 2; ++pr) {
        const float4* tb = (const float4*)(a.ropetab + ((pr ? qc : qr) * 16 + 8 * h) * 2);
#pragma unroll
        for (int j2 = 0; j2 < 4; ++j2) {
          float4 cssn = tb[j2];
#pragma unroll
          for (int e = 0; e < 2; ++e) {
            const int j = 2 * j2 + e;
            float cs = e ? cssn.z : cssn.x, sn = e ? cssn.w : cssn.y;
            float x1 = bf2f((u16)qf[8 + 2 * pr][j]), x2 = bf2f((u16)qf[9 + 2 * pr][j]);
            qf[8 + 2 * pr][j] = (short)f2bf(x1 * cs - x2 * sn);
            qf[9 + 2 * pr][j] = (short)f2bf(x2 * cs + x1 * sn);
          }
        }
      }
    }
  }
  f32x16 acc[4];
#pragma unroll
  for (int c = 0; c < 4; ++c)
#pragma unroll
    for (int r = 0; r < 16; ++r) acc[c][r] = 0.f;
  float m_run = -1e30f, l_run = 0.f;

  int ntiles = 0;
  for (int s = 0; s < a.nseg; ++s) ntiles += a.seg[s].n >> 6;
  const int nt0 = a.seg[0].n >> 6;

  u32x4 rk[KCH], rv[2];
  attn_load_tile<DQK, MODE>(a, 0, nt0, rk, rv);

  const int blk = (lane >> 4) & 1, tq = (lane & 15) >> 2, tp = lane & 3;
  const int qrow = qtok >> 6, qcol = qtok & 63;
  int q_rs = qrow - 4; q_rs = q_rs < 0 ? 0 : (q_rs > 8 ? 8 : q_rs);
  int q_cs = qcol - 8; q_cs = q_cs < 0 ? 0 : (q_cs > 48 ? 48 : q_cs);

  for (int tile = 0; tile < ntiles; ++tile) {
    __syncthreads();
#pragma unroll
    for (int i = 0; i < 2; ++i) {
      *(u32x4*)(Ks + ((t >> 4) + 32 * i) * KLD + (t & 15) * 8) = rk[i];
      *(u32x4*)(Vs + ((t >> 4) + 32 * i) * VLD + (t & 15) * 8) = rv[i];
    }
    if constexpr (MODE == 2) {
      *(u32x4*)(Ks + (t >> 3) * KLD + 128 + (t & 7) * 8) = rk[2];
    }
    __syncthreads();
    if (tile + 1 < ntiles) attn_load_tile<DQK, MODE>(a, tile + 1, nt0, rk, rv);

    const bool local = (MODE == 1) && (tile >= nt0);
    const int krow = a.rs0 + (tile - nt0);
#pragma unroll 1
    for (int mt = 0; mt < 2; ++mt) {
      f32x16 S;
#pragma unroll
      for (int r = 0; r < 16; ++r) S[r] = 0.f;
      const u16* kbase = Ks + (mt * 32 + l31) * KLD + 8 * h;
#pragma unroll
      for (int s = 0; s < NS; ++s) {
        bf16x8 kf = *(const bf16x8*)(kbase + 16 * s);
        S = MFMA32(kf, qf[s], S);
        if ((s & 3) == 3) __builtin_amdgcn_sched_barrier(0);
      }
      float mx = -1e30f;
#pragma unroll
      for (int r = 0; r < 16; ++r) {
        float sv = S[r] * a.scale_log2;
        if (MODE == 1) {
          if (local) {
            int kcol = mt * 32 + crow(r, h);
            bool ok = (krow >= q_rs) && (krow < q_rs + 8) && (kcol >= q_cs) && (kcol < q_cs + 16);
            int dy = krow - qrow + 7, dx = kcol - qcol + 15;
            dy = dy < 0 ? 0 : (dy > 14 ? 14 : dy);
            dx = dx < 0 ? 0 : (dx > 30 ? 30 : dx);
            sv = ok ? sv + bias_s[dy * 31 + dx] : -1e30f;
          }
        }
        S[r] = sv;
        mx = fmaxf(mx, sv);
      }
      mx = fmaxf(mx, __shfl_xor(mx, 32));
      const float m_new = fmaxf(m_run, mx);
      const float alpha = exp2f(m_run - m_new);
      m_run = m_new;
      float ps = 0.f;
#pragma unroll
      for (int r = 0; r < 16; ++r) {
        float pv = exp2f(S[r] - m_new);
        if (MODE == 1) { if (S[r] <= -1e29f) pv = 0.f; }
        S[r] = pv;
        ps += pv;
      }
      l_run = l_run * alpha + ps;
#pragma unroll
      for (int c = 0; c < 4; ++c)
#pragma unroll
        for (int r = 0; r < 16; ++r) acc[c][r] *= alpha;
      bf16x8 pf[2];
#pragma unroll
      for (int s2 = 0; s2 < 2; ++s2) {
        u32x4 u;
        u[0] = pack2(S[8 * s2 + 0], S[8 * s2 + 1]);
        u[1] = pack2(S[8 * s2 + 2], S[8 * s2 + 3]);
        u[2] = pack2(S[8 * s2 + 4], S[8 * s2 + 5]);
        u[3] = pack2(S[8 * s2 + 6], S[8 * s2 + 7]);
        pf[s2] = __builtin_bit_cast(bf16x8, u);
      }
      const u16* vbase = Vs + (mt * 32 + 4 * h + tq) * VLD + 16 * blk + 4 * tp;
#pragma unroll
      for (int c = 0; c < 4; ++c)
#pragma unroll
        for (int s2 = 0; s2 < 2; ++s2) {
          const u16* vp = vbase + (16 * s2) * VLD + 32 * c;
          s16x4 lo = __builtin_amdgcn_ds_read_tr16_b64_v4i16((LDS_AS(s16x4)*)(vp));
          s16x4 hi = __builtin_amdgcn_ds_read_tr16_b64_v4i16((LDS_AS(s16x4)*)(vp + 8 * VLD));
          bf16x8 vf = __builtin_shufflevector(lo, hi, 0, 1, 2, 3, 4, 5, 6, 7);
          acc[c] = MFMA32(vf, pf[s2], acc[c]);
          if (s2 == 1 && (c & 1)) __builtin_amdgcn_sched_barrier(0);
        }
    }
  }
  float l_tot = l_run + __shfl_xor(l_run, 32);
  float linv = 1.f / l_tot;
  const size_t qrow_i = (size_t)(wave * 32 + l31);
#pragma unroll
  for (int c = 0; c < 4; ++c)
#pragma unroll
    for (int g4 = 0; g4 < 4; ++g4) {
      int dv0 = 32 * c + 8 * g4 + 4 * h;
      uint2 gt = *(const uint2*)(a.gate + qrow_i * a.gs + dv0);
      float o0 = acc[c][4 * g4 + 0] * linv * silu(bflo(gt.x));
      float o1 = acc[c][4 * g4 + 1] * linv * silu(bfhi(gt.x));
      float o2 = acc[c][4 * g4 + 2] * linv * silu(bflo(gt.y));
      float o3 = acc[c][4 * g4 + 3] * linv * silu(bfhi(gt.y));
      *(uint2*)(a.out + qrow_i * a.os + dv0) = make_uint2(pack2(o0, o1), pack2(o2, o3));
    }
}

DI void phase_attn0(const Params& p, char* smem) {
  const u16* QKVG = (const u16*)(p.ws + OFF_BIG);
  u16* OG = (u16*)(p.ws + OFF_H);
  const u16* KA = (const u16*)(p.ws + OFF_KA_ALL);
  const u16* VA = (const u16*)(p.ws + OFF_VA_ALL);
  const u16* KBC = (const u16*)(p.ws + OFF_KB_CTX);
  const u16* VBC = (const u16*)(p.ws + OFF_VB_CTX);
  const float sc = 0.08838834764831845f * LOG2E;
  for (int it = blockIdx.x; it < 1024; it += gridDim.x) {
    AttnArgs a;
    a.qs = L0_IN; a.gs = L0_IN; a.os = D; a.scale_log2 = sc; a.rpb = nullptr; a.qtok0 = 0; a.rs0 = 0; a.rope = 0; a.ropetab = nullptr;
    a.seg[1].k = nullptr; a.seg[1].v = nullptr; a.seg[1].kr = nullptr; a.seg[1].ks = 0; a.seg[1].vs = 0; a.seg[1].n = 0;
    a.seg[0].kr = nullptr;
    if (it >= 256 && it < 512) {
      int i = it - 256;
      int b = i >> 5, hh = (i >> 2) & 7, qb = i & 3;
      size_t tok = (size_t)NCTX + b * 1024 + qb * 256;
      a.q = QKVG + tok * L0_IN + 1536 + hh * 128;
      a.gate = QKVG + tok * L0_IN + 4608 + 1024 + hh * 128;
      a.out = OG + tok * D + 1024 + hh * 128;
      a.nseg = 2;
      a.seg[0].k = KBC + (size_t)b * 512 * 1024 + hh * 128; a.seg[0].ks = 1024;
      a.seg[0].v = VBC + (size_t)b * 512 * 1024 + hh * 128; a.seg[0].vs = 1024;
      a.seg[0].n = 512;
      int rs0 = 4 * qb - 4; rs0 = rs0 < 0 ? 0 : (rs0 > 8 ? 8 : rs0);
      int rs1 = 4 * qb - 1; rs1 = rs1 < 0 ? 0 : (rs1 > 8 ? 8 : rs1);
      int nrows = rs1 + 8 - rs0;
      size_t ktok = (size_t)NCTX + b * 1024 + rs0 * 64;
      a.seg[1].k = QKVG + ktok * L0_IN + 2560 + hh * 128; a.seg[1].ks = L0_IN;
      a.seg[1].v = QKVG + ktok * L0_IN + 3584 + hh * 128; a.seg[1].vs = L0_IN;
      a.seg[1].n = nrows * 64;
      a.rpb = p.l0_rpb + hh * 15 * 31;
      a.qtok0 = qb * 256; a.rs0 = rs0;
      attn_block<128, 1>(a, smem);
    } else {
      a.nseg = 1;
      if (it < 256) {
        int b = it >> 5, hq = (it >> 2) & 7, qb = it & 3;
        size_t tok = (size_t)NCTX + b * 1024 + qb * 256;
        a.q = QKVG + tok * L0_IN + hq * 128;
        a.gate = QKVG + tok * L0_IN + 4608 + hq * 128;
        a.out = OG + tok * D + hq * 128;
        a.seg[0].k = KA + (size_t)b * 1536 * 256 + (hq >> 2) * 128; a.seg[0].ks = 256;
        a.seg[0].v = VA + (size_t)b * 1536 * 256 + (hq >> 2) * 128; a.seg[0].vs = 256;
        a.seg[0].n = 1536;
      } else {
        int i = it - 512;
        bool isB = i >= 256; i &= 255;
        int b = i >> 3, hh = i & 7;
        size_t tok = (size_t)b * 256;
        a.seg[0].n = 256; a.seg[0].ks = L0_IN; a.seg[0].vs = L0_IN;
        if (!isB) {
          a.q = QKVG + tok * L0_IN + hh * 128;
          a.gate = QKVG + tok * L0_IN + 4608 + hh * 128;
          a.out = OG + tok * D + hh * 128;
          a.seg[0].k = QKVG + tok * L0_IN + 1024 + (hh >> 2) * 128;
          a.seg[0].v = QKVG + tok * L0_IN + 1280 + (hh >> 2) * 128;
        } else {
          a.q = QKVG + tok * L0_IN + 1536 + hh * 128;
          a.gate = QKVG + tok * L0_IN + 4608 + 1024 + hh * 128;
          a.out = OG + tok * D + 1024 + hh * 128;
          a.seg[0].k = QKVG + tok * L0_IN + 2560 + hh * 128;
          a.seg[0].v = QKVG + tok * L0_IN + 3584 + hh * 128;
        }
      }
      attn_block<128, 0>(a, smem);
    }
  }
}

DI void phase_attn1(const Params& p, char* smem, int round) {
  const u16* Q1 = (const u16*)(p.ws + OFF_Q1);
  u16* LAT1 = (u16*)(p.ws + OFF_LAT1);
  const float sc = 0.07216878364870322f * LOG2E;
  for (int it = blockIdx.x; it < 512; it += gridDim.x) {
    AttnArgs a;
    a.qs = 3072; a.gs = L1_LD; a.os = L1_LD; a.scale_log2 = sc; a.rpb = nullptr; a.rs0 = 0; a.ropetab = (const float*)(p.ws + OFF_ROPE);
    a.seg[1].k = nullptr; a.seg[1].v = nullptr; a.seg[1].kr = nullptr; a.seg[1].ks = 0; a.seg[1].vs = 0; a.seg[1].n = 0;
    a.nseg = 1;
    a.seg[0].ks = 4096; a.seg[0].vs = 4096;
    size_t tok;
    int hh;
    if (round == 0) {
      int b = it >> 4; hh = it & 15;
      tok = (size_t)b * 256;
      const u16* KV = (const u16*)(p.ws + OFF_KV_CTX) + (size_t)b * 256 * 4096 + hh * 256;
      a.seg[0].k = KV; a.seg[0].v = KV + 128;
      a.seg[0].kr = (const u16*)(p.ws + OFF_KR_CTX) + (size_t)b * 256 * 64;
      a.seg[0].n = 256;
      a.rope = 0; a.qtok0 = 0;
    } else {
      int b = it >> 6, qb = it & 3; hh = (it >> 2) & 15;
      tok = (size_t)NCTX + b * 1024 + qb * 256;
      const u16* KV = (const u16*)(p.ws + OFF_KV_LAT) + (size_t)b * 1536 * 4096 + hh * 256;
      a.seg[0].k = KV; a.seg[0].v = KV + 128;
      a.seg[0].kr = (const u16*)(p.ws + OFF_KR_ALL) + (size_t)b * 1536 * 64;
      a.seg[0].n = 1536;
      a.rope = 1; a.qtok0 = qb * 256;
    }
    a.q = Q1 + tok * 3072 + hh * 192;
    a.gate = LAT1 + tok * L1_LD + 1088 + hh * 128;
    a.out = LAT1 + tok * L1_LD + 1088 + hh * 128;
    attn_block<192, 2>(a, smem);
  }
}

__global__ void __launch_bounds__(512, 2) fwd_megakernel(Params p) {
  cg::grid_group grid = cg::this_grid();
  extern __shared__ __attribute__((aligned(16))) unsigned char dsm[];
  char* smem = (char*)dsm;
  char* ws = p.ws;
  const float* mod0 = (const float*)(ws + OFF_MOD);
  const float* mod1 = mod0 + 9 * 6144;

  phase_prep(p, smem);
  grid.sync();
  phase_normmod(p, 0);
  grid.sync();
  { EpiBf16 e{(u16*)(ws + OFF_BIG), L0_IN};
    gemm_run((PG8_LAS unsigned char*)dsm, (const u16*)(ws + OFF_H), D, (const u16*)(ws + OFF_WT_IN0), NTOK, L0_IN, 2048, e); }
  grid.sync();
  phase_qknorm0(p);
  grid.sync();
  phase_attn0(p, smem);
  grid.sync();
  { EpiResid e{p.x_prompt, p.x_sample, mod0 + 4096, p.out + OUT_Y};
    gemm_run((PG8_LAS unsigned char*)dsm, (const u16*)(ws + OFF_H), D, (const u16*)(ws + OFF_WT_OUT0), NTOK, D, 2048, e); }
  grid.sync();
  phase_normmod(p, 1);
  grid.sync();
  { EpiBf16 e{(u16*)(ws + OFF_LAT1), L1_LD};
    gemm_run((PG8_LAS unsigned char*)dsm, (const u16*)(ws + OFF_H), D, (const u16*)(ws + OFF_WT_IN1), NTOK, L1_LD, 2048, e); }
  grid.sync();
  phase_norm1(p);
  grid.sync();
  { EpiBf16 e{(u16*)(ws + OFF_Q1), 3072};
    gemm_run((PG8_LAS unsigned char*)dsm, (const u16*)(ws + OFF_QN), 512, (const u16*)(ws + OFF_WT_QB), NTOK, 3072, 512, e); }
#pragma unroll 1
  for (int round = 0; round < 2; ++round) {
    { EpiBf16 e{(u16*)(ws + (round ? OFF_KV_LAT : OFF_KV_CTX)), 4096};
      gemm_run((PG8_LAS unsigned char*)dsm, (const u16*)(ws + (round ? OFF_CKV_ALL : OFF_CKV_CTX)), 512, (const u16*)(ws + OFF_WT_KVB),
               round ? 12288 : NCTX, 4096, 512, e); }
    grid.sync();
    phase_attn1(p, smem, round);
    grid.sync();
  }
  { EpiResid e{p.out + OUT_Y, p.out + OUT_Y + (size_t)NCTX * D, mod1 + 4096, p.out + OUT_Y};
    gemm_run((PG8_LAS unsigned char*)dsm, (const u16*)(ws + OFF_LAT1) + 1088, L1_LD, (const u16*)(ws + OFF_WT_OUT1), NTOK, D, 2048, e); }
  grid.sync();
  phase_final(p);
}

extern "C" void kernel_launch(void* const* d_in, const int* in_sizes, int n_in, void* d_out, int out_size, void* d_ws,
                              size_t ws_size, hipStream_t stream) {
  (void)in_sizes; (void)n_in; (void)out_size;
  if (ws_size < WS_NEEDED) { fprintf(stderr, "workspace too small: %zu < %zu\n", ws_size, (size_t)WS_NEEDED); return; }
  static int grid_blocks = 0;
  if (!grid_blocks) {
    int dev = 0, cus = 0, per_cu = 0;
    (void)hipGetDevice(&dev);
    (void)hipDeviceGetAttribute(&cus, hipDeviceAttributeMultiprocessorCount, dev);
    if (hipFuncSetAttribute((const void*)fwd_megakernel, hipFuncAttributeMaxDynamicSharedMemorySize, SMEM_BYTES) != hipSuccess) {
      fprintf(stderr, "hipFuncSetAttribute failed\n"); return; }
    (void)hipOccupancyMaxActiveBlocksPerMultiprocessor(&per_cu, fwd_megakernel, NT, SMEM_BYTES);
    if (per_cu < 1) { fprintf(stderr, "occupancy query returned %d\n", per_cu); return; }
    grid_blocks = cus;
  }
  Params p{};
  const float** pf = (const float**)&p;
  for (int i = 0; i < 28; ++i) pf[i] = (const float*)d_in[i];
  p.out = (float*)d_out;
  p.ws = (char*)d_ws;
  void* args[] = {&p};
  hipError_t e = hipLaunchCooperativeKernel((void*)fwd_megakernel, dim3(grid_blocks), dim3(NT), args, SMEM_BYTES, stream);
  if (e != hipSuccess) fprintf(stderr, "cooperative launch failed: %s (grid %d)\n", hipGetErrorString(e), grid_blocks);
}
```

```cpp
#include <hip/hip_runtime.h>
#include <hip/hip_cooperative_groups.h>
#include <cstdio>
namespace cg = cooperative_groups;

typedef unsigned short u16;
using bf16x8 = __attribute__((ext_vector_type(8))) short;
using s16x4  = __attribute__((ext_vector_type(4))) short;
using f32x16 = __attribute__((ext_vector_type(16))) float;
using f32x4  = __attribute__((ext_vector_type(4))) float;
using u32x4  = __attribute__((ext_vector_type(4))) unsigned;
typedef __bf16 bf16x2_t __attribute__((ext_vector_type(2)));
typedef float f32x2_t __attribute__((ext_vector_type(2)));
#define DI __device__ __forceinline__
#define MFMA32(a, b, c) __builtin_amdgcn_mfma_f32_32x32x16_bf16((a), (b), (c), 0, 0, 0)
#define LDS_AS(T) __attribute__((address_space(3))) T

constexpr int D = 2048;
constexpr int NTOK = 16384;
constexpr int NCTX = 8192;
constexpr int L0_IN = 6656;
constexpr int L1_IN = 3136;
constexpr int L1_LD = 3328;
constexpr float EPS = 1e-6f;
constexpr float LOG2E = 1.4426950408889634f;
constexpr float LOG2_THETA = 13.287712379549449f;
#ifndef REP_G
#define REP_G 1
#endif
#ifndef REP_A0
#define REP_A0 1
#endif
constexpr int NT = 512;
constexpr int NW = 8;

constexpr size_t OFF_WT_IN1  = 0;
constexpr size_t OFF_WT_QB   = OFF_WT_IN1 + (size_t)3328 * 2048 * 2;
constexpr size_t OFF_WT_KVB  = OFF_WT_QB + (size_t)3072 * 512 * 2;
constexpr size_t OFF_WT_OUT1 = OFF_WT_KVB + (size_t)4096 * 512 * 2;
constexpr size_t OFF_WL0     = OFF_WT_OUT1 + (size_t)2048 * 2048 * 2;
constexpr size_t OFF_WT_IN0  = OFF_WL0;
constexpr size_t OFF_WT_OUT0 = OFF_WT_IN0 + (size_t)6656 * 2048 * 2;
constexpr size_t OFF_H       = OFF_WT_OUT0 + (size_t)2048 * 2048 * 2;
constexpr size_t OFF_BIG     = OFF_H + (size_t)NTOK * 2048 * 2;
constexpr size_t OFF_C       = OFF_BIG + (size_t)NTOK * 6656 * 2;
constexpr size_t OFF_KA_ALL  = OFF_C;
constexpr size_t OFF_VA_ALL  = OFF_KA_ALL + (size_t)8 * 1536 * 256 * 2;
constexpr size_t OFF_KB_CTX  = OFF_VA_ALL + (size_t)8 * 1536 * 256 * 2;
constexpr size_t OFF_VB_CTX  = OFF_KB_CTX + (size_t)8 * 512 * 1024 * 2;
constexpr size_t OFF_CKV_ALL = OFF_VB_CTX + (size_t)8 * 512 * 1024 * 2;
constexpr size_t OFF_KR_ALL  = OFF_CKV_ALL + (size_t)8 * 1536 * 512 * 2;
constexpr size_t OFF_MOD     = OFF_KR_ALL + (size_t)8 * 1536 * 64 * 2;
constexpr size_t OFF_ROPE    = OFF_MOD + (size_t)2 * 9 * 6144 * 4;
constexpr size_t OFF_ROPE0   = OFF_ROPE + (size_t)64 * 16 * 2 * 4;
constexpr size_t OFF_BAR     = OFF_ROPE0 + (size_t)64 * 32 * 2 * 4;
constexpr size_t BAR_BYTES   = 3456 * 4;
constexpr size_t WS_NEEDED   = OFF_BAR + BAR_BYTES;
constexpr size_t OFF_QN      = OFF_WL0;
constexpr size_t OFF_CKV_CTX = OFF_QN + (size_t)NTOK * 512 * 2;
constexpr size_t OFF_KR_CTX  = OFF_CKV_CTX + (size_t)NCTX * 512 * 2;
constexpr size_t OFF_KV_CTX  = OFF_H;
constexpr size_t OFF_KV_LAT  = OFF_WL0;
constexpr size_t OFF_LAT1    = OFF_BIG;
constexpr size_t OFF_Q1      = OFF_BIG + (size_t)NTOK * L1_LD * 2;
static_assert(OFF_KR_CTX + (size_t)NCTX * 64 * 2 <= OFF_WT_OUT0, "l1 small bufs overflow");
static_assert(OFF_KV_LAT + (size_t)12288 * 4096 * 2 <= OFF_BIG, "kv_lat overflow");
static_assert(OFF_Q1 + (size_t)NTOK * 3072 * 2 <= OFF_C, "q1 overflow");

constexpr size_t OUT_Y   = 0;
constexpr size_t OUT_NAK = (size_t)NTOK * 2048;
constexpr size_t OUT_NAV = OUT_NAK + (size_t)NCTX * 256;
constexpr size_t OUT_NBK = OUT_NAV + (size_t)NCTX * 256;
constexpr size_t OUT_NBV = OUT_NBK + (size_t)NCTX * 1024;
constexpr size_t OUT_NCKV = OUT_NBV + (size_t)NCTX * 1024;
constexpr size_t OUT_NKR = OUT_NCKV + (size_t)NCTX * 512;

constexpr int SMEM_BYTES = 128 * 1024 + 256;

struct Params {
  const float *x_prompt, *x_sample, *ca_k, *ca_v, *cb_k, *cb_v, *c_ckv, *c_kr, *c, *c_ctx;
  const float *l0_norm, *l0_ada_w, *l0_ada_b, *l0_w_in, *l0_qn, *l0_kn, *l0_rpb, *l0_w_out;
  const float *l1_norm, *l1_ada_w, *l1_ada_b, *l1_w_in, *l1_qan, *l1_wqb, *l1_kvan, *l1_wkvb, *l1_w_out, *fnorm;
  float* out;
  char* ws;
};

DI int threadIdx_x_raw() { return (int)__builtin_amdgcn_workitem_id_x(); }
DI u16 f2bf(float x) { unsigned u = __float_as_uint(x); u += 0x7fffu + ((u >> 16) & 1u); return (u16)(u >> 16); }
DI float bf2f(u16 v) { return __uint_as_float(((unsigned)v) << 16); }
DI unsigned pack2(float a, float b) { f32x2_t f = {a, b}; bf16x2_t r = __builtin_convertvector(f, bf16x2_t); return __builtin_bit_cast(unsigned, r); }
DI float bflo(unsigned u) { return __uint_as_float(u << 16); }
DI float bfhi(unsigned u) { return __uint_as_float(u & 0xffff0000u); }
DI float wave_sum(float v) {
#pragma unroll
  for (int o = 32; o >= 1; o >>= 1) v += __shfl_xor(v, o);
  return v;
}
DI int TID() { int t = threadIdx_x_raw(); asm volatile("" : "+v"(t)); return t; }
DI int crow(int i, int h) { return (i & 3) + 8 * (i >> 2) + 4 * h; }
DI float silu(float x) { return x / (1.f + __expf(-x)); }
DI int tok_modrow(int tok) { return tok < NCTX ? 0 : 1 + ((tok - NCTX) >> 10); }

DI void transpose_tile(const float* __restrict__ src, int K, int N, u16* __restrict__ dst, int kt, int nt, float* sm) {
  const int t = TID();
  float4 v[8];
#pragma unroll
  for (int i = 0; i < 8; ++i) {
    int id = t + NT * i, r = id >> 6, c4 = id & 63, n = nt * 256 + c4 * 4;
    v[i] = (n < N) ? *(const float4*)(src + (size_t)(kt * 64 + r) * N + n) : make_float4(0.f, 0.f, 0.f, 0.f);
  }
#pragma unroll
  for (int i = 0; i < 8; ++i) {
    int id = t + NT * i, r = id >> 6, c4 = id & 63;
    *(float4*)(sm + r * 260 + c4 * 4) = v[i];
  }
  __syncthreads();
  {
    const int nl = t >> 1, kq = t & 1, n = nt * 256 + nl;
    if (n < N) {
      u16* dp = dst + (size_t)n * K + kt * 64 + kq * 32;
#pragma unroll
      for (int q = 0; q < 4; ++q) {
        u32x4 o;
#pragma unroll
        for (int j = 0; j < 4; ++j) o[j] = pack2(sm[(kq * 32 + q * 8 + 2 * j) * 260 + nl], sm[(kq * 32 + q * 8 + 2 * j + 1) * 260 + nl]);
        *(u32x4*)(dp + q * 8) = o;
      }
    }
  }
  __syncthreads();
}

DI void adaln_item(const Params& p, int l, int chunk, float* sm) {
  const float* W = l ? p.l1_ada_w : p.l0_ada_w;
  const float* bias = l ? p.l1_ada_b : p.l0_ada_b;
  float* mod = (float*)(p.ws + OFF_MOD) + (size_t)l * 9 * 6144;
  const int t = TID(), col = chunk * 64 + (t & 63), kg = t >> 6;
  float acc[9];
#pragma unroll
  for (int r = 0; r < 9; ++r) acc[r] = 0.f;
  for (int kh = 0; kh < 2; ++kh) {
    __syncthreads();
    for (int e = t; e < 9 * 1024; e += NT) {
      int r = e >> 10, k = e & 1023;
      float cv = (r == 0) ? p.c_ctx[kh * 1024 + k] : p.c[(r - 1) * 2048 + kh * 1024 + k];
      sm[r * 1024 + k] = silu(cv);
    }
    __syncthreads();
    const float* wp = W + (size_t)(kh * 1024 + kg * 128) * 6144 + col;
    const float* sp = sm + kg * 128;
#pragma unroll 8
    for (int k = 0; k < 128; ++k) {
      float w = wp[(size_t)k * 6144];
#pragma unroll
      for (int r = 0; r < 9; ++r) acc[r] += sp[r * 1024 + k] * w;
    }
  }
  __syncthreads();
#pragma unroll
  for (int r = 0; r < 9; ++r) sm[(kg * 9 + r) * 64 + (t & 63)] = acc[r];
  __syncthreads();
  for (int e = t; e < 9 * 64; e += NT) {
    int r = e >> 6, cc = e & 63;
    float s = 0.f;
#pragma unroll
    for (int g = 0; g < NW; ++g) s += sm[(g * 9 + r) * 64 + cc];
    mod[(size_t)r * 6144 + chunk * 64 + cc] = s + bias[chunk * 64 + cc];
  }
  __syncthreads();
}

DI void convert_item(const float* __restrict__ src, u16* __restrict__ dst, int W, int dstT, int item) {
  size_t e = (size_t)item * 4096 + TID() * 8;
  size_t per_b = (size_t)512 * W;
  size_t b = e / per_b, r = e % per_b;
  float4 v0 = *(const float4*)(src + e), v1 = *(const float4*)(src + e + 4);
  u32x4 o = {pack2(v0.x, v0.y), pack2(v0.z, v0.w), pack2(v1.x, v1.y), pack2(v1.z, v1.w)};
  *(u32x4*)(dst + b * (size_t)dstT * W + r) = o;
}

DI void phase_prep(const Params& p, char* smem) {
  float* sm = (float*)smem;
  char* ws = p.ws;
  constexpr int T_IN0 = 32 * 26, T_OUT0 = 32 * 8, T_IN1 = 32 * 13, T_QB = 8 * 12, T_KVB = 8 * 16, T_OUT1 = 32 * 8;
  constexpr int C_A = 256, C_B = 1024, C_CKV = 512, C_KR = 64;
  constexpr int B1 = 0, B2 = B1 + T_IN0, B3 = B2 + T_OUT0, B4 = B3 + T_IN1, B5 = B4 + T_QB, B6 = B5 + T_KVB, B7 = B6 + T_OUT1;
  constexpr int B8 = B7 + C_A, B9 = B8 + C_A, B10 = B9 + C_B, B11 = B10 + C_B, B12 = B11 + C_CKV, B13 = B12 + C_KR;
  if (blockIdx.x == gridDim.x - 1) {
    float* tab = (float*)(ws + OFF_ROPE);
    for (int e = TID(); e < 64 * 16; e += NT) {
      int pos = e >> 4, i = e & 15;
      float inv = exp2f(-(float)i * (LOG2_THETA / 16.f));
      float sn, cs; sincosf((float)pos * inv, &sn, &cs);
      tab[2 * e] = cs; tab[2 * e + 1] = sn;
    }
    float* tab0 = (float*)(ws + OFF_ROPE0);
    for (int e = TID(); e < 64 * 32; e += NT) {
      int pos = e >> 5, i = e & 31;
      float inv = exp2f(-(float)i * (LOG2_THETA / 32.f));
      float sn, cs; sincosf((float)pos * inv, &sn, &cs);
      tab0[2 * e] = cs; tab0[2 * e + 1] = sn;
    }
  }
  const int nada = (gridDim.x > 128) ? 96 : 0;
  if ((int)blockIdx.x < nada) { adaln_item(p, 0, blockIdx.x, sm); return; }
  if (nada == 0) { for (int c = blockIdx.x; c < 96; c += gridDim.x) adaln_item(p, 0, c, sm); }
  for (int it = blockIdx.x - nada; it < B13; it += gridDim.x - nada) {
    if (it < B2) { int i = it - B1; transpose_tile(p.l0_w_in, 2048, 6656, (u16*)(ws + OFF_WT_IN0), i / 26, i % 26, sm); }
    else if (it < B3) { int i = it - B2; transpose_tile(p.l0_w_out, 2048, 2048, (u16*)(ws + OFF_WT_OUT0), i / 8, i % 8, sm); }
    else if (it < B4) { int i = it - B3; transpose_tile(p.l1_w_in, 2048, 3136, (u16*)(ws + OFF_WT_IN1), i / 13, i % 13, sm); }
    else if (it < B5) { int i = it - B4; transpose_tile(p.l1_wqb, 512, 3072, (u16*)(ws + OFF_WT_QB), i / 12, i % 12, sm); }
    else if (it < B6) { int i = it - B5; transpose_tile(p.l1_wkvb, 512, 4096, (u16*)(ws + OFF_WT_KVB), i / 16, i % 16, sm); }
    else if (it < B7) { int i = it - B6; transpose_tile(p.l1_w_out, 2048, 2048, (u16*)(ws + OFF_WT_OUT1), i / 8, i % 8, sm); }
    else if (it < B8) convert_item(p.ca_k, (u16*)(ws + OFF_KA_ALL), 256, 1536, it - B7);
    else if (it < B9) convert_item(p.ca_v, (u16*)(ws + OFF_VA_ALL), 256, 1536, it - B8);
    else if (it < B10) convert_item(p.cb_k, (u16*)(ws + OFF_KB_CTX), 1024, 512, it - B9);
    else if (it < B11) convert_item(p.cb_v, (u16*)(ws + OFF_VB_CTX), 1024, 512, it - B10);
    else if (it < B12) convert_item(p.c_ckv, (u16*)(ws + OFF_CKV_ALL), 512, 1536, it - B11);
    else convert_item(p.c_kr, (u16*)(ws + OFF_KR_ALL), 64, 1536, it - B12);
  }
}

DI void phase_normmod(const Params& p, int layer) {
  const int wave = TID() >> 6, lane = TID() & 63;
  const float* g = layer ? p.l1_norm : p.l0_norm;
  const float* mod = (const float*)(p.ws + OFF_MOD) + (size_t)layer * 9 * 6144;
  u16* H = (u16*)(p.ws + OFF_H);
  for (int it = blockIdx.x; it < NTOK / NW; it += gridDim.x) {
    int row = it * NW + wave;
    const float* src;
    if (layer == 0) src = row < NCTX ? p.x_prompt + (size_t)row * D : p.x_sample + (size_t)(row - NCTX) * D;
    else src = p.out + OUT_Y + (size_t)row * D;
    const float* mr = mod + (size_t)tok_modrow(row) * 6144;
    float4 v[8];
    float ss = 0.f;
#pragma unroll
    for (int i = 0; i < 8; ++i) {
      v[i] = *(const float4*)(src + (i * 64 + lane) * 4);
      ss += v[i].x * v[i].x + v[i].y * v[i].y + v[i].z * v[i].z + v[i].w * v[i].w;
    }
    ss = wave_sum(ss);
    float rinv = rsqrtf(ss * (1.f / D) + EPS);
#pragma unroll
    for (int i = 0; i < 8; ++i) {
      int col = (i * 64 + lane) * 4;
      float4 gg = *(const float4*)(g + col);
      float4 sh = *(const float4*)(mr + col);
      float4 sc = *(const float4*)(mr + 2048 + col);
      float h0 = v[i].x * rinv * gg.x * (1.f + sc.x) + sh.x;
      float h1 = v[i].y * rinv * gg.y * (1.f + sc.y) + sh.y;
      float h2 = v[i].z * rinv * gg.z * (1.f + sc.z) + sh.z;
      float h3 = v[i].w * rinv * gg.w * (1.f + sc.w) + sh.w;
      *(uint2*)(H + (size_t)row * D + col) = make_uint2(pack2(h0, h1), pack2(h2, h3));
    }
  }
}

namespace pg8 {
#define PG8_LAS __attribute__((address_space(3)))
typedef unsigned short bf16_t;
typedef short bf16x8 __attribute__((ext_vector_type(8)));
typedef float f32x4 __attribute__((ext_vector_type(4)));
typedef unsigned u32x4 __attribute__((ext_vector_type(4)));
constexpr int BM = 256, BK = 64, HALF = 128, HTB = HALF * BK * 2  , STAGE_BYTES = 8 * HTB, NXCD = 8, WGM = 8;

__host__ __device__ __forceinline__ int lds_byte(int r, int c) { const int st = (r >> 4) * 2 + (c >> 5), rr = r & 15, cc = c & 31, ob = rr * 64 + cc * 2; return st * 1024 + (ob ^ (((ob >> 9) & 1) << 5)); }
__host__ __device__ __forceinline__ void stage_rc(int b, int& R, int& C) { const int st = b / 1024, sb = b % 1024, swz = sb ^ (((sb >> 9) & 1) << 5); R = (st >> 1) * 16 + swz / 64; C = (st & 1) * 32 + (swz % 64) / 2; }
__host__ __device__ __forceinline__ int perm32(int rho) { const int n = rho >> 4, i = rho & 15; return 8 * (i >> 2) + 4 * n + (i & 3); }

struct Unit { int pm, pn; };
struct Gemm { const bf16_t* A; const bf16_t* Bt; int M, N, K, lda; };
struct StaticOrder {
    int nM, nN, nwg, G, c;
    __host__ __device__ void init(int M, int N, int G_, int c_) { nM = M / BM; nN = N / BM; nwg = nM * nN; G = G_; c = c_; }
    __host__ __device__ bool next(int i, Unit& u) const {
        const long L = (long)i * G + c; if (L >= nwg) return false;
        int wgid = (int)L; { const int q = nwg / NXCD, r = nwg % NXCD, xcd = wgid % NXCD, off = wgid / NXCD; wgid = (xcd < r ? xcd * (q + 1) : r * (q + 1) + (xcd - r) * q) + off; }
        const int nig = WGM * nN, gid = wgid / nig, fm = gid * WGM, gsz = (nM - fm) < WGM ? (nM - fm) : WGM;
        u.pm = fm + ((wgid % nig) % gsz); u.pn = (wgid % nig) / gsz; return true;
    }
    __device__ __forceinline__ void a_ready(const Unit&) const {}
    __device__ __forceinline__ void done(const Unit&) const {}
};
template <class Epi, class Sched, bool STAMP = false>
__device__ __forceinline__ void gemm_phase(PG8_LAS unsigned char* lds, const Gemm g, const Sched& S, const Epi& E, unsigned long long* stamps) {
    const int tid = TID(), wid = __builtin_amdgcn_readfirstlane(tid >> 6), lane = tid & 63, wr = wid >> 2, wc = wid & 3, fr = lane & 15, fq = lane >> 4;
    const int K = g.K, nt = K / BK;
    int ts_lo = 0, ts_hi = 0, nts = 0; const unsigned long long rt_entry = STAMP ? (unsigned long long)wall_clock64() : 0ull;
#define PG8_STAMP() do { if (STAMP && wid == 0 && nts < 64) { const unsigned long long _c = (unsigned long long)clock64(); \
        ts_lo = (lane == nts) ? (int)(unsigned)_c : ts_lo; ts_hi = (lane == nts) ? (int)(unsigned)(_c >> 32) : ts_hi; ++nts; } } while (0)
    PG8_STAMP();
    unsigned voffA[2], voffB[2];
#pragma unroll
    for (int i = 0; i < 2; ++i) { int R, C; stage_rc(tid * 16 + i * 8192, R, C); const int Rb = Epi::PERM ? ((R & ~31) + perm32(R & 31)) : R;
        voffA[i] = (unsigned)(R * g.lda + C) * 2u; voffB[i] = (unsigned)(Rb * K + C) * 2u; }
    const size_t kstep = (size_t)(BK * 2);
    const size_t hstepB = (size_t)HALF * K * 2, hstepA = (size_t)HALF * g.lda * 2;
    const size_t tstepB = 2 * hstepB, tstepA = 2 * hstepA;
    const unsigned ldsw = (unsigned)wid * 1024u;
    const int aoff = lds_byte(wr * 64 + fr, fq * 8), boff = lds_byte(wc * 32 + fr, fq * 8);
#define PG8_SA(b, h) (((b) * 2 + (h)) * HTB)
#define PG8_SB(b, h) ((4 + (b) * 2 + (h)) * HTB)
#define PG8_STAGE(bufoff, gbase, voff) do { _Pragma("unroll") for (int _i = 0; _i < 2; ++_i) \
        __builtin_amdgcn_global_load_lds((const unsigned*)((const char*)(gbase) + (voff)[_i]), (PG8_LAS unsigned*)(lds + (bufoff) + ldsw + _i * 8192), 16, 0, 0); } while (0)
#define PG8_LDA(dst, b, h) do { _Pragma("unroll") for (int m = 0; m < 4; ++m) _Pragma("unroll") for (int k = 0; k < 2; ++k) dst[m][k] = *(const PG8_LAS bf16x8*)(lds + PG8_SA(b, h) + aoff + m * 2048 + k * 1024); } while (0)
#define PG8_LDB(dst, b, h) do { _Pragma("unroll") for (int n = 0; n < 2; ++n) _Pragma("unroll") for (int k = 0; k < 2; ++k) dst[n][k] = *(const PG8_LAS bf16x8*)(lds + PG8_SB(b, h) + boff + n * 2048 + k * 1024); } while (0)
#define PG8_MMA(ai, bj, At, Bt) do { __builtin_amdgcn_s_setprio(1); _Pragma("unroll") for (int m = 0; m < 4; ++m) _Pragma("unroll") for (int n = 0; n < 2; ++n) _Pragma("unroll") for (int k = 0; k < 2; ++k) \
        acc[ai][bj][m][n] = __builtin_amdgcn_mfma_f32_16x16x32_bf16(Bt[n][k], At[m][k], acc[ai][bj][m][n], 0, 0, 0); __builtin_amdgcn_s_setprio(0); } while (0)
#define PG8_WAIT_V(n) asm volatile("s_waitcnt vmcnt(" #n ")" ::: "memory")
#define PG8_WAIT_L(n) asm volatile("s_waitcnt lgkmcnt(" #n ")" ::: "memory")
#define PG8_BAR __builtin_amdgcn_s_barrier()
#define PG8_SCHED __builtin_amdgcn_sched_barrier(0)
    Unit cur, nxt; int ui = 0;
    if (!S.next(0, cur)) return;
    f32x4 acc[2][2][4][2];
#pragma unroll
    for (int a = 0; a < 2; ++a)
#pragma unroll
        for (int b = 0; b < 2; ++b)
#pragma unroll
            for (int m = 0; m < 4; ++m)
#pragma unroll
                for (int n = 0; n < 2; ++n) acc[a][b][m][n] = (f32x4){0.f, 0.f, 0.f, 0.f};
    bf16x8 At[4][2], B0[2][2], B1[2][2];
    const char* cA = (const char*)g.A + (size_t)cur.pm * tstepA; const char* cB = (const char*)g.Bt + (size_t)cur.pn * tstepB;
    S.a_ready(cur);
    PG8_STAGE(PG8_SB(0, 0), cB, voffB); PG8_STAGE(PG8_SA(0, 0), cA, voffA); PG8_STAGE(PG8_SB(0, 1), cB + hstepB, voffB); PG8_STAGE(PG8_SA(0, 1), cA + hstepA, voffA);
    if (wr == 1) PG8_BAR;
    PG8_WAIT_V(4); PG8_BAR;
    PG8_STAGE(PG8_SB(1, 0), cB + kstep, voffB); PG8_STAGE(PG8_SA(1, 0), cA + kstep, voffA); PG8_STAGE(PG8_SB(1, 1), cB + hstepB + kstep, voffB);
    PG8_WAIT_V(6); PG8_BAR;
    PG8_STAMP();
    for (;;) {
        const bool has_next = S.next(ui + 1, nxt);
        const char* nA = has_next ? (const char*)g.A + (size_t)nxt.pm * tstepA : cA; const char* nB = has_next ? (const char*)g.Bt + (size_t)nxt.pn * tstepB : cB;
        for (int t = 0; t < nt; t += 2) {
            const bool last = (t == nt - 2);
            const char* a1 = cA + (size_t)(t + 1) * kstep;
            const char* a2 = last ? nA : cA + (size_t)(t + 2) * kstep; const char* b2 = last ? nB : cB + (size_t)(t + 2) * kstep;
            const char* a3 = a2 + kstep; const char* b3 = b2 + kstep;
            if (last && has_next) S.a_ready(nxt);
            PG8_LDB(B0, 0, 0); PG8_SCHED; PG8_LDA(At, 0, 0); PG8_STAGE(PG8_SA(1, 1), a1 + hstepA, voffA);
            PG8_WAIT_L(8); PG8_BAR; PG8_WAIT_L(0); PG8_MMA(0, 0, At, B0); PG8_BAR; PG8_SCHED;
            PG8_LDB(B1, 0, 1); PG8_STAGE(PG8_SB(0, 0), b2, voffB);
            PG8_BAR; PG8_WAIT_L(0); PG8_MMA(0, 1, At, B1); PG8_BAR;
            PG8_LDA(At, 0, 1); PG8_STAGE(PG8_SA(0, 0), a2, voffA);
            PG8_BAR; PG8_WAIT_L(0); PG8_MMA(1, 0, At, B0); PG8_BAR; PG8_SCHED;
            PG8_STAGE(PG8_SB(0, 1), b2 + hstepB, voffB);
            PG8_WAIT_V(6); PG8_BAR; PG8_MMA(1, 1, At, B1); PG8_BAR;
            PG8_LDB(B0, 1, 0); PG8_SCHED; PG8_LDA(At, 1, 0); PG8_STAGE(PG8_SA(0, 1), a2 + hstepA, voffA);
            PG8_WAIT_L(8); PG8_BAR; PG8_WAIT_L(0); PG8_MMA(0, 0, At, B0); PG8_BAR; PG8_SCHED;
            PG8_LDB(B1, 1, 1); PG8_STAGE(PG8_SB(1, 0), b3, voffB);
            PG8_BAR; PG8_WAIT_L(0); PG8_MMA(0, 1, At, B1); PG8_BAR;
            PG8_LDA(At, 1, 1); PG8_STAGE(PG8_SA(1, 0), a3, voffA);
            PG8_BAR; PG8_WAIT_L(0); PG8_MMA(1, 0, At, B0); PG8_BAR; PG8_SCHED;
            PG8_STAGE(PG8_SB(1, 1), b3 + hstepB, voffB);
            PG8_WAIT_V(6); PG8_BAR; PG8_MMA(1, 1, At, B1); PG8_BAR;
        }
        PG8_STAMP();
        if constexpr (!Epi::AFTER_DRAIN) { E(acc, cur, wr, wc, fr, fq); S.done(cur); }
        PG8_STAMP();
        if (!has_next) break;
#pragma unroll
        for (int a = 0; a < 2; ++a)
#pragma unroll
            for (int b = 0; b < 2; ++b)
#pragma unroll
                for (int m = 0; m < 4; ++m)
#pragma unroll
                    for (int n = 0; n < 2; ++n) acc[a][b][m][n] = (f32x4){0.f, 0.f, 0.f, 0.f};
        cur = nxt; cA = nA; cB = nB; ++ui;
    }
    PG8_WAIT_V(0);
    if (wr == 0) PG8_BAR;
    PG8_BAR;
    if constexpr (Epi::AFTER_DRAIN) { E.fused(acc, cur, wr, wc, fr, fq, lds, wid, lane); S.done(cur); }
    PG8_STAMP();
    if (STAMP && wid == 0) { stamps[lane] = lane < nts ? (((unsigned long long)(unsigned)ts_hi << 32) | (unsigned)ts_lo) : 0ull;
        if (lane == 62) stamps[62] = rt_entry; if (lane == 63) stamps[63] = (unsigned long long)wall_clock64(); }
#undef PG8_STAMP
#undef PG8_SA
#undef PG8_SB
#undef PG8_STAGE
#undef PG8_LDA
#undef PG8_LDB
#undef PG8_MMA
#undef PG8_WAIT_V
#undef PG8_WAIT_L
#undef PG8_BAR
#undef PG8_SCHED
}
}


struct EpiBf16 {
  static constexpr bool PERM = true, AFTER_DRAIN = false;
  u16* O; int ldc;
  DI void operator()(const f32x4 (&acc)[2][2][4][2], const pg8::Unit& u, int wr, int wc, int fr, int fq) const {
    const int row0 = u.pm * 256 + wr * 64 + fr, col0 = u.pn * 256 + wc * 32 + 8 * fq;
#pragma unroll
    for (int ai = 0; ai < 2; ++ai)
#pragma unroll
      for (int m = 0; m < 4; ++m) {
        u16* rowp = O + (size_t)(row0 + ai * 128 + m * 16) * ldc + col0;
#pragma unroll
        for (int bj = 0; bj < 2; ++bj) {
          f32x4 v0 = acc[ai][bj][m][0], v1 = acc[ai][bj][m][1];
          u32x4 w = {pack2(v0[0], v0[1]), pack2(v0[2], v0[3]), pack2(v1[0], v1[1]), pack2(v1[2], v1[3])};
          *(u32x4*)(rowp + bj * 128) = w;
        }
      }
  }
};
struct EpiResid {
  static constexpr bool PERM = false, AFTER_DRAIN = false;
  const float* xa; const float* xb; const float* gate; float* out;
  DI void operator()(const f32x4 (&acc)[2][2][4][2], const pg8::Unit& u, int wr, int wc, int fr, int fq) const {
    const int row0 = u.pm * 256 + wr * 64 + fr, col0 = u.pn * 256 + wc * 32 + 4 * fq;
#pragma unroll
    for (int ai = 0; ai < 2; ++ai)
#pragma unroll
      for (int m = 0; m < 4; ++m) {
        const int row = row0 + ai * 128 + m * 16;
        const float* xr = (row < NCTX) ? xa + (size_t)row * D : xb + (size_t)(row - NCTX) * D;
        const float* gr = gate + (size_t)tok_modrow(row) * 6144;
        float* orow = out + (size_t)row * D;
#pragma unroll
        for (int bj = 0; bj < 2; ++bj)
#pragma unroll
          for (int n = 0; n < 2; ++n) {
            const int col = col0 + bj * 128 + n * 16;
            f32x4 xv = *(const f32x4*)(xr + col);
            f32x4 gv = *(const f32x4*)(gr + col);
            *(f32x4*)(orow + col) = xv + gv * acc[ai][bj][m][n];
          }
      }
  }
};

template <class Epi>
DI void gemm_run(PG8_LAS unsigned char* lds, const u16* A, int lda, const u16* Bt, int M, int N, int K, const Epi& e) {
  pg8::Gemm g{A, Bt, M, N, K, lda};
  pg8::StaticOrder S; S.init(M, N, (int)gridDim.x, (int)blockIdx.x);
#pragma unroll 1
  for (int rep = 0; rep < (Epi::PERM ? REP_G : 1); ++rep) {
    __syncthreads();
    pg8::gemm_phase<Epi, pg8::StaticOrder, false>(lds, g, S, e, nullptr);
    __syncthreads();
  }
}

DI void phase_qknorm0(const Params& p) {
  const int t = TID(), wave = t >> 6, lane = t & 63, l15 = lane & 15;
  u16* QKVG = (u16*)(p.ws + OFF_BIG);
  u16* KA = (u16*)(p.ws + OFF_KA_ALL);
  u16* VA = (u16*)(p.ws + OFF_VA_ALL);
  const float* tab = (const float*)(p.ws + OFF_ROPE0);
  float gq[8], gk[8];
#pragma unroll
  for (int j = 0; j < 8; ++j) { gq[j] = p.l0_qn[l15 * 8 + j]; gk[j] = p.l0_kn[l15 * 8 + j]; }
  const bool hi = (l15 & 4) != 0;
  const bool colrot = l15 >= 8;
  const int f0 = (l15 & 3) * 8;
  for (int it = blockIdx.x; it < NTOK / NW; it += gridDim.x) {
    const int tk = it * NW + wave;
    u16* base = QKVG + (size_t)tk * L0_IN;
    const bool lat = tk >= NCTX;
    const int lt = tk - NCTX, b = lt >> 10, tt = lt & 1023;
    u32x4 v[3];
#pragma unroll
    for (int ps = 0; ps < 3; ++ps) v[ps] = *(const u32x4*)(base + (ps * 64 + lane) * 8);
    u32x4 kb[2], vb[2];
    if (!lat) {
#pragma unroll
      for (int q = 0; q < 2; ++q) { kb[q] = *(const u32x4*)(base + 2560 + (q * 64 + lane) * 8); vb[q] = *(const u32x4*)(base + 3584 + (q * 64 + lane) * 8); }
    }
    float cs[8], sn[8];
    if (lat) {
      const int pos = colrot ? (tt & 63) : (tt >> 6);
      const float4* tp = (const float4*)(tab + (pos * 32 + f0) * 2);
#pragma unroll
      for (int j2 = 0; j2 < 4; ++j2) { float4 c = tp[j2]; cs[2 * j2] = c.x; sn[2 * j2] = c.y; cs[2 * j2 + 1] = c.z; sn[2 * j2 + 1] = c.w; }
    } else {
#pragma unroll
      for (int j = 0; j < 8; ++j) { cs[j] = 1.f; sn[j] = 0.f; }
    }
    const size_t arow = (size_t)b * 1536 + 512 + tt;
#pragma unroll
    for (int ps = 0; ps < 3; ++ps) {
      float x[8];
#pragma unroll
      for (int j = 0; j < 4; ++j) { x[2 * j] = bflo(v[ps][j]); x[2 * j + 1] = bfhi(v[ps][j]); }
      float ss = 0.f;
#pragma unroll
      for (int j = 0; j < 8; ++j) ss += x[j] * x[j];
      ss += __shfl_xor(ss, 8); ss += __shfl_xor(ss, 4); ss += __shfl_xor(ss, 2); ss += __shfl_xor(ss, 1);
      const float rinv = rsqrtf(ss * (1.f / 128.f) + EPS);
      float o[8];
#pragma unroll
      for (int j = 0; j < 8; ++j) {
        const float y = x[j] * rinv * (ps < 2 ? gq[j] : gk[j]);
        const float pr = __shfl_xor(y, 4);
        o[j] = hi ? (y * cs[j] + pr * sn[j]) : (y * cs[j] - pr * sn[j]);
      }
      if (ps < 2) {
        u32x4 w = {pack2(o[0], o[1]), pack2(o[2], o[3]), pack2(o[4], o[5]), pack2(o[6], o[7])};
        *(u32x4*)(base + (ps * 64 + lane) * 8) = w;
      } else if (lane < 32) {
        u32x4 w = {pack2(o[0], o[1]), pack2(o[2], o[3]), pack2(o[4], o[5]), pack2(o[6], o[7])};
        if (!lat) {
          *(u32x4*)(base + 1024 + lane * 8) = w;
          float* op = p.out + OUT_NAK + (size_t)tk * 256 + lane * 8;
          *(float4*)op = make_float4(o[0], o[1], o[2], o[3]);
          *(float4*)(op + 4) = make_float4(o[4], o[5], o[6], o[7]);
        } else *(u32x4*)(KA + arow * 256 + lane * 8) = w;
      } else {
        if (!lat) {
          float* op = p.out + OUT_NAV + (size_t)tk * 256 + (lane - 32) * 8;
          *(float4*)op = make_float4(x[0], x[1], x[2], x[3]);
          *(float4*)(op + 4) = make_float4(x[4], x[5], x[6], x[7]);
        } else *(u32x4*)(VA + arow * 256 + (lane - 32) * 8) = v[2];
      }
    }
    if (!lat) {
#pragma unroll
      for (int q = 0; q < 2; ++q) {
        float* ok = p.out + OUT_NBK + (size_t)tk * 1024 + (q * 64 + lane) * 8;
        float* ov = p.out + OUT_NBV + (size_t)tk * 1024 + (q * 64 + lane) * 8;
        *(float4*)ok = make_float4(bflo(kb[q][0]), bfhi(kb[q][0]), bflo(kb[q][1]), bfhi(kb[q][1]));
        *(float4*)(ok + 4) = make_float4(bflo(kb[q][2]), bfhi(kb[q][2]), bflo(kb[q][3]), bfhi(kb[q][3]));
        *(float4*)ov = make_float4(bflo(vb[q][0]), bfhi(vb[q][0]), bflo(vb[q][1]), bfhi(vb[q][1]));
        *(float4*)(ov + 4) = make_float4(bflo(vb[q][2]), bfhi(vb[q][2]), bflo(vb[q][3]), bfhi(vb[q][3]));
      }
    }
  }
}

DI void phase_norm1(const Params& p) {
  const int wave = TID() >> 6, lane = TID() & 63;
  const u16* LAT1 = (const u16*)(p.ws + OFF_LAT1);
  u16* QN = (u16*)(p.ws + OFF_QN);
  u16* CKVC = (u16*)(p.ws + OFF_CKV_CTX);
  u16* KRC = (u16*)(p.ws + OFF_KR_CTX);
  u16* CKVA = (u16*)(p.ws + OFF_CKV_ALL);
  u16* KRA = (u16*)(p.ws + OFF_KR_ALL);
  float gq[8], gk[8];
#pragma unroll
  for (int j = 0; j < 8; ++j) { gq[j] = p.l1_qan[lane * 8 + j]; gk[j] = p.l1_kvan[lane * 8 + j]; }
  const int ri = lane & 15, rhalf = (lane >> 4) & 1;
  const int rd1 = rhalf * 32 + ri, rd2 = rd1 + 16;
  const float inv = exp2f(-(float)ri * (LOG2_THETA / 16.f));
  for (int it = blockIdx.x; it < NTOK / NW; it += gridDim.x) {
    int tk = it * NW + wave;
    const u16* base = LAT1 + (size_t)tk * L1_LD;
    const bool lat = tk >= NCTX;
    int lt = tk - NCTX, b = lt >> 10, tt = lt & 1023;
    size_t arow = (size_t)b * 1536 + 512 + tt;
#pragma unroll
    for (int part = 0; part < 2; ++part) {
      uint4 v = *(const uint4*)(base + part * 512 + lane * 8);
      float x[8] = {bflo(v.x), bfhi(v.x), bflo(v.y), bfhi(v.y), bflo(v.z), bfhi(v.z), bflo(v.w), bfhi(v.w)};
      float ss = 0.f;
#pragma unroll
      for (int j = 0; j < 8; ++j) ss += x[j] * x[j];
      ss = wave_sum(ss);
      float rinv = rsqrtf(ss * (1.f / 512.f) + EPS);
#pragma unroll
      for (int j = 0; j < 8; ++j) x[j] = x[j] * rinv * (part ? gk[j] : gq[j]);
      uint4 o = make_uint4(pack2(x[0], x[1]), pack2(x[2], x[3]), pack2(x[4], x[5]), pack2(x[6], x[7]));
      if (part == 0) *(uint4*)(QN + (size_t)tk * 512 + lane * 8) = o;
      else if (!lat) {
        *(uint4*)(CKVC + (size_t)tk * 512 + lane * 8) = o;
        float* op = p.out + OUT_NCKV + (size_t)tk * 512 + lane * 8;
        *(float4*)op = make_float4(x[0], x[1], x[2], x[3]);
        *(float4*)(op + 4) = make_float4(x[4], x[5], x[6], x[7]);
      } else *(uint4*)(CKVA + arow * 512 + lane * 8) = o;
    }
    if (lane < 32) {
      float x1 = bf2f(base[1024 + rd1]), x2 = bf2f(base[1024 + rd2]);
      if (!lat) {
        KRC[(size_t)tk * 64 + rd1] = f2bf(x1); KRC[(size_t)tk * 64 + rd2] = f2bf(x2);
        p.out[OUT_NKR + (size_t)tk * 64 + rd1] = x1; p.out[OUT_NKR + (size_t)tk * 64 + rd2] = x2;
      } else {
        float pos = rhalf ? (float)(tt & 63) : (float)(tt >> 6);
        float sn, cs; sincosf(pos * inv, &sn, &cs);
        KRA[arow * 64 + rd1] = f2bf(x1 * cs - x2 * sn);
        KRA[arow * 64 + rd2] = f2bf(x2 * cs + x1 * sn);
      }
    }
  }
}

DI void phase_final(const Params& p) {
  const int wave = TID() >> 6, lane = TID() & 63;
  for (int it = blockIdx.x; it < NTOK / NW; it += gridDim.x) {
    int row = it * NW + wave;
    float* y = p.out + OUT_Y + (size_t)row * D;
    float4 v[8];
    float ss = 0.f;
#pragma unroll
    for (int i = 0; i < 8; ++i) {
      v[i] = *(const float4*)(y + (i * 64 + lane) * 4);
      ss += v[i].x * v[i].x + v[i].y * v[i].y + v[i].z * v[i].z + v[i].w * v[i].w;
    }
    ss = wave_sum(ss);
    float rinv = rsqrtf(ss * (1.f / D) + EPS);
#pragma unroll
    for (int i = 0; i < 8; ++i) {
      int col = (i * 64 + lane) * 4;
      float4 gg = *(const float4*)(p.fnorm + col);
      *(float4*)(y + col) = make_float4(v[i].x * rinv * gg.x, v[i].y * rinv * gg.y, v[i].z * rinv * gg.z, v[i].w * rinv * gg.w);
    }
  }
}

struct KVSeg { const u16* k; const u16* v; const u16* kr; int ks, vs, n; };
struct AttnArgs {
  const u16* q; int qs;
  KVSeg seg[2]; int nseg;
  const u16* gate; int gs;
  u16* out; int os;
  float scale_log2;
  const float* rpb;
  int qtok0;
  int rs0;
  int rope;
  const float* ropetab;
};

template <int DQK, int MODE>
DI void attn_load_tile(const AttnArgs& a, int tile, int nt0, u32x4 (&rk)[DQK / 64], u32x4 (&rv)[2]) {
  const int t = TID();
  const int sg = tile >= nt0 ? 1 : 0;
  const int off = (sg ? tile - nt0 : tile) * 64;
  const u16* kp = sg ? a.seg[1].k : a.seg[0].k;
  const u16* vp = sg ? a.seg[1].v : a.seg[0].v;
  const int ks = sg ? a.seg[1].ks : a.seg[0].ks;
  const int vs = sg ? a.seg[1].vs : a.seg[0].vs;
  const int r0 = t >> 4, c0 = (t & 15) * 8;
#pragma unroll
  for (int i = 0; i < 2; ++i) {
    rk[i] = *(const u32x4*)(kp + (unsigned)((off + r0 + 32 * i) * ks + c0));
    rv[i] = *(const u32x4*)(vp + (unsigned)((off + r0 + 32 * i) * vs + c0));
  }
  if constexpr (MODE == 2) {
    const u16* krp = sg ? a.seg[1].kr : a.seg[0].kr;
    rk[2] = *(const u32x4*)(krp + (unsigned)((off + (t >> 3)) * 64 + (t & 7) * 8));
  }
}

template <int DQK, int MODE>
DI void attn_block(const AttnArgs& a, char* smem) {
  constexpr int KLD = DQK + 8;
  constexpr int VLD = 128 + 16;
  constexpr int KCH = DQK / 64;
  constexpr int NS = DQK / 16;
  u16* Ks = (u16*)smem;
  u16* Vs = Ks + 64 * KLD;
  float* bias_s = (float*)(Vs + 64 * VLD);
  const int t = TID(), wave = t >> 6, lane = t & 63, l31 = lane & 31, h = lane >> 5;

  __syncthreads();
  if constexpr (MODE == 1) {
    for (int e = t; e < 15 * 31; e += NT) bias_s[e] = a.rpb[e] * LOG2E;
  }
  bf16x8 qf[NS];
  {
    const u16* qp = a.q + (size_t)(wave * 32 + l31) * a.qs + 8 * h;
#pragma unroll
    for (int s = 0; s < NS; ++s) qf[s] = *(const bf16x8*)(qp + 16 * s);
  }
  const int qtok = a.qtok0 + wave * 32 + l31;
  if constexpr (MODE == 2) {
    if (a.rope) {
      const int qr = qtok >> 6, qc = qtok & 63;
#pragma unroll
      for (int pr = 0; pr < 2; ++pr) {
        const float4* tb = (const float4*)(a.ropetab + ((pr ? qc : qr) * 16 + 8 * h) * 2);
#pragma unroll
        for (int j2 = 0; j2 < 4; ++j2) {
          float4 cssn = tb[j2];
#pragma unroll
          for (int e = 0; e < 2; ++e) {
            const int j = 2 * j2 + e;
            float cs = e ? cssn.z : cssn.x, sn = e ? cssn.w : cssn.y;
            float x1 = bf2f((u16)qf[8 + 2 * pr][j]), x2 = bf2f((u16)qf[9 + 2 * pr][j]);
            qf[8 + 2 * pr][j] = (short)f2bf(x1 * cs - x2 * sn);
            qf[9 + 2 * pr][j] = (short)f2bf(x2 * cs + x1 * sn);
          }
        }
      }
    }
  }
  f32x16 acc[4];
#pragma unroll
  for (int c = 0; c < 4; ++c)
#pragma unroll
    for (int r = 0; r < 16; ++r) acc[c][r] = 0.f;
  float m_run = -1e30f, l_run = 0.f;

  int ntiles = 0;
  for (int s = 0; s < a.nseg; ++s) ntiles += a.seg[s].n >> 6;
  const int nt0 = a.seg[0].n >> 6;

  u32x4 rk[KCH], rv[2];
  attn_load_tile<DQK, MODE>(a, 0, nt0, rk, rv);

  const int blk = (lane >> 4) & 1, tq = (lane & 15) >> 2, tp = lane & 3;
  const int qrow = qtok >> 6, qcol = qtok & 63;
  int q_rs = qrow - 4; q_rs = q_rs < 0 ? 0 : (q_rs > 8 ? 8 : q_rs);
  int q_cs = qcol - 8; q_cs = q_cs < 0 ? 0 : (q_cs > 48 ? 48 : q_cs);

  for (int tile = 0; tile < ntiles; ++tile) {
    __syncthreads();
#pragma unroll
    for (int i = 0; i < 2; ++i) {
      *(u32x4*)(Ks + ((t >> 4) + 32 * i) * KLD + (t & 15) * 8) = rk[i];
      *(u32x4*)(Vs + ((t >> 4) + 32 * i) * VLD + (t & 15) * 8) = rv[i];
    }
    if constexpr (MODE == 2) {
      *(u32x4*)(Ks + (t >> 3) * KLD + 128 + (t & 7) * 8) = rk[2];
    }
    __syncthreads();
    if (tile + 1 < ntiles) attn_load_tile<DQK, MODE>(a, tile + 1, nt0, rk, rv);

    const bool local = (MODE == 1) && (tile >= nt0);
    const int krow = a.rs0 + (tile - nt0);
#pragma unroll 1
    for (int mt = 0; mt < 2; ++mt) {
      f32x16 S;
#pragma unroll
      for (int r = 0; r < 16; ++r) S[r] = 0.f;
      const u16* kbase = Ks + (mt * 32 + l31) * KLD + 8 * h;
#pragma unroll
      for (int s = 0; s < NS; ++s) {
        bf16x8 kf = *(const bf16x8*)(kbase + 16 * s);
        S = MFMA32(kf, qf[s], S);
        if ((s & 3) == 3) __builtin_amdgcn_sched_barrier(0);
      }
      float mx = -1e30f;
#pragma unroll
      for (int r = 0; r < 16; ++r) {
        float sv = S[r] * a.scale_log2;
        if (MODE == 1) {
          if (local) {
            int kcol = mt * 32 + crow(r, h);
            bool ok = (krow >= q_rs) && (krow < q_rs + 8) && (kcol >= q_cs) && (kcol < q_cs + 16);
            int dy = krow - qrow + 7, dx = kcol - qcol + 15;
            dy = dy < 0 ? 0 : (dy > 14 ? 14 : dy);
            dx = dx < 0 ? 0 : (dx > 30 ? 30 : dx);
            sv = ok ? sv + bias_s[dy * 31 + dx] : -1e30f;
          }
        }
        S[r] = sv;
        mx = fmaxf(mx, sv);
      }
      mx = fmaxf(mx, __shfl_xor(mx, 32));
      const float m_new = fmaxf(m_run, mx);
      const float alpha = exp2f(m_run - m_new);
      m_run = m_new;
      float ps = 0.f;
#pragma unroll
      for (int r = 0; r < 16; ++r) {
        float pv = exp2f(S[r] - m_new);
        if (MODE == 1) { if (S[r] <= -1e29f) pv = 0.f; }
        S[r] = pv;
        ps += pv;
      }
      l_run = l_run * alpha + ps;
#pragma unroll
      for (int c = 0; c < 4; ++c)
#pragma unroll
        for (int r = 0; r < 16; ++r) acc[c][r] *= alpha;
      bf16x8 pf[2];
#pragma unroll
      for (int s2 = 0; s2 < 2; ++s2) {
        u32x4 u;
        u[0] = pack2(S[8 * s2 + 0], S[8 * s2 + 1]);
        u[1] = pack2(S[8 * s2 + 2], S[8 * s2 + 3]);
        u[2] = pack2(S[8 * s2 + 4], S[8 * s2 + 5]);
        u[3] = pack2(S[8 * s2 + 6], S[8 * s2 + 7]);
        pf[s2] = __builtin_bit_cast(bf16x8, u);
      }
      const u16* vbase = Vs + (mt * 32 + 4 * h + tq) * VLD + 16 * blk + 4 * tp;
#pragma unroll
      for (int c = 0; c < 4; ++c)
#pragma unroll
        for (int s2 = 0; s2 < 2; ++s2) {
          const u16* vp = vbase + (16 * s2) * VLD + 32 * c;
          s16x4 lo = __builtin_amdgcn_ds_read_tr16_b64_v4i16((LDS_AS(s16x4)*)(vp));
          s16x4 hi = __builtin_amdgcn_ds_read_tr16_b64_v4i16((LDS_AS(s16x4)*)(vp + 8 * VLD));
          bf16x8 vf = __builtin_shufflevector(lo, hi, 0, 1, 2, 3, 4, 5, 6, 7);
          acc[c] = MFMA32(vf, pf[s2], acc[c]);
          if (s2 == 1 && (c & 1)) __builtin_amdgcn_sched_barrier(0);
        }
    }
  }
  float l_tot = l_run + __shfl_xor(l_run, 32);
  float linv = 1.f / l_tot;
  const size_t qrow_i = (size_t)(wave * 32 + l31);
#pragma unroll
  for (int c = 0; c < 4; ++c)
#pragma unroll
    for (int g4 = 0; g4 < 4; ++g4) {
      int dv0 = 32 * c + 8 * g4 + 4 * h;
      uint2 gt = *(const uint2*)(a.gate + qrow_i * a.gs + dv0);
      float o0 = acc[c][4 * g4 + 0] * linv * silu(bflo(gt.x));
      float o1 = acc[c][4 * g4 + 1] * linv * silu(bfhi(gt.x));
      float o2 = acc[c][4 * g4 + 2] * linv * silu(bflo(gt.y));
      float o3 = acc[c][4 * g4 + 3] * linv * silu(bfhi(gt.y));
      *(uint2*)(a.out + qrow_i * a.os + dv0) = make_uint2(pack2(o0, o1), pack2(o2, o3));
    }
}

DI void phase_attn0(const Params& p, char* smem) {
  const u16* QKVG = (const u16*)(p.ws + OFF_BIG);
  u16* OG = (u16*)(p.ws + OFF_H);
  const u16* KA = (const u16*)(p.ws + OFF_KA_ALL);
  const u16* VA = (const u16*)(p.ws + OFF_VA_ALL);
  const u16* KBC = (const u16*)(p.ws + OFF_KB_CTX);
  const u16* VBC = (const u16*)(p.ws + OFF_VB_CTX);
  const float sc = 0.08838834764831845f * LOG2E;
  for (int it = blockIdx.x; it < 1024; it += gridDim.x) {
    AttnArgs a;
    a.qs = L0_IN; a.gs = L0_IN; a.os = D; a.scale_log2 = sc; a.rpb = nullptr; a.qtok0 = 0; a.rs0 = 0; a.rope = 0; a.ropetab = nullptr;
    a.seg[1].k = nullptr; a.seg[1].v = nullptr; a.seg[1].kr = nullptr; a.seg[1].ks = 0; a.seg[1].vs = 0; a.seg[1].n = 0;
    a.seg[0].kr = nullptr;
    if (it >= 256 && it < 512) {
      int i = it - 256;
      int b = i >> 5, hh = (i >> 2) & 7, qb = i & 3;
      size_t tok = (size_t)NCTX + b * 1024 + qb * 256;
      a.q = QKVG + tok * L0_IN + 1536 + hh * 128;
      a.gate = QKVG + tok * L0_IN + 4608 + 1024 + hh * 128;
      a.out = OG + tok * D + 1024 + hh * 128;
      a.nseg = 2;
      a.seg[0].k = KBC + (size_t)b * 512 * 1024 + hh * 128; a.seg[0].ks = 1024;
      a.seg[0].v = VBC + (size_t)b * 512 * 1024 + hh * 128; a.seg[0].vs = 1024;
      a.seg[0].n = 512;
      int rs0 = 4 * qb - 4; rs0 = rs0 < 0 ? 0 : (rs0 > 8 ? 8 : rs0);
      int rs1 = 4 * qb - 1; rs1 = rs1 < 0 ? 0 : (rs1 > 8 ? 8 : rs1);
      int nrows = rs1 + 8 - rs0;
      size_t ktok = (size_t)NCTX + b * 1024 + rs0 * 64;
      a.seg[1].k = QKVG + ktok * L0_IN + 2560 + hh * 128; a.seg[1].ks = L0_IN;
      a.seg[1].v = QKVG + ktok * L0_IN + 3584 + hh * 128; a.seg[1].vs = L0_IN;
      a.seg[1].n = nrows * 64;
      a.rpb = p.l0_rpb + hh * 15 * 31;
      a.qtok0 = qb * 256; a.rs0 = rs0;
      attn_block<128, 1>(a, smem);
    } else {
      a.nseg = 1;
      if (it < 256) {
        int b = it >> 5, hq = (it >> 2) & 7, qb = it & 3;
        size_t tok = (size_t)NCTX + b * 1024 + qb * 256;
        a.q = QKVG + tok * L0_IN + hq * 128;
        a.gate = QKVG + tok * L0_IN + 4608 + hq * 128;
        a.out = OG + tok * D + hq * 128;
        a.seg[0].k = KA + (size_t)b * 1536 * 256 + (hq >> 2) * 128; a.seg[0].ks = 256;
        a.seg[0].v = VA + (size_t)b * 1536 * 256 + (hq >> 2) * 128; a.seg[0].vs = 256;
        a.seg[0].n = 1536;
      } else {
        int i = it - 512;
        bool isB = i >= 256; i &= 255;
        int b = i >> 3, hh = i & 7;
        size_t tok = (size_t)b * 256;
        a.seg[0].n = 256; a.seg[0].ks = L0_IN; a.seg[0].vs = L0_IN;
        if (!isB) {
          a.q = QKVG + tok * L0_IN + hh * 128;
          a.gate = QKVG + tok * L0_IN + 4608 + hh * 128;
          a.out = OG + tok * D + hh * 128;
          a.seg[0].k = QKVG + tok * L0_IN + 1024 + (hh >> 2) * 128;
          a.seg[0].v = QKVG + tok * L0_IN + 1280 + (hh >> 2) * 128;
        } else {
          a.q = QKVG + tok * L0_IN + 1536 + hh * 128;
          a.gate = QKVG + tok * L0_IN + 4608 + 1024 + hh * 128;
          a.out = OG + tok * D + 1024 + hh * 128;
          a.seg[0].k = QKVG + tok * L0_IN + 2560 + hh * 128;
          a.seg[0].v = QKVG + tok * L0_IN + 3584 + hh * 128;
        }
      }
      attn_block<128, 0>(a, smem);
    }
  }
}

DI void phase_attn1(const Params& p, char* smem, int round) {
  const u16* Q1 = (const u16*)(p.ws + OFF_Q1);
  u16* LAT1 = (u16*)(p.ws + OFF_LAT1);
  const float sc = 0.07216878364870322f * LOG2E;
  for (int it = blockIdx.x; it < 512; it += gridDim.x) {
    AttnArgs a;
    a.qs = 3072; a.gs = L1_LD; a.os = L1_LD; a.scale_log2 = sc; a.rpb = nullptr; a.rs0 = 0; a.ropetab = (const float*)(p.ws + OFF_ROPE);
    a.seg[1].k = nullptr; a.seg[1].v = nullptr; a.seg[1].kr = nullptr; a.seg[1].ks = 0; a.seg[1].vs = 0; a.seg[1].n = 0;
    a.nseg = 1;
    a.seg[0].ks = 4096; a.seg[0].vs = 4096;
    size_t tok;
    int hh;
    if (round == 0) {
      int b = it >> 4; hh = it & 15;
      tok = (size_t)b * 256;
      const u16* KV = (const u16*)(p.ws + OFF_KV_CTX) + (size_t)b * 256 * 4096 + hh * 256;
      a.seg[0].k = KV; a.seg[0].v = KV + 128;
      a.seg[0].kr = (const u16*)(p.ws + OFF_KR_CTX) + (size_t)b * 256 * 64;
      a.seg[0].n = 256;
      a.rope = 0; a.qtok0 = 0;
    } else {
      int b = it >> 6, qb = it & 3; hh = (it >> 2) & 15;
      tok = (size_t)NCTX + b * 1024 + qb * 256;
      const u16* KV = (const u16*)(p.ws + OFF_KV_LAT) + (size_t)b * 1536 * 4096 + hh * 256;
      a.seg[0].k = KV; a.seg[0].v = KV + 128;
      a.seg[0].kr = (const u16*)(p.ws + OFF_KR_ALL) + (size_t)b * 1536 * 64;
      a.seg[0].n = 1536;
      a.rope = 1; a.qtok0 = qb * 256;
    }
    a.q = Q1 + tok * 3072 + hh * 192;
    a.gate = LAT1 + tok * L1_LD + 1088 + hh * 128;
    a.out = LAT1 + tok * L1_LD + 1088 + hh * 128;
    attn_block<192, 2>(a, smem);
  }
}

#define XB_TMO      128
#define XB_XCNT(j)  (256  + 64 * (j))
#define XB_XSUB(j)  (1280 + 64 * (j))
#define XB_XGEN(j)  (2304 + 64 * (j))
#define XB_TOP      3328
#define XB_TOPGEN   3392
#define XCD_BAR_WORDS 3456
#define XB_SPIN_CAP (1u << 18)
#define XLAS __attribute__((address_space(3)))

__device__ __forceinline__ unsigned xb_ld(unsigned* p)              { return __hip_atomic_load(p, __ATOMIC_RELAXED, __HIP_MEMORY_SCOPE_AGENT); }
__device__ __forceinline__ unsigned xb_add(unsigned* p, unsigned v) { return __hip_atomic_fetch_add(p, v, __ATOMIC_RELAXED, __HIP_MEMORY_SCOPE_AGENT); }
__device__ __forceinline__ unsigned xb_xcc_id() { return (unsigned)__builtin_amdgcn_s_getreg((3 << 11) | 20) & 0xFu; }
#define XB_SPIN(cond, bar) do { unsigned _sp = 0; while (cond) { __builtin_amdgcn_s_sleep(1); \
    if ((++_sp & 255u) == 0u) { if (xb_ld(&(bar)[XB_TMO])) break; if (_sp > XB_SPIN_CAP) { atomicAdd(&(bar)[XB_TMO], 1u); break; } } } } while (0)

struct XcdBarrier {
    unsigned* bar; unsigned x;
    volatile XLAS unsigned* st;
};

__device__ __forceinline__ XcdBarrier xcd_barrier_post(unsigned* bar, volatile XLAS unsigned* st) {
    XcdBarrier b; b.bar = bar; b.x = xb_xcc_id(); b.st = st;
    if (threadIdx.x == 0) (void)xb_add(&bar[XB_XCNT(b.x)], 1u);
    return b;
}
__device__ __forceinline__ void xcd_barrier_complete(unsigned* bar, unsigned x, unsigned& nloc, unsigned& nx) {
    const unsigned G = gridDim.x * gridDim.y * gridDim.z;
    unsigned sum, cnt, mine, sp = 0u;
    for (;;) {
        sum = 0u; cnt = 0u; mine = 0u;
#pragma unroll
        for (unsigned j = 0; j < 16; ++j) { const unsigned c = xb_ld(&bar[XB_XCNT(j)]); sum += c; cnt += (c > 0u) ? 1u : 0u; mine = (j == x) ? c : mine; }
        if (sum == G) break;
        __builtin_amdgcn_s_sleep(1);
        if ((++sp & 255u) == 0u) { if (xb_ld(&bar[XB_TMO])) break; if (sp > XB_SPIN_CAP) { atomicAdd(&bar[XB_TMO], 1u); break; } }
    }
    nloc = mine > 0u ? mine : 1u; nx = cnt > 0u ? cnt : 1u;
}

__device__ __forceinline__ void xcd_barrier(const XcdBarrier& b) {
    asm volatile("s_waitcnt vmcnt(0)" ::: "memory");
    __syncthreads();
    if (threadIdx.x == 0) {
        unsigned* bar = b.bar;
        __builtin_amdgcn_s_waitcnt(0);
        unsigned nloc = b.st[0], nx = b.st[1];
        if (nloc == 0u) { xcd_barrier_complete(bar, b.x, nloc, nx); b.st[0] = nloc; b.st[1] = nx; }
        const unsigned old = xb_add(&bar[XB_XSUB(b.x)], 1u);
        const unsigned gen = old / nloc;
        if (old + 1u == (gen + 1u) * nloc) {
            __builtin_amdgcn_fence(__ATOMIC_RELEASE, "agent");
            asm volatile("s_waitcnt vmcnt(0)" ::: "memory");
            const unsigned og = xb_add(&bar[XB_TOP], 1u);
            const unsigned tg = og / nx;
            if (og + 1u == (tg + 1u) * nx) xb_add(&bar[XB_TOPGEN], 1u);
            else XB_SPIN(xb_ld(&bar[XB_TOPGEN]) == tg, bar);
            __builtin_amdgcn_fence(__ATOMIC_ACQUIRE, "agent");
            xb_add(&bar[XB_XGEN(b.x)], 1u);
            asm volatile("s_waitcnt vmcnt(0)" ::: "memory");
        } else {
            XB_SPIN(xb_ld(&bar[XB_XGEN(b.x)]) == gen, bar);
            __builtin_amdgcn_fence(__ATOMIC_ACQUIRE, "agent");
            asm volatile("s_waitcnt vmcnt(0)" ::: "memory");
        }
    }
    __syncthreads();
}

__global__ void __launch_bounds__(512, 2) fwd_megakernel(Params p) {
  cg::grid_group grid = cg::this_grid();
  extern __shared__ __attribute__((aligned(16))) unsigned char dsm[];
  char* smem = (char*)dsm;
  char* ws = p.ws;
  const float* mod0 = (const float*)(ws + OFF_MOD);
  const float* mod1 = mod0 + 9 * 6144;

  volatile XLAS unsigned* xst = (volatile XLAS unsigned*)((XLAS unsigned char*)dsm + 128 * 1024);
  if (threadIdx.x < 4) xst[threadIdx.x] = 0u;
  __syncthreads();
  const XcdBarrier xb = xcd_barrier_post((unsigned*)(ws + OFF_BAR), xst);
  phase_prep(p, smem);
  grid.sync();
  phase_normmod(p, 0);
  xcd_barrier(xb);
  { EpiBf16 e{(u16*)(ws + OFF_BIG), L0_IN};
    gemm_run((PG8_LAS unsigned char*)dsm, (const u16*)(ws + OFF_H), D, (const u16*)(ws + OFF_WT_IN0), NTOK, L0_IN, 2048, e); }
  if (gridDim.x == 256) { if (blockIdx.x >= 128 && blockIdx.x < 224) adaln_item(p, 1, blockIdx.x - 128, (float*)smem); }
  else { for (int c = blockIdx.x; c < 96; c += gridDim.x) adaln_item(p, 1, c, (float*)smem); }
  xcd_barrier(xb);
  phase_qknorm0(p);
  xcd_barrier(xb);
#pragma unroll 1
  for (int rep = 0; rep < REP_A0; ++rep) phase_attn0(p, smem);
  xcd_barrier(xb);
  { EpiResid e{p.x_prompt, p.x_sample, mod0 + 4096, p.out + OUT_Y};
    gemm_run((PG8_LAS unsigned char*)dsm, (const u16*)(ws + OFF_H), D, (const u16*)(ws + OFF_WT_OUT0), NTOK, D, 2048, e); }
  xcd_barrier(xb);
  phase_normmod(p, 1);
  xcd_barrier(xb);
  { EpiBf16 e{(u16*)(ws + OFF_LAT1), L1_LD};
    gemm_run((PG8_LAS unsigned char*)dsm, (const u16*)(ws + OFF_H), D, (const u16*)(ws + OFF_WT_IN1), NTOK, L1_LD, 2048, e); }
  xcd_barrier(xb);
  phase_norm1(p);
  xcd_barrier(xb);
  { EpiBf16 e{(u16*)(ws + OFF_Q1), 3072};
    gemm_run((PG8_LAS unsigned char*)dsm, (const u16*)(ws + OFF_QN), 512, (const u16*)(ws + OFF_WT_QB), NTOK, 3072, 512, e); }
#pragma unroll 1
  for (int round = 0; round < 2; ++round) {
    { EpiBf16 e{(u16*)(ws + (round ? OFF_KV_LAT : OFF_KV_CTX)), 4096};
      gemm_run((PG8_LAS unsigned char*)dsm, (const u16*)(ws + (round ? OFF_CKV_ALL : OFF_CKV_CTX)), 512, (const u16*)(ws + OFF_WT_KVB),
               round ? 12288 : NCTX, 4096, 512, e); }
    xcd_barrier(xb);
    phase_attn1(p, smem, round);
    xcd_barrier(xb);
  }
  { EpiResid e{p.out + OUT_Y, p.out + OUT_Y + (size_t)NCTX * D, mod1 + 4096, p.out + OUT_Y};
    gemm_run((PG8_LAS unsigned char*)dsm, (const u16*)(ws + OFF_LAT1) + 1088, L1_LD, (const u16*)(ws + OFF_WT_OUT1), NTOK, D, 2048, e); }
  xcd_barrier(xb);
  phase_final(p);
}

extern "C" void kernel_launch(void* const* d_in, const int* in_sizes, int n_in, void* d_out, int out_size, void* d_ws,
                              size_t ws_size, hipStream_t stream) {
  (void)in_sizes; (void)n_in; (void)out_size;
  if (ws_size < WS_NEEDED) { fprintf(stderr, "workspace too small: %zu < %zu\n", ws_size, (size_t)WS_NEEDED); return; }
  static int grid_blocks = 0;
  if (!grid_blocks) {
    int dev = 0, cus = 0, per_cu = 0;
    (void)hipGetDevice(&dev);
    (void)hipDeviceGetAttribute(&cus, hipDeviceAttributeMultiprocessorCount, dev);
    if (hipFuncSetAttribute((const void*)fwd_megakernel, hipFuncAttributeMaxDynamicSharedMemorySize, SMEM_BYTES) != hipSuccess) {
      fprintf(stderr, "hipFuncSetAttribute failed\n"); return; }
    (void)hipOccupancyMaxActiveBlocksPerMultiprocessor(&per_cu, fwd_megakernel, NT, SMEM_BYTES);
    if (per_cu < 1) { fprintf(stderr, "occupancy query returned %d\n", per_cu); return; }
    grid_blocks = cus;
  }
  Params p{};
  const float** pf = (const float**)&p;
  for (int i = 0; i < 28; ++i) pf[i] = (const float*)d_in[i];
  p.out = (float*)d_out;
  p.ws = (char*)d_ws;
  (void)hipMemsetAsync((char*)d_ws + OFF_BAR, 0, BAR_BYTES, stream);
  void* args[] = {&p};
  hipError_t e = hipLaunchCooperativeKernel((void*)fwd_megakernel, dim3(grid_blocks), dim3(NT), args, SMEM_BYTES, stream);
  if (e != hipSuccess) fprintf(stderr, "cooperative launch failed: %s (grid %d)\n", hipGetErrorString(e), grid_blocks);
}
```

```cpp
#include <hip/hip_runtime.h>
#include <hip/hip_cooperative_groups.h>
#include <cstdio>
namespace cg = cooperative_groups;

typedef unsigned short u16;
using bf16x8 = __attribute__((ext_vector_type(8))) short;
using s16x4  = __attribute__((ext_vector_type(4))) short;
using f32x16 = __attribute__((ext_vector_type(16))) float;
using f32x4  = __attribute__((ext_vector_type(4))) float;
using u32x4  = __attribute__((ext_vector_type(4))) unsigned;
typedef __bf16 bf16x2_t __attribute__((ext_vector_type(2)));
typedef float f32x2_t __attribute__((ext_vector_type(2)));
#define DI __device__ __forceinline__
#define MFMA32(a, b, c) __builtin_amdgcn_mfma_f32_32x32x16_bf16((a), (b), (c), 0, 0, 0)
#define LDS_AS(T) __attribute__((address_space(3))) T

constexpr int D = 2048;
constexpr int NTOK = 16384;
constexpr int NCTX = 8192;
constexpr int L0_IN = 6656;
constexpr int L1_IN = 3136;
constexpr int L1_LD = 3328;
constexpr float EPS = 1e-6f;
constexpr float LOG2E = 1.4426950408889634f;
constexpr float LOG2_THETA = 13.287712379549449f;
#ifndef REP_G
#define REP_G 1
#endif
#ifndef REP_A0
#define REP_A0 1
#endif
constexpr int NT = 512;
constexpr int NW = 8;

constexpr size_t OFF_WT_IN1  = 0;
constexpr size_t OFF_WT_QB   = OFF_WT_IN1 + (size_t)3328 * 2048 * 2;
constexpr size_t OFF_WT_KVB  = OFF_WT_QB + (size_t)3072 * 512 * 2;
constexpr size_t OFF_WT_OUT1 = OFF_WT_KVB + (size_t)4096 * 512 * 2;
constexpr size_t OFF_WL0     = OFF_WT_OUT1 + (size_t)2048 * 2048 * 2;
constexpr size_t OFF_WT_IN0  = OFF_WL0;
constexpr size_t OFF_WT_OUT0 = OFF_WT_IN0 + (size_t)6656 * 2048 * 2;
constexpr size_t OFF_H       = OFF_WT_OUT0 + (size_t)2048 * 2048 * 2;
constexpr size_t OFF_BIG     = OFF_H + (size_t)NTOK * 2048 * 2;
constexpr size_t OFF_C       = OFF_BIG + (size_t)NTOK * 6656 * 2;
constexpr size_t OFF_KA_ALL  = OFF_C;
constexpr size_t OFF_VA_ALL  = OFF_KA_ALL + (size_t)8 * 1536 * 256 * 2;
constexpr size_t OFF_KB_CTX  = OFF_VA_ALL + (size_t)8 * 1536 * 256 * 2;
constexpr size_t OFF_VB_CTX  = OFF_KB_CTX + (size_t)8 * 512 * 1024 * 2;
constexpr size_t OFF_CKV_ALL = OFF_VB_CTX + (size_t)8 * 512 * 1024 * 2;
constexpr size_t OFF_KR_ALL  = OFF_CKV_ALL + (size_t)8 * 1536 * 512 * 2;
constexpr size_t OFF_MOD     = OFF_KR_ALL + (size_t)8 * 1536 * 64 * 2;
constexpr size_t OFF_ROPE    = OFF_MOD + (size_t)2 * 9 * 6144 * 4;
constexpr size_t OFF_ROPE0   = OFF_ROPE + (size_t)64 * 16 * 2 * 4;
constexpr size_t OFF_BAR     = OFF_ROPE0 + (size_t)64 * 32 * 2 * 4;
constexpr size_t BAR_BYTES   = 3456 * 4;
constexpr size_t WS_NEEDED   = OFF_BAR + BAR_BYTES;
constexpr size_t OFF_QN      = OFF_WL0;
constexpr size_t OFF_CKV_CTX = OFF_QN + (size_t)NTOK * 512 * 2;
constexpr size_t OFF_KR_CTX  = OFF_CKV_CTX + (size_t)NCTX * 512 * 2;
constexpr size_t OFF_KV_CTX  = OFF_H;
constexpr size_t OFF_KV_LAT  = OFF_WL0;
constexpr size_t OFF_LAT1    = OFF_BIG;
constexpr size_t OFF_Q1      = OFF_BIG + (size_t)NTOK * L1_LD * 2;
static_assert(OFF_KR_CTX + (size_t)NCTX * 64 * 2 <= OFF_WT_OUT0, "l1 small bufs overflow");
static_assert(OFF_KV_LAT + (size_t)12288 * 4096 * 2 <= OFF_BIG, "kv_lat overflow");
static_assert(OFF_Q1 + (size_t)NTOK * 3072 * 2 <= OFF_C, "q1 overflow");

constexpr size_t OUT_Y   = 0;
constexpr size_t OUT_NAK = (size_t)NTOK * 2048;
constexpr size_t OUT_NAV = OUT_NAK + (size_t)NCTX * 256;
constexpr size_t OUT_NBK = OUT_NAV + (size_t)NCTX * 256;
constexpr size_t OUT_NBV = OUT_NBK + (size_t)NCTX * 1024;
constexpr size_t OUT_NCKV = OUT_NBV + (size_t)NCTX * 1024;
constexpr size_t OUT_NKR = OUT_NCKV + (size_t)NCTX * 512;

constexpr int SMEM_BYTES = 128 * 1024 + 256;

struct Params {
  const float *x_prompt, *x_sample, *ca_k, *ca_v, *cb_k, *cb_v, *c_ckv, *c_kr, *c, *c_ctx;
  const float *l0_norm, *l0_ada_w, *l0_ada_b, *l0_w_in, *l0_qn, *l0_kn, *l0_rpb, *l0_w_out;
  const float *l1_norm, *l1_ada_w, *l1_ada_b, *l1_w_in, *l1_qan, *l1_wqb, *l1_kvan, *l1_wkvb, *l1_w_out, *fnorm;
  float* out;
  char* ws;
};

DI int threadIdx_x_raw() { return (int)__builtin_amdgcn_workitem_id_x(); }
DI u16 f2bf(float x) { unsigned u = __float_as_uint(x); u += 0x7fffu + ((u >> 16) & 1u); return (u16)(u >> 16); }
DI float bf2f(u16 v) { return __uint_as_float(((unsigned)v) << 16); }
DI unsigned pack2(float a, float b) { f32x2_t f = {a, b}; bf16x2_t r = __builtin_convertvector(f, bf16x2_t); return __builtin_bit_cast(unsigned, r); }
DI float bflo(unsigned u) { return __uint_as_float(u << 16); }
DI float bfhi(unsigned u) { return __uint_as_float(u & 0xffff0000u); }
DI float wave_sum(float v) {
#pragma unroll
  for (int o = 32; o >= 1; o >>= 1) v += __shfl_xor(v, o);
  return v;
}
DI int TID() { int t = threadIdx_x_raw(); asm volatile("" : "+v"(t)); return t; }
DI int crow(int i, int h) { return (i & 3) + 8 * (i >> 2) + 4 * h; }
DI float silu(float x) { return x / (1.f + __expf(-x)); }
DI int tok_modrow(int tok) { return tok < NCTX ? 0 : 1 + ((tok - NCTX) >> 10); }

DI void transpose_tile(const float* __restrict__ src, int K, int N, u16* __restrict__ dst, int kt, int nt, float* sm) {
  const int t = TID();
  float4 v[8];
#pragma unroll
  for (int i = 0; i < 8; ++i) {
    int id = t + NT * i, r = id >> 6, c4 = id & 63, n = nt * 256 + c4 * 4;
    v[i] = (n < N) ? *(const float4*)(src + (size_t)(kt * 64 + r) * N + n) : make_float4(0.f, 0.f, 0.f, 0.f);
  }
#pragma unroll
  for (int i = 0; i < 8; ++i) {
    int id = t + NT * i, r = id >> 6, c4 = id & 63;
    *(float4*)(sm + r * 260 + c4 * 4) = v[i];
  }
  __syncthreads();
  {
    const int nl = t >> 1, kq = t & 1, n = nt * 256 + nl;
    if (n < N) {
      u16* dp = dst + (size_t)n * K + kt * 64 + kq * 32;
#pragma unroll
      for (int q = 0; q < 4; ++q) {
        u32x4 o;
#pragma unroll
        for (int j = 0; j < 4; ++j) o[j] = pack2(sm[(kq * 32 + q * 8 + 2 * j) * 260 + nl], sm[(kq * 32 + q * 8 + 2 * j + 1) * 260 + nl]);
        *(u32x4*)(dp + q * 8) = o;
      }
    }
  }
  __syncthreads();
}

DI void adaln_item(const Params& p, int l, int chunk, float* sm) {
  const float* W = l ? p.l1_ada_w : p.l0_ada_w;
  const float* bias = l ? p.l1_ada_b : p.l0_ada_b;
  float* mod = (float*)(p.ws + OFF_MOD) + (size_t)l * 9 * 6144;
  const int t = TID(), col = chunk * 64 + (t & 63), kg = t >> 6;
  float acc[9];
#pragma unroll
  for (int r = 0; r < 9; ++r) acc[r] = 0.f;
  for (int kh = 0; kh < 2; ++kh) {
    __syncthreads();
    for (int e = t; e < 9 * 1024; e += NT) {
      int r = e >> 10, k = e & 1023;
      float cv = (r == 0) ? p.c_ctx[kh * 1024 + k] : p.c[(r - 1) * 2048 + kh * 1024 + k];
      sm[r * 1024 + k] = silu(cv);
    }
    __syncthreads();
    const float* wp = W + (size_t)(kh * 1024 + kg * 128) * 6144 + col;
    const float* sp = sm + kg * 128;
#pragma unroll 8
    for (int k = 0; k < 128; ++k) {
      float w = wp[(size_t)k * 6144];
#pragma unroll
      for (int r = 0; r < 9; ++r) acc[r] += sp[r * 1024 + k] * w;
    }
  }
  __syncthreads();
#pragma unroll
  for (int r = 0; r < 9; ++r) sm[(kg * 9 + r) * 64 + (t & 63)] = acc[r];
  __syncthreads();
  for (int e = t; e < 9 * 64; e += NT) {
    int r = e >> 6, cc = e & 63;
    float s = 0.f;
#pragma unroll
    for (int g = 0; g < NW; ++g) s += sm[(g * 9 + r) * 64 + cc];
    mod[(size_t)r * 6144 + chunk * 64 + cc] = s + bias[chunk * 64 + cc];
  }
  __syncthreads();
}

DI void convert_item(const float* __restrict__ src, u16* __restrict__ dst, int W, int dstT, int item) {
  size_t e = (size_t)item * 4096 + TID() * 8;
  size_t per_b = (size_t)512 * W;
  size_t b = e / per_b, r = e % per_b;
  float4 v0 = *(const float4*)(src + e), v1 = *(const float4*)(src + e + 4);
  u32x4 o = {pack2(v0.x, v0.y), pack2(v0.z, v0.w), pack2(v1.x, v1.y), pack2(v1.z, v1.w)};
  *(u32x4*)(dst + b * (size_t)dstT * W + r) = o;
}

DI void phase_prep(const Params& p, char* smem) {
  float* sm = (float*)smem;
  char* ws = p.ws;
  constexpr int T_IN0 = 32 * 26, T_OUT0 = 32 * 8, T_IN1 = 32 * 13, T_QB = 8 * 12, T_KVB = 8 * 16, T_OUT1 = 32 * 8;
  constexpr int C_A = 256, C_B = 1024, C_CKV = 512, C_KR = 64;
  constexpr int B1 = 0, B2 = B1 + T_IN0, B3 = B2 + T_OUT0, B4 = B3 + T_IN1, B5 = B4 + T_QB, B6 = B5 + T_KVB, B7 = B6 + T_OUT1;
  constexpr int B8 = B7 + C_A, B9 = B8 + C_A, B10 = B9 + C_B, B11 = B10 + C_B, B12 = B11 + C_CKV, B13 = B12 + C_KR;
  if (blockIdx.x == gridDim.x - 1) {
    float* tab = (float*)(ws + OFF_ROPE);
    for (int e = TID(); e < 64 * 16; e += NT) {
      int pos = e >> 4, i = e & 15;
      float inv = exp2f(-(float)i * (LOG2_THETA / 16.f));
      float sn, cs; sincosf((float)pos * inv, &sn, &cs);
      tab[2 * e] = cs; tab[2 * e + 1] = sn;
    }
    float* tab0 = (float*)(ws + OFF_ROPE0);
    for (int e = TID(); e < 64 * 32; e += NT) {
      int pos = e >> 5, i = e & 31;
      float inv = exp2f(-(float)i * (LOG2_THETA / 32.f));
      float sn, cs; sincosf((float)pos * inv, &sn, &cs);
      tab0[2 * e] = cs; tab0[2 * e + 1] = sn;
    }
  }
  const int nada = (gridDim.x > 128) ? 96 : 0;
  if ((int)blockIdx.x < nada) { adaln_item(p, 0, blockIdx.x, sm); return; }
  if (nada == 0) { for (int c = blockIdx.x; c < 96; c += gridDim.x) adaln_item(p, 0, c, sm); }
  for (int it = blockIdx.x - nada; it < B13; it += gridDim.x - nada) {
    if (it < B2) { int i = it - B1; transpose_tile(p.l0_w_in, 2048, 6656, (u16*)(ws + OFF_WT_IN0), i / 26, i % 26, sm); }
    else if (it < B3) { int i = it - B2; transpose_tile(p.l0_w_out, 2048, 2048, (u16*)(ws + OFF_WT_OUT0), i / 8, i % 8, sm); }
    else if (it < B4) { int i = it - B3; transpose_tile(p.l1_w_in, 2048, 3136, (u16*)(ws + OFF_WT_IN1), i / 13, i % 13, sm); }
    else if (it < B5) { int i = it - B4; transpose_tile(p.l1_wqb, 512, 3072, (u16*)(ws + OFF_WT_QB), i / 12, i % 12, sm); }
    else if (it < B6) { int i = it - B5; transpose_tile(p.l1_wkvb, 512, 4096, (u16*)(ws + OFF_WT_KVB), i / 16, i % 16, sm); }
    else if (it < B7) { int i = it - B6; transpose_tile(p.l1_w_out, 2048, 2048, (u16*)(ws + OFF_WT_OUT1), i / 8, i % 8, sm); }
    else if (it < B8) convert_item(p.ca_k, (u16*)(ws + OFF_KA_ALL), 256, 1536, it - B7);
    else if (it < B9) convert_item(p.ca_v, (u16*)(ws + OFF_VA_ALL), 256, 1536, it - B8);
    else if (it < B10) convert_item(p.cb_k, (u16*)(ws + OFF_KB_CTX), 1024, 512, it - B9);
    else if (it < B11) convert_item(p.cb_v, (u16*)(ws + OFF_VB_CTX), 1024, 512, it - B10);
    else if (it < B12) convert_item(p.c_ckv, (u16*)(ws + OFF_CKV_ALL), 512, 1536, it - B11);
    else convert_item(p.c_kr, (u16*)(ws + OFF_KR_ALL), 64, 1536, it - B12);
  }
}

DI void phase_normmod(const Params& p, int layer) {
  const int wave = TID() >> 6, lane = TID() & 63;
  const float* g = layer ? p.l1_norm : p.l0_norm;
  const float* mod = (const float*)(p.ws + OFF_MOD) + (size_t)layer * 9 * 6144;
  u16* H = (u16*)(p.ws + OFF_H);
  for (int it = blockIdx.x; it < NTOK / NW; it += gridDim.x) {
    int row = it * NW + wave;
    const float* src;
    if (layer == 0) src = row < NCTX ? p.x_prompt + (size_t)row * D : p.x_sample + (size_t)(row - NCTX) * D;
    else src = p.out + OUT_Y + (size_t)row * D;
    const float* mr = mod + (size_t)tok_modrow(row) * 6144;
    float4 v[8];
    float ss = 0.f;
#pragma unroll
    for (int i = 0; i < 8; ++i) {
      v[i] = *(const float4*)(src + (i * 64 + lane) * 4);
      ss += v[i].x * v[i].x + v[i].y * v[i].y + v[i].z * v[i].z + v[i].w * v[i].w;
    }
    ss = wave_sum(ss);
    float rinv = rsqrtf(ss * (1.f / D) + EPS);
#pragma unroll
    for (int i = 0; i < 8; ++i) {
      int col = (i * 64 + lane) * 4;
      float4 gg = *(const float4*)(g + col);
      float4 sh = *(const float4*)(mr + col);
      float4 sc = *(const float4*)(mr + 2048 + col);
      float h0 = v[i].x * rinv * gg.x * (1.f + sc.x) + sh.x;
      float h1 = v[i].y * rinv * gg.y * (1.f + sc.y) + sh.y;
      float h2 = v[i].z * rinv * gg.z * (1.f + sc.z) + sh.z;
      float h3 = v[i].w * rinv * gg.w * (1.f + sc.w) + sh.w;
      *(uint2*)(H + (size_t)row * D + col) = make_uint2(pack2(h0, h1), pack2(h2, h3));
    }
  }
}

namespace pg8 {
#define PG8_LAS __attribute__((address_space(3)))
typedef unsigned short bf16_t;
typedef short bf16x8 __attribute__((ext_vector_type(8)));
typedef float f32x4 __attribute__((ext_vector_type(4)));
typedef unsigned u32x4 __attribute__((ext_vector_type(4)));
constexpr int BM = 256, BK = 64, HALF = 128, HTB = HALF * BK * 2  , STAGE_BYTES = 8 * HTB, NXCD = 8, WGM = 8;

__host__ __device__ __forceinline__ int lds_byte(int r, int c) { const int st = (r >> 4) * 2 + (c >> 5), rr = r & 15, cc = c & 31, ob = rr * 64 + cc * 2; return st * 1024 + (ob ^ (((ob >> 9) & 1) << 5)); }
__host__ __device__ __forceinline__ void stage_rc(int b, int& R, int& C) { const int st = b / 1024, sb = b % 1024, swz = sb ^ (((sb >> 9) & 1) << 5); R = (st >> 1) * 16 + swz / 64; C = (st & 1) * 32 + (swz % 64) / 2; }
__host__ __device__ __forceinline__ int perm32(int rho) { const int n = rho >> 4, i = rho & 15; return 8 * (i >> 2) + 4 * n + (i & 3); }

struct Unit { int pm, pn; };
struct Gemm { const bf16_t* A; const bf16_t* Bt; int M, N, K, lda; };
struct StaticOrder {
    int nM, nN, nwg, G, c;
    __host__ __device__ void init(int M, int N, int G_, int c_) { nM = M / BM; nN = N / BM; nwg = nM * nN; G = G_; c = c_; }
    __host__ __device__ bool next(int i, Unit& u) const {
        const long L = (long)i * G + c; if (L >= nwg) return false;
        int wgid = (int)L; { const int q = nwg / NXCD, r = nwg % NXCD, xcd = wgid % NXCD, off = wgid / NXCD; wgid = (xcd < r ? xcd * (q + 1) : r * (q + 1) + (xcd - r) * q) + off; }
        const int nig = WGM * nN, gid = wgid / nig, fm = gid * WGM, gsz = (nM - fm) < WGM ? (nM - fm) : WGM;
        u.pm = fm + ((wgid % nig) % gsz); u.pn = (wgid % nig) / gsz; return true;
    }
    __device__ __forceinline__ void a_ready(const Unit&) const {}
    __device__ __forceinline__ void done(const Unit&) const {}
};
template <class Epi, class Sched, bool STAMP = false>
__device__ __forceinline__ void gemm_phase(PG8_LAS unsigned char* lds, const Gemm g, const Sched& S, const Epi& E, unsigned long long* stamps) {
    const int tid = TID(), wid = __builtin_amdgcn_readfirstlane(tid >> 6), lane = tid & 63, wr = wid >> 2, wc = wid & 3, fr = lane & 15, fq = lane >> 4;
    const int K = g.K, nt = K / BK;
    int ts_lo = 0, ts_hi = 0, nts = 0; const unsigned long long rt_entry = STAMP ? (unsigned long long)wall_clock64() : 0ull;
#define PG8_STAMP() do { if (STAMP && wid == 0 && nts < 64) { const unsigned long long _c = (unsigned long long)clock64(); \
        ts_lo = (lane == nts) ? (int)(unsigned)_c : ts_lo; ts_hi = (lane == nts) ? (int)(unsigned)(_c >> 32) : ts_hi; ++nts; } } while (0)
    PG8_STAMP();
    unsigned voffA[2], voffB[2];
#pragma unroll
    for (int i = 0; i < 2; ++i) { int R, C; stage_rc(tid * 16 + i * 8192, R, C); const int Rb = Epi::PERM ? ((R & ~31) + perm32(R & 31)) : R;
        voffA[i] = (unsigned)(R * g.lda + C) * 2u; voffB[i] = (unsigned)(Rb * K + C) * 2u; }
    const size_t kstep = (size_t)(BK * 2);
    const size_t hstepB = (size_t)HALF * K * 2, hstepA = (size_t)HALF * g.lda * 2;
    const size_t tstepB = 2 * hstepB, tstepA = 2 * hstepA;
    const unsigned ldsw = (unsigned)wid * 1024u;
    const int aoff = lds_byte(wr * 64 + fr, fq * 8), boff = lds_byte(wc * 32 + fr, fq * 8);
#define PG8_SA(b, h) (((b) * 2 + (h)) * HTB)
#define PG8_SB(b, h) ((4 + (b) * 2 + (h)) * HTB)
#define PG8_STAGE(bufoff, gbase, voff) do { _Pragma("unroll") for (int _i = 0; _i < 2; ++_i) \
        __builtin_amdgcn_global_load_lds((const unsigned*)((const char*)(gbase) + (voff)[_i]), (PG8_LAS unsigned*)(lds + (bufoff) + ldsw + _i * 8192), 16, 0, 0); } while (0)
#define PG8_LDA(dst, b, h) do { _Pragma("unroll") for (int m = 0; m < 4; ++m) _Pragma("unroll") for (int k = 0; k < 2; ++k) dst[m][k] = *(const PG8_LAS bf16x8*)(lds + PG8_SA(b, h) + aoff + m * 2048 + k * 1024); } while (0)
#define PG8_LDB(dst, b, h) do { _Pragma("unroll") for (int n = 0; n < 2; ++n) _Pragma("unroll") for (int k = 0; k < 2; ++k) dst[n][k] = *(const PG8_LAS bf16x8*)(lds + PG8_SB(b, h) + boff + n * 2048 + k * 1024); } while (0)
#define PG8_MMA(ai, bj, At, Bt) do { __builtin_amdgcn_s_setprio(1); _Pragma("unroll") for (int m = 0; m < 4; ++m) _Pragma("unroll") for (int n = 0; n < 2; ++n) _Pragma("unroll") for (int k = 0; k < 2; ++k) \
        acc[ai][bj][m][n] = __builtin_amdgcn_mfma_f32_16x16x32_bf16(Bt[n][k], At[m][k], acc[ai][bj][m][n], 0, 0, 0); __builtin_amdgcn_s_setprio(0); } while (0)
#define PG8_WAIT_V(n) asm volatile("s_waitcnt vmcnt(" #n ")" ::: "memory")
#define PG8_WAIT_L(n) asm volatile("s_waitcnt lgkmcnt(" #n ")" ::: "memory")
#define PG8_BAR __builtin_amdgcn_s_barrier()
#define PG8_SCHED __builtin_amdgcn_sched_barrier(0)
    Unit cur, nxt; int ui = 0;
    if (!S.next(0, cur)) return;
    f32x4 acc[2][2][4][2];
#pragma unroll
    for (int a = 0; a < 2; ++a)
#pragma unroll
        for (int b = 0; b < 2; ++b)
#pragma unroll
            for (int m = 0; m < 4; ++m)
#pragma unroll
                for (int n = 0; n < 2; ++n) acc[a][b][m][n] = (f32x4){0.f, 0.f, 0.f, 0.f};
    bf16x8 At[4][2], B0[2][2], B1[2][2];
    const char* cA = (const char*)g.A + (size_t)cur.pm * tstepA; const char* cB = (const char*)g.Bt + (size_t)cur.pn * tstepB;
    S.a_ready(cur);
    PG8_STAGE(PG8_SB(0, 0), cB, voffB); PG8_STAGE(PG8_SA(0, 0), cA, voffA); PG8_STAGE(PG8_SB(0, 1), cB + hstepB, voffB); PG8_STAGE(PG8_SA(0, 1), cA + hstepA, voffA);
    if (wr == 1) PG8_BAR;
    PG8_WAIT_V(4); PG8_BAR;
    PG8_STAGE(PG8_SB(1, 0), cB + kstep, voffB); PG8_STAGE(PG8_SA(1, 0), cA + kstep, voffA); PG8_STAGE(PG8_SB(1, 1), cB + hstepB + kstep, voffB);
    PG8_WAIT_V(6); PG8_BAR;
    PG8_STAMP();
    for (;;) {
        const bool has_next = S.next(ui + 1, nxt);
        const char* nA = has_next ? (const char*)g.A + (size_t)nxt.pm * tstepA : cA; const char* nB = has_next ? (const char*)g.Bt + (size_t)nxt.pn * tstepB : cB;
        for (int t = 0; t < nt; t += 2) {
            const bool last = (t == nt - 2);
            const char* a1 = cA + (size_t)(t + 1) * kstep;
            const char* a2 = last ? nA : cA + (size_t)(t + 2) * kstep; const char* b2 = last ? nB : cB + (size_t)(t + 2) * kstep;
            const char* a3 = a2 + kstep; const char* b3 = b2 + kstep;
            if (last && has_next) S.a_ready(nxt);
            PG8_LDB(B0, 0, 0); PG8_SCHED; PG8_LDA(At, 0, 0); PG8_STAGE(PG8_SA(1, 1), a1 + hstepA, voffA);
            PG8_WAIT_L(8); PG8_BAR; PG8_WAIT_L(0); PG8_MMA(0, 0, At, B0); PG8_BAR; PG8_SCHED;
            PG8_LDB(B1, 0, 1); PG8_STAGE(PG8_SB(0, 0), b2, voffB);
            PG8_BAR; PG8_WAIT_L(0); PG8_MMA(0, 1, At, B1); PG8_BAR;
            PG8_LDA(At, 0, 1); PG8_STAGE(PG8_SA(0, 0), a2, voffA);
            PG8_BAR; PG8_WAIT_L(0); PG8_MMA(1, 0, At, B0); PG8_BAR; PG8_SCHED;
            PG8_STAGE(PG8_SB(0, 1), b2 + hstepB, voffB);
            PG8_WAIT_V(6); PG8_BAR; PG8_MMA(1, 1, At, B1); PG8_BAR;
            PG8_LDB(B0, 1, 0); PG8_SCHED; PG8_LDA(At, 1, 0); PG8_STAGE(PG8_SA(0, 1), a2 + hstepA, voffA);
            PG8_WAIT_L(8); PG8_BAR; PG8_WAIT_L(0); PG8_MMA(0, 0, At, B0); PG8_BAR; PG8_SCHED;
            PG8_LDB(B1, 1, 1); PG8_STAGE(PG8_SB(1, 0), b3, voffB);
            PG8_BAR; PG8_WAIT_L(0); PG8_MMA(0, 1, At, B1); PG8_BAR;
            PG8_LDA(At, 1, 1); PG8_STAGE(PG8_SA(1, 0), a3, voffA);
            PG8_BAR; PG8_WAIT_L(0); PG8_MMA(1, 0, At, B0); PG8_BAR; PG8_SCHED;
            PG8_STAGE(PG8_SB(1, 1), b3 + hstepB, voffB);
            PG8_WAIT_V(6); PG8_BAR; PG8_MMA(1, 1, At, B1); PG8_BAR;
        }
        PG8_STAMP();
        if constexpr (!Epi::AFTER_DRAIN) { E(acc, cur, wr, wc, fr, fq); S.done(cur); }
        PG8_STAMP();
        if (!has_next) break;
#pragma unroll
        for (int a = 0; a < 2; ++a)
#pragma unroll
            for (int b = 0; b < 2; ++b)
#pragma unroll
                for (int m = 0; m < 4; ++m)
#pragma unroll
                    for (int n = 0; n < 2; ++n) acc[a][b][m][n] = (f32x4){0.f, 0.f, 0.f, 0.f};
        cur = nxt; cA = nA; cB = nB; ++ui;
    }
    PG8_WAIT_V(0);
    if (wr == 0) PG8_BAR;
    PG8_BAR;
    if constexpr (Epi::AFTER_DRAIN) { E.fused(acc, cur, wr, wc, fr, fq, lds, wid, lane); S.done(cur); }
    PG8_STAMP();
    if (STAMP && wid == 0) { stamps[lane] = lane < nts ? (((unsigned long long)(unsigned)ts_hi << 32) | (unsigned)ts_lo) : 0ull;
        if (lane == 62) stamps[62] = rt_entry; if (lane == 63) stamps[63] = (unsigned long long)wall_clock64(); }
#undef PG8_STAMP
#undef PG8_SA
#undef PG8_SB
#undef PG8_STAGE
#undef PG8_LDA
#undef PG8_LDB
#undef PG8_MMA
#undef PG8_WAIT_V
#undef PG8_WAIT_L
#undef PG8_BAR
#undef PG8_SCHED
}
}


struct EpiBf16 {
  static constexpr bool PERM = true, AFTER_DRAIN = false;
  u16* O; int ldc;
  DI void operator()(const f32x4 (&acc)[2][2][4][2], const pg8::Unit& u, int wr, int wc, int fr, int fq) const {
    const int row0 = u.pm * 256 + wr * 64 + fr, col0 = u.pn * 256 + wc * 32 + 8 * fq;
#pragma unroll
    for (int ai = 0; ai < 2; ++ai)
#pragma unroll
      for (int m = 0; m < 4; ++m) {
        u16* rowp = O + (size_t)(row0 + ai * 128 + m * 16) * ldc + col0;
#pragma unroll
        for (int bj = 0; bj < 2; ++bj) {
          f32x4 v0 = acc[ai][bj][m][0], v1 = acc[ai][bj][m][1];
          u32x4 w = {pack2(v0[0], v0[1]), pack2(v0[2], v0[3]), pack2(v1[0], v1[1]), pack2(v1[2], v1[3])};
          *(u32x4*)(rowp + bj * 128) = w;
        }
      }
  }
};
struct EpiResid {
  static constexpr bool PERM = false, AFTER_DRAIN = false;
  const float* xa; const float* xb; const float* gate; float* out;
  DI void operator()(const f32x4 (&acc)[2][2][4][2], const pg8::Unit& u, int wr, int wc, int fr, int fq) const {
    const int row0 = u.pm * 256 + wr * 64 + fr, col0 = u.pn * 256 + wc * 32 + 4 * fq;
#pragma unroll
    for (int ai = 0; ai < 2; ++ai)
#pragma unroll
      for (int m = 0; m < 4; ++m) {
        const int row = row0 + ai * 128 + m * 16;
        const float* xr = (row < NCTX) ? xa + (size_t)row * D : xb + (size_t)(row - NCTX) * D;
        const float* gr = gate + (size_t)tok_modrow(row) * 6144;
        float* orow = out + (size_t)row * D;
#pragma unroll
        for (int bj = 0; bj < 2; ++bj)
#pragma unroll
          for (int n = 0; n < 2; ++n) {
            const int col = col0 + bj * 128 + n * 16;
            f32x4 xv = *(const f32x4*)(xr + col);
            f32x4 gv = *(const f32x4*)(gr + col);
            *(f32x4*)(orow + col) = xv + gv * acc[ai][bj][m][n];
          }
      }
  }
};

template <class Epi>
DI void gemm_run(PG8_LAS unsigned char* lds, const u16* A, int lda, const u16* Bt, int M, int N, int K, const Epi& e) {
  pg8::Gemm g{A, Bt, M, N, K, lda};
  pg8::StaticOrder S; S.init(M, N, (int)gridDim.x, (int)blockIdx.x);
#pragma unroll 1
  for (int rep = 0; rep < (Epi::PERM ? REP_G : 1); ++rep) {
    __syncthreads();
    pg8::gemm_phase<Epi, pg8::StaticOrder, false>(lds, g, S, e, nullptr);
    __syncthreads();
  }
}

DI void phase_qknorm0(const Params& p) {
  const int t = TID(), wave = t >> 6, lane = t & 63, l15 = lane & 15;
  u16* QKVG = (u16*)(p.ws + OFF_BIG);
  u16* KA = (u16*)(p.ws + OFF_KA_ALL);
  u16* VA = (u16*)(p.ws + OFF_VA_ALL);
  const float* tab = (const float*)(p.ws + OFF_ROPE0);
  float gq[8], gk[8];
#pragma unroll
  for (int j = 0; j < 8; ++j) { gq[j] = p.l0_qn[l15 * 8 + j]; gk[j] = p.l0_kn[l15 * 8 + j]; }
  const bool hi = (l15 & 4) != 0;
  const bool colrot = l15 >= 8;
  const int f0 = (l15 & 3) * 8;
  for (int it = blockIdx.x; it < NTOK / NW; it += gridDim.x) {
    const int tk = it * NW + wave;
    u16* base = QKVG + (size_t)tk * L0_IN;
    const bool lat = tk >= NCTX;
    const int lt = tk - NCTX, b = lt >> 10, tt = lt & 1023;
    u32x4 v[3];
#pragma unroll
    for (int ps = 0; ps < 3; ++ps) v[ps] = *(const u32x4*)(base + (ps * 64 + lane) * 8);
    u32x4 kb[2], vb[2];
    if (!lat) {
#pragma unroll
      for (int q = 0; q < 2; ++q) { kb[q] = *(const u32x4*)(base + 2560 + (q * 64 + lane) * 8); vb[q] = *(const u32x4*)(base + 3584 + (q * 64 + lane) * 8); }
    }
    float cs[8], sn[8];
    if (lat) {
      const int pos = colrot ? (tt & 63) : (tt >> 6);
      const float4* tp = (const float4*)(tab + (pos * 32 + f0) * 2);
#pragma unroll
      for (int j2 = 0; j2 < 4; ++j2) { float4 c = tp[j2]; cs[2 * j2] = c.x; sn[2 * j2] = c.y; cs[2 * j2 + 1] = c.z; sn[2 * j2 + 1] = c.w; }
    } else {
#pragma unroll
      for (int j = 0; j < 8; ++j) { cs[j] = 1.f; sn[j] = 0.f; }
    }
    const size_t arow = (size_t)b * 1536 + 512 + tt;
#pragma unroll
    for (int ps = 0; ps < 3; ++ps) {
      float x[8];
#pragma unroll
      for (int j = 0; j < 4; ++j) { x[2 * j] = bflo(v[ps][j]); x[2 * j + 1] = bfhi(v[ps][j]); }
      float ss = 0.f;
#pragma unroll
      for (int j = 0; j < 8; ++j) ss += x[j] * x[j];
      ss += __shfl_xor(ss, 8); ss += __shfl_xor(ss, 4); ss += __shfl_xor(ss, 2); ss += __shfl_xor(ss, 1);
      const float rinv = rsqrtf(ss * (1.f / 128.f) + EPS);
      float o[8];
#pragma unroll
      for (int j = 0; j < 8; ++j) {
        const float y = x[j] * rinv * (ps < 2 ? gq[j] : gk[j]);
        const float pr = __shfl_xor(y, 4);
        o[j] = hi ? (y * cs[j] + pr * sn[j]) : (y * cs[j] - pr * sn[j]);
      }
      if (ps < 2) {
        u32x4 w = {pack2(o[0], o[1]), pack2(o[2], o[3]), pack2(o[4], o[5]), pack2(o[6], o[7])};
        *(u32x4*)(base + (ps * 64 + lane) * 8) = w;
      } else if (lane < 32) {
        u32x4 w = {pack2(o[0], o[1]), pack2(o[2], o[3]), pack2(o[4], o[5]), pack2(o[6], o[7])};
        if (!lat) {
          *(u32x4*)(base + 1024 + lane * 8) = w;
          float* op = p.out + OUT_NAK + (size_t)tk * 256 + lane * 8;
          *(float4*)op = make_float4(o[0], o[1], o[2], o[3]);
          *(float4*)(op + 4) = make_float4(o[4], o[5], o[6], o[7]);
        } else *(u32x4*)(KA + arow * 256 + lane * 8) = w;
      } else {
        if (!lat) {
          float* op = p.out + OUT_NAV + (size_t)tk * 256 + (lane - 32) * 8;
          *(float4*)op = make_float4(x[0], x[1], x[2], x[3]);
          *(float4*)(op + 4) = make_float4(x[4], x[5], x[6], x[7]);
        } else *(u32x4*)(VA + arow * 256 + (lane - 32) * 8) = v[2];
      }
    }
    if (!lat) {
#pragma unroll
      for (int q = 0; q < 2; ++q) {
        float* ok = p.out + OUT_NBK + (size_t)tk * 1024 + (q * 64 + lane) * 8;
        float* ov = p.out + OUT_NBV + (size_t)tk * 1024 + (q * 64 + lane) * 8;
        *(float4*)ok = make_float4(bflo(kb[q][0]), bfhi(kb[q][0]), bflo(kb[q][1]), bfhi(kb[q][1]));
        *(float4*)(ok + 4) = make_float4(bflo(kb[q][2]), bfhi(kb[q][2]), bflo(kb[q][3]), bfhi(kb[q][3]));
        *(float4*)ov = make_float4(bflo(vb[q][0]), bfhi(vb[q][0]), bflo(vb[q][1]), bfhi(vb[q][1]));
        *(float4*)(ov + 4) = make_float4(bflo(vb[q][2]), bfhi(vb[q][2]), bflo(vb[q][3]), bfhi(vb[q][3]));
      }
    }
  }
}

DI void phase_norm1(const Params& p) {
  const int wave = TID() >> 6, lane = TID() & 63;
  const u16* LAT1 = (const u16*)(p.ws + OFF_LAT1);
  u16* QN = (u16*)(p.ws + OFF_QN);
  u16* CKVC = (u16*)(p.ws + OFF_CKV_CTX);
  u16* KRC = (u16*)(p.ws + OFF_KR_CTX);
  u16* CKVA = (u16*)(p.ws + OFF_CKV_ALL);
  u16* KRA = (u16*)(p.ws + OFF_KR_ALL);
  float gq[8], gk[8];
#pragma unroll
  for (int j = 0; j < 8; ++j) { gq[j] = p.l1_qan[lane * 8 + j]; gk[j] = p.l1_kvan[lane * 8 + j]; }
  const int ri = lane & 15, rhalf = (lane >> 4) & 1;
  const int rd1 = rhalf * 32 + ri, rd2 = rd1 + 16;
  const float inv = exp2f(-(float)ri * (LOG2_THETA / 16.f));
  for (int it = blockIdx.x; it < NTOK / NW; it += gridDim.x) {
    int tk = it * NW + wave;
    const u16* base = LAT1 + (size_t)tk * L1_LD;
    const bool lat = tk >= NCTX;
    int lt = tk - NCTX, b = lt >> 10, tt = lt & 1023;
    size_t arow = (size_t)b * 1536 + 512 + tt;
#pragma unroll
    for (int part = 0; part < 2; ++part) {
      uint4 v = *(const uint4*)(base + part * 512 + lane * 8);
      float x[8] = {bflo(v.x), bfhi(v.x), bflo(v.y), bfhi(v.y), bflo(v.z), bfhi(v.z), bflo(v.w), bfhi(v.w)};
      float ss = 0.f;
#pragma unroll
      for (int j = 0; j < 8; ++j) ss += x[j] * x[j];
      ss = wave_sum(ss);
      float rinv = rsqrtf(ss * (1.f / 512.f) + EPS);
#pragma unroll
      for (int j = 0; j < 8; ++j) x[j] = x[j] * rinv * (part ? gk[j] : gq[j]);
      uint4 o = make_uint4(pack2(x[0], x[1]), pack2(x[2], x[3]), pack2(x[4], x[5]), pack2(x[6], x[7]));
      if (part == 0) *(uint4*)(QN + (size_t)tk * 512 + lane * 8) = o;
      else if (!lat) {
        *(uint4*)(CKVC + (size_t)tk * 512 + lane * 8) = o;
        float* op = p.out + OUT_NCKV + (size_t)tk * 512 + lane * 8;
        *(float4*)op = make_float4(x[0], x[1], x[2], x[3]);
        *(float4*)(op + 4) = make_float4(x[4], x[5], x[6], x[7]);
      } else *(uint4*)(CKVA + arow * 512 + lane * 8) = o;
    }
    if (lane < 32) {
      float x1 = bf2f(base[1024 + rd1]), x2 = bf2f(base[1024 + rd2]);
      if (!lat) {
        KRC[(size_t)tk * 64 + rd1] = f2bf(x1); KRC[(size_t)tk * 64 + rd2] = f2bf(x2);
        p.out[OUT_NKR + (size_t)tk * 64 + rd1] = x1; p.out[OUT_NKR + (size_t)tk * 64 + rd2] = x2;
      } else {
        float pos = rhalf ? (float)(tt & 63) : (float)(tt >> 6);
        float sn, cs; sincosf(pos * inv, &sn, &cs);
        KRA[arow * 64 + rd1] = f2bf(x1 * cs - x2 * sn);
        KRA[arow * 64 + rd2] = f2bf(x2 * cs + x1 * sn);
      }
    }
  }
}

DI void phase_final(const Params& p) {
  const int wave = TID() >> 6, lane = TID() & 63;
  for (int it = blockIdx.x; it < NTOK / NW; it += gridDim.x) {
    int row = it * NW + wave;
    float* y = p.out + OUT_Y + (size_t)row * D;
    float4 v[8];
    float ss = 0.f;
#pragma unroll
    for (int i = 0; i < 8; ++i) {
      v[i] = *(const float4*)(y + (i * 64 + lane) * 4);
      ss += v[i].x * v[i].x + v[i].y * v[i].y + v[i].z * v[i].z + v[i].w * v[i].w;
    }
    ss = wave_sum(ss);
    float rinv = rsqrtf(ss * (1.f / D) + EPS);
#pragma unroll
    for (int i = 0; i < 8; ++i) {
      int col = (i * 64 + lane) * 4;
      float4 gg = *(const float4*)(p.fnorm + col);
      *(float4*)(y + col) = make_float4(v[i].x * rinv * gg.x, v[i].y * rinv * gg.y, v[i].z * rinv * gg.z, v[i].w * rinv * gg.w);
    }
  }
}

struct KVSeg { const u16* k; const u16* v; const u16* kr; int ks, vs, n; };
struct AttnArgs {
  const u16* q; int qs;
  KVSeg seg[2]; int nseg;
  const u16* gate; int gs;
  u16* out; int os;
  float scale_log2;
  const float* rpb;
  int qtok0;
  int rs0;
  int rope;
  const float* ropetab;
};

DI float xhalf_max(float v) {
  unsigned u = __float_as_uint(v);
  auto r = __builtin_amdgcn_permlane32_swap(u, u, false, false);
  return fmaxf(__uint_as_float(r[0]), __uint_as_float(r[1]));
}
DI int swz16(int r) { return ((r & 3) << 2) | ((r >> 2) & 3); }

template <int DQK, int MODE>
DI void attn_issue_tile(const AttnArgs& a, int tile, int nt0, LDS_AS(unsigned char)* slot, int wave, int lane) {
  const int sg = tile >= nt0 ? 1 : 0;
  const int off = (sg ? tile - nt0 : tile) * 64;
  const u16* kp = sg ? a.seg[1].k : a.seg[0].k;
  const u16* vp = sg ? a.seg[1].v : a.seg[0].v;
  const int ks = sg ? a.seg[1].ks : a.seg[0].ks;
  const int vs = sg ? a.seg[1].vs : a.seg[0].vs;
  const int sw = ((lane >> 4) << 2) | (wave & 3);
  const int ch = (lane & 15) ^ sw;
#pragma unroll
  for (int j = 0; j < 2; ++j) {
    const int row = off + (j * 8 + wave) * 4 + (lane >> 4);
    __builtin_amdgcn_global_load_lds((const unsigned*)(kp + (unsigned)(row * ks + ch * 8)), (LDS_AS(unsigned)*)(slot + (j * 8 + wave) * 1024), 16, 0, 0);
    __builtin_amdgcn_global_load_lds((const unsigned*)(vp + (unsigned)(row * vs + ch * 8)), (LDS_AS(unsigned)*)(slot + 16384 + (j * 8 + wave) * 1024), 16, 0, 0);
  }
  if constexpr (MODE == 2) {
    const u16* krp = sg ? a.seg[1].kr : a.seg[0].kr;
    const int row = wave * 8 + (lane >> 3);
    const int c2 = (lane & 7) ^ ((row >> 1) & 7);
    __builtin_amdgcn_global_load_lds((const unsigned*)(krp + (unsigned)((off + row) * 64 + c2 * 8)), (LDS_AS(unsigned)*)(slot + 32768 + wave * 1024), 16, 0, 0);
  }
}

template <int DQK, int MODE>
DI void attn_block(const AttnArgs& a, LDS_AS(unsigned char)* lds) {
  constexpr int NS = DQK / 16;
  constexpr int SLOTB = (MODE == 2) ? 40960 : 32768;
  constexpr int NLOAD = (MODE == 2) ? 5 : 4;
  LDS_AS(float)* bias_s = (LDS_AS(float)*)(lds + 3 * SLOTB);
  const int t = TID(), wave = __builtin_amdgcn_readfirstlane(t >> 6), lane = t & 63, l31 = lane & 31, h = lane >> 5;

  __syncthreads();
  if constexpr (MODE == 1) {
    for (int e = t; e < 15 * 31; e += NT) bias_s[e] = a.rpb[e] * LOG2E;
    __syncthreads();
  }
  int ntiles = 0;
  for (int s = 0; s < a.nseg; ++s) ntiles += a.seg[s].n >> 6;
  const int nt0 = a.seg[0].n >> 6;
  bf16x8 qf[NS];
  {
    const u16* qp = a.q + (size_t)(wave * 32 + l31) * a.qs + 8 * h;
#pragma unroll
    for (int s = 0; s < NS; ++s) qf[s] = *(const bf16x8*)(qp + 16 * s);
  }
  attn_issue_tile<DQK, MODE>(a, 0, nt0, lds, wave, lane);
  attn_issue_tile<DQK, MODE>(a, ntiles > 1 ? 1 : 0, nt0, lds + SLOTB, wave, lane);
  const int qtok = a.qtok0 + wave * 32 + l31;
  if constexpr (MODE == 2) {
    if (a.rope) {
      const int qr = qtok >> 6, qc = qtok & 63;
#pragma unroll
      for (int pr = 0; pr < 2; ++pr) {
        const float4* tb = (const float4*)(a.ropetab + ((pr ? qc : qr) * 16 + 8 * h) * 2);
#pragma unroll
        for (int j2 = 0; j2 < 4; ++j2) {
          float4 cssn = tb[j2];
#pragma unroll
          for (int e = 0; e < 2; ++e) {
            const int j = 2 * j2 + e;
            float cs = e ? cssn.z : cssn.x, sn = e ? cssn.w : cssn.y;
            float x1 = bf2f((u16)qf[8 + 2 * pr][j]), x2 = bf2f((u16)qf[9 + 2 * pr][j]);
            qf[8 + 2 * pr][j] = (short)f2bf(x1 * cs - x2 * sn);
            qf[9 + 2 * pr][j] = (short)f2bf(x2 * cs + x1 * sn);
          }
        }
      }
    }
  }
  f32x16 acc[4];
#pragma unroll
  for (int c = 0; c < 4; ++c)
#pragma unroll
    for (int r = 0; r < 16; ++r) acc[c][r] = 0.f;
  float m_run = -1e30f, l_run = 0.f;

  const int blk = (lane >> 4) & 1, tq = (lane & 15) >> 2, tp = lane & 3;
  const int kswz = swz16(l31);
  const int kb0 = l31 * 256 + ((h ^ (kswz & 1)) << 4);
  const int ksw = kswz >> 1;
  const int kr0 = 32768 + l31 * 128;
  const int krsw = (l31 >> 1) & 7;
  const int vlow0 = (2 * blk + (tp >> 1)) ^ (h & 3);
  const int vlow1 = (2 * blk + (tp >> 1)) ^ ((2 + h) & 3);
  const int vb0 = 16384 + (4 * h + tq) * 256 + (vlow0 << 4) + 8 * (tp & 1);
  const int vb1 = 16384 + (8 + 4 * h + tq) * 256 + (vlow1 << 4) + 8 * (tp & 1);
  const int qrow = qtok >> 6, qcol = qtok & 63;
  int q_rs = qrow - 4; q_rs = q_rs < 0 ? 0 : (q_rs > 8 ? 8 : q_rs);
  int q_cs = qcol - 8; q_cs = q_cs < 0 ? 0 : (q_cs > 48 ? 48 : q_cs);

  int sl = 0;
  for (int tile = 0; tile < ntiles; ++tile) {
    if constexpr (NLOAD == 5) asm volatile("s_waitcnt vmcnt(5)" ::: "memory"); else asm volatile("s_waitcnt vmcnt(4)" ::: "memory");
    __builtin_amdgcn_s_barrier();
    asm volatile("" ::: "memory");
    {
      int nx = tile + 2; nx = nx < ntiles ? nx : ntiles - 1;
      int sn = sl + 2; sn = sn >= 3 ? sn - 3 : sn;
      attn_issue_tile<DQK, MODE>(a, nx, nt0, lds + sn * SLOTB, wave, lane);
    }
    LDS_AS(unsigned char)* slot = lds + sl * SLOTB;
    sl = sl == 2 ? 0 : sl + 1;

    const bool local = (MODE == 1) && (tile >= nt0);
    const int krow = a.rs0 + (tile - nt0);
#pragma unroll 1
    for (int mt = 0; mt < 2; ++mt) {
      f32x16 S;
#pragma unroll
      for (int r = 0; r < 16; ++r) S[r] = 0.f;
      LDS_AS(unsigned char)* kbase = slot + mt * 8192 + kb0;
#pragma unroll
      for (int s = 0; s < 8; ++s) {
        bf16x8 kf = *(const LDS_AS(bf16x8)*)(kbase + ((s ^ ksw) << 5));
        S = MFMA32(kf, qf[s], S);
      }
      if constexpr (MODE == 2) {
        LDS_AS(unsigned char)* rbase = slot + mt * 4096 + kr0;
#pragma unroll
        for (int s2 = 0; s2 < 4; ++s2) {
          bf16x8 kf = *(const LDS_AS(bf16x8)*)(rbase + (((2 * s2 + h) ^ krsw) << 4));
          S = MFMA32(kf, qf[8 + s2], S);
        }
      }
      float mx = -1e30f;
#pragma unroll
      for (int r = 0; r < 16; ++r) {
        float sv = S[r] * a.scale_log2;
        if (MODE == 1) {
          if (local) {
            int kcol = mt * 32 + crow(r, h);
            bool ok = (krow >= q_rs) && (krow < q_rs + 8) && (kcol >= q_cs) && (kcol < q_cs + 16);
            int dy = krow - qrow + 7, dx = kcol - qcol + 15;
            dy = dy < 0 ? 0 : (dy > 14 ? 14 : dy);
            dx = dx < 0 ? 0 : (dx > 30 ? 30 : dx);
            const float bv = bias_s[dy * 31 + dx];
            sv = ok ? sv + bv : -1e30f;
          }
        }
        S[r] = sv;
        mx = fmaxf(mx, sv);
      }
      mx = xhalf_max(mx);
      const float m_old = m_run;
      const float m_new = fmaxf(m_run, mx);
      const float alpha = __builtin_amdgcn_exp2f(m_run - m_new);
      m_run = m_new;
      float ps = 0.f;
#pragma unroll
      for (int r = 0; r < 16; ++r) {
        float pv = __builtin_amdgcn_exp2f(S[r] - m_new);
        if (MODE == 1) { if (S[r] <= -1e29f) pv = 0.f; }
        S[r] = pv;
        ps += pv;
      }
      l_run = l_run * alpha + ps;
      if (__builtin_amdgcn_ballot_w64(m_new != m_old) != 0) {
#pragma unroll
        for (int c = 0; c < 4; ++c)
#pragma unroll
          for (int r = 0; r < 16; ++r) acc[c][r] *= alpha;
      }
      bf16x8 pf[2];
#pragma unroll
      for (int s2 = 0; s2 < 2; ++s2) {
        u32x4 u;
        u[0] = pack2(S[8 * s2 + 0], S[8 * s2 + 1]);
        u[1] = pack2(S[8 * s2 + 2], S[8 * s2 + 3]);
        u[2] = pack2(S[8 * s2 + 4], S[8 * s2 + 5]);
        u[3] = pack2(S[8 * s2 + 6], S[8 * s2 + 7]);
        pf[s2] = __builtin_bit_cast(bf16x8, u);
      }
      const unsigned vaddr = (unsigned)(size_t)(slot + mt * 8192);
#pragma unroll
      for (int c0 = 0; c0 < 4; c0 += 2) {
        const unsigned a0 = vaddr + vb0 + ((c0 ^ tq) << 6), a1 = vaddr + vb1 + ((c0 ^ tq) << 6);
        const unsigned a2 = vaddr + vb0 + (((c0 + 1) ^ tq) << 6), a3 = vaddr + vb1 + (((c0 + 1) ^ tq) << 6);
        s16x4 r0, r1, r2, r3, r4, r5, r6, r7;
        asm volatile(
            "ds_read_b64_tr_b16 %0, %8\n\t"
            "ds_read_b64_tr_b16 %1, %9\n\t"
            "ds_read_b64_tr_b16 %2, %8 offset:4096\n\t"
            "ds_read_b64_tr_b16 %3, %9 offset:4096\n\t"
            "ds_read_b64_tr_b16 %4, %10\n\t"
            "ds_read_b64_tr_b16 %5, %11\n\t"
            "ds_read_b64_tr_b16 %6, %10 offset:4096\n\t"
            "ds_read_b64_tr_b16 %7, %11 offset:4096\n\t"
            "s_waitcnt lgkmcnt(0)"
            : "=&v"(r0), "=&v"(r1), "=&v"(r2), "=&v"(r3), "=&v"(r4), "=&v"(r5), "=&v"(r6), "=&v"(r7)
            : "v"(a0), "v"(a1), "v"(a2), "v"(a3)
            : "memory");
        acc[c0] = MFMA32(__builtin_shufflevector(r0, r1, 0, 1, 2, 3, 4, 5, 6, 7), pf[0], acc[c0]);
        acc[c0] = MFMA32(__builtin_shufflevector(r2, r3, 0, 1, 2, 3, 4, 5, 6, 7), pf[1], acc[c0]);
        acc[c0 + 1] = MFMA32(__builtin_shufflevector(r4, r5, 0, 1, 2, 3, 4, 5, 6, 7), pf[0], acc[c0 + 1]);
        acc[c0 + 1] = MFMA32(__builtin_shufflevector(r6, r7, 0, 1, 2, 3, 4, 5, 6, 7), pf[1], acc[c0 + 1]);
      }
    }
  }
  asm volatile("s_waitcnt vmcnt(0)" ::: "memory");
  float l_tot = l_run + __shfl_xor(l_run, 32);
  float linv = 1.f / l_tot;
  const size_t qrow_i = (size_t)(wave * 32 + l31);
#pragma unroll
  for (int c = 0; c < 4; ++c)
#pragma unroll
    for (int g4 = 0; g4 < 4; ++g4) {
      int dv0 = 32 * c + 8 * g4 + 4 * h;
      uint2 gt = *(const uint2*)(a.gate + qrow_i * a.gs + dv0);
      float o0 = acc[c][4 * g4 + 0] * linv * silu(bflo(gt.x));
      float o1 = acc[c][4 * g4 + 1] * linv * silu(bfhi(gt.x));
      float o2 = acc[c][4 * g4 + 2] * linv * silu(bflo(gt.y));
      float o3 = acc[c][4 * g4 + 3] * linv * silu(bfhi(gt.y));
      *(uint2*)(a.out + qrow_i * a.os + dv0) = make_uint2(pack2(o0, o1), pack2(o2, o3));
    }
}

DI void phase_attn0(const Params& p, LDS_AS(unsigned char)* smem) {
  const u16* QKVG = (const u16*)(p.ws + OFF_BIG);
  u16* OG = (u16*)(p.ws + OFF_H);
  const u16* KA = (const u16*)(p.ws + OFF_KA_ALL);
  const u16* VA = (const u16*)(p.ws + OFF_VA_ALL);
  const u16* KBC = (const u16*)(p.ws + OFF_KB_CTX);
  const u16* VBC = (const u16*)(p.ws + OFF_VB_CTX);
  const float sc = 0.08838834764831845f * LOG2E;
  for (int it = blockIdx.x; it < 1024; it += gridDim.x) {
    AttnArgs a;
    a.qs = L0_IN; a.gs = L0_IN; a.os = D; a.scale_log2 = sc; a.rpb = nullptr; a.qtok0 = 0; a.rs0 = 0; a.rope = 0; a.ropetab = nullptr;
    a.seg[1].k = nullptr; a.seg[1].v = nullptr; a.seg[1].kr = nullptr; a.seg[1].ks = 0; a.seg[1].vs = 0; a.seg[1].n = 0;
    a.seg[0].kr = nullptr;
    if (it >= 256 && it < 512) {
      int i = it - 256;
      int bh = (i >> 5) * 8 + (i & 7), qb = (i >> 3) & 3;
      int b = bh >> 3, hh = bh & 7;
      size_t tok = (size_t)NCTX + b * 1024 + qb * 256;
      a.q = QKVG + tok * L0_IN + 1536 + hh * 128;
      a.gate = QKVG + tok * L0_IN + 4608 + 1024 + hh * 128;
      a.out = OG + tok * D + 1024 + hh * 128;
      a.nseg = 2;
      a.seg[0].k = KBC + (size_t)b * 512 * 1024 + hh * 128; a.seg[0].ks = 1024;
      a.seg[0].v = VBC + (size_t)b * 512 * 1024 + hh * 128; a.seg[0].vs = 1024;
      a.seg[0].n = 512;
      int rs0 = 4 * qb - 4; rs0 = rs0 < 0 ? 0 : (rs0 > 8 ? 8 : rs0);
      int rs1 = 4 * qb - 1; rs1 = rs1 < 0 ? 0 : (rs1 > 8 ? 8 : rs1);
      int nrows = rs1 + 8 - rs0;
      size_t ktok = (size_t)NCTX + b * 1024 + rs0 * 64;
      a.seg[1].k = QKVG + ktok * L0_IN + 2560 + hh * 128; a.seg[1].ks = L0_IN;
      a.seg[1].v = QKVG + ktok * L0_IN + 3584 + hh * 128; a.seg[1].vs = L0_IN;
      a.seg[1].n = nrows * 64;
      a.rpb = p.l0_rpb + hh * 15 * 31;
      a.qtok0 = qb * 256; a.rs0 = rs0;
      attn_block<128, 1>(a, smem);
    } else {
      a.nseg = 1;
      if (it < 256) {
        int g = (it >> 7) * 8 + (it & 7), j = (it >> 3) & 15;
        int b = g >> 1, hq = (g & 1) * 4 + (j >> 2), qb = j & 3;
        size_t tok = (size_t)NCTX + b * 1024 + qb * 256;
        a.q = QKVG + tok * L0_IN + hq * 128;
        a.gate = QKVG + tok * L0_IN + 4608 + hq * 128;
        a.out = OG + tok * D + hq * 128;
        a.seg[0].k = KA + (size_t)b * 1536 * 256 + (hq >> 2) * 128; a.seg[0].ks = 256;
        a.seg[0].v = VA + (size_t)b * 1536 * 256 + (hq >> 2) * 128; a.seg[0].vs = 256;
        a.seg[0].n = 1536;
      } else {
        int i = it - 512;
        bool isB = i >= 256; i &= 255;
        int g = (i >> 5) * 8 + (i & 7), j = (i >> 3) & 3;
        int b = isB ? (i >> 3) : (g >> 1), hh = isB ? (i & 7) : ((g & 1) * 4 + j);
        size_t tok = (size_t)b * 256;
        a.seg[0].n = 256; a.seg[0].ks = L0_IN; a.seg[0].vs = L0_IN;
        if (!isB) {
          a.q = QKVG + tok * L0_IN + hh * 128;
          a.gate = QKVG + tok * L0_IN + 4608 + hh * 128;
          a.out = OG + tok * D + hh * 128;
          a.seg[0].k = QKVG + tok * L0_IN + 1024 + (hh >> 2) * 128;
          a.seg[0].v = QKVG + tok * L0_IN + 1280 + (hh >> 2) * 128;
        } else {
          a.q = QKVG + tok * L0_IN + 1536 + hh * 128;
          a.gate = QKVG + tok * L0_IN + 4608 + 1024 + hh * 128;
          a.out = OG + tok * D + 1024 + hh * 128;
          a.seg[0].k = QKVG + tok * L0_IN + 2560 + hh * 128;
          a.seg[0].v = QKVG + tok * L0_IN + 3584 + hh * 128;
        }
      }
      attn_block<128, 0>(a, smem);
    }
  }
}

DI void phase_attn1(const Params& p, LDS_AS(unsigned char)* smem, int round) {
  const u16* Q1 = (const u16*)(p.ws + OFF_Q1);
  u16* LAT1 = (u16*)(p.ws + OFF_LAT1);
  const float sc = 0.07216878364870322f * LOG2E;
  for (int it = blockIdx.x; it < 512; it += gridDim.x) {
    AttnArgs a;
    a.qs = 3072; a.gs = L1_LD; a.os = L1_LD; a.scale_log2 = sc; a.rpb = nullptr; a.rs0 = 0; a.ropetab = (const float*)(p.ws + OFF_ROPE);
    a.seg[1].k = nullptr; a.seg[1].v = nullptr; a.seg[1].kr = nullptr; a.seg[1].ks = 0; a.seg[1].vs = 0; a.seg[1].n = 0;
    a.nseg = 1;
    a.seg[0].ks = 4096; a.seg[0].vs = 4096;
    size_t tok;
    int hh;
    if (round == 0) {
      int b = it >> 4; hh = it & 15;
      tok = (size_t)b * 256;
      const u16* KV = (const u16*)(p.ws + OFF_KV_CTX) + (size_t)b * 256 * 4096 + hh * 256;
      a.seg[0].k = KV; a.seg[0].v = KV + 128;
      a.seg[0].kr = (const u16*)(p.ws + OFF_KR_CTX) + (size_t)b * 256 * 64;
      a.seg[0].n = 256;
      a.rope = 0; a.qtok0 = 0;
    } else {
      int bh = (it >> 5) * 8 + (it & 7), qb = (it >> 3) & 3;
      int b = bh >> 4; hh = bh & 15;
      tok = (size_t)NCTX + b * 1024 + qb * 256;
      const u16* KV = (const u16*)(p.ws + OFF_KV_LAT) + (size_t)b * 1536 * 4096 + hh * 256;
      a.seg[0].k = KV; a.seg[0].v = KV + 128;
      a.seg[0].kr = (const u16*)(p.ws + OFF_KR_ALL) + (size_t)b * 1536 * 64;
      a.seg[0].n = 1536;
      a.rope = 1; a.qtok0 = qb * 256;
    }
    a.q = Q1 + tok * 3072 + hh * 192;
    a.gate = LAT1 + tok * L1_LD + 1088 + hh * 128;
    a.out = LAT1 + tok * L1_LD + 1088 + hh * 128;
    attn_block<192, 2>(a, smem);
  }
}

#define XB_TMO      128
#define XB_XCNT(j)  (256  + 64 * (j))
#define XB_XSUB(j)  (1280 + 64 * (j))
#define XB_XGEN(j)  (2304 + 64 * (j))
#define XB_TOP      3328
#define XB_TOPGEN   3392
#define XCD_BAR_WORDS 3456
#define XB_SPIN_CAP (1u << 18)
#define XLAS __attribute__((address_space(3)))

__device__ __forceinline__ unsigned xb_ld(unsigned* p)              { return __hip_atomic_load(p, __ATOMIC_RELAXED, __HIP_MEMORY_SCOPE_AGENT); }
__device__ __forceinline__ unsigned xb_add(unsigned* p, unsigned v) { return __hip_atomic_fetch_add(p, v, __ATOMIC_RELAXED, __HIP_MEMORY_SCOPE_AGENT); }
__device__ __forceinline__ unsigned xb_xcc_id() { return (unsigned)__builtin_amdgcn_s_getreg((3 << 11) | 20) & 0xFu; }
#define XB_SPIN(cond, bar) do { unsigned _sp = 0; while (cond) { __builtin_amdgcn_s_sleep(1); \
    if ((++_sp & 255u) == 0u) { if (xb_ld(&(bar)[XB_TMO])) break; if (_sp > XB_SPIN_CAP) { atomicAdd(&(bar)[XB_TMO], 1u); break; } } } } while (0)

struct XcdBarrier {
    unsigned* bar; unsigned x;
    volatile XLAS unsigned* st;
};

__device__ __forceinline__ XcdBarrier xcd_barrier_post(unsigned* bar, volatile XLAS unsigned* st) {
    XcdBarrier b; b.bar = bar; b.x = xb_xcc_id(); b.st = st;
    if (threadIdx.x == 0) (void)xb_add(&bar[XB_XCNT(b.x)], 1u);
    return b;
}
__device__ __forceinline__ void xcd_barrier_complete(unsigned* bar, unsigned x, unsigned& nloc, unsigned& nx) {
    const unsigned G = gridDim.x * gridDim.y * gridDim.z;
    unsigned sum, cnt, mine, sp = 0u;
    for (;;) {
        sum = 0u; cnt = 0u; mine = 0u;
#pragma unroll
        for (unsigned j = 0; j < 16; ++j) { const unsigned c = xb_ld(&bar[XB_XCNT(j)]); sum += c; cnt += (c > 0u) ? 1u : 0u; mine = (j == x) ? c : mine; }
        if (sum == G) break;
        __builtin_amdgcn_s_sleep(1);
        if ((++sp & 255u) == 0u) { if (xb_ld(&bar[XB_TMO])) break; if (sp > XB_SPIN_CAP) { atomicAdd(&bar[XB_TMO], 1u); break; } }
    }
    nloc = mine > 0u ? mine : 1u; nx = cnt > 0u ? cnt : 1u;
}

__device__ __forceinline__ void xcd_barrier(const XcdBarrier& b) {
    asm volatile("s_waitcnt vmcnt(0)" ::: "memory");
    __syncthreads();
    if (threadIdx.x == 0) {
        unsigned* bar = b.bar;
        __builtin_amdgcn_s_waitcnt(0);
        unsigned nloc = b.st[0], nx = b.st[1];
        if (nloc == 0u) { xcd_barrier_complete(bar, b.x, nloc, nx); b.st[0] = nloc; b.st[1] = nx; }
        const unsigned old = xb_add(&bar[XB_XSUB(b.x)], 1u);
        const unsigned gen = old / nloc;
        if (old + 1u == (gen + 1u) * nloc) {
            __builtin_amdgcn_fence(__ATOMIC_RELEASE, "agent");
            asm volatile("s_waitcnt vmcnt(0)" ::: "memory");
            const unsigned og = xb_add(&bar[XB_TOP], 1u);
            const unsigned tg = og / nx;
            if (og + 1u == (tg + 1u) * nx) xb_add(&bar[XB_TOPGEN], 1u);
            else XB_SPIN(xb_ld(&bar[XB_TOPGEN]) == tg, bar);
            __builtin_amdgcn_fence(__ATOMIC_ACQUIRE, "agent");
            xb_add(&bar[XB_XGEN(b.x)], 1u);
            asm volatile("s_waitcnt vmcnt(0)" ::: "memory");
        } else {
            XB_SPIN(xb_ld(&bar[XB_XGEN(b.x)]) == gen, bar);
            __builtin_amdgcn_fence(__ATOMIC_ACQUIRE, "agent");
            asm volatile("s_waitcnt vmcnt(0)" ::: "memory");
        }
    }
    __syncthreads();
}

__global__ void __launch_bounds__(512, 2) fwd_megakernel(Params p) {
  cg::grid_group grid = cg::this_grid();
  extern __shared__ __attribute__((aligned(16))) unsigned char dsm[];
  char* smem = (char*)dsm;
  char* ws = p.ws;
  const float* mod0 = (const float*)(ws + OFF_MOD);
  const float* mod1 = mod0 + 9 * 6144;

  volatile XLAS unsigned* xst = (volatile XLAS unsigned*)((XLAS unsigned char*)dsm + 128 * 1024);
  if (threadIdx.x < 4) xst[threadIdx.x] = 0u;
  __syncthreads();
  const XcdBarrier xb = xcd_barrier_post((unsigned*)(ws + OFF_BAR), xst);
  phase_prep(p, smem);
  grid.sync();
  phase_normmod(p, 0);
  xcd_barrier(xb);
  { EpiBf16 e{(u16*)(ws + OFF_BIG), L0_IN};
    gemm_run((PG8_LAS unsigned char*)dsm, (const u16*)(ws + OFF_H), D, (const u16*)(ws + OFF_WT_IN0), NTOK, L0_IN, 2048, e); }
  if (gridDim.x == 256) { if (blockIdx.x >= 128 && blockIdx.x < 224) adaln_item(p, 1, blockIdx.x - 128, (float*)smem); }
  else { for (int c = blockIdx.x; c < 96; c += gridDim.x) adaln_item(p, 1, c, (float*)smem); }
  xcd_barrier(xb);
  phase_qknorm0(p);
  xcd_barrier(xb);
#pragma unroll 1
  for (int rep = 0; rep < REP_A0; ++rep) phase_attn0(p, (LDS_AS(unsigned char)*)dsm);
  xcd_barrier(xb);
  { EpiResid e{p.x_prompt, p.x_sample, mod0 + 4096, p.out + OUT_Y};
    gemm_run((PG8_LAS unsigned char*)dsm, (const u16*)(ws + OFF_H), D, (const u16*)(ws + OFF_WT_OUT0), NTOK, D, 2048, e); }
  xcd_barrier(xb);
  phase_normmod(p, 1);
  xcd_barrier(xb);
  { EpiBf16 e{(u16*)(ws + OFF_LAT1), L1_LD};
    gemm_run((PG8_LAS unsigned char*)dsm, (const u16*)(ws + OFF_H), D, (const u16*)(ws + OFF_WT_IN1), NTOK, L1_LD, 2048, e); }
  xcd_barrier(xb);
  phase_norm1(p);
  xcd_barrier(xb);
  { EpiBf16 e{(u16*)(ws + OFF_Q1), 3072};
    gemm_run((PG8_LAS unsigned char*)dsm, (const u16*)(ws + OFF_QN), 512, (const u16*)(ws + OFF_WT_QB), NTOK, 3072, 512, e); }
#pragma unroll 1
  for (int round = 0; round < 2; ++round) {
    { EpiBf16 e{(u16*)(ws + (round ? OFF_KV_LAT : OFF_KV_CTX)), 4096};
      gemm_run((PG8_LAS unsigned char*)dsm, (const u16*)(ws + (round ? OFF_CKV_ALL : OFF_CKV_CTX)), 512, (const u16*)(ws + OFF_WT_KVB),
               round ? 12288 : NCTX, 4096, 512, e); }
    xcd_barrier(xb);
    phase_attn1(p, (LDS_AS(unsigned char)*)dsm, round);
    xcd_barrier(xb);
  }
  { EpiResid e{p.out + OUT_Y, p.out + OUT_Y + (size_t)NCTX * D, mod1 + 4096, p.out + OUT_Y};
    gemm_run((PG8_LAS unsigned char*)dsm, (const u16*)(ws + OFF_LAT1) + 1088, L1_LD, (const u16*)(ws + OFF_WT_OUT1), NTOK, D, 2048, e); }
  xcd_barrier(xb);
  phase_final(p);
}

extern "C" void kernel_launch(void* const* d_in, const int* in_sizes, int n_in, void* d_out, int out_size, void* d_ws,
                              size_t ws_size, hipStream_t stream) {
  (void)in_sizes; (void)n_in; (void)out_size;
  if (ws_size < WS_NEEDED) { fprintf(stderr, "workspace too small: %zu < %zu\n", ws_size, (size_t)WS_NEEDED); return; }
  static int grid_blocks = 0;
  if (!grid_blocks) {
    int dev = 0, cus = 0, per_cu = 0;
    (void)hipGetDevice(&dev);
    (void)hipDeviceGetAttribute(&cus, hipDeviceAttributeMultiprocessorCount, dev);
    if (hipFuncSetAttribute((const void*)fwd_megakernel, hipFuncAttributeMaxDynamicSharedMemorySize, SMEM_BYTES) != hipSuccess) {
      fprintf(stderr, "hipFuncSetAttribute failed\n"); return; }
    (void)hipOccupancyMaxActiveBlocksPerMultiprocessor(&per_cu, fwd_megakernel, NT, SMEM_BYTES);
    if (per_cu < 1) { fprintf(stderr, "occupancy query returned %d\n", per_cu); return; }
    grid_blocks = cus;
  }
  Params p{};
  const float** pf = (const float**)&p;
  for (int i = 0; i < 28; ++i) pf[i] = (const float*)d_in[i];
  p.out = (float*)d_out;
  p.ws = (char*)d_ws;
  (void)hipMemsetAsync((char*)d_ws + OFF_BAR, 0, BAR_BYTES, stream);
  void* args[] = {&p};
  hipError_t e = hipLaunchCooperativeKernel((void*)fwd_megakernel, dim3(grid_blocks), dim3(NT), args, SMEM_BYTES, stream);
  if (e != hipSuccess) fprintf(stderr, "cooperative launch failed: %s (grid %d)\n", hipGetErrorString(e), grid_blocks);
}
```

```cpp
#include <hip/hip_runtime.h>
#include <hip/hip_cooperative_groups.h>
#include <cstdio>
namespace cg = cooperative_groups;

typedef unsigned short u16;
using bf16x8 = __attribute__((ext_vector_type(8))) short;
using s16x4  = __attribute__((ext_vector_type(4))) short;
using f32x16 = __attribute__((ext_vector_type(16))) float;
using f32x4  = __attribute__((ext_vector_type(4))) float;
using u32x4  = __attribute__((ext_vector_type(4))) unsigned;
typedef __bf16 bf16x2_t __attribute__((ext_vector_type(2)));
typedef float f32x2_t __attribute__((ext_vector_type(2)));
#define DI __device__ __forceinline__
#define MFMA32(a, b, c) __builtin_amdgcn_mfma_f32_32x32x16_bf16((a), (b), (c), 0, 0, 0)
#define LDS_AS(T) __attribute__((address_space(3))) T

constexpr int D = 2048;
constexpr int NTOK = 16384;
constexpr int NCTX = 8192;
constexpr int L0_IN = 6656;
constexpr int L1_IN = 3136;
constexpr int L1_LD = 3328;
constexpr float EPS = 1e-6f;
constexpr float LOG2E = 1.4426950408889634f;
constexpr float LOG2_THETA = 13.287712379549449f;
#ifndef REP_G
#define REP_G 1
#endif
#ifndef REP_A0
#define REP_A0 1
#endif
constexpr int NT = 512;
constexpr int NW = 8;

constexpr size_t OFF_WT_IN1  = 0;
constexpr size_t OFF_WT_QB   = OFF_WT_IN1 + (size_t)3328 * 2048 * 2;
constexpr size_t OFF_WT_KVB  = OFF_WT_QB + (size_t)3072 * 512 * 2;
constexpr size_t OFF_WT_OUT1 = OFF_WT_KVB + (size_t)4096 * 512 * 2;
constexpr size_t OFF_WL0     = OFF_WT_OUT1 + (size_t)2048 * 2048 * 2;
constexpr size_t OFF_WT_IN0  = OFF_WL0;
constexpr size_t OFF_WT_OUT0 = OFF_WT_IN0 + (size_t)6656 * 2048 * 2;
constexpr size_t OFF_H       = OFF_WT_OUT0 + (size_t)2048 * 2048 * 2;
constexpr size_t OFF_BIG     = OFF_H + (size_t)NTOK * 2048 * 2;
constexpr size_t OFF_C       = OFF_BIG + (size_t)NTOK * 6656 * 2;
constexpr size_t OFF_KA_ALL  = OFF_C;
constexpr size_t OFF_VA_ALL  = OFF_KA_ALL + (size_t)8 * 1536 * 256 * 2;
constexpr size_t OFF_KB_CTX  = OFF_VA_ALL + (size_t)8 * 1536 * 256 * 2;
constexpr size_t OFF_VB_CTX  = OFF_KB_CTX + (size_t)8 * 512 * 1024 * 2;
constexpr size_t OFF_CKV_ALL = OFF_VB_CTX + (size_t)8 * 512 * 1024 * 2;
constexpr size_t OFF_KR_ALL  = OFF_CKV_ALL + (size_t)8 * 1536 * 512 * 2;
constexpr size_t OFF_MOD     = OFF_KR_ALL + (size_t)8 * 1536 * 64 * 2;
constexpr size_t OFF_ROPE    = OFF_MOD + (size_t)2 * 9 * 6144 * 4;
constexpr size_t OFF_ROPE0   = OFF_ROPE + (size_t)64 * 16 * 2 * 4;
constexpr size_t OFF_BAR     = OFF_ROPE0 + (size_t)64 * 32 * 2 * 4;
constexpr size_t BAR_BYTES   = 3456 * 4;
constexpr size_t WS_NEEDED   = OFF_BAR + BAR_BYTES;
constexpr size_t OFF_QN      = OFF_WL0;
constexpr size_t OFF_CKV_CTX = OFF_QN + (size_t)NTOK * 512 * 2;
constexpr size_t OFF_KR_CTX  = OFF_CKV_CTX + (size_t)NCTX * 512 * 2;
constexpr size_t OFF_KV_CTX  = OFF_H;
constexpr size_t OFF_KV_LAT  = OFF_WL0;
constexpr size_t OFF_LAT1    = OFF_BIG;
constexpr size_t OFF_Q1      = OFF_BIG + (size_t)NTOK * L1_LD * 2;
static_assert(OFF_KR_CTX + (size_t)NCTX * 64 * 2 <= OFF_WT_OUT0, "l1 small bufs overflow");
static_assert(OFF_KV_LAT + (size_t)12288 * 4096 * 2 <= OFF_BIG, "kv_lat overflow");
static_assert(OFF_Q1 + (size_t)NTOK * 3072 * 2 <= OFF_C, "q1 overflow");

constexpr size_t OUT_Y   = 0;
constexpr size_t OUT_NAK = (size_t)NTOK * 2048;
constexpr size_t OUT_NAV = OUT_NAK + (size_t)NCTX * 256;
constexpr size_t OUT_NBK = OUT_NAV + (size_t)NCTX * 256;
constexpr size_t OUT_NBV = OUT_NBK + (size_t)NCTX * 1024;
constexpr size_t OUT_NCKV = OUT_NBV + (size_t)NCTX * 1024;
constexpr size_t OUT_NKR = OUT_NCKV + (size_t)NCTX * 512;

constexpr int SMEM_BYTES = 128 * 1024 + 256;

struct Params {
  const float *x_prompt, *x_sample, *ca_k, *ca_v, *cb_k, *cb_v, *c_ckv, *c_kr, *c, *c_ctx;
  const float *l0_norm, *l0_ada_w, *l0_ada_b, *l0_w_in, *l0_qn, *l0_kn, *l0_rpb, *l0_w_out;
  const float *l1_norm, *l1_ada_w, *l1_ada_b, *l1_w_in, *l1_qan, *l1_wqb, *l1_kvan, *l1_wkvb, *l1_w_out, *fnorm;
  float* out;
  char* ws;
};

DI int threadIdx_x_raw() { return (int)__builtin_amdgcn_workitem_id_x(); }
DI u16 f2bf(float x) { unsigned u = __float_as_uint(x); u += 0x7fffu + ((u >> 16) & 1u); return (u16)(u >> 16); }
DI float bf2f(u16 v) { return __uint_as_float(((unsigned)v) << 16); }
DI unsigned pack2(float a, float b) { f32x2_t f = {a, b}; bf16x2_t r = __builtin_convertvector(f, bf16x2_t); return __builtin_bit_cast(unsigned, r); }
DI float bflo(unsigned u) { return __uint_as_float(u << 16); }
DI float bfhi(unsigned u) { return __uint_as_float(u & 0xffff0000u); }
DI float wave_sum(float v) {
#pragma unroll
  for (int o = 32; o >= 1; o >>= 1) v += __shfl_xor(v, o);
  return v;
}
DI int TID() { int t = threadIdx_x_raw(); asm volatile("" : "+v"(t)); return t; }
DI int crow(int i, int h) { return (i & 3) + 8 * (i >> 2) + 4 * h; }
DI float silu(float x) { return x / (1.f + __expf(-x)); }
DI int tok_modrow(int tok) { return tok < NCTX ? 0 : 1 + ((tok - NCTX) >> 10); }

DI void transpose_tile(const float* __restrict__ src, int K, int N, u16* __restrict__ dst, int kt, int nt, float* sm) {
  const int t = TID();
  float4 v[8];
#pragma unroll
  for (int i = 0; i < 8; ++i) {
    int id = t + NT * i, r = id >> 6, c4 = id & 63, n = nt * 256 + c4 * 4;
    v[i] = (n < N) ? *(const float4*)(src + (size_t)(kt * 64 + r) * N + n) : make_float4(0.f, 0.f, 0.f, 0.f);
  }
#pragma unroll
  for (int i = 0; i < 8; ++i) {
    int id = t + NT * i, r = id >> 6, c4 = id & 63;
    *(float4*)(sm + r * 260 + c4 * 4) = v[i];
  }
  __syncthreads();
  {
    const int nl = t >> 1, kq = t & 1, n = nt * 256 + nl;
    if (n < N) {
      u16* dp = dst + (size_t)n * K + kt * 64 + kq * 32;
#pragma unroll
      for (int q = 0; q < 4; ++q) {
        u32x4 o;
#pragma unroll
        for (int j = 0; j < 4; ++j) o[j] = pack2(sm[(kq * 32 + q * 8 + 2 * j) * 260 + nl], sm[(kq * 32 + q * 8 + 2 * j + 1) * 260 + nl]);
        *(u32x4*)(dp + q * 8) = o;
      }
    }
  }
  __syncthreads();
}

DI void adaln_item(const Params& p, int l, int chunk, float* sm) {
  const float* W = l ? p.l1_ada_w : p.l0_ada_w;
  const float* bias = l ? p.l1_ada_b : p.l0_ada_b;
  float* mod = (float*)(p.ws + OFF_MOD) + (size_t)l * 9 * 6144;
  const int t = TID(), col = chunk * 64 + (t & 63), kg = t >> 6;
  float acc[9];
#pragma unroll
  for (int r = 0; r < 9; ++r) acc[r] = 0.f;
  for (int kh = 0; kh < 2; ++kh) {
    __syncthreads();
    for (int e = t; e < 9 * 1024; e += NT) {
      int r = e >> 10, k = e & 1023;
      float cv = (r == 0) ? p.c_ctx[kh * 1024 + k] : p.c[(r - 1) * 2048 + kh * 1024 + k];
      sm[r * 1024 + k] = silu(cv);
    }
    __syncthreads();
    const float* wp = W + (size_t)(kh * 1024 + kg * 128) * 6144 + col;
    const float* sp = sm + kg * 128;
#pragma unroll 8
    for (int k = 0; k < 128; ++k) {
      float w = wp[(size_t)k * 6144];
#pragma unroll
      for (int r = 0; r < 9; ++r) acc[r] += sp[r * 1024 + k] * w;
    }
  }
  __syncthreads();
#pragma unroll
  for (int r = 0; r < 9; ++r) sm[(kg * 9 + r) * 64 + (t & 63)] = acc[r];
  __syncthreads();
  for (int e = t; e < 9 * 64; e += NT) {
    int r = e >> 6, cc = e & 63;
    float s = 0.f;
#pragma unroll
    for (int g = 0; g < NW; ++g) s += sm[(g * 9 + r) * 64 + cc];
    mod[(size_t)r * 6144 + chunk * 64 + cc] = s + bias[chunk * 64 + cc];
  }
  __syncthreads();
}

DI void convert_item(const float* __restrict__ src, u16* __restrict__ dst, int W, int dstT, int item) {
  size_t e = (size_t)item * 4096 + TID() * 8;
  size_t per_b = (size_t)512 * W;
  size_t b = e / per_b, r = e % per_b;
  float4 v0 = *(const float4*)(src + e), v1 = *(const float4*)(src + e + 4);
  u32x4 o = {pack2(v0.x, v0.y), pack2(v0.z, v0.w), pack2(v1.x, v1.y), pack2(v1.z, v1.w)};
  *(u32x4*)(dst + b * (size_t)dstT * W + r) = o;
}

DI void phase_prep(const Params& p, char* smem) {
  float* sm = (float*)smem;
  char* ws = p.ws;
  constexpr int T_IN0 = 32 * 26, T_OUT0 = 32 * 8, T_IN1 = 32 * 13, T_QB = 8 * 12, T_KVB = 8 * 16, T_OUT1 = 32 * 8;
  constexpr int C_A = 256, C_B = 1024, C_CKV = 512, C_KR = 64;
  constexpr int B1 = 0, B2 = B1 + T_IN0, B3 = B2 + T_OUT0, B4 = B3 + T_IN1, B5 = B4 + T_QB, B6 = B5 + T_KVB, B7 = B6 + T_OUT1;
  constexpr int B8 = B7 + C_A, B9 = B8 + C_A, B10 = B9 + C_B, B11 = B10 + C_B, B12 = B11 + C_CKV, B13 = B12 + C_KR;
  if (blockIdx.x == gridDim.x - 1) {
    float* tab = (float*)(ws + OFF_ROPE);
    for (int e = TID(); e < 64 * 16; e += NT) {
      int pos = e >> 4, i = e & 15;
      float inv = exp2f(-(float)i * (LOG2_THETA / 16.f));
      float sn, cs; sincosf((float)pos * inv, &sn, &cs);
      tab[2 * e] = cs; tab[2 * e + 1] = sn;
    }
    float* tab0 = (float*)(ws + OFF_ROPE0);
    for (int e = TID(); e < 64 * 32; e += NT) {
      int pos = e >> 5, i = e & 31;
      float inv = exp2f(-(float)i * (LOG2_THETA / 32.f));
      float sn, cs; sincosf((float)pos * inv, &sn, &cs);
      tab0[2 * e] = cs; tab0[2 * e + 1] = sn;
    }
  }
  const int nada = (gridDim.x > 128) ? 96 : 0;
  if ((int)blockIdx.x < nada) { adaln_item(p, 0, blockIdx.x, sm); return; }
  if (nada == 0) { for (int c = blockIdx.x; c < 96; c += gridDim.x) adaln_item(p, 0, c, sm); }
  for (int it = blockIdx.x - nada; it < B13; it += gridDim.x - nada) {
    if (it < B2) { int i = it - B1; transpose_tile(p.l0_w_in, 2048, 6656, (u16*)(ws + OFF_WT_IN0), i / 26, i % 26, sm); }
    else if (it < B3) { int i = it - B2; transpose_tile(p.l0_w_out, 2048, 2048, (u16*)(ws + OFF_WT_OUT0), i / 8, i % 8, sm); }
    else if (it < B4) { int i = it - B3; transpose_tile(p.l1_w_in, 2048, 3136, (u16*)(ws + OFF_WT_IN1), i / 13, i % 13, sm); }
    else if (it < B5) { int i = it - B4; transpose_tile(p.l1_wqb, 512, 3072, (u16*)(ws + OFF_WT_QB), i / 12, i % 12, sm); }
    else if (it < B6) { int i = it - B5; transpose_tile(p.l1_wkvb, 512, 4096, (u16*)(ws + OFF_WT_KVB), i / 16, i % 16, sm); }
    else if (it < B7) { int i = it - B6; transpose_tile(p.l1_w_out, 2048, 2048, (u16*)(ws + OFF_WT_OUT1), i / 8, i % 8, sm); }
    else if (it < B8) convert_item(p.ca_k, (u16*)(ws + OFF_KA_ALL), 256, 1536, it - B7);
    else if (it < B9) convert_item(p.ca_v, (u16*)(ws + OFF_VA_ALL), 256, 1536, it - B8);
    else if (it < B10) convert_item(p.cb_k, (u16*)(ws + OFF_KB_CTX), 1024, 512, it - B9);
    else if (it < B11) convert_item(p.cb_v, (u16*)(ws + OFF_VB_CTX), 1024, 512, it - B10);
    else if (it < B12) convert_item(p.c_ckv, (u16*)(ws + OFF_CKV_ALL), 512, 1536, it - B11);
    else convert_item(p.c_kr, (u16*)(ws + OFF_KR_ALL), 64, 1536, it - B12);
  }
}

DI void phase_normmod(const Params& p, int layer) {
  const int wave = TID() >> 6, lane = TID() & 63;
  const float* g = layer ? p.l1_norm : p.l0_norm;
  const float* mod = (const float*)(p.ws + OFF_MOD) + (size_t)layer * 9 * 6144;
  u16* H = (u16*)(p.ws + OFF_H);
  for (int it = blockIdx.x; it < NTOK / NW; it += gridDim.x) {
    int row = it * NW + wave;
    const float* src;
    if (layer == 0) src = row < NCTX ? p.x_prompt + (size_t)row * D : p.x_sample + (size_t)(row - NCTX) * D;
    else src = p.out + OUT_Y + (size_t)row * D;
    const float* mr = mod + (size_t)tok_modrow(row) * 6144;
    float4 v[8];
    float ss = 0.f;
#pragma unroll
    for (int i = 0; i < 8; ++i) {
      v[i] = *(const float4*)(src + (i * 64 + lane) * 4);
      ss += v[i].x * v[i].x + v[i].y * v[i].y + v[i].z * v[i].z + v[i].w * v[i].w;
    }
    ss = wave_sum(ss);
    float rinv = rsqrtf(ss * (1.f / D) + EPS);
#pragma unroll
    for (int i = 0; i < 8; ++i) {
      int col = (i * 64 + lane) * 4;
      float4 gg = *(const float4*)(g + col);
      float4 sh = *(const float4*)(mr + col);
      float4 sc = *(const float4*)(mr + 2048 + col);
      float h0 = v[i].x * rinv * gg.x * (1.f + sc.x) + sh.x;
      float h1 = v[i].y * rinv * gg.y * (1.f + sc.y) + sh.y;
      float h2 = v[i].z * rinv * gg.z * (1.f + sc.z) + sh.z;
      float h3 = v[i].w * rinv * gg.w * (1.f + sc.w) + sh.w;
      *(uint2*)(H + (size_t)row * D + col) = make_uint2(pack2(h0, h1), pack2(h2, h3));
    }
  }
}

namespace pg8 {
#define PG8_LAS __attribute__((address_space(3)))
typedef unsigned short bf16_t;
typedef short bf16x8 __attribute__((ext_vector_type(8)));
typedef float f32x4 __attribute__((ext_vector_type(4)));
typedef unsigned u32x4 __attribute__((ext_vector_type(4)));
constexpr int BM = 256, BK = 64, HALF = 128, HTB = HALF * BK * 2  , STAGE_BYTES = 8 * HTB, NXCD = 8, WGM = 8;

__host__ __device__ __forceinline__ int lds_byte(int r, int c) { const int st = (r >> 4) * 2 + (c >> 5), rr = r & 15, cc = c & 31, ob = rr * 64 + cc * 2; return st * 1024 + (ob ^ (((ob >> 9) & 1) << 5)); }
__host__ __device__ __forceinline__ void stage_rc(int b, int& R, int& C) { const int st = b / 1024, sb = b % 1024, swz = sb ^ (((sb >> 9) & 1) << 5); R = (st >> 1) * 16 + swz / 64; C = (st & 1) * 32 + (swz % 64) / 2; }
__host__ __device__ __forceinline__ int perm32(int rho) { const int n = rho >> 4, i = rho & 15; return 8 * (i >> 2) + 4 * n + (i & 3); }

struct Unit { int pm, pn; };
struct Gemm { const bf16_t* A; const bf16_t* Bt; int M, N, K, lda; };
struct StaticOrder {
    int nM, nN, nwg, G, c;
    __host__ __device__ void init(int M, int N, int G_, int c_) { nM = M / BM; nN = N / BM; nwg = nM * nN; G = G_; c = c_; }
    __host__ __device__ bool next(int i, Unit& u) const {
        const long L = (long)i * G + c; if (L >= nwg) return false;
        int wgid = (int)L; { const int q = nwg / NXCD, r = nwg % NXCD, xcd = wgid % NXCD, off = wgid / NXCD; wgid = (xcd < r ? xcd * (q + 1) : r * (q + 1) + (xcd - r) * q) + off; }
        const int nig = WGM * nN, gid = wgid / nig, fm = gid * WGM, gsz = (nM - fm) < WGM ? (nM - fm) : WGM;
        u.pm = fm + ((wgid % nig) % gsz); u.pn = (wgid % nig) / gsz; return true;
    }
    __device__ __forceinline__ void a_ready(const Unit&) const {}
    __device__ __forceinline__ void done(const Unit&) const {}
};
template <class Epi, class Sched, bool STAMP = false>
__device__ __forceinline__ void gemm_phase(PG8_LAS unsigned char* lds, const Gemm g, const Sched& S, const Epi& E, unsigned long long* stamps) {
    const int tid = TID(), wid = __builtin_amdgcn_readfirstlane(tid >> 6), lane = tid & 63, wr = wid >> 2, wc = wid & 3, fr = lane & 15, fq = lane >> 4;
    const int K = g.K, nt = K / BK;
    int ts_lo = 0, ts_hi = 0, nts = 0; const unsigned long long rt_entry = STAMP ? (unsigned long long)wall_clock64() : 0ull;
#define PG8_STAMP() do { if (STAMP && wid == 0 && nts < 64) { const unsigned long long _c = (unsigned long long)clock64(); \
        ts_lo = (lane == nts) ? (int)(unsigned)_c : ts_lo; ts_hi = (lane == nts) ? (int)(unsigned)(_c >> 32) : ts_hi; ++nts; } } while (0)
    PG8_STAMP();
    unsigned voffA[2], voffB[2];
#pragma unroll
    for (int i = 0; i < 2; ++i) { int R, C; stage_rc(tid * 16 + i * 8192, R, C); const int Rb = Epi::PERM ? ((R & ~31) + perm32(R & 31)) : R;
        voffA[i] = (unsigned)(R * g.lda + C) * 2u; voffB[i] = (unsigned)(Rb * K + C) * 2u; }
    const size_t kstep = (size_t)(BK * 2);
    const size_t hstepB = (size_t)HALF * K * 2, hstepA = (size_t)HALF * g.lda * 2;
    const size_t tstepB = 2 * hstepB, tstepA = 2 * hstepA;
    const unsigned ldsw = (unsigned)wid * 1024u;
    const int aoff = lds_byte(wr * 64 + fr, fq * 8), boff = lds_byte(wc * 32 + fr, fq * 8);
#define PG8_SA(b, h) (((b) * 2 + (h)) * HTB)
#define PG8_SB(b, h) ((4 + (b) * 2 + (h)) * HTB)
#define PG8_STAGE(bufoff, gbase, voff) do { _Pragma("unroll") for (int _i = 0; _i < 2; ++_i) \
        __builtin_amdgcn_global_load_lds((const unsigned*)((const char*)(gbase) + (voff)[_i]), (PG8_LAS unsigned*)(lds + (bufoff) + ldsw + _i * 8192), 16, 0, 0); } while (0)
#define PG8_LDA(dst, b, h) do { _Pragma("unroll") for (int m = 0; m < 4; ++m) _Pragma("unroll") for (int k = 0; k < 2; ++k) dst[m][k] = *(const PG8_LAS bf16x8*)(lds + PG8_SA(b, h) + aoff + m * 2048 + k * 1024); } while (0)
#define PG8_LDB(dst, b, h) do { _Pragma("unroll") for (int n = 0; n < 2; ++n) _Pragma("unroll") for (int k = 0; k < 2; ++k) dst[n][k] = *(const PG8_LAS bf16x8*)(lds + PG8_SB(b, h) + boff + n * 2048 + k * 1024); } while (0)
#define PG8_MMA(ai, bj, At, Bt) do { __builtin_amdgcn_s_setprio(1); _Pragma("unroll") for (int m = 0; m < 4; ++m) _Pragma("unroll") for (int n = 0; n < 2; ++n) _Pragma("unroll") for (int k = 0; k < 2; ++k) \
        acc[ai][bj][m][n] = __builtin_amdgcn_mfma_f32_16x16x32_bf16(Bt[n][k], At[m][k], acc[ai][bj][m][n], 0, 0, 0); __builtin_amdgcn_s_setprio(0); } while (0)
#define PG8_WAIT_V(n) asm volatile("s_waitcnt vmcnt(" #n ")" ::: "memory")
#define PG8_WAIT_L(n) asm volatile("s_waitcnt lgkmcnt(" #n ")" ::: "memory")
#define PG8_BAR __builtin_amdgcn_s_barrier()
#define PG8_SCHED __builtin_amdgcn_sched_barrier(0)
    Unit cur, nxt; int ui = 0;
    if (!S.next(0, cur)) return;
    f32x4 acc[2][2][4][2];
#pragma unroll
    for (int a = 0; a < 2; ++a)
#pragma unroll
        for (int b = 0; b < 2; ++b)
#pragma unroll
            for (int m = 0; m < 4; ++m)
#pragma unroll
                for (int n = 0; n < 2; ++n) acc[a][b][m][n] = (f32x4){0.f, 0.f, 0.f, 0.f};
    bf16x8 At[4][2], B0[2][2], B1[2][2];
    const char* cA = (const char*)g.A + (size_t)cur.pm * tstepA; const char* cB = (const char*)g.Bt + (size_t)cur.pn * tstepB;
    S.a_ready(cur);
    PG8_STAGE(PG8_SB(0, 0), cB, voffB); PG8_STAGE(PG8_SA(0, 0), cA, voffA); PG8_STAGE(PG8_SB(0, 1), cB + hstepB, voffB); PG8_STAGE(PG8_SA(0, 1), cA + hstepA, voffA);
    if (wr == 1) PG8_BAR;
    PG8_WAIT_V(4); PG8_BAR;
    PG8_STAGE(PG8_SB(1, 0), cB + kstep, voffB); PG8_STAGE(PG8_SA(1, 0), cA + kstep, voffA); PG8_STAGE(PG8_SB(1, 1), cB + hstepB + kstep, voffB);
    PG8_WAIT_V(6); PG8_BAR;
    PG8_STAMP();
    for (;;) {
        const bool has_next = S.next(ui + 1, nxt);
        const char* nA = has_next ? (const char*)g.A + (size_t)nxt.pm * tstepA : cA; const char* nB = has_next ? (const char*)g.Bt + (size_t)nxt.pn * tstepB : cB;
        for (int t = 0; t < nt; t += 2) {
            const bool last = (t == nt - 2);
            const char* a1 = cA + (size_t)(t + 1) * kstep;
            const char* a2 = last ? nA : cA + (size_t)(t + 2) * kstep; const char* b2 = last ? nB : cB + (size_t)(t + 2) * kstep;
            const char* a3 = a2 + kstep; const char* b3 = b2 + kstep;
            if (last && has_next) S.a_ready(nxt);
            PG8_LDB(B0, 0, 0); PG8_SCHED; PG8_LDA(At, 0, 0); PG8_STAGE(PG8_SA(1, 1), a1 + hstepA, voffA);
            PG8_WAIT_L(8); PG8_BAR; PG8_WAIT_L(0); PG8_MMA(0, 0, At, B0); PG8_BAR; PG8_SCHED;
            PG8_LDB(B1, 0, 1); PG8_STAGE(PG8_SB(0, 0), b2, voffB);
            PG8_BAR; PG8_WAIT_L(0); PG8_MMA(0, 1, At, B1); PG8_BAR;
            PG8_LDA(At, 0, 1); PG8_STAGE(PG8_SA(0, 0), a2, voffA);
            PG8_BAR; PG8_WAIT_L(0); PG8_MMA(1, 0, At, B0); PG8_BAR; PG8_SCHED;
            PG8_STAGE(PG8_SB(0, 1), b2 + hstepB, voffB);
            PG8_WAIT_V(6); PG8_BAR; PG8_MMA(1, 1, At, B1); PG8_BAR;
            PG8_LDB(B0, 1, 0); PG8_SCHED; PG8_LDA(At, 1, 0); PG8_STAGE(PG8_SA(0, 1), a2 + hstepA, voffA);
            PG8_WAIT_L(8); PG8_BAR; PG8_WAIT_L(0); PG8_MMA(0, 0, At, B0); PG8_BAR; PG8_SCHED;
            PG8_LDB(B1, 1, 1); PG8_STAGE(PG8_SB(1, 0), b3, voffB);
            PG8_BAR; PG8_WAIT_L(0); PG8_MMA(0, 1, At, B1); PG8_BAR;
            PG8_LDA(At, 1, 1); PG8_STAGE(PG8_SA(1, 0), a3, voffA);
            PG8_BAR; PG8_WAIT_L(0); PG8_MMA(1, 0, At, B0); PG8_BAR; PG8_SCHED;
            PG8_STAGE(PG8_SB(1, 1), b3 + hstepB, voffB);
            PG8_WAIT_V(6); PG8_BAR; PG8_MMA(1, 1, At, B1); PG8_BAR;
        }
        PG8_STAMP();
        if constexpr (!Epi::AFTER_DRAIN) { E(acc, cur, wr, wc, fr, fq); S.done(cur); }
        PG8_STAMP();
        if (!has_next) break;
#pragma unroll
        for (int a = 0; a < 2; ++a)
#pragma unroll
            for (int b = 0; b < 2; ++b)
#pragma unroll
                for (int m = 0; m < 4; ++m)
#pragma unroll
                    for (int n = 0; n < 2; ++n) acc[a][b][m][n] = (f32x4){0.f, 0.f, 0.f, 0.f};
        cur = nxt; cA = nA; cB = nB; ++ui;
    }
    PG8_WAIT_V(0);
    if (wr == 0) PG8_BAR;
    PG8_BAR;
    if constexpr (Epi::AFTER_DRAIN) { E.fused(acc, cur, wr, wc, fr, fq, lds, wid, lane); S.done(cur); }
    PG8_STAMP();
    if (STAMP && wid == 0) { stamps[lane] = lane < nts ? (((unsigned long long)(unsigned)ts_hi << 32) | (unsigned)ts_lo) : 0ull;
        if (lane == 62) stamps[62] = rt_entry; if (lane == 63) stamps[63] = (unsigned long long)wall_clock64(); }
#undef PG8_STAMP
#undef PG8_SA
#undef PG8_SB
#undef PG8_STAGE
#undef PG8_LDA
#undef PG8_LDB
#undef PG8_MMA
#undef PG8_WAIT_V
#undef PG8_WAIT_L
#undef PG8_BAR
#undef PG8_SCHED
}
}


struct EpiBf16 {
  static constexpr bool PERM = true, AFTER_DRAIN = false;
  u16* O; int ldc;
  DI void operator()(const f32x4 (&acc)[2][2][4][2], const pg8::Unit& u, int wr, int wc, int fr, int fq) const {
    const int row0 = u.pm * 256 + wr * 64 + fr, col0 = u.pn * 256 + wc * 32 + 8 * fq;
#pragma unroll
    for (int ai = 0; ai < 2; ++ai)
#pragma unroll
      for (int m = 0; m < 4; ++m) {
        u16* rowp = O + (size_t)(row0 + ai * 128 + m * 16) * ldc + col0;
#pragma unroll
        for (int bj = 0; bj < 2; ++bj) {
          f32x4 v0 = acc[ai][bj][m][0], v1 = acc[ai][bj][m][1];
          u32x4 w = {pack2(v0[0], v0[1]), pack2(v0[2], v0[3]), pack2(v1[0], v1[1]), pack2(v1[2], v1[3])};
          *(u32x4*)(rowp + bj * 128) = w;
        }
      }
  }
};
struct EpiResid {
  static constexpr bool PERM = false, AFTER_DRAIN = false;
  const float* xa; const float* xb; const float* gate; float* out;
  DI void operator()(const f32x4 (&acc)[2][2][4][2], const pg8::Unit& u, int wr, int wc, int fr, int fq) const {
    const int row0 = u.pm * 256 + wr * 64 + fr, col0 = u.pn * 256 + wc * 32 + 4 * fq;
#pragma unroll
    for (int ai = 0; ai < 2; ++ai)
#pragma unroll
      for (int m = 0; m < 4; ++m) {
        const int row = row0 + ai * 128 + m * 16;
        const float* xr = (row < NCTX) ? xa + (size_t)row * D : xb + (size_t)(row - NCTX) * D;
        const float* gr = gate + (size_t)tok_modrow(row) * 6144;
        float* orow = out + (size_t)row * D;
#pragma unroll
        for (int bj = 0; bj < 2; ++bj)
#pragma unroll
          for (int n = 0; n < 2; ++n) {
            const int col = col0 + bj * 128 + n * 16;
            f32x4 xv = *(const f32x4*)(xr + col);
            f32x4 gv = *(const f32x4*)(gr + col);
            *(f32x4*)(orow + col) = xv + gv * acc[ai][bj][m][n];
          }
      }
  }
};

template <class Epi>
DI void gemm_run(PG8_LAS unsigned char* lds, const u16* A, int lda, const u16* Bt, int M, int N, int K, const Epi& e) {
  pg8::Gemm g{A, Bt, M, N, K, lda};
  pg8::StaticOrder S; S.init(M, N, (int)gridDim.x, (int)blockIdx.x);
#pragma unroll 1
  for (int rep = 0; rep < (Epi::PERM ? REP_G : 1); ++rep) {
    __syncthreads();
    pg8::gemm_phase<Epi, pg8::StaticOrder, false>(lds, g, S, e, nullptr);
    __syncthreads();
  }
}

DI void phase_qknorm0(const Params& p) {
  const int t = TID(), wave = t >> 6, lane = t & 63, l15 = lane & 15;
  u16* QKVG = (u16*)(p.ws + OFF_BIG);
  u16* KA = (u16*)(p.ws + OFF_KA_ALL);
  u16* VA = (u16*)(p.ws + OFF_VA_ALL);
  const float* tab = (const float*)(p.ws + OFF_ROPE0);
  float gq[8], gk[8];
#pragma unroll
  for (int j = 0; j < 8; ++j) { gq[j] = p.l0_qn[l15 * 8 + j]; gk[j] = p.l0_kn[l15 * 8 + j]; }
  const bool hi = (l15 & 4) != 0;
  const bool colrot = l15 >= 8;
  const int f0 = (l15 & 3) * 8;
  for (int it = blockIdx.x; it < NTOK / NW; it += gridDim.x) {
    const int tk = it * NW + wave;
    u16* base = QKVG + (size_t)tk * L0_IN;
    const bool lat = tk >= NCTX;
    const int lt = tk - NCTX, b = lt >> 10, tt = lt & 1023;
    u32x4 v[3];
#pragma unroll
    for (int ps = 0; ps < 3; ++ps) v[ps] = *(const u32x4*)(base + (ps * 64 + lane) * 8);
    u32x4 kb[2], vb[2];
    if (!lat) {
#pragma unroll
      for (int q = 0; q < 2; ++q) { kb[q] = *(const u32x4*)(base + 2560 + (q * 64 + lane) * 8); vb[q] = *(const u32x4*)(base + 3584 + (q * 64 + lane) * 8); }
    }
    float cs[8], sn[8];
    if (lat) {
      const int pos = colrot ? (tt & 63) : (tt >> 6);
      const float4* tp = (const float4*)(tab + (pos * 32 + f0) * 2);
#pragma unroll
      for (int j2 = 0; j2 < 4; ++j2) { float4 c = tp[j2]; cs[2 * j2] = c.x; sn[2 * j2] = c.y; cs[2 * j2 + 1] = c.z; sn[2 * j2 + 1] = c.w; }
    } else {
#pragma unroll
      for (int j = 0; j < 8; ++j) { cs[j] = 1.f; sn[j] = 0.f; }
    }
    const size_t arow = (size_t)b * 1536 + 512 + tt;
#pragma unroll
    for (int ps = 0; ps < 3; ++ps) {
      float x[8];
#pragma unroll
      for (int j = 0; j < 4; ++j) { x[2 * j] = bflo(v[ps][j]); x[2 * j + 1] = bfhi(v[ps][j]); }
      float ss = 0.f;
#pragma unroll
      for (int j = 0; j < 8; ++j) ss += x[j] * x[j];
      ss += __shfl_xor(ss, 8); ss += __shfl_xor(ss, 4); ss += __shfl_xor(ss, 2); ss += __shfl_xor(ss, 1);
      const float rinv = rsqrtf(ss * (1.f / 128.f) + EPS);
      float o[8];
#pragma unroll
      for (int j = 0; j < 8; ++j) {
        const float y = x[j] * rinv * (ps < 2 ? gq[j] : gk[j]);
        const float pr = __shfl_xor(y, 4);
        o[j] = hi ? (y * cs[j] + pr * sn[j]) : (y * cs[j] - pr * sn[j]);
      }
      if (ps < 2) {
        u32x4 w = {pack2(o[0], o[1]), pack2(o[2], o[3]), pack2(o[4], o[5]), pack2(o[6], o[7])};
        *(u32x4*)(base + (ps * 64 + lane) * 8) = w;
      } else if (lane < 32) {
        u32x4 w = {pack2(o[0], o[1]), pack2(o[2], o[3]), pack2(o[4], o[5]), pack2(o[6], o[7])};
        if (!lat) {
          *(u32x4*)(base + 1024 + lane * 8) = w;
          float* op = p.out + OUT_NAK + (size_t)tk * 256 + lane * 8;
          *(float4*)op = make_float4(o[0], o[1], o[2], o[3]);
          *(float4*)(op + 4) = make_float4(o[4], o[5], o[6], o[7]);
        } else *(u32x4*)(KA + arow * 256 + lane * 8) = w;
      } else {
        if (!lat) {
          float* op = p.out + OUT_NAV + (size_t)tk * 256 + (lane - 32) * 8;
          *(float4*)op = make_float4(x[0], x[1], x[2], x[3]);
          *(float4*)(op + 4) = make_float4(x[4], x[5], x[6], x[7]);
        } else *(u32x4*)(VA + arow * 256 + (lane - 32) * 8) = v[2];
      }
    }
    if (!lat) {
#pragma unroll
      for (int q = 0; q < 2; ++q) {
        float* ok = p.out + OUT_NBK + (size_t)tk * 1024 + (q * 64 + lane) * 8;
        float* ov = p.out + OUT_NBV + (size_t)tk * 1024 + (q * 64 + lane) * 8;
        *(float4*)ok = make_float4(bflo(kb[q][0]), bfhi(kb[q][0]), bflo(kb[q][1]), bfhi(kb[q][1]));
        *(float4*)(ok + 4) = make_float4(bflo(kb[q][2]), bfhi(kb[q][2]), bflo(kb[q][3]), bfhi(kb[q][3]));
        *(float4*)ov = make_float4(bflo(vb[q][0]), bfhi(vb[q][0]), bflo(vb[q][1]), bfhi(vb[q][1]));
        *(float4*)(ov + 4) = make_float4(bflo(vb[q][2]), bfhi(vb[q][2]), bflo(vb[q][3]), bfhi(vb[q][3]));
      }
    }
  }
}

DI void phase_norm1(const Params& p) {
  const int wave = TID() >> 6, lane = TID() & 63;
  const u16* LAT1 = (const u16*)(p.ws + OFF_LAT1);
  u16* QN = (u16*)(p.ws + OFF_QN);
  u16* CKVC = (u16*)(p.ws + OFF_CKV_CTX);
  u16* KRC = (u16*)(p.ws + OFF_KR_CTX);
  u16* CKVA = (u16*)(p.ws + OFF_CKV_ALL);
  u16* KRA = (u16*)(p.ws + OFF_KR_ALL);
  float gq[8], gk[8];
#pragma unroll
  for (int j = 0; j < 8; ++j) { gq[j] = p.l1_qan[lane * 8 + j]; gk[j] = p.l1_kvan[lane * 8 + j]; }
  const int ri = lane & 15, rhalf = (lane >> 4) & 1;
  const int rd1 = rhalf * 32 + ri, rd2 = rd1 + 16;
  const float inv = exp2f(-(float)ri * (LOG2_THETA / 16.f));
  for (int it = blockIdx.x; it < NTOK / NW; it += gridDim.x) {
    int tk = it * NW + wave;
    const u16* base = LAT1 + (size_t)tk * L1_LD;
    const bool lat = tk >= NCTX;
    int lt = tk - NCTX, b = lt >> 10, tt = lt & 1023;
    size_t arow = (size_t)b * 1536 + 512 + tt;
#pragma unroll
    for (int part = 0; part < 2; ++part) {
      uint4 v = *(const uint4*)(base + part * 512 + lane * 8);
      float x[8] = {bflo(v.x), bfhi(v.x), bflo(v.y), bfhi(v.y), bflo(v.z), bfhi(v.z), bflo(v.w), bfhi(v.w)};
      float ss = 0.f;
#pragma unroll
      for (int j = 0; j < 8; ++j) ss += x[j] * x[j];
      ss = wave_sum(ss);
      float rinv = rsqrtf(ss * (1.f / 512.f) + EPS);
#pragma unroll
      for (int j = 0; j < 8; ++j) x[j] = x[j] * rinv * (part ? gk[j] : gq[j]);
      uint4 o = make_uint4(pack2(x[0], x[1]), pack2(x[2], x[3]), pack2(x[4], x[5]), pack2(x[6], x[7]));
      if (part == 0) *(uint4*)(QN + (size_t)tk * 512 + lane * 8) = o;
      else if (!lat) {
        *(uint4*)(CKVC + (size_t)tk * 512 + lane * 8) = o;
        float* op = p.out + OUT_NCKV + (size_t)tk * 512 + lane * 8;
        *(float4*)op = make_float4(x[0], x[1], x[2], x[3]);
        *(float4*)(op + 4) = make_float4(x[4], x[5], x[6], x[7]);
      } else *(uint4*)(CKVA + arow * 512 + lane * 8) = o;
    }
    if (lane < 32) {
      float x1 = bf2f(base[1024 + rd1]), x2 = bf2f(base[1024 + rd2]);
      if (!lat) {
        KRC[(size_t)tk * 64 + rd1] = f2bf(x1); KRC[(size_t)tk * 64 + rd2] = f2bf(x2);
        p.out[OUT_NKR + (size_t)tk * 64 + rd1] = x1; p.out[OUT_NKR + (size_t)tk * 64 + rd2] = x2;
      } else {
        float pos = rhalf ? (float)(tt & 63) : (float)(tt >> 6);
        float sn, cs; sincosf(pos * inv, &sn, &cs);
        KRA[arow * 64 + rd1] = f2bf(x1 * cs - x2 * sn);
        KRA[arow * 64 + rd2] = f2bf(x2 * cs + x1 * sn);
      }
    }
  }
}

DI void phase_final(const Params& p) {
  const int wave = TID() >> 6, lane = TID() & 63;
  for (int it = blockIdx.x; it < NTOK / NW; it += gridDim.x) {
    int row = it * NW + wave;
    float* y = p.out + OUT_Y + (size_t)row * D;
    float4 v[8];
    float ss = 0.f;
#pragma unroll
    for (int i = 0; i < 8; ++i) {
      v[i] = *(const float4*)(y + (i * 64 + lane) * 4);
      ss += v[i].x * v[i].x + v[i].y * v[i].y + v[i].z * v[i].z + v[i].w * v[i].w;
    }
    ss = wave_sum(ss);
    float rinv = rsqrtf(ss * (1.f / D) + EPS);
#pragma unroll
    for (int i = 0; i < 8; ++i) {
      int col = (i * 64 + lane) * 4;
      float4 gg = *(const float4*)(p.fnorm + col);
      *(float4*)(y + col) = make_float4(v[i].x * rinv * gg.x, v[i].y * rinv * gg.y, v[i].z * rinv * gg.z, v[i].w * rinv * gg.w);
    }
  }
}

struct KVSeg { const u16* k; const u16* v; const u16* kr; int ks, vs, n; };
struct AttnArgs {
  const u16* q; int qs;
  KVSeg seg[2]; int nseg;
  const u16* gate; int gs;
  u16* out; int os;
  float scale_log2;
  const float* rpb;
  int qtok0;
  int rs0;
  int rope;
  const float* ropetab;
};

DI float xhalf_max(float v) {
  unsigned u = __float_as_uint(v);
  auto r = __builtin_amdgcn_permlane32_swap(u, u, false, false);
  return fmaxf(__uint_as_float(r[0]), __uint_as_float(r[1]));
}
DI int swz16(int r) { return ((r & 3) << 2) | ((r >> 2) & 3); }

template <int DQK, int MODE>
DI void attn_issue_tile(const AttnArgs& a, int tile, int nt0, LDS_AS(unsigned char)* slot, int wave, int lane) {
  const int sg = tile >= nt0 ? 1 : 0;
  const int off = (sg ? tile - nt0 : tile) * 64;
  const u16* kp = sg ? a.seg[1].k : a.seg[0].k;
  const u16* vp = sg ? a.seg[1].v : a.seg[0].v;
  const int ks = sg ? a.seg[1].ks : a.seg[0].ks;
  const int vs = sg ? a.seg[1].vs : a.seg[0].vs;
  const int sw = ((lane >> 4) << 2) | (wave & 3);
  const int ch = (lane & 15) ^ sw;
#pragma unroll
  for (int j = 0; j < 2; ++j) {
    const int row = off + (j * 8 + wave) * 4 + (lane >> 4);
    __builtin_amdgcn_global_load_lds((const unsigned*)(kp + (unsigned)(row * ks + ch * 8)), (LDS_AS(unsigned)*)(slot + (j * 8 + wave) * 1024), 16, 0, 0);
    __builtin_amdgcn_global_load_lds((const unsigned*)(vp + (unsigned)(row * vs + ch * 8)), (LDS_AS(unsigned)*)(slot + 16384 + (j * 8 + wave) * 1024), 16, 0, 0);
  }
  if constexpr (MODE == 2) {
    const u16* krp = sg ? a.seg[1].kr : a.seg[0].kr;
    const int row = wave * 8 + (lane >> 3);
    const int c2 = (lane & 7) ^ ((row >> 1) & 7);
    __builtin_amdgcn_global_load_lds((const unsigned*)(krp + (unsigned)((off + row) * 64 + c2 * 8)), (LDS_AS(unsigned)*)(slot + 32768 + wave * 1024), 16, 0, 0);
  }
}

template <int DQK, int MODE>
DI void attn_block(const AttnArgs& a, LDS_AS(unsigned char)* lds) {
  constexpr int NS = DQK / 16;
  constexpr int SLOTB = (MODE == 2) ? 40960 : 32768;
  constexpr int NLOAD = (MODE == 2) ? 5 : 4;
  LDS_AS(float)* bias_s = (LDS_AS(float)*)(lds + 3 * SLOTB);
  const int t = TID(), wave = __builtin_amdgcn_readfirstlane(t >> 6), lane = t & 63, l31 = lane & 31, h = lane >> 5;

  __syncthreads();
  if constexpr (MODE == 1) {
    for (int e = t; e < 15 * 31; e += NT) bias_s[e] = a.rpb[e] * LOG2E;
    __syncthreads();
  }
  int ntiles = 0;
  for (int s = 0; s < a.nseg; ++s) ntiles += a.seg[s].n >> 6;
  const int nt0 = a.seg[0].n >> 6;
  bf16x8 qf[NS];
  {
    const u16* qp = a.q + (size_t)(wave * 32 + l31) * a.qs + 8 * h;
#pragma unroll
    for (int s = 0; s < NS; ++s) qf[s] = *(const bf16x8*)(qp + 16 * s);
  }
  attn_issue_tile<DQK, MODE>(a, 0, nt0, lds, wave, lane);
  attn_issue_tile<DQK, MODE>(a, ntiles > 1 ? 1 : 0, nt0, lds + SLOTB, wave, lane);
  const int qtok = a.qtok0 + wave * 32 + l31;
  if constexpr (MODE == 2) {
    if (a.rope) {
      const int qr = qtok >> 6, qc = qtok & 63;
#pragma unroll
      for (int pr = 0; pr < 2; ++pr) {
        const float4* tb = (const float4*)(a.ropetab + ((pr ? qc : qr) * 16 + 8 * h) * 2);
#pragma unroll
        for (int j2 = 0; j2 < 4; ++j2) {
          float4 cssn = tb[j2];
#pragma unroll
          for (int e = 0; e < 2; ++e) {
            const int j = 2 * j2 + e;
            float cs = e ? cssn.z : cssn.x, sn = e ? cssn.w : cssn.y;
            float x1 = bf2f((u16)qf[8 + 2 * pr][j]), x2 = bf2f((u16)qf[9 + 2 * pr][j]);
            qf[8 + 2 * pr][j] = (short)f2bf(x1 * cs - x2 * sn);
            qf[9 + 2 * pr][j] = (short)f2bf(x2 * cs + x1 * sn);
          }
        }
      }
    }
  }
  f32x16 acc[4];
#pragma unroll
  for (int c = 0; c < 4; ++c)
#pragma unroll
    for (int r = 0; r < 16; ++r) acc[c][r] = 0.f;
  float m_run = -1e30f, l_run = 0.f;

  const int blk = (lane >> 4) & 1, tq = (lane & 15) >> 2, tp = lane & 3;
  const int kswz = swz16(l31);
  const int kb0 = l31 * 256 + ((h ^ (kswz & 1)) << 4);
  const int ksw = kswz >> 1;
  const int kr0 = 32768 + l31 * 128;
  const int krsw = (l31 >> 1) & 7;
  const int vlow0 = (2 * blk + (tp >> 1)) ^ (h & 3);
  const int vlow1 = (2 * blk + (tp >> 1)) ^ ((2 + h) & 3);
  const int vb0 = 16384 + (4 * h + tq) * 256 + (vlow0 << 4) + 8 * (tp & 1);
  const int vb1 = 16384 + (8 + 4 * h + tq) * 256 + (vlow1 << 4) + 8 * (tp & 1);
  const int qrow = qtok >> 6, qcol = qtok & 63;
  int q_rs = qrow - 4; q_rs = q_rs < 0 ? 0 : (q_rs > 8 ? 8 : q_rs);
  int q_cs = qcol - 8; q_cs = q_cs < 0 ? 0 : (q_cs > 48 ? 48 : q_cs);

  int sl = 0;
  for (int tile = 0; tile < ntiles; ++tile) {
    if constexpr (NLOAD == 5) asm volatile("s_waitcnt vmcnt(5)" ::: "memory"); else asm volatile("s_waitcnt vmcnt(4)" ::: "memory");
    __builtin_amdgcn_s_barrier();
    asm volatile("" ::: "memory");
    {
      int nx = tile + 2; nx = nx < ntiles ? nx : ntiles - 1;
      int sn = sl + 2; sn = sn >= 3 ? sn - 3 : sn;
      attn_issue_tile<DQK, MODE>(a, nx, nt0, lds + sn * SLOTB, wave, lane);
    }
    LDS_AS(unsigned char)* slot = lds + sl * SLOTB;
    sl = sl == 2 ? 0 : sl + 1;

    const bool local = (MODE == 1) && (tile >= nt0);
    const int krow = a.rs0 + (tile - nt0);
#pragma unroll 1
    for (int mt = 0; mt < 2; ++mt) {
      f32x16 S;
#pragma unroll
      for (int r = 0; r < 16; ++r) S[r] = 0.f;
      LDS_AS(unsigned char)* kbase = slot + mt * 8192 + kb0;
#pragma unroll
      for (int s = 0; s < 8; ++s) {
        bf16x8 kf = *(const LDS_AS(bf16x8)*)(kbase + ((s ^ ksw) << 5));
        S = MFMA32(kf, qf[s], S);
      }
      if constexpr (MODE == 2) {
        LDS_AS(unsigned char)* rbase = slot + mt * 4096 + kr0;
#pragma unroll
        for (int s2 = 0; s2 < 4; ++s2) {
          bf16x8 kf = *(const LDS_AS(bf16x8)*)(rbase + (((2 * s2 + h) ^ krsw) << 4));
          S = MFMA32(kf, qf[8 + s2], S);
        }
      }
      float mx = -1e30f;
#pragma unroll
      for (int r = 0; r < 16; ++r) {
        float sv = S[r] * a.scale_log2;
        if (MODE == 1) {
          if (local) {
            int kcol = mt * 32 + crow(r, h);
            bool ok = (krow >= q_rs) && (krow < q_rs + 8) && (kcol >= q_cs) && (kcol < q_cs + 16);
            int dy = krow - qrow + 7, dx = kcol - qcol + 15;
            dy = dy < 0 ? 0 : (dy > 14 ? 14 : dy);
            dx = dx < 0 ? 0 : (dx > 30 ? 30 : dx);
            const float bv = bias_s[dy * 31 + dx];
            sv = ok ? sv + bv : -1e30f;
          }
        }
        S[r] = sv;
        mx = fmaxf(mx, sv);
      }
      mx = xhalf_max(mx);
      const float m_old = m_run;
      const float m_new = fmaxf(m_run, mx);
      const float alpha = __builtin_amdgcn_exp2f(m_run - m_new);
      m_run = m_new;
      float ps = 0.f;
#pragma unroll
      for (int r = 0; r < 16; ++r) {
        float pv = __builtin_amdgcn_exp2f(S[r] - m_new);
        if (MODE == 1) { if (S[r] <= -1e29f) pv = 0.f; }
        S[r] = pv;
        ps += pv;
      }
      l_run = l_run * alpha + ps;
      if (__builtin_amdgcn_ballot_w64(m_new != m_old) != 0) {
#pragma unroll
        for (int c = 0; c < 4; ++c)
#pragma unroll
          for (int r = 0; r < 16; ++r) acc[c][r] *= alpha;
      }
      bf16x8 pf[2];
#pragma unroll
      for (int s2 = 0; s2 < 2; ++s2) {
        u32x4 u;
        u[0] = pack2(S[8 * s2 + 0], S[8 * s2 + 1]);
        u[1] = pack2(S[8 * s2 + 2], S[8 * s2 + 3]);
        u[2] = pack2(S[8 * s2 + 4], S[8 * s2 + 5]);
        u[3] = pack2(S[8 * s2 + 6], S[8 * s2 + 7]);
        pf[s2] = __builtin_bit_cast(bf16x8, u);
      }
      const unsigned vaddr = (unsigned)(size_t)(slot + mt * 8192);
#pragma unroll
      for (int c0 = 0; c0 < 4; c0 += 2) {
        const unsigned a0 = vaddr + vb0 + ((c0 ^ tq) << 6), a1 = vaddr + vb1 + ((c0 ^ tq) << 6);
        const unsigned a2 = vaddr + vb0 + (((c0 + 1) ^ tq) << 6), a3 = vaddr + vb1 + (((c0 + 1) ^ tq) << 6);
        s16x4 r0, r1, r2, r3, r4, r5, r6, r7;
        asm volatile(
            "ds_read_b64_tr_b16 %0, %8\n\t"
            "ds_read_b64_tr_b16 %1, %9\n\t"
            "ds_read_b64_tr_b16 %2, %8 offset:4096\n\t"
            "ds_read_b64_tr_b16 %3, %9 offset:4096\n\t"
            "ds_read_b64_tr_b16 %4, %10\n\t"
            "ds_read_b64_tr_b16 %5, %11\n\t"
            "ds_read_b64_tr_b16 %6, %10 offset:4096\n\t"
            "ds_read_b64_tr_b16 %7, %11 offset:4096\n\t"
            "s_waitcnt lgkmcnt(0)"
            : "=&v"(r0), "=&v"(r1), "=&v"(r2), "=&v"(r3), "=&v"(r4), "=&v"(r5), "=&v"(r6), "=&v"(r7)
            : "v"(a0), "v"(a1), "v"(a2), "v"(a3)
            : "memory");
        acc[c0] = MFMA32(__builtin_shufflevector(r0, r1, 0, 1, 2, 3, 4, 5, 6, 7), pf[0], acc[c0]);
        acc[c0] = MFMA32(__builtin_shufflevector(r2, r3, 0, 1, 2, 3, 4, 5, 6, 7), pf[1], acc[c0]);
        acc[c0 + 1] = MFMA32(__builtin_shufflevector(r4, r5, 0, 1, 2, 3, 4, 5, 6, 7), pf[0], acc[c0 + 1]);
        acc[c0 + 1] = MFMA32(__builtin_shufflevector(r6, r7, 0, 1, 2, 3, 4, 5, 6, 7), pf[1], acc[c0 + 1]);
      }
    }
  }
  asm volatile("s_waitcnt vmcnt(0)" ::: "memory");
  float l_tot = l_run + __shfl_xor(l_run, 32);
  float linv = 1.f / l_tot;
  const size_t qrow_i = (size_t)(wave * 32 + l31);
#pragma unroll
  for (int c = 0; c < 4; ++c)
#pragma unroll
    for (int g4 = 0; g4 < 4; ++g4) {
      int dv0 = 32 * c + 8 * g4 + 4 * h;
      uint2 gt = *(const uint2*)(a.gate + qrow_i * a.gs + dv0);
      float o0 = acc[c][4 * g4 + 0] * linv * silu(bflo(gt.x));
      float o1 = acc[c][4 * g4 + 1] * linv * silu(bfhi(gt.x));
      float o2 = acc[c][4 * g4 + 2] * linv * silu(bflo(gt.y));
      float o3 = acc[c][4 * g4 + 3] * linv * silu(bfhi(gt.y));
      *(uint2*)(a.out + qrow_i * a.os + dv0) = make_uint2(pack2(o0, o1), pack2(o2, o3));
    }
}

DI void phase_attn0(const Params& p, LDS_AS(unsigned char)* smem) {
  const u16* QKVG = (const u16*)(p.ws + OFF_BIG);
  u16* OG = (u16*)(p.ws + OFF_H);
  const u16* KA = (const u16*)(p.ws + OFF_KA_ALL);
  const u16* VA = (const u16*)(p.ws + OFF_VA_ALL);
  const u16* KBC = (const u16*)(p.ws + OFF_KB_CTX);
  const u16* VBC = (const u16*)(p.ws + OFF_VB_CTX);
  const float sc = 0.08838834764831845f * LOG2E;
  for (int it = blockIdx.x; it < 1024; it += gridDim.x) {
    AttnArgs a;
    a.qs = L0_IN; a.gs = L0_IN; a.os = D; a.scale_log2 = sc; a.rpb = nullptr; a.qtok0 = 0; a.rs0 = 0; a.rope = 0; a.ropetab = nullptr;
    a.seg[1].k = nullptr; a.seg[1].v = nullptr; a.seg[1].kr = nullptr; a.seg[1].ks = 0; a.seg[1].vs = 0; a.seg[1].n = 0;
    a.seg[0].kr = nullptr;
    if (it >= 256 && it < 512) {
      int i = it - 256;
      int bh = (i >> 5) * 8 + (i & 7), qb = (i >> 3) & 3;
      int b = bh >> 3, hh = bh & 7;
      size_t tok = (size_t)NCTX + b * 1024 + qb * 256;
      a.q = QKVG + tok * L0_IN + 1536 + hh * 128;
      a.gate = QKVG + tok * L0_IN + 4608 + 1024 + hh * 128;
      a.out = OG + tok * D + 1024 + hh * 128;
      a.nseg = 2;
      a.seg[0].k = KBC + (size_t)b * 512 * 1024 + hh * 128; a.seg[0].ks = 1024;
      a.seg[0].v = VBC + (size_t)b * 512 * 1024 + hh * 128; a.seg[0].vs = 1024;
      a.seg[0].n = 512;
      int rs0 = 4 * qb - 4; rs0 = rs0 < 0 ? 0 : (rs0 > 8 ? 8 : rs0);
      int rs1 = 4 * qb - 1; rs1 = rs1 < 0 ? 0 : (rs1 > 8 ? 8 : rs1);
      int nrows = rs1 + 8 - rs0;
      size_t ktok = (size_t)NCTX + b * 1024 + rs0 * 64;
      a.seg[1].k = QKVG + ktok * L0_IN + 2560 + hh * 128; a.seg[1].ks = L0_IN;
      a.seg[1].v = QKVG + ktok * L0_IN + 3584 + hh * 128; a.seg[1].vs = L0_IN;
      a.seg[1].n = nrows * 64;
      a.rpb = p.l0_rpb + hh * 15 * 31;
      a.qtok0 = qb * 256; a.rs0 = rs0;
      attn_block<128, 1>(a, smem);
    } else {
      a.nseg = 1;
      if (it < 256) {
        int g = (it >> 7) * 8 + (it & 7), j = (it >> 3) & 15;
        int b = g >> 1, hq = (g & 1) * 4 + (j >> 2), qb = j & 3;
        size_t tok = (size_t)NCTX + b * 1024 + qb * 256;
        a.q = QKVG + tok * L0_IN + hq * 128;
        a.gate = QKVG + tok * L0_IN + 4608 + hq * 128;
        a.out = OG + tok * D + hq * 128;
        a.seg[0].k = KA + (size_t)b * 1536 * 256 + (hq >> 2) * 128; a.seg[0].ks = 256;
        a.seg[0].v = VA + (size_t)b * 1536 * 256 + (hq >> 2) * 128; a.seg[0].vs = 256;
        a.seg[0].n = 1536;
      } else {
        int i = it - 512;
        bool isB = i >= 256; i &= 255;
        int g = (i >> 5) * 8 + (i & 7), j = (i >> 3) & 3;
        int b = isB ? (i >> 3) : (g >> 1), hh = isB ? (i & 7) : ((g & 1) * 4 + j);
        size_t tok = (size_t)b * 256;
        a.seg[0].n = 256; a.seg[0].ks = L0_IN; a.seg[0].vs = L0_IN;
        if (!isB) {
          a.q = QKVG + tok * L0_IN + hh * 128;
          a.gate = QKVG + tok * L0_IN + 4608 + hh * 128;
          a.out = OG + tok * D + hh * 128;
          a.seg[0].k = QKVG + tok * L0_IN + 1024 + (hh >> 2) * 128;
          a.seg[0].v = QKVG + tok * L0_IN + 1280 + (hh >> 2) * 128;
        } else {
          a.q = QKVG + tok * L0_IN + 1536 + hh * 128;
          a.gate = QKVG + tok * L0_IN + 4608 + 1024 + hh * 128;
          a.out = OG + tok * D + 1024 + hh * 128;
          a.seg[0].k = QKVG + tok * L0_IN + 2560 + hh * 128;
          a.seg[0].v = QKVG + tok * L0_IN + 3584 + hh * 128;
        }
      }
      attn_block<128, 0>(a, smem);
    }
  }
}

DI void phase_attn1(const Params& p, LDS_AS(unsigned char)* smem, int round) {
  const u16* Q1 = (const u16*)(p.ws + OFF_Q1);
  u16* LAT1 = (u16*)(p.ws + OFF_LAT1);
  const float sc = 0.07216878364870322f * LOG2E;
  for (int it = blockIdx.x; it < 512; it += gridDim.x) {
    AttnArgs a;
    a.qs = 3072; a.gs = L1_LD; a.os = L1_LD; a.scale_log2 = sc; a.rpb = nullptr; a.rs0 = 0; a.ropetab = (const float*)(p.ws + OFF_ROPE);
    a.seg[1].k = nullptr; a.seg[1].v = nullptr; a.seg[1].kr = nullptr; a.seg[1].ks = 0; a.seg[1].vs = 0; a.seg[1].n = 0;
    a.nseg = 1;
    a.seg[0].ks = 4096; a.seg[0].vs = 4096;
    size_t tok;
    int hh;
    if (round == 0) {
      int b = it >> 4; hh = it & 15;
      tok = (size_t)b * 256;
      const u16* KV = (const u16*)(p.ws + OFF_KV_CTX) + (size_t)b * 256 * 4096 + hh * 256;
      a.seg[0].k = KV; a.seg[0].v = KV + 128;
      a.seg[0].kr = (const u16*)(p.ws + OFF_KR_CTX) + (size_t)b * 256 * 64;
      a.seg[0].n = 256;
      a.rope = 0; a.qtok0 = 0;
    } else {
      int bh = (it >> 5) * 8 + (it & 7), qb = (it >> 3) & 3;
      int b = bh >> 4; hh = bh & 15;
      tok = (size_t)NCTX + b * 1024 + qb * 256;
      const u16* KV = (const u16*)(p.ws + OFF_KV_LAT) + (size_t)b * 1536 * 4096 + hh * 256;
      a.seg[0].k = KV; a.seg[0].v = KV + 128;
      a.seg[0].kr = (const u16*)(p.ws + OFF_KR_ALL) + (size_t)b * 1536 * 64;
      a.seg[0].n = 1536;
      a.rope = 1; a.qtok0 = qb * 256;
    }
    a.q = Q1 + tok * 3072 + hh * 192;
    a.gate = LAT1 + tok * L1_LD + 1088 + hh * 128;
    a.out = LAT1 + tok * L1_LD + 1088 + hh * 128;
    attn_block<192, 2>(a, smem);
  }
}

#define XB_TMO      128
#define XB_XCNT(j)  (256  + 64 * (j))
#define XB_XSUB(j)  (1280 + 64 * (j))
#define XB_XGEN(j)  (2304 + 64 * (j))
#define XB_TOP      3328
#define XB_TOPGEN   3392
#define XCD_BAR_WORDS 3456
#define XB_SPIN_CAP (1u << 18)
#define XLAS __attribute__((address_space(3)))

__device__ __forceinline__ unsigned xb_ld(unsigned* p)              { return __hip_atomic_load(p, __ATOMIC_RELAXED, __HIP_MEMORY_SCOPE_AGENT); }
__device__ __forceinline__ unsigned xb_add(unsigned* p, unsigned v) { return __hip_atomic_fetch_add(p, v, __ATOMIC_RELAXED, __HIP_MEMORY_SCOPE_AGENT); }
__device__ __forceinline__ unsigned xb_xcc_id() { return (unsigned)__builtin_amdgcn_s_getreg((3 << 11) | 20) & 0xFu; }
#define XB_SPIN(cond, bar) do { unsigned _sp = 0; while (cond) { __builtin_amdgcn_s_sleep(1); \
    if ((++_sp & 255u) == 0u) { if (xb_ld(&(bar)[XB_TMO])) break; if (_sp > XB_SPIN_CAP) { atomicAdd(&(bar)[XB_TMO], 1u); break; } } } } while (0)

struct XcdBarrier {
    unsigned* bar; unsigned x;
    volatile XLAS unsigned* st;
};

__device__ __forceinline__ XcdBarrier xcd_barrier_post(unsigned* bar, volatile XLAS unsigned* st) {
    XcdBarrier b; b.bar = bar; b.x = xb_xcc_id(); b.st = st;
    if (threadIdx.x == 0) (void)xb_add(&bar[XB_XCNT(b.x)], 1u);
    return b;
}
__device__ __forceinline__ void xcd_barrier_complete(unsigned* bar, unsigned x, unsigned& nloc, unsigned& nx) {
    const unsigned G = gridDim.x * gridDim.y * gridDim.z;
    unsigned sum, cnt, mine, sp = 0u;
    for (;;) {
        sum = 0u; cnt = 0u; mine = 0u;
#pragma unroll
        for (unsigned j = 0; j < 16; ++j) { const unsigned c = xb_ld(&bar[XB_XCNT(j)]); sum += c; cnt += (c > 0u) ? 1u : 0u; mine = (j == x) ? c : mine; }
        if (sum == G) break;
        __builtin_amdgcn_s_sleep(1);
        if ((++sp & 255u) == 0u) { if (xb_ld(&bar[XB_TMO])) break; if (sp > XB_SPIN_CAP) { atomicAdd(&bar[XB_TMO], 1u); break; } }
    }
    nloc = mine > 0u ? mine : 1u; nx = cnt > 0u ? cnt : 1u;
}

__device__ __forceinline__ void xcd_barrier(const XcdBarrier& b) {
    asm volatile("s_waitcnt vmcnt(0)" ::: "memory");
    __syncthreads();
    if (threadIdx.x == 0) {
        unsigned* bar = b.bar;
        __builtin_amdgcn_s_waitcnt(0);
        unsigned nloc = b.st[0], nx = b.st[1];
        if (nloc == 0u) { xcd_barrier_complete(bar, b.x, nloc, nx); b.st[0] = nloc; b.st[1] = nx; }
        const unsigned old = xb_add(&bar[XB_XSUB(b.x)], 1u);
        const unsigned gen = old / nloc;
        if (old + 1u == (gen + 1u) * nloc) {
            __builtin_amdgcn_fence(__ATOMIC_RELEASE, "agent");
            asm volatile("s_waitcnt vmcnt(0)" ::: "memory");
            const unsigned og = xb_add(&bar[XB_TOP], 1u);
            const unsigned tg = og / nx;
            if (og + 1u == (tg + 1u) * nx) xb_add(&bar[XB_TOPGEN], 1u);
            else XB_SPIN(xb_ld(&bar[XB_TOPGEN]) == tg, bar);
            __builtin_amdgcn_fence(__ATOMIC_ACQUIRE, "agent");
            xb_add(&bar[XB_XGEN(b.x)], 1u);
            asm volatile("s_waitcnt vmcnt(0)" ::: "memory");
        } else {
            XB_SPIN(xb_ld(&bar[XB_XGEN(b.x)]) == gen, bar);
            __builtin_amdgcn_fence(__ATOMIC_ACQUIRE, "agent");
            asm volatile("s_waitcnt vmcnt(0)" ::: "memory");
        }
    }
    __syncthreads();
}

__global__ void __launch_bounds__(512, 2) fwd_megakernel(Params p) {
  cg::grid_group grid = cg::this_grid();
  extern __shared__ __attribute__((aligned(16))) unsigned char dsm[];
  char* smem = (char*)dsm;
  char* ws = p.ws;
  const float* mod0 = (const float*)(ws + OFF_MOD);
  const float* mod1 = mod0 + 9 * 6144;

  volatile XLAS unsigned* xst = (volatile XLAS unsigned*)((XLAS unsigned char*)dsm + 128 * 1024);
  if (threadIdx.x < 4) xst[threadIdx.x] = 0u;
  __syncthreads();
  const XcdBarrier xb = xcd_barrier_post((unsigned*)(ws + OFF_BAR), xst);
  phase_prep(p, smem);
  if (p.out == nullptr) grid.sync();
  xcd_barrier(xb);
  phase_normmod(p, 0);
  xcd_barrier(xb);
  { EpiBf16 e{(u16*)(ws + OFF_BIG), L0_IN};
    gemm_run((PG8_LAS unsigned char*)dsm, (const u16*)(ws + OFF_H), D, (const u16*)(ws + OFF_WT_IN0), NTOK, L0_IN, 2048, e); }
  if (gridDim.x == 256) { if (blockIdx.x >= 128 && blockIdx.x < 224) adaln_item(p, 1, blockIdx.x - 128, (float*)smem); }
  else { for (int c = blockIdx.x; c < 96; c += gridDim.x) adaln_item(p, 1, c, (float*)smem); }
  xcd_barrier(xb);
  phase_qknorm0(p);
  xcd_barrier(xb);
#pragma unroll 1
  for (int rep = 0; rep < REP_A0; ++rep) phase_attn0(p, (LDS_AS(unsigned char)*)dsm);
  xcd_barrier(xb);
  { EpiResid e{p.x_prompt, p.x_sample, mod0 + 4096, p.out + OUT_Y};
    gemm_run((PG8_LAS unsigned char*)dsm, (const u16*)(ws + OFF_H), D, (const u16*)(ws + OFF_WT_OUT0), NTOK, D, 2048, e); }
  xcd_barrier(xb);
  phase_normmod(p, 1);
  xcd_barrier(xb);
  { EpiBf16 e{(u16*)(ws + OFF_LAT1), L1_LD};
    gemm_run((PG8_LAS unsigned char*)dsm, (const u16*)(ws + OFF_H), D, (const u16*)(ws + OFF_WT_IN1), NTOK, L1_LD, 2048, e); }
  xcd_barrier(xb);
  phase_norm1(p);
  xcd_barrier(xb);
  { EpiBf16 e{(u16*)(ws + OFF_Q1), 3072};
    gemm_run((PG8_LAS unsigned char*)dsm, (const u16*)(ws + OFF_QN), 512, (const u16*)(ws + OFF_WT_QB), NTOK, 3072, 512, e); }
#pragma unroll 1
  for (int round = 0; round < 2; ++round) {
    { EpiBf16 e{(u16*)(ws + (round ? OFF_KV_LAT : OFF_KV_CTX)), 4096};
      gemm_run((PG8_LAS unsigned char*)dsm, (const u16*)(ws + (round ? OFF_CKV_ALL : OFF_CKV_CTX)), 512, (const u16*)(ws + OFF_WT_KVB),
               round ? 12288 : NCTX, 4096, 512, e); }
    xcd_barrier(xb);
    phase_attn1(p, (LDS_AS(unsigned char)*)dsm, round);
    xcd_barrier(xb);
  }
  { EpiResid e{p.out + OUT_Y, p.out + OUT_Y + (size_t)NCTX * D, mod1 + 4096, p.out + OUT_Y};
    gemm_run((PG8_LAS unsigned char*)dsm, (const u16*)(ws + OFF_LAT1) + 1088, L1_LD, (const u16*)(ws + OFF_WT_OUT1), NTOK, D, 2048, e); }
  xcd_barrier(xb);
  phase_final(p);
}

extern "C" void kernel_launch(void* const* d_in, const int* in_sizes, int n_in, void* d_out, int out_size, void* d_ws,
                              size_t ws_size, hipStream_t stream) {
  (void)in_sizes; (void)n_in; (void)out_size;
  if (ws_size < WS_NEEDED) { fprintf(stderr, "workspace too small: %zu < %zu\n", ws_size, (size_t)WS_NEEDED); return; }
  static int grid_blocks = 0;
  if (!grid_blocks) {
    int dev = 0, cus = 0, per_cu = 0;
    (void)hipGetDevice(&dev);
    (void)hipDeviceGetAttribute(&cus, hipDeviceAttributeMultiprocessorCount, dev);
    if (hipFuncSetAttribute((const void*)fwd_megakernel, hipFuncAttributeMaxDynamicSharedMemorySize, SMEM_BYTES) != hipSuccess) {
      fprintf(stderr, "hipFuncSetAttribute failed\n"); return; }
    (void)hipOccupancyMaxActiveBlocksPerMultiprocessor(&per_cu, fwd_megakernel, NT, SMEM_BYTES);
    if (per_cu < 1) { fprintf(stderr, "occupancy query returned %d\n", per_cu); return; }
    grid_blocks = cus;
  }
  Params p{};
  const float** pf = (const float**)&p;
  for (int i = 0; i < 28; ++i) pf[i] = (const float*)d_in[i];
  p.out = (float*)d_out;
  p.ws = (char*)d_ws;
  (void)hipMemsetAsync((char*)d_ws + OFF_BAR, 0, BAR_BYTES, stream);
  void* args[] = {&p};
  hipError_t e = hipLaunchCooperativeKernel((void*)fwd_megakernel, dim3(grid_blocks), dim3(NT), args, SMEM_BYTES, stream);
  if (e != hipSuccess) fprintf(stderr, "cooperative launch failed: %s (grid %d)\n", hipGetErrorString(e), grid_blocks);
}
```

```cpp
#include <hip/hip_runtime.h>
#include <hip/hip_cooperative_groups.h>
#include <cstdio>
namespace cg = cooperative_groups;

typedef unsigned short u16;
using bf16x8 = __attribute__((ext_vector_type(8))) short;
using s16x4  = __attribute__((ext_vector_type(4))) short;
using f32x16 = __attribute__((ext_vector_type(16))) float;
using f32x4  = __attribute__((ext_vector_type(4))) float;
using u32x4  = __attribute__((ext_vector_type(4))) unsigned;
typedef __bf16 bf16x2_t __attribute__((ext_vector_type(2)));
typedef float f32x2_t __attribute__((ext_vector_type(2)));
#define DI __device__ __forceinline__
#define MFMA32(a, b, c) __builtin_amdgcn_mfma_f32_32x32x16_bf16((a), (b), (c), 0, 0, 0)
#define LDS_AS(T) __attribute__((address_space(3))) T

constexpr int D = 2048;
constexpr int NTOK = 16384;
constexpr int NCTX = 8192;
constexpr int L0_IN = 6656;
constexpr int L1_IN = 3136;
constexpr int L1_LD = 3328;
constexpr float EPS = 1e-6f;
constexpr float LOG2E = 1.4426950408889634f;
constexpr float LOG2_THETA = 13.287712379549449f;
#ifndef REP_G
#define REP_G 1
#endif
#ifndef REP_A0
#define REP_A0 1
#endif
constexpr int NT = 512;
constexpr int NW = 8;

constexpr size_t OFF_WT_IN1  = 0;
constexpr size_t OFF_WT_QB   = OFF_WT_IN1 + (size_t)3328 * 2048 * 2;
constexpr size_t OFF_WT_KVB  = OFF_WT_QB + (size_t)3072 * 512 * 2;
constexpr size_t OFF_WT_OUT1 = OFF_WT_KVB + (size_t)4096 * 512 * 2;
constexpr size_t OFF_WL0     = OFF_WT_OUT1 + (size_t)2048 * 2048 * 2;
constexpr size_t OFF_WT_IN0  = OFF_WL0;
constexpr size_t OFF_WT_OUT0 = OFF_WT_IN0 + (size_t)6656 * 2048 * 2;
constexpr size_t OFF_H       = OFF_WT_OUT0 + (size_t)2048 * 2048 * 2;
constexpr size_t OFF_BIG     = OFF_H + (size_t)NTOK * 2048 * 2;
constexpr size_t OFF_C       = OFF_BIG + (size_t)NTOK * 6656 * 2;
constexpr size_t OFF_KA_ALL  = OFF_C;
constexpr size_t OFF_VA_ALL  = OFF_KA_ALL + (size_t)8 * 1536 * 256 * 2;
constexpr size_t OFF_KB_CTX  = OFF_VA_ALL + (size_t)8 * 1536 * 256 * 2;
constexpr size_t OFF_VB_CTX  = OFF_KB_CTX + (size_t)8 * 512 * 1024 * 2;
constexpr size_t OFF_CKV_ALL = OFF_VB_CTX + (size_t)8 * 512 * 1024 * 2;
constexpr size_t OFF_KR_ALL  = OFF_CKV_ALL + (size_t)8 * 1536 * 512 * 2;
constexpr size_t OFF_MOD     = OFF_KR_ALL + (size_t)8 * 1536 * 64 * 2;
constexpr size_t OFF_ROPE    = OFF_MOD + (size_t)2 * 9 * 6144 * 4;
constexpr size_t OFF_ROPE0   = OFF_ROPE + (size_t)64 * 16 * 2 * 4;
constexpr size_t OFF_BAR     = OFF_ROPE0 + (size_t)64 * 32 * 2 * 4;
constexpr size_t BAR_BYTES   = 3456 * 4;
constexpr size_t WS_NEEDED   = OFF_BAR + BAR_BYTES;
constexpr size_t OFF_QN      = OFF_WL0;
constexpr size_t OFF_CKV_CTX = OFF_QN + (size_t)NTOK * 512 * 2;
constexpr size_t OFF_KR_CTX  = OFF_CKV_CTX + (size_t)NCTX * 512 * 2;
constexpr size_t OFF_KV_CTX  = OFF_H;
constexpr size_t OFF_KV_LAT  = OFF_WL0;
constexpr size_t OFF_LAT1    = OFF_BIG;
constexpr size_t OFF_Q1      = OFF_BIG + (size_t)NTOK * L1_LD * 2;
static_assert(OFF_KR_CTX + (size_t)NCTX * 64 * 2 <= OFF_WT_OUT0, "l1 small bufs overflow");
static_assert(OFF_KV_LAT + (size_t)12288 * 4096 * 2 <= OFF_BIG, "kv_lat overflow");
static_assert(OFF_Q1 + (size_t)NTOK * 3072 * 2 <= OFF_C, "q1 overflow");

constexpr size_t OUT_Y   = 0;
constexpr size_t OUT_NAK = (size_t)NTOK * 2048;
constexpr size_t OUT_NAV = OUT_NAK + (size_t)NCTX * 256;
constexpr size_t OUT_NBK = OUT_NAV + (size_t)NCTX * 256;
constexpr size_t OUT_NBV = OUT_NBK + (size_t)NCTX * 1024;
constexpr size_t OUT_NCKV = OUT_NBV + (size_t)NCTX * 1024;
constexpr size_t OUT_NKR = OUT_NCKV + (size_t)NCTX * 512;

constexpr int SMEM_BYTES = 128 * 1024 + 256;

struct Params {
  const float *x_prompt, *x_sample, *ca_k, *ca_v, *cb_k, *cb_v, *c_ckv, *c_kr, *c, *c_ctx;
  const float *l0_norm, *l0_ada_w, *l0_ada_b, *l0_w_in, *l0_qn, *l0_kn, *l0_rpb, *l0_w_out;
  const float *l1_norm, *l1_ada_w, *l1_ada_b, *l1_w_in, *l1_qan, *l1_wqb, *l1_kvan, *l1_wkvb, *l1_w_out, *fnorm;
  float* out;
  char* ws;
};

DI int threadIdx_x_raw() { return (int)__builtin_amdgcn_workitem_id_x(); }
DI u16 f2bf(float x) { unsigned u = __float_as_uint(x); u += 0x7fffu + ((u >> 16) & 1u); return (u16)(u >> 16); }
DI float bf2f(u16 v) { return __uint_as_float(((unsigned)v) << 16); }
DI unsigned pack2(float a, float b) { f32x2_t f = {a, b}; bf16x2_t r = __builtin_convertvector(f, bf16x2_t); return __builtin_bit_cast(unsigned, r); }
DI float bflo(unsigned u) { return __uint_as_float(u << 16); }
DI float bfhi(unsigned u) { return __uint_as_float(u & 0xffff0000u); }
DI float wave_sum(float v) {
#pragma unroll
  for (int o = 32; o >= 1; o >>= 1) v += __shfl_xor(v, o);
  return v;
}
DI int TID() { int t = threadIdx_x_raw(); asm volatile("" : "+v"(t)); return t; }
DI int crow(int i, int h) { return (i & 3) + 8 * (i >> 2) + 4 * h; }
DI float silu(float x) { return x / (1.f + __expf(-x)); }
DI int tok_modrow(int tok) { return tok < NCTX ? 0 : 1 + ((tok - NCTX) >> 10); }

DI void transpose_tile(const float* __restrict__ src, int K, int N, u16* __restrict__ dst, int kt, int nt, float* sm) {
  const int t = TID();
  float4 v[8];
#pragma unroll
  for (int i = 0; i < 8; ++i) {
    int id = t + NT * i, r = id >> 6, c4 = id & 63, n = nt * 256 + c4 * 4;
    v[i] = (n < N) ? *(const float4*)(src + (size_t)(kt * 64 + r) * N + n) : make_float4(0.f, 0.f, 0.f, 0.f);
  }
#pragma unroll
  for (int i = 0; i < 8; ++i) {
    int id = t + NT * i, r = id >> 6, c4 = id & 63;
    *(float4*)(sm + r * 260 + c4 * 4) = v[i];
  }
  __syncthreads();
  {
    const int nl = t >> 1, kq = t & 1, n = nt * 256 + nl;
    if (n < N) {
      u16* dp = dst + (size_t)n * K + kt * 64 + kq * 32;
#pragma unroll
      for (int q = 0; q < 4; ++q) {
        u32x4 o;
#pragma unroll
        for (int j = 0; j < 4; ++j) o[j] = pack2(sm[(kq * 32 + q * 8 + 2 * j) * 260 + nl], sm[(kq * 32 + q * 8 + 2 * j + 1) * 260 + nl]);
        *(u32x4*)(dp + q * 8) = o;
      }
    }
  }
  __syncthreads();
}

DI void adaln_item(const Params& p, int l, int chunk, float* sm) {
  const float* W = l ? p.l1_ada_w : p.l0_ada_w;
  const float* bias = l ? p.l1_ada_b : p.l0_ada_b;
  float* mod = (float*)(p.ws + OFF_MOD) + (size_t)l * 9 * 6144;
  const int t = TID(), col = chunk * 64 + (t & 63), kg = t >> 6;
  float acc[9];
#pragma unroll
  for (int r = 0; r < 9; ++r) acc[r] = 0.f;
  for (int kh = 0; kh < 2; ++kh) {
    __syncthreads();
    for (int e = t; e < 9 * 1024; e += NT) {
      int r = e >> 10, k = e & 1023;
      float cv = (r == 0) ? p.c_ctx[kh * 1024 + k] : p.c[(r - 1) * 2048 + kh * 1024 + k];
      sm[r * 1024 + k] = silu(cv);
    }
    __syncthreads();
    const float* wp = W + (size_t)(kh * 1024 + kg * 128) * 6144 + col;
    const float* sp = sm + kg * 128;
#pragma unroll 8
    for (int k = 0; k < 128; ++k) {
      float w = wp[(size_t)k * 6144];
#pragma unroll
      for (int r = 0; r < 9; ++r) acc[r] += sp[r * 1024 + k] * w;
    }
  }
  __syncthreads();
#pragma unroll
  for (int r = 0; r < 9; ++r) sm[(kg * 9 + r) * 64 + (t & 63)] = acc[r];
  __syncthreads();
  for (int e = t; e < 9 * 64; e += NT) {
    int r = e >> 6, cc = e & 63;
    float s = 0.f;
#pragma unroll
    for (int g = 0; g < NW; ++g) s += sm[(g * 9 + r) * 64 + cc];
    mod[(size_t)r * 6144 + chunk * 64 + cc] = s + bias[chunk * 64 + cc];
  }
  __syncthreads();
}

DI void convert_item(const float* __restrict__ src, u16* __restrict__ dst, int W, int dstT, int item) {
  size_t e = (size_t)item * 4096 + TID() * 8;
  size_t per_b = (size_t)512 * W;
  size_t b = e / per_b, r = e % per_b;
  float4 v0 = *(const float4*)(src + e), v1 = *(const float4*)(src + e + 4);
  u32x4 o = {pack2(v0.x, v0.y), pack2(v0.z, v0.w), pack2(v1.x, v1.y), pack2(v1.z, v1.w)};
  *(u32x4*)(dst + b * (size_t)dstT * W + r) = o;
}

DI void phase_prep(const Params& p, char* smem) {
  float* sm = (float*)smem;
  char* ws = p.ws;
  constexpr int T_IN0 = 32 * 26, T_OUT0 = 32 * 8, T_IN1 = 32 * 13, T_QB = 8 * 12, T_KVB = 8 * 16, T_OUT1 = 32 * 8;
  constexpr int C_A = 256, C_B = 1024, C_CKV = 512, C_KR = 64;
  constexpr int B1 = 0, B2 = B1 + T_IN0, B3 = B2 + T_OUT0, B4 = B3 + T_IN1, B5 = B4 + T_QB, B6 = B5 + T_KVB, B7 = B6 + T_OUT1;
  constexpr int B8 = B7 + C_A, B9 = B8 + C_A, B10 = B9 + C_B, B11 = B10 + C_B, B12 = B11 + C_CKV, B13 = B12 + C_KR;
  if (blockIdx.x == gridDim.x - 1) {
    float* tab = (float*)(ws + OFF_ROPE);
    for (int e = TID(); e < 64 * 16; e += NT) {
      int pos = e >> 4, i = e & 15;
      float inv = exp2f(-(float)i * (LOG2_THETA / 16.f));
      float sn, cs; sincosf((float)pos * inv, &sn, &cs);
      tab[2 * e] = cs; tab[2 * e + 1] = sn;
    }
    float* tab0 = (float*)(ws + OFF_ROPE0);
    for (int e = TID(); e < 64 * 32; e += NT) {
      int pos = e >> 5, i = e & 31;
      float inv = exp2f(-(float)i * (LOG2_THETA / 32.f));
      float sn, cs; sincosf((float)pos * inv, &sn, &cs);
      tab0[2 * e] = cs; tab0[2 * e + 1] = sn;
    }
  }
  const int nada = (gridDim.x > 128) ? 96 : 0;
  if ((int)blockIdx.x < nada) { adaln_item(p, 0, blockIdx.x, sm); return; }
  if (nada == 0) { for (int c = blockIdx.x; c < 96; c += gridDim.x) adaln_item(p, 0, c, sm); }
  for (int it = blockIdx.x - nada; it < B13; it += gridDim.x - nada) {
    if (it < B2) { int i = it - B1; transpose_tile(p.l0_w_in, 2048, 6656, (u16*)(ws + OFF_WT_IN0), i / 26, i % 26, sm); }
    else if (it < B3) { int i = it - B2; transpose_tile(p.l0_w_out, 2048, 2048, (u16*)(ws + OFF_WT_OUT0), i / 8, i % 8, sm); }
    else if (it < B4) { int i = it - B3; transpose_tile(p.l1_w_in, 2048, 3136, (u16*)(ws + OFF_WT_IN1), i / 13, i % 13, sm); }
    else if (it < B5) { int i = it - B4; transpose_tile(p.l1_wqb, 512, 3072, (u16*)(ws + OFF_WT_QB), i / 12, i % 12, sm); }
    else if (it < B6) { int i = it - B5; transpose_tile(p.l1_wkvb, 512, 4096, (u16*)(ws + OFF_WT_KVB), i / 16, i % 16, sm); }
    else if (it < B7) { int i = it - B6; transpose_tile(p.l1_w_out, 2048, 2048, (u16*)(ws + OFF_WT_OUT1), i / 8, i % 8, sm); }
    else if (it < B8) convert_item(p.ca_k, (u16*)(ws + OFF_KA_ALL), 256, 1536, it - B7);
    else if (it < B9) convert_item(p.ca_v, (u16*)(ws + OFF_VA_ALL), 256, 1536, it - B8);
    else if (it < B10) convert_item(p.cb_k, (u16*)(ws + OFF_KB_CTX), 1024, 512, it - B9);
    else if (it < B11) convert_item(p.cb_v, (u16*)(ws + OFF_VB_CTX), 1024, 512, it - B10);
    else if (it < B12) convert_item(p.c_ckv, (u16*)(ws + OFF_CKV_ALL), 512, 1536, it - B11);
    else convert_item(p.c_kr, (u16*)(ws + OFF_KR_ALL), 64, 1536, it - B12);
  }
}

DI void phase_normmod(const Params& p, int layer) {
  const int wave = TID() >> 6, lane = TID() & 63;
  const float* g = layer ? p.l1_norm : p.l0_norm;
  const float* mod = (const float*)(p.ws + OFF_MOD) + (size_t)layer * 9 * 6144;
  u16* H = (u16*)(p.ws + OFF_H);
  for (int it = blockIdx.x; it < NTOK / NW; it += gridDim.x) {
    int row = it * NW + wave;
    const float* src;
    if (layer == 0) src = row < NCTX ? p.x_prompt + (size_t)row * D : p.x_sample + (size_t)(row - NCTX) * D;
    else src = p.out + OUT_Y + (size_t)row * D;
    const float* mr = mod + (size_t)tok_modrow(row) * 6144;
    float4 v[8];
    float ss = 0.f;
#pragma unroll
    for (int i = 0; i < 8; ++i) {
      v[i] = *(const float4*)(src + (i * 64 + lane) * 4);
      ss += v[i].x * v[i].x + v[i].y * v[i].y + v[i].z * v[i].z + v[i].w * v[i].w;
    }
    ss = wave_sum(ss);
    float rinv = rsqrtf(ss * (1.f / D) + EPS);
#pragma unroll
    for (int i = 0; i < 8; ++i) {
      int col = (i * 64 + lane) * 4;
      float4 gg = *(const float4*)(g + col);
      float4 sh = *(const float4*)(mr + col);
      float4 sc = *(const float4*)(mr + 2048 + col);
      float h0 = v[i].x * rinv * gg.x * (1.f + sc.x) + sh.x;
      float h1 = v[i].y * rinv * gg.y * (1.f + sc.y) + sh.y;
      float h2 = v[i].z * rinv * gg.z * (1.f + sc.z) + sh.z;
      float h3 = v[i].w * rinv * gg.w * (1.f + sc.w) + sh.w;
      *(uint2*)(H + (size_t)row * D + col) = make_uint2(pack2(h0, h1), pack2(h2, h3));
    }
  }
}

namespace pg8 {
#define PG8_LAS __attribute__((address_space(3)))
typedef unsigned short bf16_t;
typedef short bf16x8 __attribute__((ext_vector_type(8)));
typedef float f32x4 __attribute__((ext_vector_type(4)));
typedef unsigned u32x4 __attribute__((ext_vector_type(4)));
constexpr int BM = 256, BK = 64, HALF = 128, HTB = HALF * BK * 2  , STAGE_BYTES = 8 * HTB, NXCD = 8, WGM = 8;

__host__ __device__ __forceinline__ int lds_byte(int r, int c) { const int st = (r >> 4) * 2 + (c >> 5), rr = r & 15, cc = c & 31, ob = rr * 64 + cc * 2; return st * 1024 + (ob ^ (((ob >> 9) & 1) << 5)); }
__host__ __device__ __forceinline__ void stage_rc(int b, int& R, int& C) { const int st = b / 1024, sb = b % 1024, swz = sb ^ (((sb >> 9) & 1) << 5); R = (st >> 1) * 16 + swz / 64; C = (st & 1) * 32 + (swz % 64) / 2; }
__host__ __device__ __forceinline__ int perm32(int rho) { const int n = rho >> 4, i = rho & 15; return 8 * (i >> 2) + 4 * n + (i & 3); }

struct Unit { int pm, pn; };
struct Gemm { const bf16_t* A; const bf16_t* Bt; int M, N, K, lda; };
struct StaticOrder {
    int nM, nN, nwg, G, c;
    __host__ __device__ void init(int M, int N, int G_, int c_) { nM = M / BM; nN = N / BM; nwg = nM * nN; G = G_; c = c_; }
    __host__ __device__ bool next(int i, Unit& u) const {
        const long L = (long)i * G + c; if (L >= nwg) return false;
        int wgid = (int)L; { const int q = nwg / NXCD, r = nwg % NXCD, xcd = wgid % NXCD, off = wgid / NXCD; wgid = (xcd < r ? xcd * (q + 1) : r * (q + 1) + (xcd - r) * q) + off; }
        const int nig = WGM * nN, gid = wgid / nig, fm = gid * WGM, gsz = (nM - fm) < WGM ? (nM - fm) : WGM;
        u.pm = fm + ((wgid % nig) % gsz); u.pn = (wgid % nig) / gsz; return true;
    }
    __device__ __forceinline__ void a_ready(const Unit&) const {}
    __device__ __forceinline__ void done(const Unit&) const {}
};
template <class Epi, class Sched, bool STAMP = false>
__device__ __forceinline__ void gemm_phase(PG8_LAS unsigned char* lds, const Gemm g, const Sched& S, const Epi& E, unsigned long long* stamps) {
    const int tid = TID(), wid = __builtin_amdgcn_readfirstlane(tid >> 6), lane = tid & 63, wr = wid >> 2, wc = wid & 3, fr = lane & 15, fq = lane >> 4;
    const int K = g.K, nt = K / BK;
    int ts_lo = 0, ts_hi = 0, nts = 0; const unsigned long long rt_entry = STAMP ? (unsigned long long)wall_clock64() : 0ull;
#define PG8_STAMP() do { if (STAMP && wid == 0 && nts < 64) { const unsigned long long _c = (unsigned long long)clock64(); \
        ts_lo = (lane == nts) ? (int)(unsigned)_c : ts_lo; ts_hi = (lane == nts) ? (int)(unsigned)(_c >> 32) : ts_hi; ++nts; } } while (0)
    PG8_STAMP();
    unsigned voffA[2], voffB[2];
#pragma unroll
    for (int i = 0; i < 2; ++i) { int R, C; stage_rc(tid * 16 + i * 8192, R, C); const int Rb = Epi::PERM ? ((R & ~31) + perm32(R & 31)) : R;
        voffA[i] = (unsigned)(R * g.lda + C) * 2u; voffB[i] = (unsigned)(Rb * K + C) * 2u; }
    const size_t kstep = (size_t)(BK * 2);
    const size_t hstepB = (size_t)HALF * K * 2, hstepA = (size_t)HALF * g.lda * 2;
    const size_t tstepB = 2 * hstepB, tstepA = 2 * hstepA;
    const unsigned ldsw = (unsigned)wid * 1024u;
    const int aoff = lds_byte(wr * 64 + fr, fq * 8), boff = lds_byte(wc * 32 + fr, fq * 8);
#define PG8_SA(b, h) (((b) * 2 + (h)) * HTB)
#define PG8_SB(b, h) ((4 + (b) * 2 + (h)) * HTB)
#define PG8_STAGE(bufoff, gbase, voff) do { _Pragma("unroll") for (int _i = 0; _i < 2; ++_i) \
        __builtin_amdgcn_global_load_lds((const unsigned*)((const char*)(gbase) + (voff)[_i]), (PG8_LAS unsigned*)(lds + (bufoff) + ldsw + _i * 8192), 16, 0, 0); } while (0)
#define PG8_LDA(dst, b, h) do { _Pragma("unroll") for (int m = 0; m < 4; ++m) _Pragma("unroll") for (int k = 0; k < 2; ++k) dst[m][k] = *(const PG8_LAS bf16x8*)(lds + PG8_SA(b, h) + aoff + m * 2048 + k * 1024); } while (0)
#define PG8_LDB(dst, b, h) do { _Pragma("unroll") for (int n = 0; n < 2; ++n) _Pragma("unroll") for (int k = 0; k < 2; ++k) dst[n][k] = *(const PG8_LAS bf16x8*)(lds + PG8_SB(b, h) + boff + n * 2048 + k * 1024); } while (0)
#define PG8_MMA(ai, bj, At, Bt) do { __builtin_amdgcn_s_setprio(1); _Pragma("unroll") for (int m = 0; m < 4; ++m) _Pragma("unroll") for (int n = 0; n < 2; ++n) _Pragma("unroll") for (int k = 0; k < 2; ++k) \
        acc[ai][bj][m][n] = __builtin_amdgcn_mfma_f32_16x16x32_bf16(Bt[n][k], At[m][k], acc[ai][bj][m][n], 0, 0, 0); __builtin_amdgcn_s_setprio(0); } while (0)
#define PG8_WAIT_V(n) asm volatile("s_waitcnt vmcnt(" #n ")" ::: "memory")
#define PG8_WAIT_L(n) asm volatile("s_waitcnt lgkmcnt(" #n ")" ::: "memory")
#define PG8_BAR __builtin_amdgcn_s_barrier()
#define PG8_SCHED __builtin_amdgcn_sched_barrier(0)
    Unit cur, nxt; int ui = 0;
    if (!S.next(0, cur)) return;
    f32x4 acc[2][2][4][2];
#pragma unroll
    for (int a = 0; a < 2; ++a)
#pragma unroll
        for (int b = 0; b < 2; ++b)
#pragma unroll
            for (int m = 0; m < 4; ++m)
#pragma unroll
                for (int n = 0; n < 2; ++n) acc[a][b][m][n] = (f32x4){0.f, 0.f, 0.f, 0.f};
    bf16x8 At[4][2], B0[2][2], B1[2][2];
    const char* cA = (const char*)g.A + (size_t)cur.pm * tstepA; const char* cB = (const char*)g.Bt + (size_t)cur.pn * tstepB;
    S.a_ready(cur);
    PG8_STAGE(PG8_SB(0, 0), cB, voffB); PG8_STAGE(PG8_SA(0, 0), cA, voffA); PG8_STAGE(PG8_SB(0, 1), cB + hstepB, voffB); PG8_STAGE(PG8_SA(0, 1), cA + hstepA, voffA);
    if (wr == 1) PG8_BAR;
    PG8_WAIT_V(4); PG8_BAR;
    PG8_STAGE(PG8_SB(1, 0), cB + kstep, voffB); PG8_STAGE(PG8_SA(1, 0), cA + kstep, voffA); PG8_STAGE(PG8_SB(1, 1), cB + hstepB + kstep, voffB);
    PG8_WAIT_V(6); PG8_BAR;
    PG8_STAMP();
    for (;;) {
        const bool has_next = S.next(ui + 1, nxt);
        const char* nA = has_next ? (const char*)g.A + (size_t)nxt.pm * tstepA : cA; const char* nB = has_next ? (const char*)g.Bt + (size_t)nxt.pn * tstepB : cB;
        for (int t = 0; t < nt; t += 2) {
            const bool last = (t == nt - 2);
            const char* a1 = cA + (size_t)(t + 1) * kstep;
            const char* a2 = last ? nA : cA + (size_t)(t + 2) * kstep; const char* b2 = last ? nB : cB + (size_t)(t + 2) * kstep;
            const char* a3 = a2 + kstep; const char* b3 = b2 + kstep;
            if (last && has_next) S.a_ready(nxt);
            PG8_LDB(B0, 0, 0); PG8_SCHED; PG8_LDA(At, 0, 0); PG8_STAGE(PG8_SA(1, 1), a1 + hstepA, voffA);
            PG8_WAIT_L(8); PG8_BAR; PG8_WAIT_L(0); PG8_MMA(0, 0, At, B0); PG8_BAR; PG8_SCHED;
            PG8_LDB(B1, 0, 1); PG8_STAGE(PG8_SB(0, 0), b2, voffB);
            PG8_BAR; PG8_WAIT_L(0); PG8_MMA(0, 1, At, B1); PG8_BAR;
            PG8_LDA(At, 0, 1); PG8_STAGE(PG8_SA(0, 0), a2, voffA);
            PG8_BAR; PG8_WAIT_L(0); PG8_MMA(1, 0, At, B0); PG8_BAR; PG8_SCHED;
            PG8_STAGE(PG8_SB(0, 1), b2 + hstepB, voffB);
            PG8_WAIT_V(6); PG8_BAR; PG8_MMA(1, 1, At, B1); PG8_BAR;
            PG8_LDB(B0, 1, 0); PG8_SCHED; PG8_LDA(At, 1, 0); PG8_STAGE(PG8_SA(0, 1), a2 + hstepA, voffA);
            PG8_WAIT_L(8); PG8_BAR; PG8_WAIT_L(0); PG8_MMA(0, 0, At, B0); PG8_BAR; PG8_SCHED;
            PG8_LDB(B1, 1, 1); PG8_STAGE(PG8_SB(1, 0), b3, voffB);
            PG8_BAR; PG8_WAIT_L(0); PG8_MMA(0, 1, At, B1); PG8_BAR;
            PG8_LDA(At, 1, 1); PG8_STAGE(PG8_SA(1, 0), a3, voffA);
            PG8_BAR; PG8_WAIT_L(0); PG8_MMA(1, 0, At, B0); PG8_BAR; PG8_SCHED;
            PG8_STAGE(PG8_SB(1, 1), b3 + hstepB, voffB);
            PG8_WAIT_V(6); PG8_BAR; PG8_MMA(1, 1, At, B1); PG8_BAR;
        }
        PG8_STAMP();
        if constexpr (!Epi::AFTER_DRAIN) { E(acc, cur, wr, wc, fr, fq); S.done(cur); }
        PG8_STAMP();
        if (!has_next) break;
#pragma unroll
        for (int a = 0; a < 2; ++a)
#pragma unroll
            for (int b = 0; b < 2; ++b)
#pragma unroll
                for (int m = 0; m < 4; ++m)
#pragma unroll
                    for (int n = 0; n < 2; ++n) acc[a][b][m][n] = (f32x4){0.f, 0.f, 0.f, 0.f};
        cur = nxt; cA = nA; cB = nB; ++ui;
    }
    PG8_WAIT_V(0);
    if (wr == 0) PG8_BAR;
    PG8_BAR;
    if constexpr (Epi::AFTER_DRAIN) { E.fused(acc, cur, wr, wc, fr, fq, lds, wid, lane); S.done(cur); }
    PG8_STAMP();
    if (STAMP && wid == 0) { stamps[lane] = lane < nts ? (((unsigned long long)(unsigned)ts_hi << 32) | (unsigned)ts_lo) : 0ull;
        if (lane == 62) stamps[62] = rt_entry; if (lane == 63) stamps[63] = (unsigned long long)wall_clock64(); }
#undef PG8_STAMP
#undef PG8_SA
#undef PG8_SB
#undef PG8_STAGE
#undef PG8_LDA
#undef PG8_LDB
#undef PG8_MMA
#undef PG8_WAIT_V
#undef PG8_WAIT_L
#undef PG8_BAR
#undef PG8_SCHED
}
}


struct EpiBf16 {
  static constexpr bool PERM = true, AFTER_DRAIN = false;
  u16* O; int ldc;
  DI void operator()(const f32x4 (&acc)[2][2][4][2], const pg8::Unit& u, int wr, int wc, int fr, int fq) const {
    const int row0 = u.pm * 256 + wr * 64 + fr, col0 = u.pn * 256 + wc * 32 + 8 * fq;
#pragma unroll
    for (int ai = 0; ai < 2; ++ai)
#pragma unroll
      for (int m = 0; m < 4; ++m) {
        u16* rowp = O + (size_t)(row0 + ai * 128 + m * 16) * ldc + col0;
#pragma unroll
        for (int bj = 0; bj < 2; ++bj) {
          f32x4 v0 = acc[ai][bj][m][0], v1 = acc[ai][bj][m][1];
          u32x4 w = {pack2(v0[0], v0[1]), pack2(v0[2], v0[3]), pack2(v1[0], v1[1]), pack2(v1[2], v1[3])};
          *(u32x4*)(rowp + bj * 128) = w;
        }
      }
  }
};
struct EpiResid {
  static constexpr bool PERM = false, AFTER_DRAIN = false;
  const float* xa; const float* xb; const float* gate; float* out;
  DI void operator()(const f32x4 (&acc)[2][2][4][2], const pg8::Unit& u, int wr, int wc, int fr, int fq) const {
    const int row0 = u.pm * 256 + wr * 64 + fr, col0 = u.pn * 256 + wc * 32 + 4 * fq;
#pragma unroll
    for (int ai = 0; ai < 2; ++ai)
#pragma unroll
      for (int m = 0; m < 4; ++m) {
        const int row = row0 + ai * 128 + m * 16;
        const float* xr = (row < NCTX) ? xa + (size_t)row * D : xb + (size_t)(row - NCTX) * D;
        const float* gr = gate + (size_t)tok_modrow(row) * 6144;
        float* orow = out + (size_t)row * D;
#pragma unroll
        for (int bj = 0; bj < 2; ++bj)
#pragma unroll
          for (int n = 0; n < 2; ++n) {
            const int col = col0 + bj * 128 + n * 16;
            f32x4 xv = *(const f32x4*)(xr + col);
            f32x4 gv = *(const f32x4*)(gr + col);
            *(f32x4*)(orow + col) = xv + gv * acc[ai][bj][m][n];
          }
      }
  }
};

template <class Epi>
DI void gemm_run(PG8_LAS unsigned char* lds, const u16* A, int lda, const u16* Bt, int M, int N, int K, const Epi& e) {
  pg8::Gemm g{A, Bt, M, N, K, lda};
  pg8::StaticOrder S; S.init(M, N, (int)gridDim.x, (int)blockIdx.x);
#pragma unroll 1
  for (int rep = 0; rep < (Epi::PERM ? REP_G : 1); ++rep) {
    __syncthreads();
    pg8::gemm_phase<Epi, pg8::StaticOrder, false>(lds, g, S, e, nullptr);
    __syncthreads();
  }
}

DI void phase_qknorm0(const Params& p) {
  const int t = TID(), wave = t >> 6, lane = t & 63, l15 = lane & 15;
  u16* QKVG = (u16*)(p.ws + OFF_BIG);
  u16* KA = (u16*)(p.ws + OFF_KA_ALL);
  u16* VA = (u16*)(p.ws + OFF_VA_ALL);
  const float* tab = (const float*)(p.ws + OFF_ROPE0);
  float gq[8], gk[8];
#pragma unroll
  for (int j = 0; j < 8; ++j) { gq[j] = p.l0_qn[l15 * 8 + j]; gk[j] = p.l0_kn[l15 * 8 + j]; }
  const bool hi = (l15 & 4) != 0;
  const bool colrot = l15 >= 8;
  const int f0 = (l15 & 3) * 8;
  for (int it = blockIdx.x; it < NTOK / NW; it += gridDim.x) {
    const int tk = it * NW + wave;
    u16* base = QKVG + (size_t)tk * L0_IN;
    const bool lat = tk >= NCTX;
    const int lt = tk - NCTX, b = lt >> 10, tt = lt & 1023;
    u32x4 v[3];
#pragma unroll
    for (int ps = 0; ps < 3; ++ps) v[ps] = *(const u32x4*)(base + (ps * 64 + lane) * 8);
    u32x4 kb[2], vb[2];
    if (!lat) {
#pragma unroll
      for (int q = 0; q < 2; ++q) { kb[q] = *(const u32x4*)(base + 2560 + (q * 64 + lane) * 8); vb[q] = *(const u32x4*)(base + 3584 + (q * 64 + lane) * 8); }
    }
    float cs[8], sn[8];
    if (lat) {
      const int pos = colrot ? (tt & 63) : (tt >> 6);
      const float4* tp = (const float4*)(tab + (pos * 32 + f0) * 2);
#pragma unroll
      for (int j2 = 0; j2 < 4; ++j2) { float4 c = tp[j2]; cs[2 * j2] = c.x; sn[2 * j2] = c.y; cs[2 * j2 + 1] = c.z; sn[2 * j2 + 1] = c.w; }
    } else {
#pragma unroll
      for (int j = 0; j < 8; ++j) { cs[j] = 1.f; sn[j] = 0.f; }
    }
    const size_t arow = (size_t)b * 1536 + 512 + tt;
#pragma unroll
    for (int ps = 0; ps < 3; ++ps) {
      float x[8];
#pragma unroll
      for (int j = 0; j < 4; ++j) { x[2 * j] = bflo(v[ps][j]); x[2 * j + 1] = bfhi(v[ps][j]); }
      float ss = 0.f;
#pragma unroll
      for (int j = 0; j < 8; ++j) ss += x[j] * x[j];
      ss += __shfl_xor(ss, 8); ss += __shfl_xor(ss, 4); ss += __shfl_xor(ss, 2); ss += __shfl_xor(ss, 1);
      const float rinv = rsqrtf(ss * (1.f / 128.f) + EPS);
      float o[8];
#pragma unroll
      for (int j = 0; j < 8; ++j) {
        const float y = x[j] * rinv * (ps < 2 ? gq[j] : gk[j]);
        const float pr = __shfl_xor(y, 4);
        o[j] = hi ? (y * cs[j] + pr * sn[j]) : (y * cs[j] - pr * sn[j]);
      }
      if (ps < 2) {
        u32x4 w = {pack2(o[0], o[1]), pack2(o[2], o[3]), pack2(o[4], o[5]), pack2(o[6], o[7])};
        *(u32x4*)(base + (ps * 64 + lane) * 8) = w;
      } else if (lane < 32) {
        u32x4 w = {pack2(o[0], o[1]), pack2(o[2], o[3]), pack2(o[4], o[5]), pack2(o[6], o[7])};
        if (!lat) {
          *(u32x4*)(base + 1024 + lane * 8) = w;
          float* op = p.out + OUT_NAK + (size_t)tk * 256 + lane * 8;
          *(float4*)op = make_float4(o[0], o[1], o[2], o[3]);
          *(float4*)(op + 4) = make_float4(o[4], o[5], o[6], o[7]);
        } else *(u32x4*)(KA + arow * 256 + lane * 8) = w;
      } else {
        if (!lat) {
          float* op = p.out + OUT_NAV + (size_t)tk * 256 + (lane - 32) * 8;
          *(float4*)op = make_float4(x[0], x[1], x[2], x[3]);
          *(float4*)(op + 4) = make_float4(x[4], x[5], x[6], x[7]);
        } else *(u32x4*)(VA + arow * 256 + (lane - 32) * 8) = v[2];
      }
    }
    if (!lat) {
#pragma unroll
      for (int q = 0; q < 2; ++q) {
        float* ok = p.out + OUT_NBK + (size_t)tk * 1024 + (q * 64 + lane) * 8;
        float* ov = p.out + OUT_NBV + (size_t)tk * 1024 + (q * 64 + lane) * 8;
        *(float4*)ok = make_float4(bflo(kb[q][0]), bfhi(kb[q][0]), bflo(kb[q][1]), bfhi(kb[q][1]));
        *(float4*)(ok + 4) = make_float4(bflo(kb[q][2]), bfhi(kb[q][2]), bflo(kb[q][3]), bfhi(kb[q][3]));
        *(float4*)ov = make_float4(bflo(vb[q][0]), bfhi(vb[q][0]), bflo(vb[q][1]), bfhi(vb[q][1]));
        *(float4*)(ov + 4) = make_float4(bflo(vb[q][2]), bfhi(vb[q][2]), bflo(vb[q][3]), bfhi(vb[q][3]));
      }
    }
  }
}

DI void phase_norm1(const Params& p) {
  const int wave = TID() >> 6, lane = TID() & 63;
  const u16* LAT1 = (const u16*)(p.ws + OFF_LAT1);
  u16* QN = (u16*)(p.ws + OFF_QN);
  u16* CKVC = (u16*)(p.ws + OFF_CKV_CTX);
  u16* KRC = (u16*)(p.ws + OFF_KR_CTX);
  u16* CKVA = (u16*)(p.ws + OFF_CKV_ALL);
  u16* KRA = (u16*)(p.ws + OFF_KR_ALL);
  float gq[8], gk[8];
#pragma unroll
  for (int j = 0; j < 8; ++j) { gq[j] = p.l1_qan[lane * 8 + j]; gk[j] = p.l1_kvan[lane * 8 + j]; }
  const int ri = lane & 15, rhalf = (lane >> 4) & 1;
  const int rd1 = rhalf * 32 + ri, rd2 = rd1 + 16;
  const float inv = exp2f(-(float)ri * (LOG2_THETA / 16.f));
  for (int it = blockIdx.x; it < NTOK / NW; it += gridDim.x) {
    int tk = it * NW + wave;
    const u16* base = LAT1 + (size_t)tk * L1_LD;
    const bool lat = tk >= NCTX;
    int lt = tk - NCTX, b = lt >> 10, tt = lt & 1023;
    size_t arow = (size_t)b * 1536 + 512 + tt;
#pragma unroll
    for (int part = 0; part < 2; ++part) {
      uint4 v = *(const uint4*)(base + part * 512 + lane * 8);
      float x[8] = {bflo(v.x), bfhi(v.x), bflo(v.y), bfhi(v.y), bflo(v.z), bfhi(v.z), bflo(v.w), bfhi(v.w)};
      float ss = 0.f;
#pragma unroll
      for (int j = 0; j < 8; ++j) ss += x[j] * x[j];
      ss = wave_sum(ss);
      float rinv = rsqrtf(ss * (1.f / 512.f) + EPS);
#pragma unroll
      for (int j = 0; j < 8; ++j) x[j] = x[j] * rinv * (part ? gk[j] : gq[j]);
      uint4 o = make_uint4(pack2(x[0], x[1]), pack2(x[2], x[3]), pack2(x[4], x[5]), pack2(x[6], x[7]));
      if (part == 0) *(uint4*)(QN + (size_t)tk * 512 + lane * 8) = o;
      else if (!lat) {
        *(uint4*)(CKVC + (size_t)tk * 512 + lane * 8) = o;
        float* op = p.out + OUT_NCKV + (size_t)tk * 512 + lane * 8;
        *(float4*)op = make_float4(x[0], x[1], x[2], x[3]);
        *(float4*)(op + 4) = make_float4(x[4], x[5], x[6], x[7]);
      } else *(uint4*)(CKVA + arow * 512 + lane * 8) = o;
    }
    if (lane < 32) {
      float x1 = bf2f(base[1024 + rd1]), x2 = bf2f(base[1024 + rd2]);
      if (!lat) {
        KRC[(size_t)tk * 64 + rd1] = f2bf(x1); KRC[(size_t)tk * 64 + rd2] = f2bf(x2);
        p.out[OUT_NKR + (size_t)tk * 64 + rd1] = x1; p.out[OUT_NKR + (size_t)tk * 64 + rd2] = x2;
      } else {
        float pos = rhalf ? (float)(tt & 63) : (float)(tt >> 6);
        float sn, cs; sincosf(pos * inv, &sn, &cs);
        KRA[arow * 64 + rd1] = f2bf(x1 * cs - x2 * sn);
        KRA[arow * 64 + rd2] = f2bf(x2 * cs + x1 * sn);
      }
    }
  }
}

DI void phase_final(const Params& p) {
  const int wave = TID() >> 6, lane = TID() & 63;
  for (int it = blockIdx.x; it < NTOK / NW; it += gridDim.x) {
    int row = it * NW + wave;
    float* y = p.out + OUT_Y + (size_t)row * D;
    float4 v[8];
    float ss = 0.f;
#pragma unroll
    for (int i = 0; i < 8; ++i) {
      v[i] = *(const float4*)(y + (i * 64 + lane) * 4);
      ss += v[i].x * v[i].x + v[i].y * v[i].y + v[i].z * v[i].z + v[i].w * v[i].w;
    }
    ss = wave_sum(ss);
    float rinv = rsqrtf(ss * (1.f / D) + EPS);
#pragma unroll
    for (int i = 0; i < 8; ++i) {
      int col = (i * 64 + lane) * 4;
      float4 gg = *(const float4*)(p.fnorm + col);
      *(float4*)(y + col) = make_float4(v[i].x * rinv * gg.x, v[i].y * rinv * gg.y, v[i].z * rinv * gg.z, v[i].w * rinv * gg.w);
    }
  }
}

struct KVSeg { const u16* k; const u16* v; const u16* kr; int ks, vs, n; };
struct AttnArgs {
  const u16* q; int qs;
  KVSeg seg[2]; int nseg;
  const u16* gate; int gs;
  u16* out; int os;
  float scale_log2;
  const float* rpb;
  int qtok0;
  int rs0;
  int rope;
  const float* ropetab;
};

DI float xhalf_max(float v) {
  unsigned u = __float_as_uint(v);
  auto r = __builtin_amdgcn_permlane32_swap(u, u, false, false);
  return fmaxf(__uint_as_float(r[0]), __uint_as_float(r[1]));
}
DI int swz16(int r) { return ((r & 3) << 2) | ((r >> 2) & 3); }

template <int DQK, int MODE>
DI void attn_issue_tile(const AttnArgs& a, int tile, int nt0, LDS_AS(unsigned char)* slot, int wave, int lane) {
  const int sg = tile >= nt0 ? 1 : 0;
  const int off = (sg ? tile - nt0 : tile) * 64;
  const u16* kp = sg ? a.seg[1].k : a.seg[0].k;
  const u16* vp = sg ? a.seg[1].v : a.seg[0].v;
  const int ks = sg ? a.seg[1].ks : a.seg[0].ks;
  const int vs = sg ? a.seg[1].vs : a.seg[0].vs;
  const int sw = ((lane >> 4) << 2) | (wave & 3);
  const int ch = (lane & 15) ^ sw;
#pragma unroll
  for (int j = 0; j < 2; ++j) {
    const int row = off + (j * 8 + wave) * 4 + (lane >> 4);
    __builtin_amdgcn_global_load_lds((const unsigned*)(kp + (unsigned)(row * ks + ch * 8)), (LDS_AS(unsigned)*)(slot + (j * 8 + wave) * 1024), 16, 0, 0);
    __builtin_amdgcn_global_load_lds((const unsigned*)(vp + (unsigned)(row * vs + ch * 8)), (LDS_AS(unsigned)*)(slot + 16384 + (j * 8 + wave) * 1024), 16, 0, 0);
  }
  if constexpr (MODE == 2) {
    const u16* krp = sg ? a.seg[1].kr : a.seg[0].kr;
    const int row = wave * 8 + (lane >> 3);
    const int c2 = (lane & 7) ^ ((row >> 1) & 7);
    __builtin_amdgcn_global_load_lds((const unsigned*)(krp + (unsigned)((off + row) * 64 + c2 * 8)), (LDS_AS(unsigned)*)(slot + 32768 + wave * 1024), 16, 0, 0);
  }
}

template <int DQK, int MODE>
DI void attn_block(const AttnArgs& a, LDS_AS(unsigned char)* lds) {
  constexpr int NS = DQK / 16;
  constexpr int SLOTB = (MODE == 2) ? 40960 : 32768;
  constexpr int NLOAD = (MODE == 2) ? 5 : 4;
  LDS_AS(float)* bias_s = (LDS_AS(float)*)(lds + 3 * SLOTB);
  const int t = TID(), wave = __builtin_amdgcn_readfirstlane(t >> 6), lane = t & 63, l31 = lane & 31, h = lane >> 5;

  __syncthreads();
  if constexpr (MODE == 1) {
    for (int e = t; e < 15 * 31; e += NT) bias_s[e] = a.rpb[e] * LOG2E;
    __syncthreads();
  }
  int ntiles = 0;
  for (int s = 0; s < a.nseg; ++s) ntiles += a.seg[s].n >> 6;
  const int nt0 = a.seg[0].n >> 6;
  bf16x8 qf[NS];
  {
    const u16* qp = a.q + (size_t)(wave * 32 + l31) * a.qs + 8 * h;
#pragma unroll
    for (int s = 0; s < NS; ++s) qf[s] = *(const bf16x8*)(qp + 16 * s);
  }
  attn_issue_tile<DQK, MODE>(a, 0, nt0, lds, wave, lane);
  attn_issue_tile<DQK, MODE>(a, ntiles > 1 ? 1 : 0, nt0, lds + SLOTB, wave, lane);
  const int qtok = a.qtok0 + wave * 32 + l31;
  if constexpr (MODE == 2) {
    if (a.rope) {
      const int qr = qtok >> 6, qc = qtok & 63;
#pragma unroll
      for (int pr = 0; pr < 2; ++pr) {
        const float4* tb = (const float4*)(a.ropetab + ((pr ? qc : qr) * 16 + 8 * h) * 2);
#pragma unroll
        for (int j2 = 0; j2 < 4; ++j2) {
          float4 cssn = tb[j2];
#pragma unroll
          for (int e = 0; e < 2; ++e) {
            const int j = 2 * j2 + e;
            float cs = e ? cssn.z : cssn.x, sn = e ? cssn.w : cssn.y;
            float x1 = bf2f((u16)qf[8 + 2 * pr][j]), x2 = bf2f((u16)qf[9 + 2 * pr][j]);
            qf[8 + 2 * pr][j] = (short)f2bf(x1 * cs - x2 * sn);
            qf[9 + 2 * pr][j] = (short)f2bf(x2 * cs + x1 * sn);
          }
        }
      }
    }
  }
  f32x16 acc[4];
#pragma unroll
  for (int c = 0; c < 4; ++c)
#pragma unroll
    for (int r = 0; r < 16; ++r) acc[c][r] = 0.f;
  float m_run = -1e30f, l_run = 0.f;

  const int blk = (lane >> 4) & 1, tq = (lane & 15) >> 2, tp = lane & 3;
  const int kswz = swz16(l31);
  const int kb0 = l31 * 256 + ((h ^ (kswz & 1)) << 4);
  const int ksw = kswz >> 1;
  const int kr0 = 32768 + l31 * 128;
  const int krsw = (l31 >> 1) & 7;
  const int vlow0 = (2 * blk + (tp >> 1)) ^ (h & 3);
  const int vlow1 = (2 * blk + (tp >> 1)) ^ ((2 + h) & 3);
  const int vb0 = 16384 + (4 * h + tq) * 256 + (vlow0 << 4) + 8 * (tp & 1);
  const int vb1 = 16384 + (8 + 4 * h + tq) * 256 + (vlow1 << 4) + 8 * (tp & 1);
  const int qrow = qtok >> 6, qcol = qtok & 63;
  int q_rs = qrow - 4; q_rs = q_rs < 0 ? 0 : (q_rs > 8 ? 8 : q_rs);
  int q_cs = qcol - 8; q_cs = q_cs < 0 ? 0 : (q_cs > 48 ? 48 : q_cs);

  int sl = 0;
  for (int tile = 0; tile < ntiles; ++tile) {
    if constexpr (NLOAD == 5) asm volatile("s_waitcnt vmcnt(5)" ::: "memory"); else asm volatile("s_waitcnt vmcnt(4)" ::: "memory");
    __builtin_amdgcn_s_barrier();
    asm volatile("" ::: "memory");
    {
      int nx = tile + 2; nx = nx < ntiles ? nx : ntiles - 1;
      int sn = sl + 2; sn = sn >= 3 ? sn - 3 : sn;
      attn_issue_tile<DQK, MODE>(a, nx, nt0, lds + sn * SLOTB, wave, lane);
    }
    LDS_AS(unsigned char)* slot = lds + sl * SLOTB;
    sl = sl == 2 ? 0 : sl + 1;

    const bool local = (MODE == 1) && (tile >= nt0);
    const int krow = a.rs0 + (tile - nt0);
#pragma unroll 1
    for (int mt = 0; mt < 2; ++mt) {
      f32x16 S;
#pragma unroll
      for (int r = 0; r < 16; ++r) S[r] = 0.f;
      LDS_AS(unsigned char)* kbase = slot + mt * 8192 + kb0;
#pragma unroll
      for (int s = 0; s < 8; ++s) {
        bf16x8 kf = *(const LDS_AS(bf16x8)*)(kbase + ((s ^ ksw) << 5));
        S = MFMA32(kf, qf[s], S);
      }
      if constexpr (MODE == 2) {
        LDS_AS(unsigned char)* rbase = slot + mt * 4096 + kr0;
#pragma unroll
        for (int s2 = 0; s2 < 4; ++s2) {
          bf16x8 kf = *(const LDS_AS(bf16x8)*)(rbase + (((2 * s2 + h) ^ krsw) << 4));
          S = MFMA32(kf, qf[8 + s2], S);
        }
      }
      float mx = -1e30f;
      float m_new, alpha;
      float ps = 0.f;
      const float m_old = m_run;
      if constexpr (MODE == 1) {
#pragma unroll
        for (int r = 0; r < 16; ++r) {
          float sv = S[r] * a.scale_log2;
          if (local) {
            int kcol = mt * 32 + crow(r, h);
            bool ok = (krow >= q_rs) && (krow < q_rs + 8) && (kcol >= q_cs) && (kcol < q_cs + 16);
            int dy = krow - qrow + 7, dx = kcol - qcol + 15;
            dy = dy < 0 ? 0 : (dy > 14 ? 14 : dy);
            dx = dx < 0 ? 0 : (dx > 30 ? 30 : dx);
            const float bv = bias_s[dy * 31 + dx];
            sv = ok ? sv + bv : -1e30f;
          }
          S[r] = sv;
          mx = fmaxf(mx, sv);
        }
        mx = xhalf_max(mx);
        m_new = fmaxf(m_run, mx);
        alpha = __builtin_amdgcn_exp2f(m_run - m_new);
        m_run = m_new;
#pragma unroll
        for (int r = 0; r < 16; ++r) {
          float pv = __builtin_amdgcn_exp2f(S[r] - m_new);
          if (S[r] <= -1e29f) pv = 0.f;
          S[r] = pv;
          ps += pv;
        }
      } else {
#pragma unroll
        for (int r = 0; r < 16; ++r) mx = fmaxf(mx, S[r]);
        mx = xhalf_max(mx) * a.scale_log2;
        m_new = fmaxf(m_run, mx);
        alpha = __builtin_amdgcn_exp2f(m_run - m_new);
        m_run = m_new;
        const float nm = -m_new;
#pragma unroll
        for (int r = 0; r < 16; ++r) {
          float pv = __builtin_amdgcn_exp2f(__builtin_fmaf(S[r], a.scale_log2, nm));
          S[r] = pv;
          ps += pv;
        }
      }
      l_run = l_run * alpha + ps;
      if (__builtin_amdgcn_ballot_w64(m_new != m_old) != 0) {
#pragma unroll
        for (int c = 0; c < 4; ++c)
#pragma unroll
          for (int r = 0; r < 16; ++r) acc[c][r] *= alpha;
      }
      bf16x8 pf[2];
#pragma unroll
      for (int s2 = 0; s2 < 2; ++s2) {
        u32x4 u;
        u[0] = pack2(S[8 * s2 + 0], S[8 * s2 + 1]);
        u[1] = pack2(S[8 * s2 + 2], S[8 * s2 + 3]);
        u[2] = pack2(S[8 * s2 + 4], S[8 * s2 + 5]);
        u[3] = pack2(S[8 * s2 + 6], S[8 * s2 + 7]);
        pf[s2] = __builtin_bit_cast(bf16x8, u);
      }
      const unsigned vaddr = (unsigned)(size_t)(slot + mt * 8192);
#pragma unroll
      for (int c0 = 0; c0 < 4; c0 += 2) {
        const unsigned a0 = vaddr + vb0 + ((c0 ^ tq) << 6), a1 = vaddr + vb1 + ((c0 ^ tq) << 6);
        const unsigned a2 = vaddr + vb0 + (((c0 + 1) ^ tq) << 6), a3 = vaddr + vb1 + (((c0 + 1) ^ tq) << 6);
        s16x4 r0, r1, r2, r3, r4, r5, r6, r7;
        asm volatile(
            "ds_read_b64_tr_b16 %0, %8\n\t"
            "ds_read_b64_tr_b16 %1, %9\n\t"
            "ds_read_b64_tr_b16 %2, %8 offset:4096\n\t"
            "ds_read_b64_tr_b16 %3, %9 offset:4096\n\t"
            "ds_read_b64_tr_b16 %4, %10\n\t"
            "ds_read_b64_tr_b16 %5, %11\n\t"
            "ds_read_b64_tr_b16 %6, %10 offset:4096\n\t"
            "ds_read_b64_tr_b16 %7, %11 offset:4096\n\t"
            "s_waitcnt lgkmcnt(0)"
            : "=&v"(r0), "=&v"(r1), "=&v"(r2), "=&v"(r3), "=&v"(r4), "=&v"(r5), "=&v"(r6), "=&v"(r7)
            : "v"(a0), "v"(a1), "v"(a2), "v"(a3)
            : "memory");
        acc[c0] = MFMA32(__builtin_shufflevector(r0, r1, 0, 1, 2, 3, 4, 5, 6, 7), pf[0], acc[c0]);
        acc[c0] = MFMA32(__builtin_shufflevector(r2, r3, 0, 1, 2, 3, 4, 5, 6, 7), pf[1], acc[c0]);
        acc[c0 + 1] = MFMA32(__builtin_shufflevector(r4, r5, 0, 1, 2, 3, 4, 5, 6, 7), pf[0], acc[c0 + 1]);
        acc[c0 + 1] = MFMA32(__builtin_shufflevector(r6, r7, 0, 1, 2, 3, 4, 5, 6, 7), pf[1], acc[c0 + 1]);
      }
    }
  }
  asm volatile("s_waitcnt vmcnt(0)" ::: "memory");
  float l_tot = l_run + __shfl_xor(l_run, 32);
  float linv = 1.f / l_tot;
  const size_t qrow_i = (size_t)(wave * 32 + l31);
#pragma unroll
  for (int c = 0; c < 4; ++c)
#pragma unroll
    for (int g4 = 0; g4 < 4; ++g4) {
      int dv0 = 32 * c + 8 * g4 + 4 * h;
      uint2 gt = *(const uint2*)(a.gate + qrow_i * a.gs + dv0);
      float o0 = acc[c][4 * g4 + 0] * linv * silu(bflo(gt.x));
      float o1 = acc[c][4 * g4 + 1] * linv * silu(bfhi(gt.x));
      float o2 = acc[c][4 * g4 + 2] * linv * silu(bflo(gt.y));
      float o3 = acc[c][4 * g4 + 3] * linv * silu(bfhi(gt.y));
      *(uint2*)(a.out + qrow_i * a.os + dv0) = make_uint2(pack2(o0, o1), pack2(o2, o3));
    }
}

DI void phase_attn0(const Params& p, LDS_AS(unsigned char)* smem) {
  const u16* QKVG = (const u16*)(p.ws + OFF_BIG);
  u16* OG = (u16*)(p.ws + OFF_H);
  const u16* KA = (const u16*)(p.ws + OFF_KA_ALL);
  const u16* VA = (const u16*)(p.ws + OFF_VA_ALL);
  const u16* KBC = (const u16*)(p.ws + OFF_KB_CTX);
  const u16* VBC = (const u16*)(p.ws + OFF_VB_CTX);
  const float sc = 0.08838834764831845f * LOG2E;
  for (int it = blockIdx.x; it < 1024; it += gridDim.x) {
    AttnArgs a;
    a.qs = L0_IN; a.gs = L0_IN; a.os = D; a.scale_log2 = sc; a.rpb = nullptr; a.qtok0 = 0; a.rs0 = 0; a.rope = 0; a.ropetab = nullptr;
    a.seg[1].k = nullptr; a.seg[1].v = nullptr; a.seg[1].kr = nullptr; a.seg[1].ks = 0; a.seg[1].vs = 0; a.seg[1].n = 0;
    a.seg[0].kr = nullptr;
    if (it >= 256 && it < 512) {
      int i = it - 256;
      int bh = (i >> 5) * 8 + (i & 7), qb = (i >> 3) & 3;
      int b = bh >> 3, hh = bh & 7;
      size_t tok = (size_t)NCTX + b * 1024 + qb * 256;
      a.q = QKVG + tok * L0_IN + 1536 + hh * 128;
      a.gate = QKVG + tok * L0_IN + 4608 + 1024 + hh * 128;
      a.out = OG + tok * D + 1024 + hh * 128;
      a.nseg = 2;
      a.seg[0].k = KBC + (size_t)b * 512 * 1024 + hh * 128; a.seg[0].ks = 1024;
      a.seg[0].v = VBC + (size_t)b * 512 * 1024 + hh * 128; a.seg[0].vs = 1024;
      a.seg[0].n = 512;
      int rs0 = 4 * qb - 4; rs0 = rs0 < 0 ? 0 : (rs0 > 8 ? 8 : rs0);
      int rs1 = 4 * qb - 1; rs1 = rs1 < 0 ? 0 : (rs1 > 8 ? 8 : rs1);
      int nrows = rs1 + 8 - rs0;
      size_t ktok = (size_t)NCTX + b * 1024 + rs0 * 64;
      a.seg[1].k = QKVG + ktok * L0_IN + 2560 + hh * 128; a.seg[1].ks = L0_IN;
      a.seg[1].v = QKVG + ktok * L0_IN + 3584 + hh * 128; a.seg[1].vs = L0_IN;
      a.seg[1].n = nrows * 64;
      a.rpb = p.l0_rpb + hh * 15 * 31;
      a.qtok0 = qb * 256; a.rs0 = rs0;
      attn_block<128, 1>(a, smem);
    } else {
      a.nseg = 1;
      if (it < 256) {
        int g = (it >> 7) * 8 + (it & 7), j = (it >> 3) & 15;
        int b = g >> 1, hq = (g & 1) * 4 + (j >> 2), qb = j & 3;
        size_t tok = (size_t)NCTX + b * 1024 + qb * 256;
        a.q = QKVG + tok * L0_IN + hq * 128;
        a.gate = QKVG + tok * L0_IN + 4608 + hq * 128;
        a.out = OG + tok * D + hq * 128;
        a.seg[0].k = KA + (size_t)b * 1536 * 256 + (hq >> 2) * 128; a.seg[0].ks = 256;
        a.seg[0].v = VA + (size_t)b * 1536 * 256 + (hq >> 2) * 128; a.seg[0].vs = 256;
        a.seg[0].n = 1536;
      } else {
        int i = it - 512;
        bool isB = i >= 256; i &= 255;
        int g = (i >> 5) * 8 + (i & 7), j = (i >> 3) & 3;
        int b = isB ? (i >> 3) : (g >> 1), hh = isB ? (i & 7) : ((g & 1) * 4 + j);
        size_t tok = (size_t)b * 256;
        a.seg[0].n = 256; a.seg[0].ks = L0_IN; a.seg[0].vs = L0_IN;
        if (!isB) {
          a.q = QKVG + tok * L0_IN + hh * 128;
          a.gate = QKVG + tok * L0_IN + 4608 + hh * 128;
          a.out = OG + tok * D + hh * 128;
          a.seg[0].k = QKVG + tok * L0_IN + 1024 + (hh >> 2) * 128;
          a.seg[0].v = QKVG + tok * L0_IN + 1280 + (hh >> 2) * 128;
        } else {
          a.q = QKVG + tok * L0_IN + 1536 + hh * 128;
          a.gate = QKVG + tok * L0_IN + 4608 + 1024 + hh * 128;
          a.out = OG + tok * D + 1024 + hh * 128;
          a.seg[0].k = QKVG + tok * L0_IN + 2560 + hh * 128;
          a.seg[0].v = QKVG + tok * L0_IN + 3584 + hh * 128;
        }
      }
      attn_block<128, 0>(a, smem);
    }
  }
}

DI void phase_attn1(const Params& p, LDS_AS(unsigned char)* smem, int round) {
  const u16* Q1 = (const u16*)(p.ws + OFF_Q1);
  u16* LAT1 = (u16*)(p.ws + OFF_LAT1);
  const float sc = 0.07216878364870322f * LOG2E;
  for (int it = blockIdx.x; it < 512; it += gridDim.x) {
    AttnArgs a;
    a.qs = 3072; a.gs = L1_LD; a.os = L1_LD; a.scale_log2 = sc; a.rpb = nullptr; a.rs0 = 0; a.ropetab = (const float*)(p.ws + OFF_ROPE);
    a.seg[1].k = nullptr; a.seg[1].v = nullptr; a.seg[1].kr = nullptr; a.seg[1].ks = 0; a.seg[1].vs = 0; a.seg[1].n = 0;
    a.nseg = 1;
    a.seg[0].ks = 4096; a.seg[0].vs = 4096;
    size_t tok;
    int hh;
    if (round == 0) {
      int b = it >> 4; hh = it & 15;
      tok = (size_t)b * 256;
      const u16* KV = (const u16*)(p.ws + OFF_KV_CTX) + (size_t)b * 256 * 4096 + hh * 256;
      a.seg[0].k = KV; a.seg[0].v = KV + 128;
      a.seg[0].kr = (const u16*)(p.ws + OFF_KR_CTX) + (size_t)b * 256 * 64;
      a.seg[0].n = 256;
      a.rope = 0; a.qtok0 = 0;
    } else {
      int bh = (it >> 5) * 8 + (it & 7), qb = (it >> 3) & 3;
      int b = bh >> 4; hh = bh & 15;
      tok = (size_t)NCTX + b * 1024 + qb * 256;
      const u16* KV = (const u16*)(p.ws + OFF_KV_LAT) + (size_t)b * 1536 * 4096 + hh * 256;
      a.seg[0].k = KV; a.seg[0].v = KV + 128;
      a.seg[0].kr = (const u16*)(p.ws + OFF_KR_ALL) + (size_t)b * 1536 * 64;
      a.seg[0].n = 1536;
      a.rope = 1; a.qtok0 = qb * 256;
    }
    a.q = Q1 + tok * 3072 + hh * 192;
    a.gate = LAT1 + tok * L1_LD + 1088 + hh * 128;
    a.out = LAT1 + tok * L1_LD + 1088 + hh * 128;
    attn_block<192, 2>(a, smem);
  }
}

#define XB_TMO      128
#define XB_XCNT(j)  (256  + 64 * (j))
#define XB_XSUB(j)  (1280 + 64 * (j))
#define XB_XGEN(j)  (2304 + 64 * (j))
#define XB_TOP      3328
#define XB_TOPGEN   3392
#define XCD_BAR_WORDS 3456
#define XB_SPIN_CAP (1u << 18)
#define XLAS __attribute__((address_space(3)))

__device__ __forceinline__ unsigned xb_ld(unsigned* p)              { return __hip_atomic_load(p, __ATOMIC_RELAXED, __HIP_MEMORY_SCOPE_AGENT); }
__device__ __forceinline__ unsigned xb_add(unsigned* p, unsigned v) { return __hip_atomic_fetch_add(p, v, __ATOMIC_RELAXED, __HIP_MEMORY_SCOPE_AGENT); }
__device__ __forceinline__ unsigned xb_xcc_id() { return (unsigned)__builtin_amdgcn_s_getreg((3 << 11) | 20) & 0xFu; }
#define XB_SPIN(cond, bar) do { unsigned _sp = 0; while (cond) { __builtin_amdgcn_s_sleep(1); \
    if ((++_sp & 255u) == 0u) { if (xb_ld(&(bar)[XB_TMO])) break; if (_sp > XB_SPIN_CAP) { atomicAdd(&(bar)[XB_TMO], 1u); break; } } } } while (0)

struct XcdBarrier {
    unsigned* bar; unsigned x;
    volatile XLAS unsigned* st;
};

__device__ __forceinline__ XcdBarrier xcd_barrier_post(unsigned* bar, volatile XLAS unsigned* st) {
    XcdBarrier b; b.bar = bar; b.x = xb_xcc_id(); b.st = st;
    if (threadIdx.x == 0) (void)xb_add(&bar[XB_XCNT(b.x)], 1u);
    return b;
}
__device__ __forceinline__ void xcd_barrier_complete(unsigned* bar, unsigned x, unsigned& nloc, unsigned& nx) {
    const unsigned G = gridDim.x * gridDim.y * gridDim.z;
    unsigned sum, cnt, mine, sp = 0u;
    for (;;) {
        sum = 0u; cnt = 0u; mine = 0u;
#pragma unroll
        for (unsigned j = 0; j < 16; ++j) { const unsigned c = xb_ld(&bar[XB_XCNT(j)]); sum += c; cnt += (c > 0u) ? 1u : 0u; mine = (j == x) ? c : mine; }
        if (sum == G) break;
        __builtin_amdgcn_s_sleep(1);
        if ((++sp & 255u) == 0u) { if (xb_ld(&bar[XB_TMO])) break; if (sp > XB_SPIN_CAP) { atomicAdd(&bar[XB_TMO], 1u); break; } }
    }
    nloc = mine > 0u ? mine : 1u; nx = cnt > 0u ? cnt : 1u;
}

__device__ __forceinline__ void xcd_barrier(const XcdBarrier& b) {
    asm volatile("s_waitcnt vmcnt(0)" ::: "memory");
    __syncthreads();
    if (threadIdx.x == 0) {
        unsigned* bar = b.bar;
        __builtin_amdgcn_s_waitcnt(0);
        unsigned nloc = b.st[0], nx = b.st[1];
        if (nloc == 0u) { xcd_barrier_complete(bar, b.x, nloc, nx); b.st[0] = nloc; b.st[1] = nx; }
        const unsigned old = xb_add(&bar[XB_XSUB(b.x)], 1u);
        const unsigned gen = old / nloc;
        if (old + 1u == (gen + 1u) * nloc) {
            __builtin_amdgcn_fence(__ATOMIC_RELEASE, "agent");
            asm volatile("s_waitcnt vmcnt(0)" ::: "memory");
            const unsigned og = xb_add(&bar[XB_TOP], 1u);
            const unsigned tg = og / nx;
            if (og + 1u == (tg + 1u) * nx) xb_add(&bar[XB_TOPGEN], 1u);
            else XB_SPIN(xb_ld(&bar[XB_TOPGEN]) == tg, bar);
            __builtin_amdgcn_fence(__ATOMIC_ACQUIRE, "agent");
            xb_add(&bar[XB_XGEN(b.x)], 1u);
            asm volatile("s_waitcnt vmcnt(0)" ::: "memory");
        } else {
            XB_SPIN(xb_ld(&bar[XB_XGEN(b.x)]) == gen, bar);
            __builtin_amdgcn_fence(__ATOMIC_ACQUIRE, "agent");
            asm volatile("s_waitcnt vmcnt(0)" ::: "memory");
        }
    }
    __syncthreads();
}

__global__ void __launch_bounds__(512, 2) fwd_megakernel(Params p) {
  cg::grid_group grid = cg::this_grid();
  extern __shared__ __attribute__((aligned(16))) unsigned char dsm[];
  char* smem = (char*)dsm;
  char* ws = p.ws;
  const float* mod0 = (const float*)(ws + OFF_MOD);
  const float* mod1 = mod0 + 9 * 6144;

  volatile XLAS unsigned* xst = (volatile XLAS unsigned*)((XLAS unsigned char*)dsm + 128 * 1024);
  if (threadIdx.x < 4) xst[threadIdx.x] = 0u;
  __syncthreads();
  const XcdBarrier xb = xcd_barrier_post((unsigned*)(ws + OFF_BAR), xst);
  phase_prep(p, smem);
  if (p.out == nullptr) grid.sync();
  xcd_barrier(xb);
  phase_normmod(p, 0);
  xcd_barrier(xb);
  { EpiBf16 e{(u16*)(ws + OFF_BIG), L0_IN};
    gemm_run((PG8_LAS unsigned char*)dsm, (const u16*)(ws + OFF_H), D, (const u16*)(ws + OFF_WT_IN0), NTOK, L0_IN, 2048, e); }
  if (gridDim.x == 256) { if (blockIdx.x >= 128 && blockIdx.x < 224) adaln_item(p, 1, blockIdx.x - 128, (float*)smem); }
  else { for (int c = blockIdx.x; c < 96; c += gridDim.x) adaln_item(p, 1, c, (float*)smem); }
  xcd_barrier(xb);
  phase_qknorm0(p);
  xcd_barrier(xb);
#pragma unroll 1
  for (int rep = 0; rep < REP_A0; ++rep) phase_attn0(p, (LDS_AS(unsigned char)*)dsm);
  xcd_barrier(xb);
  { EpiResid e{p.x_prompt, p.x_sample, mod0 + 4096, p.out + OUT_Y};
    gemm_run((PG8_LAS unsigned char*)dsm, (const u16*)(ws + OFF_H), D, (const u16*)(ws + OFF_WT_OUT0), NTOK, D, 2048, e); }
  xcd_barrier(xb);
  phase_normmod(p, 1);
  xcd_barrier(xb);
  { EpiBf16 e{(u16*)(ws + OFF_LAT1), L1_LD};
    gemm_run((PG8_LAS unsigned char*)dsm, (const u16*)(ws + OFF_H), D, (const u16*)(ws + OFF_WT_IN1), NTOK, L1_LD, 2048, e); }
  xcd_barrier(xb);
  phase_norm1(p);
  xcd_barrier(xb);
  { EpiBf16 e{(u16*)(ws + OFF_Q1), 3072};
    gemm_run((PG8_LAS unsigned char*)dsm, (const u16*)(ws + OFF_QN), 512, (const u16*)(ws + OFF_WT_QB), NTOK, 3072, 512, e); }
#pragma unroll 1
  for (int round = 0; round < 2; ++round) {
    { EpiBf16 e{(u16*)(ws + (round ? OFF_KV_LAT : OFF_KV_CTX)), 4096};
      gemm_run((PG8_LAS unsigned char*)dsm, (const u16*)(ws + (round ? OFF_CKV_ALL : OFF_CKV_CTX)), 512, (const u16*)(ws + OFF_WT_KVB),
               round ? 12288 : NCTX, 4096, 512, e); }
    xcd_barrier(xb);
    phase_attn1(p, (LDS_AS(unsigned char)*)dsm, round);
    xcd_barrier(xb);
  }
  { EpiResid e{p.out + OUT_Y, p.out + OUT_Y + (size_t)NCTX * D, mod1 + 4096, p.out + OUT_Y};
    gemm_run((PG8_LAS unsigned char*)dsm, (const u16*)(ws + OFF_LAT1) + 1088, L1_LD, (const u16*)(ws + OFF_WT_OUT1), NTOK, D, 2048, e); }
  xcd_barrier(xb);
  phase_final(p);
}

extern "C" void kernel_launch(void* const* d_in, const int* in_sizes, int n_in, void* d_out, int out_size, void* d_ws,
                              size_t ws_size, hipStream_t stream) {
  (void)in_sizes; (void)n_in; (void)out_size;
  if (ws_size < WS_NEEDED) { fprintf(stderr, "workspace too small: %zu < %zu\n", ws_size, (size_t)WS_NEEDED); return; }
  static int grid_blocks = 0;
  if (!grid_blocks) {
    int dev = 0, cus = 0, per_cu = 0;
    (void)hipGetDevice(&dev);
    (void)hipDeviceGetAttribute(&cus, hipDeviceAttributeMultiprocessorCount, dev);
    if (hipFuncSetAttribute((const void*)fwd_megakernel, hipFuncAttributeMaxDynamicSharedMemorySize, SMEM_BYTES) != hipSuccess) {
      fprintf(stderr, "hipFuncSetAttribute failed\n"); return; }
    (void)hipOccupancyMaxActiveBlocksPerMultiprocessor(&per_cu, fwd_megakernel, NT, SMEM_BYTES);
    if (per_cu < 1) { fprintf(stderr, "occupancy query returned %d\n", per_cu); return; }
    grid_blocks = cus;
  }
  Params p{};
  const float** pf = (const float**)&p;
  for (int i = 0; i < 28; ++i) pf[i] = (const float*)d_in[i];
  p.out = (float*)d_out;
  p.ws = (char*)d_ws;
  (void)hipMemsetAsync((char*)d_ws + OFF_BAR, 0, BAR_BYTES, stream);
  void* args[] = {&p};
  hipError_t e = hipLaunchCooperativeKernel((void*)fwd_megakernel, dim3(grid_blocks), dim3(NT), args, SMEM_BYTES, stream);
  if (e != hipSuccess) fprintf(stderr, "cooperative launch failed: %s (grid %d)\n", hipGetErrorString(e), grid_blocks);
}
```

```cpp
#include <hip/hip_runtime.h>
#include <hip/hip_cooperative_groups.h>
#include <cstdio>
namespace cg = cooperative_groups;

typedef unsigned short u16;
using bf16x8 = __attribute__((ext_vector_type(8))) short;
using s16x4  = __attribute__((ext_vector_type(4))) short;
using f32x16 = __attribute__((ext_vector_type(16))) float;
using f32x4  = __attribute__((ext_vector_type(4))) float;
using u32x4  = __attribute__((ext_vector_type(4))) unsigned;
typedef __bf16 bf16x2_t __attribute__((ext_vector_type(2)));
typedef float f32x2_t __attribute__((ext_vector_type(2)));
#define DI __device__ __forceinline__
#define MFMA32(a, b, c) __builtin_amdgcn_mfma_f32_32x32x16_bf16((a), (b), (c), 0, 0, 0)
#define LDS_AS(T) __attribute__((address_space(3))) T

constexpr int D = 2048;
constexpr int NTOK = 16384;
constexpr int NCTX = 8192;
constexpr int L0_IN = 6656;
constexpr int L1_IN = 3136;
constexpr int L1_LD = 3328;
constexpr float EPS = 1e-6f;
constexpr float LOG2E = 1.4426950408889634f;
constexpr float LOG2_THETA = 13.287712379549449f;
#ifndef REP_G
#define REP_G 1
#endif
#ifndef REP_A0
#define REP_A0 1
#endif
constexpr int NT = 512;
constexpr int NW = 8;

constexpr size_t OFF_WT_IN1  = 0;
constexpr size_t OFF_WT_QB   = OFF_WT_IN1 + (size_t)3328 * 2048 * 2;
constexpr size_t OFF_WT_KVB  = OFF_WT_QB + (size_t)3072 * 512 * 2;
constexpr size_t OFF_WT_OUT1 = OFF_WT_KVB + (size_t)4096 * 512 * 2;
constexpr size_t OFF_WL0     = OFF_WT_OUT1 + (size_t)2048 * 2048 * 2;
constexpr size_t OFF_WT_IN0  = OFF_WL0;
constexpr size_t OFF_WT_OUT0 = OFF_WT_IN0 + (size_t)6656 * 2048 * 2;
constexpr size_t OFF_H       = OFF_WT_OUT0 + (size_t)2048 * 2048 * 2;
constexpr size_t OFF_BIG     = OFF_H + (size_t)NTOK * 2048 * 2;
constexpr size_t OFF_C       = OFF_BIG + (size_t)NTOK * 6656 * 2;
constexpr size_t OFF_KA_ALL  = OFF_C;
constexpr size_t OFF_VA_ALL  = OFF_KA_ALL + (size_t)8 * 1536 * 256 * 2;
constexpr size_t OFF_KB_CTX  = OFF_VA_ALL + (size_t)8 * 1536 * 256 * 2;
constexpr size_t OFF_VB_CTX  = OFF_KB_CTX + (size_t)8 * 512 * 1024 * 2;
constexpr size_t OFF_CKV_ALL = OFF_VB_CTX + (size_t)8 * 512 * 1024 * 2;
constexpr size_t OFF_KR_ALL  = OFF_CKV_ALL + (size_t)8 * 1536 * 512 * 2;
constexpr size_t OFF_MOD     = OFF_KR_ALL + (size_t)8 * 1536 * 64 * 2;
constexpr size_t OFF_ROPE    = OFF_MOD + (size_t)2 * 9 * 6144 * 4;
constexpr size_t OFF_ROPE0   = OFF_ROPE + (size_t)64 * 16 * 2 * 4;
constexpr size_t OFF_BAR     = OFF_ROPE0 + (size_t)64 * 32 * 2 * 4;
constexpr size_t BAR_BYTES   = 3456 * 4;
constexpr size_t WS_NEEDED   = OFF_BAR + BAR_BYTES;
constexpr size_t OFF_QN      = OFF_WL0;
constexpr size_t OFF_CKV_CTX = OFF_QN + (size_t)NTOK * 512 * 2;
constexpr size_t OFF_KR_CTX  = OFF_CKV_CTX + (size_t)NCTX * 512 * 2;
constexpr size_t OFF_KV_CTX  = OFF_H;
constexpr size_t OFF_KV_LAT  = OFF_WL0;
constexpr size_t OFF_LAT1    = OFF_BIG;
constexpr size_t OFF_Q1      = OFF_BIG + (size_t)NTOK * L1_LD * 2;
static_assert(OFF_KR_CTX + (size_t)NCTX * 64 * 2 <= OFF_WT_OUT0, "l1 small bufs overflow");
static_assert(OFF_KV_LAT + (size_t)12288 * 4096 * 2 <= OFF_BIG, "kv_lat overflow");
static_assert(OFF_Q1 + (size_t)NTOK * 3072 * 2 <= OFF_C, "q1 overflow");

constexpr size_t OUT_Y   = 0;
constexpr size_t OUT_NAK = (size_t)NTOK * 2048;
constexpr size_t OUT_NAV = OUT_NAK + (size_t)NCTX * 256;
constexpr size_t OUT_NBK = OUT_NAV + (size_t)NCTX * 256;
constexpr size_t OUT_NBV = OUT_NBK + (size_t)NCTX * 1024;
constexpr size_t OUT_NCKV = OUT_NBV + (size_t)NCTX * 1024;
constexpr size_t OUT_NKR = OUT_NCKV + (size_t)NCTX * 512;

constexpr int SMEM_BYTES = 128 * 1024 + 256;

struct Params {
  const float *x_prompt, *x_sample, *ca_k, *ca_v, *cb_k, *cb_v, *c_ckv, *c_kr, *c, *c_ctx;
  const float *l0_norm, *l0_ada_w, *l0_ada_b, *l0_w_in, *l0_qn, *l0_kn, *l0_rpb, *l0_w_out;
  const float *l1_norm, *l1_ada_w, *l1_ada_b, *l1_w_in, *l1_qan, *l1_wqb, *l1_kvan, *l1_wkvb, *l1_w_out, *fnorm;
  float* out;
  char* ws;
};

DI int threadIdx_x_raw() { return (int)__builtin_amdgcn_workitem_id_x(); }
DI u16 f2bf(float x) { unsigned u = __float_as_uint(x); u += 0x7fffu + ((u >> 16) & 1u); return (u16)(u >> 16); }
DI float bf2f(u16 v) { return __uint_as_float(((unsigned)v) << 16); }
DI unsigned pack2(float a, float b) { f32x2_t f = {a, b}; bf16x2_t r = __builtin_convertvector(f, bf16x2_t); return __builtin_bit_cast(unsigned, r); }
DI float bflo(unsigned u) { return __uint_as_float(u << 16); }
DI float bfhi(unsigned u) { return __uint_as_float(u & 0xffff0000u); }
DI float wave_sum(float v) {
#pragma unroll
  for (int o = 32; o >= 1; o >>= 1) v += __shfl_xor(v, o);
  return v;
}
DI int TID() { int t = threadIdx_x_raw(); asm volatile("" : "+v"(t)); return t; }
DI int crow(int i, int h) { return (i & 3) + 8 * (i >> 2) + 4 * h; }
DI float silu(float x) { return x / (1.f + __expf(-x)); }
DI int tok_modrow(int tok) { return tok < NCTX ? 0 : 1 + ((tok - NCTX) >> 10); }

DI void transpose_tile(const float* __restrict__ src, int K, int N, u16* __restrict__ dst, int kt, int nt, float* sm) {
  const int t = TID();
  float4 v[8];
#pragma unroll
  for (int i = 0; i < 8; ++i) {
    int id = t + NT * i, r = id >> 6, c4 = id & 63, n = nt * 256 + c4 * 4;
    v[i] = (n < N) ? *(const float4*)(src + (size_t)(kt * 64 + r) * N + n) : make_float4(0.f, 0.f, 0.f, 0.f);
  }
#pragma unroll
  for (int i = 0; i < 8; ++i) {
    int id = t + NT * i, r = id >> 6, c4 = id & 63;
    *(float4*)(sm + r * 260 + c4 * 4) = v[i];
  }
  __syncthreads();
  {
    const int nl = t >> 1, kq = t & 1, n = nt * 256 + nl;
    if (n < N) {
      u16* dp = dst + (size_t)n * K + kt * 64 + kq * 32;
#pragma unroll
      for (int q = 0; q < 4; ++q) {
        u32x4 o;
#pragma unroll
        for (int j = 0; j < 4; ++j) o[j] = pack2(sm[(kq * 32 + q * 8 + 2 * j) * 260 + nl], sm[(kq * 32 + q * 8 + 2 * j + 1) * 260 + nl]);
        *(u32x4*)(dp + q * 8) = o;
      }
    }
  }
  __syncthreads();
}

DI void adaln_item(const Params& p, int l, int chunk, float* sm) {
  const float* W = l ? p.l1_ada_w : p.l0_ada_w;
  const float* bias = l ? p.l1_ada_b : p.l0_ada_b;
  float* mod = (float*)(p.ws + OFF_MOD) + (size_t)l * 9 * 6144;
  const int t = TID(), col = chunk * 64 + (t & 63), kg = t >> 6;
  float acc[9];
#pragma unroll
  for (int r = 0; r < 9; ++r) acc[r] = 0.f;
  for (int kh = 0; kh < 2; ++kh) {
    __syncthreads();
    for (int e = t; e < 9 * 1024; e += NT) {
      int r = e >> 10, k = e & 1023;
      float cv = (r == 0) ? p.c_ctx[kh * 1024 + k] : p.c[(r - 1) * 2048 + kh * 1024 + k];
      sm[r * 1024 + k] = silu(cv);
    }
    __syncthreads();
    const float* wp = W + (size_t)(kh * 1024 + kg * 128) * 6144 + col;
    const float* sp = sm + kg * 128;
#pragma unroll 8
    for (int k = 0; k < 128; ++k) {
      float w = wp[(size_t)k * 6144];
#pragma unroll
      for (int r = 0; r < 9; ++r) acc[r] += sp[r * 1024 + k] * w;
    }
  }
  __syncthreads();
#pragma unroll
  for (int r = 0; r < 9; ++r) sm[(kg * 9 + r) * 64 + (t & 63)] = acc[r];
  __syncthreads();
  for (int e = t; e < 9 * 64; e += NT) {
    int r = e >> 6, cc = e & 63;
    float s = 0.f;
#pragma unroll
    for (int g = 0; g < NW; ++g) s += sm[(g * 9 + r) * 64 + cc];
    mod[(size_t)r * 6144 + chunk * 64 + cc] = s + bias[chunk * 64 + cc];
  }
  __syncthreads();
}

DI void convert_item(const float* __restrict__ src, u16* __restrict__ dst, int W, int dstT, int item) {
  size_t e = (size_t)item * 4096 + TID() * 8;
  size_t per_b = (size_t)512 * W;
  size_t b = e / per_b, r = e % per_b;
  float4 v0 = *(const float4*)(src + e), v1 = *(const float4*)(src + e + 4);
  u32x4 o = {pack2(v0.x, v0.y), pack2(v0.z, v0.w), pack2(v1.x, v1.y), pack2(v1.z, v1.w)};
  *(u32x4*)(dst + b * (size_t)dstT * W + r) = o;
}

DI void phase_prep(const Params& p, char* smem) {
  float* sm = (float*)smem;
  char* ws = p.ws;
  constexpr int T_IN0 = 32 * 26, T_OUT0 = 32 * 8, T_IN1 = 32 * 13, T_QB = 8 * 12, T_KVB = 8 * 16, T_OUT1 = 32 * 8;
  constexpr int C_A = 256, C_B = 1024, C_CKV = 512, C_KR = 64;
  constexpr int B1 = 0, B2 = B1 + T_IN0, B3 = B2 + T_OUT0, B4 = B3 + T_IN1, B5 = B4 + T_QB, B6 = B5 + T_KVB, B7 = B6 + T_OUT1;
  constexpr int B8 = B7 + C_A, B9 = B8 + C_A, B10 = B9 + C_B, B11 = B10 + C_B, B12 = B11 + C_CKV, B13 = B12 + C_KR;
  if (blockIdx.x == gridDim.x - 1) {
    float* tab = (float*)(ws + OFF_ROPE);
    for (int e = TID(); e < 64 * 16; e += NT) {
      int pos = e >> 4, i = e & 15;
      float inv = exp2f(-(float)i * (LOG2_THETA / 16.f));
      float sn, cs; sincosf((float)pos * inv, &sn, &cs);
      tab[2 * e] = cs; tab[2 * e + 1] = sn;
    }
    float* tab0 = (float*)(ws + OFF_ROPE0);
    for (int e = TID(); e < 64 * 32; e += NT) {
      int pos = e >> 5, i = e & 31;
      float inv = exp2f(-(float)i * (LOG2_THETA / 32.f));
      float sn, cs; sincosf((float)pos * inv, &sn, &cs);
      tab0[2 * e] = cs; tab0[2 * e + 1] = sn;
    }
  }
  const int nada = (gridDim.x > 128) ? 96 : 0;
  if ((int)blockIdx.x < nada) { adaln_item(p, 0, blockIdx.x, sm); return; }
  if (nada == 0) { for (int c = blockIdx.x; c < 96; c += gridDim.x) adaln_item(p, 0, c, sm); }
  for (int it = blockIdx.x - nada; it < B13; it += gridDim.x - nada) {
    if (it < B2) { int i = it - B1; transpose_tile(p.l0_w_in, 2048, 6656, (u16*)(ws + OFF_WT_IN0), i / 26, i % 26, sm); }
    else if (it < B3) { int i = it - B2; transpose_tile(p.l0_w_out, 2048, 2048, (u16*)(ws + OFF_WT_OUT0), i / 8, i % 8, sm); }
    else if (it < B4) { int i = it - B3; transpose_tile(p.l1_w_in, 2048, 3136, (u16*)(ws + OFF_WT_IN1), i / 13, i % 13, sm); }
    else if (it < B5) { int i = it - B4; transpose_tile(p.l1_wqb, 512, 3072, (u16*)(ws + OFF_WT_QB), i / 12, i % 12, sm); }
    else if (it < B6) { int i = it - B5; transpose_tile(p.l1_wkvb, 512, 4096, (u16*)(ws + OFF_WT_KVB), i / 16, i % 16, sm); }
    else if (it < B7) { int i = it - B6; transpose_tile(p.l1_w_out, 2048, 2048, (u16*)(ws + OFF_WT_OUT1), i / 8, i % 8, sm); }
    else if (it < B8) convert_item(p.ca_k, (u16*)(ws + OFF_KA_ALL), 256, 1536, it - B7);
    else if (it < B9) convert_item(p.ca_v, (u16*)(ws + OFF_VA_ALL), 256, 1536, it - B8);
    else if (it < B10) convert_item(p.cb_k, (u16*)(ws + OFF_KB_CTX), 1024, 512, it - B9);
    else if (it < B11) convert_item(p.cb_v, (u16*)(ws + OFF_VB_CTX), 1024, 512, it - B10);
    else if (it < B12) convert_item(p.c_ckv, (u16*)(ws + OFF_CKV_ALL), 512, 1536, it - B11);
    else convert_item(p.c_kr, (u16*)(ws + OFF_KR_ALL), 64, 1536, it - B12);
  }
}

DI void phase_normmod(const Params& p, int layer) {
  const int wave = TID() >> 6, lane = TID() & 63;
  const float* g = layer ? p.l1_norm : p.l0_norm;
  const float* mod = (const float*)(p.ws + OFF_MOD) + (size_t)layer * 9 * 6144;
  u16* H = (u16*)(p.ws + OFF_H);
  for (int it = blockIdx.x; it < NTOK / NW; it += gridDim.x) {
    int row = it * NW + wave;
    const float* src;
    if (layer == 0) src = row < NCTX ? p.x_prompt + (size_t)row * D : p.x_sample + (size_t)(row - NCTX) * D;
    else src = p.out + OUT_Y + (size_t)row * D;
    const float* mr = mod + (size_t)tok_modrow(row) * 6144;
    float4 v[8];
    float ss = 0.f;
#pragma unroll
    for (int i = 0; i < 8; ++i) {
      v[i] = *(const float4*)(src + (i * 64 + lane) * 4);
      ss += v[i].x * v[i].x + v[i].y * v[i].y + v[i].z * v[i].z + v[i].w * v[i].w;
    }
    ss = wave_sum(ss);
    float rinv = rsqrtf(ss * (1.f / D) + EPS);
#pragma unroll
    for (int i = 0; i < 8; ++i) {
      int col = (i * 64 + lane) * 4;
      float4 gg = *(const float4*)(g + col);
      float4 sh = *(const float4*)(mr + col);
      float4 sc = *(const float4*)(mr + 2048 + col);
      float h0 = v[i].x * rinv * gg.x * (1.f + sc.x) + sh.x;
      float h1 = v[i].y * rinv * gg.y * (1.f + sc.y) + sh.y;
      float h2 = v[i].z * rinv * gg.z * (1.f + sc.z) + sh.z;
      float h3 = v[i].w * rinv * gg.w * (1.f + sc.w) + sh.w;
      *(uint2*)(H + (size_t)row * D + col) = make_uint2(pack2(h0, h1), pack2(h2, h3));
    }
  }
}

DI void phase_normmod1(const Params& p) {
  const int wave = TID() >> 6, lane = TID() & 63;
  const float* g = p.l1_norm;
  const float* mod = (const float*)(p.ws + OFF_MOD) + (size_t)9 * 6144;
  const u16* X1 = (const u16*)(p.out + OUT_Y);
  u16* H = (u16*)(p.ws + OFF_H);
  for (int it = blockIdx.x; it < NTOK / NW; it += gridDim.x) {
    const int row = it * NW + wave;
    const float* mr = mod + (size_t)tok_modrow(row) * 6144;
    u32x4 v[4];
    float ss = 0.f;
#pragma unroll
    for (int i = 0; i < 4; ++i) {
      v[i] = *(const u32x4*)(X1 + (size_t)row * D + (i * 64 + lane) * 8);
#pragma unroll
      for (int j = 0; j < 4; ++j) { const float a0 = bflo(v[i][j]), a1 = bfhi(v[i][j]); ss += a0 * a0 + a1 * a1; }
    }
    ss = wave_sum(ss);
    const float rinv = rsqrtf(ss * (1.f / D) + EPS);
#pragma unroll
    for (int i = 0; i < 4; ++i) {
      const int col = (i * 64 + lane) * 8;
      u32x4 o;
#pragma unroll
      for (int q = 0; q < 2; ++q) {
        const f32x4 gg = *(const f32x4*)(g + col + 4 * q);
        const f32x4 sh = *(const f32x4*)(mr + col + 4 * q);
        const f32x4 sc = *(const f32x4*)(mr + 2048 + col + 4 * q);
        const float x0 = bflo(v[i][2 * q]), x1 = bfhi(v[i][2 * q]), x2 = bflo(v[i][2 * q + 1]), x3 = bfhi(v[i][2 * q + 1]);
        const float h0 = x0 * rinv * gg[0] * (1.f + sc[0]) + sh[0];
        const float h1 = x1 * rinv * gg[1] * (1.f + sc[1]) + sh[1];
        const float h2 = x2 * rinv * gg[2] * (1.f + sc[2]) + sh[2];
        const float h3 = x3 * rinv * gg[3] * (1.f + sc[3]) + sh[3];
        o[2 * q] = pack2(h0, h1); o[2 * q + 1] = pack2(h2, h3);
      }
      *(u32x4*)(H + (size_t)row * D + col) = o;
    }
  }
}

namespace pg8 {
#define PG8_LAS __attribute__((address_space(3)))
typedef unsigned short bf16_t;
typedef short bf16x8 __attribute__((ext_vector_type(8)));
typedef float f32x4 __attribute__((ext_vector_type(4)));
typedef unsigned u32x4 __attribute__((ext_vector_type(4)));
constexpr int BM = 256, BK = 64, HALF = 128, HTB = HALF * BK * 2  , STAGE_BYTES = 8 * HTB, NXCD = 8, WGM = 8;

__host__ __device__ __forceinline__ int lds_byte(int r, int c) { const int st = (r >> 4) * 2 + (c >> 5), rr = r & 15, cc = c & 31, ob = rr * 64 + cc * 2; return st * 1024 + (ob ^ (((ob >> 9) & 1) << 5)); }
__host__ __device__ __forceinline__ void stage_rc(int b, int& R, int& C) { const int st = b / 1024, sb = b % 1024, swz = sb ^ (((sb >> 9) & 1) << 5); R = (st >> 1) * 16 + swz / 64; C = (st & 1) * 32 + (swz % 64) / 2; }
__host__ __device__ __forceinline__ int perm32(int rho) { const int n = rho >> 4, i = rho & 15; return 8 * (i >> 2) + 4 * n + (i & 3); }

struct Unit { int pm, pn; };
struct Gemm { const bf16_t* A; const bf16_t* Bt; int M, N, K, lda; };
struct StaticOrder {
    int nM, nN, nwg, G, c;
    __host__ __device__ void init(int M, int N, int G_, int c_) { nM = M / BM; nN = N / BM; nwg = nM * nN; G = G_; c = c_; }
    __host__ __device__ bool next(int i, Unit& u) const {
        const long L = (long)i * G + c; if (L >= nwg) return false;
        int wgid = (int)L; { const int q = nwg / NXCD, r = nwg % NXCD, xcd = wgid % NXCD, off = wgid / NXCD; wgid = (xcd < r ? xcd * (q + 1) : r * (q + 1) + (xcd - r) * q) + off; }
        const int nig = WGM * nN, gid = wgid / nig, fm = gid * WGM, gsz = (nM - fm) < WGM ? (nM - fm) : WGM;
        u.pm = fm + ((wgid % nig) % gsz); u.pn = (wgid % nig) / gsz; return true;
    }
    __device__ __forceinline__ void a_ready(const Unit&) const {}
    __device__ __forceinline__ void done(const Unit&) const {}
};
template <class Epi, class Sched, bool STAMP = false>
__device__ __forceinline__ void gemm_phase(PG8_LAS unsigned char* lds, const Gemm g, const Sched& S, const Epi& E, unsigned long long* stamps) {
    const int tid = TID(), wid = __builtin_amdgcn_readfirstlane(tid >> 6), lane = tid & 63, wr = wid >> 2, wc = wid & 3, fr = lane & 15, fq = lane >> 4;
    const int K = g.K, nt = K / BK;
    int ts_lo = 0, ts_hi = 0, nts = 0; const unsigned long long rt_entry = STAMP ? (unsigned long long)wall_clock64() : 0ull;
#define PG8_STAMP() do { if (STAMP && wid == 0 && nts < 64) { const unsigned long long _c = (unsigned long long)clock64(); \
        ts_lo = (lane == nts) ? (int)(unsigned)_c : ts_lo; ts_hi = (lane == nts) ? (int)(unsigned)(_c >> 32) : ts_hi; ++nts; } } while (0)
    PG8_STAMP();
    unsigned voffA[2], voffB[2];
#pragma unroll
    for (int i = 0; i < 2; ++i) { int R, C; stage_rc(tid * 16 + i * 8192, R, C); const int Rb = Epi::PERM ? ((R & ~31) + perm32(R & 31)) : R;
        voffA[i] = (unsigned)(R * g.lda + C) * 2u; voffB[i] = (unsigned)(Rb * K + C) * 2u; }
    const size_t kstep = (size_t)(BK * 2);
    const size_t hstepB = (size_t)HALF * K * 2, hstepA = (size_t)HALF * g.lda * 2;
    const size_t tstepB = 2 * hstepB, tstepA = 2 * hstepA;
    const unsigned ldsw = (unsigned)wid * 1024u;
    const int aoff = lds_byte(wr * 64 + fr, fq * 8), boff = lds_byte(wc * 32 + fr, fq * 8);
#define PG8_SA(b, h) (((b) * 2 + (h)) * HTB)
#define PG8_SB(b, h) ((4 + (b) * 2 + (h)) * HTB)
#define PG8_STAGE(bufoff, gbase, voff) do { _Pragma("unroll") for (int _i = 0; _i < 2; ++_i) \
        __builtin_amdgcn_global_load_lds((const unsigned*)((const char*)(gbase) + (voff)[_i]), (PG8_LAS unsigned*)(lds + (bufoff) + ldsw + _i * 8192), 16, 0, 0); } while (0)
#define PG8_LDA(dst, b, h) do { _Pragma("unroll") for (int m = 0; m < 4; ++m) _Pragma("unroll") for (int k = 0; k < 2; ++k) dst[m][k] = *(const PG8_LAS bf16x8*)(lds + PG8_SA(b, h) + aoff + m * 2048 + k * 1024); } while (0)
#define PG8_LDB(dst, b, h) do { _Pragma("unroll") for (int n = 0; n < 2; ++n) _Pragma("unroll") for (int k = 0; k < 2; ++k) dst[n][k] = *(const PG8_LAS bf16x8*)(lds + PG8_SB(b, h) + boff + n * 2048 + k * 1024); } while (0)
#define PG8_MMA(ai, bj, At, Bt) do { __builtin_amdgcn_s_setprio(1); _Pragma("unroll") for (int m = 0; m < 4; ++m) _Pragma("unroll") for (int n = 0; n < 2; ++n) _Pragma("unroll") for (int k = 0; k < 2; ++k) \
        acc[ai][bj][m][n] = __builtin_amdgcn_mfma_f32_16x16x32_bf16(Bt[n][k], At[m][k], acc[ai][bj][m][n], 0, 0, 0); __builtin_amdgcn_s_setprio(0); } while (0)
#define PG8_WAIT_V(n) asm volatile("s_waitcnt vmcnt(" #n ")" ::: "memory")
#define PG8_WAIT_L(n) asm volatile("s_waitcnt lgkmcnt(" #n ")" ::: "memory")
#define PG8_BAR __builtin_amdgcn_s_barrier()
#define PG8_SCHED __builtin_amdgcn_sched_barrier(0)
    Unit cur, nxt; int ui = 0;
    if (!S.next(0, cur)) return;
    f32x4 acc[2][2][4][2];
#pragma unroll
    for (int a = 0; a < 2; ++a)
#pragma unroll
        for (int b = 0; b < 2; ++b)
#pragma unroll
            for (int m = 0; m < 4; ++m)
#pragma unroll
                for (int n = 0; n < 2; ++n) acc[a][b][m][n] = (f32x4){0.f, 0.f, 0.f, 0.f};
    bf16x8 At[4][2], B0[2][2], B1[2][2];
    const char* cA = (const char*)g.A + (size_t)cur.pm * tstepA; const char* cB = (const char*)g.Bt + (size_t)cur.pn * tstepB;
    S.a_ready(cur);
    PG8_STAGE(PG8_SB(0, 0), cB, voffB); PG8_STAGE(PG8_SA(0, 0), cA, voffA); PG8_STAGE(PG8_SB(0, 1), cB + hstepB, voffB); PG8_STAGE(PG8_SA(0, 1), cA + hstepA, voffA);
    if (wr == 1) PG8_BAR;
    PG8_WAIT_V(4); PG8_BAR;
    PG8_STAGE(PG8_SB(1, 0), cB + kstep, voffB); PG8_STAGE(PG8_SA(1, 0), cA + kstep, voffA); PG8_STAGE(PG8_SB(1, 1), cB + hstepB + kstep, voffB);
    PG8_WAIT_V(6); PG8_BAR;
    PG8_STAMP();
    for (;;) {
        const bool has_next = S.next(ui + 1, nxt);
        const char* nA = has_next ? (const char*)g.A + (size_t)nxt.pm * tstepA : cA; const char* nB = has_next ? (const char*)g.Bt + (size_t)nxt.pn * tstepB : cB;
        for (int t = 0; t < nt; t += 2) {
            const bool last = (t == nt - 2);
            const char* a1 = cA + (size_t)(t + 1) * kstep;
            const char* a2 = last ? nA : cA + (size_t)(t + 2) * kstep; const char* b2 = last ? nB : cB + (size_t)(t + 2) * kstep;
            const char* a3 = a2 + kstep; const char* b3 = b2 + kstep;
            if (last && has_next) S.a_ready(nxt);
            PG8_LDB(B0, 0, 0); PG8_SCHED; PG8_LDA(At, 0, 0); PG8_STAGE(PG8_SA(1, 1), a1 + hstepA, voffA);
            PG8_WAIT_L(8); PG8_BAR; PG8_WAIT_L(0); PG8_MMA(0, 0, At, B0); PG8_BAR; PG8_SCHED;
            PG8_LDB(B1, 0, 1); PG8_STAGE(PG8_SB(0, 0), b2, voffB);
            PG8_BAR; PG8_WAIT_L(0); PG8_MMA(0, 1, At, B1); PG8_BAR;
            PG8_LDA(At, 0, 1); PG8_STAGE(PG8_SA(0, 0), a2, voffA);
            PG8_BAR; PG8_WAIT_L(0); PG8_MMA(1, 0, At, B0); PG8_BAR; PG8_SCHED;
            PG8_STAGE(PG8_SB(0, 1), b2 + hstepB, voffB);
            PG8_WAIT_V(6); PG8_BAR; PG8_MMA(1, 1, At, B1); PG8_BAR;
            PG8_LDB(B0, 1, 0); PG8_SCHED; PG8_LDA(At, 1, 0); PG8_STAGE(PG8_SA(0, 1), a2 + hstepA, voffA);
            PG8_WAIT_L(8); PG8_BAR; PG8_WAIT_L(0); PG8_MMA(0, 0, At, B0); PG8_BAR; PG8_SCHED;
            PG8_LDB(B1, 1, 1); PG8_STAGE(PG8_SB(1, 0), b3, voffB);
            PG8_BAR; PG8_WAIT_L(0); PG8_MMA(0, 1, At, B1); PG8_BAR;
            PG8_LDA(At, 1, 1); PG8_STAGE(PG8_SA(1, 0), a3, voffA);
            PG8_BAR; PG8_WAIT_L(0); PG8_MMA(1, 0, At, B0); PG8_BAR; PG8_SCHED;
            PG8_STAGE(PG8_SB(1, 1), b3 + hstepB, voffB);
            PG8_WAIT_V(6); PG8_BAR; PG8_MMA(1, 1, At, B1); PG8_BAR;
        }
        PG8_STAMP();
        if constexpr (!Epi::AFTER_DRAIN) { E(acc, cur, wr, wc, fr, fq); S.done(cur); }
        PG8_STAMP();
        if (!has_next) break;
#pragma unroll
        for (int a = 0; a < 2; ++a)
#pragma unroll
            for (int b = 0; b < 2; ++b)
#pragma unroll
                for (int m = 0; m < 4; ++m)
#pragma unroll
                    for (int n = 0; n < 2; ++n) acc[a][b][m][n] = (f32x4){0.f, 0.f, 0.f, 0.f};
        cur = nxt; cA = nA; cB = nB; ++ui;
    }
    PG8_WAIT_V(0);
    if (wr == 0) PG8_BAR;
    PG8_BAR;
    if constexpr (Epi::AFTER_DRAIN) { E.fused(acc, cur, wr, wc, fr, fq, lds, wid, lane); S.done(cur); }
    PG8_STAMP();
    if (STAMP && wid == 0) { stamps[lane] = lane < nts ? (((unsigned long long)(unsigned)ts_hi << 32) | (unsigned)ts_lo) : 0ull;
        if (lane == 62) stamps[62] = rt_entry; if (lane == 63) stamps[63] = (unsigned long long)wall_clock64(); }
#undef PG8_STAMP
#undef PG8_SA
#undef PG8_SB
#undef PG8_STAGE
#undef PG8_LDA
#undef PG8_LDB
#undef PG8_MMA
#undef PG8_WAIT_V
#undef PG8_WAIT_L
#undef PG8_BAR
#undef PG8_SCHED
}
}


struct EpiBf16 {
  static constexpr bool PERM = true, AFTER_DRAIN = false;
  u16* O; int ldc;
  DI void operator()(const f32x4 (&acc)[2][2][4][2], const pg8::Unit& u, int wr, int wc, int fr, int fq) const {
    const int row0 = u.pm * 256 + wr * 64 + fr, col0 = u.pn * 256 + wc * 32 + 8 * fq;
#pragma unroll
    for (int ai = 0; ai < 2; ++ai)
#pragma unroll
      for (int m = 0; m < 4; ++m) {
        u16* rowp = O + (size_t)(row0 + ai * 128 + m * 16) * ldc + col0;
#pragma unroll
        for (int bj = 0; bj < 2; ++bj) {
          f32x4 v0 = acc[ai][bj][m][0], v1 = acc[ai][bj][m][1];
          u32x4 w = {pack2(v0[0], v0[1]), pack2(v0[2], v0[3]), pack2(v1[0], v1[1]), pack2(v1[2], v1[3])};
          *(u32x4*)(rowp + bj * 128) = w;
        }
      }
  }
};
struct EpiResid {
  static constexpr bool PERM = false, AFTER_DRAIN = false;
  const float* xa; const float* xb; const float* gate; float* out;
  DI void operator()(const f32x4 (&acc)[2][2][4][2], const pg8::Unit& u, int wr, int wc, int fr, int fq) const {
    const int row0 = u.pm * 256 + wr * 64 + fr, col0 = u.pn * 256 + wc * 32 + 4 * fq;
#pragma unroll
    for (int ai = 0; ai < 2; ++ai)
#pragma unroll
      for (int m = 0; m < 4; ++m) {
        const int row = row0 + ai * 128 + m * 16;
        const float* xr = (row < NCTX) ? xa + (size_t)row * D : xb + (size_t)(row - NCTX) * D;
        const float* gr = gate + (size_t)tok_modrow(row) * 6144;
        float* orow = out + (size_t)row * D;
#pragma unroll
        for (int bj = 0; bj < 2; ++bj)
#pragma unroll
          for (int n = 0; n < 2; ++n) {
            const int col = col0 + bj * 128 + n * 16;
            f32x4 xv = *(const f32x4*)(xr + col);
            f32x4 gv = *(const f32x4*)(gr + col);
            *(f32x4*)(orow + col) = xv + gv * acc[ai][bj][m][n];
          }
      }
  }
};

template <bool XBF> struct EpiResidB {
  static constexpr bool PERM = true, AFTER_DRAIN = false;
  const void* xa; const void* xb; const float* gate; u16* out;
  DI void operator()(const f32x4 (&acc)[2][2][4][2], const pg8::Unit& u, int wr, int wc, int fr, int fq) const {
    const int row0 = u.pm * 256 + wr * 64 + fr, col0 = u.pn * 256 + wc * 32 + 8 * fq;
#pragma unroll
    for (int ai = 0; ai < 2; ++ai)
#pragma unroll
      for (int m = 0; m < 4; ++m) {
        const int row = row0 + ai * 128 + m * 16;
        const float* gr = gate + (size_t)tok_modrow(row) * 6144;
        u16* orow = out + (size_t)row * D;
#pragma unroll
        for (int bj = 0; bj < 2; ++bj) {
          const int col = col0 + bj * 128;
          f32x4 x0, x1;
          if constexpr (XBF) {
            const u32x4 xv = *(const u32x4*)((const u16*)xa + (size_t)row * D + col);
            x0 = (f32x4){bflo(xv[0]), bfhi(xv[0]), bflo(xv[1]), bfhi(xv[1])};
            x1 = (f32x4){bflo(xv[2]), bfhi(xv[2]), bflo(xv[3]), bfhi(xv[3])};
          } else {
            const float* xr = (row < NCTX) ? (const float*)xa + (size_t)row * D : (const float*)xb + (size_t)(row - NCTX) * D;
            x0 = *(const f32x4*)(xr + col); x1 = *(const f32x4*)(xr + col + 4);
          }
          const f32x4 g0 = *(const f32x4*)(gr + col), g1 = *(const f32x4*)(gr + col + 4);
          const f32x4 o0 = x0 + g0 * acc[ai][bj][m][0], o1 = x1 + g1 * acc[ai][bj][m][1];
          u32x4 w = {pack2(o0[0], o0[1]), pack2(o0[2], o0[3]), pack2(o1[0], o1[1]), pack2(o1[2], o1[3])};
          *(u32x4*)(orow + col) = w;
        }
      }
  }
};

template <class Epi>
DI void gemm_run(PG8_LAS unsigned char* lds, const u16* A, int lda, const u16* Bt, int M, int N, int K, const Epi& e) {
  pg8::Gemm g{A, Bt, M, N, K, lda};
  pg8::StaticOrder S; S.init(M, N, (int)gridDim.x, (int)blockIdx.x);
#pragma unroll 1
  for (int rep = 0; rep < (Epi::PERM ? REP_G : 1); ++rep) {
    __syncthreads();
    pg8::gemm_phase<Epi, pg8::StaticOrder, false>(lds, g, S, e, nullptr);
    __syncthreads();
  }
}

DI void phase_qknorm0(const Params& p) {
  const int t = TID(), wave = t >> 6, lane = t & 63, l15 = lane & 15;
  u16* QKVG = (u16*)(p.ws + OFF_BIG);
  u16* KA = (u16*)(p.ws + OFF_KA_ALL);
  u16* VA = (u16*)(p.ws + OFF_VA_ALL);
  const float* tab = (const float*)(p.ws + OFF_ROPE0);
  float gq[8], gk[8];
#pragma unroll
  for (int j = 0; j < 8; ++j) { gq[j] = p.l0_qn[l15 * 8 + j]; gk[j] = p.l0_kn[l15 * 8 + j]; }
  const bool hi = (l15 & 4) != 0;
  const bool colrot = l15 >= 8;
  const int f0 = (l15 & 3) * 8;
  for (int it = blockIdx.x; it < NTOK / NW; it += gridDim.x) {
    const int tk = it * NW + wave;
    u16* base = QKVG + (size_t)tk * L0_IN;
    const bool lat = tk >= NCTX;
    const int lt = tk - NCTX, b = lt >> 10, tt = lt & 1023;
    u32x4 v[3];
#pragma unroll
    for (int ps = 0; ps < 3; ++ps) v[ps] = *(const u32x4*)(base + (ps * 64 + lane) * 8);
    u32x4 kb[2], vb[2];
    if (!lat) {
#pragma unroll
      for (int q = 0; q < 2; ++q) { kb[q] = *(const u32x4*)(base + 2560 + (q * 64 + lane) * 8); vb[q] = *(const u32x4*)(base + 3584 + (q * 64 + lane) * 8); }
    }
    float cs[8], sn[8];
    if (lat) {
      const int pos = colrot ? (tt & 63) : (tt >> 6);
      const float4* tp = (const float4*)(tab + (pos * 32 + f0) * 2);
#pragma unroll
      for (int j2 = 0; j2 < 4; ++j2) { float4 c = tp[j2]; cs[2 * j2] = c.x; sn[2 * j2] = c.y; cs[2 * j2 + 1] = c.z; sn[2 * j2 + 1] = c.w; }
    } else {
#pragma unroll
      for (int j = 0; j < 8; ++j) { cs[j] = 1.f; sn[j] = 0.f; }
    }
    const size_t arow = (size_t)b * 1536 + 512 + tt;
#pragma unroll
    for (int ps = 0; ps < 3; ++ps) {
      float x[8];
#pragma unroll
      for (int j = 0; j < 4; ++j) { x[2 * j] = bflo(v[ps][j]); x[2 * j + 1] = bfhi(v[ps][j]); }
      float ss = 0.f;
#pragma unroll
      for (int j = 0; j < 8; ++j) ss += x[j] * x[j];
      ss += __shfl_xor(ss, 8); ss += __shfl_xor(ss, 4); ss += __shfl_xor(ss, 2); ss += __shfl_xor(ss, 1);
      const float rinv = rsqrtf(ss * (1.f / 128.f) + EPS);
      float o[8];
#pragma unroll
      for (int j = 0; j < 8; ++j) {
        const float y = x[j] * rinv * (ps < 2 ? gq[j] : gk[j]);
        const float pr = __shfl_xor(y, 4);
        o[j] = hi ? (y * cs[j] + pr * sn[j]) : (y * cs[j] - pr * sn[j]);
      }
      if (ps < 2) {
        u32x4 w = {pack2(o[0], o[1]), pack2(o[2], o[3]), pack2(o[4], o[5]), pack2(o[6], o[7])};
        *(u32x4*)(base + (ps * 64 + lane) * 8) = w;
      } else if (lane < 32) {
        u32x4 w = {pack2(o[0], o[1]), pack2(o[2], o[3]), pack2(o[4], o[5]), pack2(o[6], o[7])};
        if (!lat) {
          *(u32x4*)(base + 1024 + lane * 8) = w;
          float* op = p.out + OUT_NAK + (size_t)tk * 256 + lane * 8;
          *(float4*)op = make_float4(o[0], o[1], o[2], o[3]);
          *(float4*)(op + 4) = make_float4(o[4], o[5], o[6], o[7]);
        } else *(u32x4*)(KA + arow * 256 + lane * 8) = w;
      } else {
        if (!lat) {
          float* op = p.out + OUT_NAV + (size_t)tk * 256 + (lane - 32) * 8;
          *(float4*)op = make_float4(x[0], x[1], x[2], x[3]);
          *(float4*)(op + 4) = make_float4(x[4], x[5], x[6], x[7]);
        } else *(u32x4*)(VA + arow * 256 + (lane - 32) * 8) = v[2];
      }
    }
    if (!lat) {
#pragma unroll
      for (int q = 0; q < 2; ++q) {
        float* ok = p.out + OUT_NBK + (size_t)tk * 1024 + (q * 64 + lane) * 8;
        float* ov = p.out + OUT_NBV + (size_t)tk * 1024 + (q * 64 + lane) * 8;
        *(float4*)ok = make_float4(bflo(kb[q][0]), bfhi(kb[q][0]), bflo(kb[q][1]), bfhi(kb[q][1]));
        *(float4*)(ok + 4) = make_float4(bflo(kb[q][2]), bfhi(kb[q][2]), bflo(kb[q][3]), bfhi(kb[q][3]));
        *(float4*)ov = make_float4(bflo(vb[q][0]), bfhi(vb[q][0]), bflo(vb[q][1]), bfhi(vb[q][1]));
        *(float4*)(ov + 4) = make_float4(bflo(vb[q][2]), bfhi(vb[q][2]), bflo(vb[q][3]), bfhi(vb[q][3]));
      }
    }
  }
}

DI void phase_norm1(const Params& p) {
  const int wave = TID() >> 6, lane = TID() & 63;
  const u16* LAT1 = (const u16*)(p.ws + OFF_LAT1);
  u16* QN = (u16*)(p.ws + OFF_QN);
  u16* CKVC = (u16*)(p.ws + OFF_CKV_CTX);
  u16* KRC = (u16*)(p.ws + OFF_KR_CTX);
  u16* CKVA = (u16*)(p.ws + OFF_CKV_ALL);
  u16* KRA = (u16*)(p.ws + OFF_KR_ALL);
  float gq[8], gk[8];
#pragma unroll
  for (int j = 0; j < 8; ++j) { gq[j] = p.l1_qan[lane * 8 + j]; gk[j] = p.l1_kvan[lane * 8 + j]; }
  const int ri = lane & 15, rhalf = (lane >> 4) & 1;
  const int rd1 = rhalf * 32 + ri, rd2 = rd1 + 16;
  const float inv = exp2f(-(float)ri * (LOG2_THETA / 16.f));
  for (int it = blockIdx.x; it < NTOK / NW; it += gridDim.x) {
    int tk = it * NW + wave;
    const u16* base = LAT1 + (size_t)tk * L1_LD;
    const bool lat = tk >= NCTX;
    int lt = tk - NCTX, b = lt >> 10, tt = lt & 1023;
    size_t arow = (size_t)b * 1536 + 512 + tt;
#pragma unroll
    for (int part = 0; part < 2; ++part) {
      uint4 v = *(const uint4*)(base + part * 512 + lane * 8);
      float x[8] = {bflo(v.x), bfhi(v.x), bflo(v.y), bfhi(v.y), bflo(v.z), bfhi(v.z), bflo(v.w), bfhi(v.w)};
      float ss = 0.f;
#pragma unroll
      for (int j = 0; j < 8; ++j) ss += x[j] * x[j];
      ss = wave_sum(ss);
      float rinv = rsqrtf(ss * (1.f / 512.f) + EPS);
#pragma unroll
      for (int j = 0; j < 8; ++j) x[j] = x[j] * rinv * (part ? gk[j] : gq[j]);
      uint4 o = make_uint4(pack2(x[0], x[1]), pack2(x[2], x[3]), pack2(x[4], x[5]), pack2(x[6], x[7]));
      if (part == 0) *(uint4*)(QN + (size_t)tk * 512 + lane * 8) = o;
      else if (!lat) {
        *(uint4*)(CKVC + (size_t)tk * 512 + lane * 8) = o;
        float* op = p.out + OUT_NCKV + (size_t)tk * 512 + lane * 8;
        *(float4*)op = make_float4(x[0], x[1], x[2], x[3]);
        *(float4*)(op + 4) = make_float4(x[4], x[5], x[6], x[7]);
      } else *(uint4*)(CKVA + arow * 512 + lane * 8) = o;
    }
    if (lane < 32) {
      float x1 = bf2f(base[1024 + rd1]), x2 = bf2f(base[1024 + rd2]);
      if (!lat) {
        KRC[(size_t)tk * 64 + rd1] = f2bf(x1); KRC[(size_t)tk * 64 + rd2] = f2bf(x2);
        p.out[OUT_NKR + (size_t)tk * 64 + rd1] = x1; p.out[OUT_NKR + (size_t)tk * 64 + rd2] = x2;
      } else {
        float pos = rhalf ? (float)(tt & 63) : (float)(tt >> 6);
        float sn, cs; sincosf(pos * inv, &sn, &cs);
        KRA[arow * 64 + rd1] = f2bf(x1 * cs - x2 * sn);
        KRA[arow * 64 + rd2] = f2bf(x2 * cs + x1 * sn);
      }
    }
  }
}

DI void phase_final(const Params& p) {
  const int wave = TID() >> 6, lane = TID() & 63;
  const u16* X2 = (const u16*)(p.ws + OFF_Q1);
  for (int it = blockIdx.x; it < NTOK / NW; it += gridDim.x) {
    const int row = it * NW + wave;
    float* y = p.out + OUT_Y + (size_t)row * D;
    u32x4 v[4];
    float ss = 0.f;
#pragma unroll
    for (int i = 0; i < 4; ++i) {
      v[i] = *(const u32x4*)(X2 + (size_t)row * D + (i * 64 + lane) * 8);
#pragma unroll
      for (int j = 0; j < 4; ++j) { const float a0 = bflo(v[i][j]), a1 = bfhi(v[i][j]); ss += a0 * a0 + a1 * a1; }
    }
    ss = wave_sum(ss);
    const float rinv = rsqrtf(ss * (1.f / D) + EPS);
#pragma unroll
    for (int i = 0; i < 4; ++i) {
      const int col = (i * 64 + lane) * 8;
#pragma unroll
      for (int q = 0; q < 2; ++q) {
        const f32x4 gg = *(const f32x4*)(p.fnorm + col + 4 * q);
        f32x4 o = {bflo(v[i][2 * q]) * rinv * gg[0], bfhi(v[i][2 * q]) * rinv * gg[1], bflo(v[i][2 * q + 1]) * rinv * gg[2], bfhi(v[i][2 * q + 1]) * rinv * gg[3]};
        *(f32x4*)(y + col + 4 * q) = o;
      }
    }
  }
}

struct KVSeg { const u16* k; const u16* v; const u16* kr; int ks, vs, n; };
struct AttnArgs {
  const u16* q; int qs;
  KVSeg seg[2]; int nseg;
  const u16* gate; int gs;
  u16* out; int os;
  float scale_log2;
  const float* rpb;
  int qtok0;
  int rs0;
  int rope;
  const float* ropetab;
};

DI float xhalf_max(float v) {
  unsigned u = __float_as_uint(v);
  auto r = __builtin_amdgcn_permlane32_swap(u, u, false, false);
  return fmaxf(__uint_as_float(r[0]), __uint_as_float(r[1]));
}
DI int swz16(int r) { return ((r & 3) << 2) | ((r >> 2) & 3); }

template <int DQK, int MODE>
DI void attn_issue_tile(const AttnArgs& a, int tile, int nt0, LDS_AS(unsigned char)* slot, int wave, int lane) {
  const int sg = tile >= nt0 ? 1 : 0;
  const int off = (sg ? tile - nt0 : tile) * 64;
  const u16* kp = sg ? a.seg[1].k : a.seg[0].k;
  const u16* vp = sg ? a.seg[1].v : a.seg[0].v;
  const int ks = sg ? a.seg[1].ks : a.seg[0].ks;
  const int vs = sg ? a.seg[1].vs : a.seg[0].vs;
  const int sw = ((lane >> 4) << 2) | (wave & 3);
  const int ch = (lane & 15) ^ sw;
#pragma unroll
  for (int j = 0; j < 2; ++j) {
    const int row = off + (j * 8 + wave) * 4 + (lane >> 4);
    __builtin_amdgcn_global_load_lds((const unsigned*)(kp + (unsigned)(row * ks + ch * 8)), (LDS_AS(unsigned)*)(slot + (j * 8 + wave) * 1024), 16, 0, 0);
    __builtin_amdgcn_global_load_lds((const unsigned*)(vp + (unsigned)(row * vs + ch * 8)), (LDS_AS(unsigned)*)(slot + 16384 + (j * 8 + wave) * 1024), 16, 0, 0);
  }
  if constexpr (MODE == 2) {
    const u16* krp = sg ? a.seg[1].kr : a.seg[0].kr;
    const int row = wave * 8 + (lane >> 3);
    const int c2 = (lane & 7) ^ ((row >> 1) & 7);
    __builtin_amdgcn_global_load_lds((const unsigned*)(krp + (unsigned)((off + row) * 64 + c2 * 8)), (LDS_AS(unsigned)*)(slot + 32768 + wave * 1024), 16, 0, 0);
  }
}

template <int DQK, int MODE>
DI void attn_block(const AttnArgs& a, LDS_AS(unsigned char)* lds) {
  constexpr int NS = DQK / 16;
  constexpr int SLOTB = (MODE == 2) ? 40960 : 32768;
  constexpr int NLOAD = (MODE == 2) ? 5 : 4;
  LDS_AS(float)* bias_s = (LDS_AS(float)*)(lds + 3 * SLOTB);
  const int t = TID(), wave = __builtin_amdgcn_readfirstlane(t >> 6), lane = t & 63, l31 = lane & 31, h = lane >> 5;

  __syncthreads();
  if constexpr (MODE == 1) {
    for (int e = t; e < 15 * 31; e += NT) bias_s[e] = a.rpb[e] * LOG2E;
    __syncthreads();
  }
  int ntiles = 0;
  for (int s = 0; s < a.nseg; ++s) ntiles += a.seg[s].n >> 6;
  const int nt0 = a.seg[0].n >> 6;
  bf16x8 qf[NS];
  {
    const u16* qp = a.q + (size_t)(wave * 32 + l31) * a.qs + 8 * h;
#pragma unroll
    for (int s = 0; s < NS; ++s) qf[s] = *(const bf16x8*)(qp + 16 * s);
  }
  attn_issue_tile<DQK, MODE>(a, 0, nt0, lds, wave, lane);
  attn_issue_tile<DQK, MODE>(a, ntiles > 1 ? 1 : 0, nt0, lds + SLOTB, wave, lane);
  const int qtok = a.qtok0 + wave * 32 + l31;
  if constexpr (MODE == 2) {
    if (a.rope) {
      const int qr = qtok >> 6, qc = qtok & 63;
#pragma unroll
      for (int pr = 0; pr < 2; ++pr) {
        const float4* tb = (const float4*)(a.ropetab + ((pr ? qc : qr) * 16 + 8 * h) * 2);
#pragma unroll
        for (int j2 = 0; j2 < 4; ++j2) {
          float4 cssn = tb[j2];
#pragma unroll
          for (int e = 0; e < 2; ++e) {
            const int j = 2 * j2 + e;
            float cs = e ? cssn.z : cssn.x, sn = e ? cssn.w : cssn.y;
            float x1 = bf2f((u16)qf[8 + 2 * pr][j]), x2 = bf2f((u16)qf[9 + 2 * pr][j]);
            qf[8 + 2 * pr][j] = (short)f2bf(x1 * cs - x2 * sn);
            qf[9 + 2 * pr][j] = (short)f2bf(x2 * cs + x1 * sn);
          }
        }
      }
    }
  }
  f32x16 acc[4];
#pragma unroll
  for (int c = 0; c < 4; ++c)
#pragma unroll
    for (int r = 0; r < 16; ++r) acc[c][r] = 0.f;
  float m_run = -1e30f, l_run = 0.f;

  const int blk = (lane >> 4) & 1, tq = (lane & 15) >> 2, tp = lane & 3;
  const int kswz = swz16(l31);
  const int kb0 = l31 * 256 + ((h ^ (kswz & 1)) << 4);
  const int ksw = kswz >> 1;
  const int kr0 = 32768 + l31 * 128;
  const int krsw = (l31 >> 1) & 7;
  const int vlow0 = (2 * blk + (tp >> 1)) ^ (h & 3);
  const int vlow1 = (2 * blk + (tp >> 1)) ^ ((2 + h) & 3);
  const int vb0 = 16384 + (4 * h + tq) * 256 + (vlow0 << 4) + 8 * (tp & 1);
  const int vb1 = 16384 + (8 + 4 * h + tq) * 256 + (vlow1 << 4) + 8 * (tp & 1);
  const int qrow = qtok >> 6, qcol = qtok & 63;
  int q_rs = qrow - 4; q_rs = q_rs < 0 ? 0 : (q_rs > 8 ? 8 : q_rs);
  int q_cs = qcol - 8; q_cs = q_cs < 0 ? 0 : (q_cs > 48 ? 48 : q_cs);

  int sl = 0;
  for (int tile = 0; tile < ntiles; ++tile) {
    if constexpr (NLOAD == 5) asm volatile("s_waitcnt vmcnt(5)" ::: "memory"); else asm volatile("s_waitcnt vmcnt(4)" ::: "memory");
    __builtin_amdgcn_s_barrier();
    asm volatile("" ::: "memory");
    {
      int nx = tile + 2; nx = nx < ntiles ? nx : ntiles - 1;
      int sn = sl + 2; sn = sn >= 3 ? sn - 3 : sn;
      attn_issue_tile<DQK, MODE>(a, nx, nt0, lds + sn * SLOTB, wave, lane);
    }
    LDS_AS(unsigned char)* slot = lds + sl * SLOTB;
    sl = sl == 2 ? 0 : sl + 1;

    const bool local = (MODE == 1) && (tile >= nt0);
    const int krow = a.rs0 + (tile - nt0);
#pragma unroll 1
    for (int mt = 0; mt < 2; ++mt) {
      f32x16 S;
#pragma unroll
      for (int r = 0; r < 16; ++r) S[r] = 0.f;
      LDS_AS(unsigned char)* kbase = slot + mt * 8192 + kb0;
#pragma unroll
      for (int s = 0; s < 8; ++s) {
        bf16x8 kf = *(const LDS_AS(bf16x8)*)(kbase + ((s ^ ksw) << 5));
        S = MFMA32(kf, qf[s], S);
      }
      if constexpr (MODE == 2) {
        LDS_AS(unsigned char)* rbase = slot + mt * 4096 + kr0;
#pragma unroll
        for (int s2 = 0; s2 < 4; ++s2) {
          bf16x8 kf = *(const LDS_AS(bf16x8)*)(rbase + (((2 * s2 + h) ^ krsw) << 4));
          S = MFMA32(kf, qf[8 + s2], S);
        }
      }
      float mx = -1e30f;
      float m_new, alpha;
      float ps = 0.f;
      const float m_old = m_run;
      if constexpr (MODE == 1) {
#pragma unroll
        for (int r = 0; r < 16; ++r) {
          float sv = S[r] * a.scale_log2;
          if (local) {
            int kcol = mt * 32 + crow(r, h);
            bool ok = (krow >= q_rs) && (krow < q_rs + 8) && (kcol >= q_cs) && (kcol < q_cs + 16);
            int dy = krow - qrow + 7, dx = kcol - qcol + 15;
            dy = dy < 0 ? 0 : (dy > 14 ? 14 : dy);
            dx = dx < 0 ? 0 : (dx > 30 ? 30 : dx);
            const float bv = bias_s[dy * 31 + dx];
            sv = ok ? sv + bv : -1e30f;
          }
          S[r] = sv;
          mx = fmaxf(mx, sv);
        }
        mx = xhalf_max(mx);
        m_new = fmaxf(m_run, mx);
        alpha = __builtin_amdgcn_exp2f(m_run - m_new);
        m_run = m_new;
#pragma unroll
        for (int r = 0; r < 16; ++r) {
          float pv = __builtin_amdgcn_exp2f(S[r] - m_new);
          if (S[r] <= -1e29f) pv = 0.f;
          S[r] = pv;
          ps += pv;
        }
      } else {
#pragma unroll
        for (int r = 0; r < 16; ++r) mx = fmaxf(mx, S[r]);
        mx = xhalf_max(mx) * a.scale_log2;
        m_new = fmaxf(m_run, mx);
        alpha = __builtin_amdgcn_exp2f(m_run - m_new);
        m_run = m_new;
        const float nm = -m_new;
#pragma unroll
        for (int r = 0; r < 16; ++r) {
          float pv = __builtin_amdgcn_exp2f(__builtin_fmaf(S[r], a.scale_log2, nm));
          S[r] = pv;
          ps += pv;
        }
      }
      l_run = l_run * alpha + ps;
      if (__builtin_amdgcn_ballot_w64(m_new != m_old) != 0) {
#pragma unroll
        for (int c = 0; c < 4; ++c)
#pragma unroll
          for (int r = 0; r < 16; ++r) acc[c][r] *= alpha;
      }
      bf16x8 pf[2];
#pragma unroll
      for (int s2 = 0; s2 < 2; ++s2) {
        u32x4 u;
        u[0] = pack2(S[8 * s2 + 0], S[8 * s2 + 1]);
        u[1] = pack2(S[8 * s2 + 2], S[8 * s2 + 3]);
        u[2] = pack2(S[8 * s2 + 4], S[8 * s2 + 5]);
        u[3] = pack2(S[8 * s2 + 6], S[8 * s2 + 7]);
        pf[s2] = __builtin_bit_cast(bf16x8, u);
      }
      const unsigned vaddr = (unsigned)(size_t)(slot + mt * 8192);
#pragma unroll
      for (int c0 = 0; c0 < 4; c0 += 2) {
        const unsigned a0 = vaddr + vb0 + ((c0 ^ tq) << 6), a1 = vaddr + vb1 + ((c0 ^ tq) << 6);
        const unsigned a2 = vaddr + vb0 + (((c0 + 1) ^ tq) << 6), a3 = vaddr + vb1 + (((c0 + 1) ^ tq) << 6);
        s16x4 r0, r1, r2, r3, r4, r5, r6, r7;
        asm volatile(
            "ds_read_b64_tr_b16 %0, %8\n\t"
            "ds_read_b64_tr_b16 %1, %9\n\t"
            "ds_read_b64_tr_b16 %2, %8 offset:4096\n\t"
            "ds_read_b64_tr_b16 %3, %9 offset:4096\n\t"
            "ds_read_b64_tr_b16 %4, %10\n\t"
            "ds_read_b64_tr_b16 %5, %11\n\t"
            "ds_read_b64_tr_b16 %6, %10 offset:4096\n\t"
            "ds_read_b64_tr_b16 %7, %11 offset:4096\n\t"
            "s_waitcnt lgkmcnt(0)"
            : "=&v"(r0), "=&v"(r1), "=&v"(r2), "=&v"(r3), "=&v"(r4), "=&v"(r5), "=&v"(r6), "=&v"(r7)
            : "v"(a0), "v"(a1), "v"(a2), "v"(a3)
            : "memory");
        acc[c0] = MFMA32(__builtin_shufflevector(r0, r1, 0, 1, 2, 3, 4, 5, 6, 7), pf[0], acc[c0]);
        acc[c0] = MFMA32(__builtin_shufflevector(r2, r3, 0, 1, 2, 3, 4, 5, 6, 7), pf[1], acc[c0]);
        acc[c0 + 1] = MFMA32(__builtin_shufflevector(r4, r5, 0, 1, 2, 3, 4, 5, 6, 7), pf[0], acc[c0 + 1]);
        acc[c0 + 1] = MFMA32(__builtin_shufflevector(r6, r7, 0, 1, 2, 3, 4, 5, 6, 7), pf[1], acc[c0 + 1]);
      }
    }
  }
  asm volatile("s_waitcnt vmcnt(0)" ::: "memory");
  float l_tot = l_run + __shfl_xor(l_run, 32);
  float linv = 1.f / l_tot;
  const size_t qrow_i = (size_t)(wave * 32 + l31);
#pragma unroll
  for (int c = 0; c < 4; ++c)
#pragma unroll
    for (int g4 = 0; g4 < 4; ++g4) {
      int dv0 = 32 * c + 8 * g4 + 4 * h;
      uint2 gt = *(const uint2*)(a.gate + qrow_i * a.gs + dv0);
      float o0 = acc[c][4 * g4 + 0] * linv * silu(bflo(gt.x));
      float o1 = acc[c][4 * g4 + 1] * linv * silu(bfhi(gt.x));
      float o2 = acc[c][4 * g4 + 2] * linv * silu(bflo(gt.y));
      float o3 = acc[c][4 * g4 + 3] * linv * silu(bfhi(gt.y));
      *(uint2*)(a.out + qrow_i * a.os + dv0) = make_uint2(pack2(o0, o1), pack2(o2, o3));
    }
}

DI void phase_attn0(const Params& p, LDS_AS(unsigned char)* smem) {
  const u16* QKVG = (const u16*)(p.ws + OFF_BIG);
  u16* OG = (u16*)(p.ws + OFF_H);
  const u16* KA = (const u16*)(p.ws + OFF_KA_ALL);
  const u16* VA = (const u16*)(p.ws + OFF_VA_ALL);
  const u16* KBC = (const u16*)(p.ws + OFF_KB_CTX);
  const u16* VBC = (const u16*)(p.ws + OFF_VB_CTX);
  const float sc = 0.08838834764831845f * LOG2E;
  for (int it = blockIdx.x; it < 1024; it += gridDim.x) {
    AttnArgs a;
    a.qs = L0_IN; a.gs = L0_IN; a.os = D; a.scale_log2 = sc; a.rpb = nullptr; a.qtok0 = 0; a.rs0 = 0; a.rope = 0; a.ropetab = nullptr;
    a.seg[1].k = nullptr; a.seg[1].v = nullptr; a.seg[1].kr = nullptr; a.seg[1].ks = 0; a.seg[1].vs = 0; a.seg[1].n = 0;
    a.seg[0].kr = nullptr;
    if (it >= 256 && it < 512) {
      int i = it - 256;
      int bh = (i >> 5) * 8 + (i & 7), qb = (i >> 3) & 3;
      int b = bh >> 3, hh = bh & 7;
      size_t tok = (size_t)NCTX + b * 1024 + qb * 256;
      a.q = QKVG + tok * L0_IN + 1536 + hh * 128;
      a.gate = QKVG + tok * L0_IN + 4608 + 1024 + hh * 128;
      a.out = OG + tok * D + 1024 + hh * 128;
      a.nseg = 2;
      a.seg[0].k = KBC + (size_t)b * 512 * 1024 + hh * 128; a.seg[0].ks = 1024;
      a.seg[0].v = VBC + (size_t)b * 512 * 1024 + hh * 128; a.seg[0].vs = 1024;
      a.seg[0].n = 512;
      int rs0 = 4 * qb - 4; rs0 = rs0 < 0 ? 0 : (rs0 > 8 ? 8 : rs0);
      int rs1 = 4 * qb - 1; rs1 = rs1 < 0 ? 0 : (rs1 > 8 ? 8 : rs1);
      int nrows = rs1 + 8 - rs0;
      size_t ktok = (size_t)NCTX + b * 1024 + rs0 * 64;
      a.seg[1].k = QKVG + ktok * L0_IN + 2560 + hh * 128; a.seg[1].ks = L0_IN;
      a.seg[1].v = QKVG + ktok * L0_IN + 3584 + hh * 128; a.seg[1].vs = L0_IN;
      a.seg[1].n = nrows * 64;
      a.rpb = p.l0_rpb + hh * 15 * 31;
      a.qtok0 = qb * 256; a.rs0 = rs0;
      attn_block<128, 1>(a, smem);
    } else {
      a.nseg = 1;
      if (it < 256) {
        int g = (it >> 7) * 8 + (it & 7), j = (it >> 3) & 15;
        int b = g >> 1, hq = (g & 1) * 4 + (j >> 2), qb = j & 3;
        size_t tok = (size_t)NCTX + b * 1024 + qb * 256;
        a.q = QKVG + tok * L0_IN + hq * 128;
        a.gate = QKVG + tok * L0_IN + 4608 + hq * 128;
        a.out = OG + tok * D + hq * 128;
        a.seg[0].k = KA + (size_t)b * 1536 * 256 + (hq >> 2) * 128; a.seg[0].ks = 256;
        a.seg[0].v = VA + (size_t)b * 1536 * 256 + (hq >> 2) * 128; a.seg[0].vs = 256;
        a.seg[0].n = 1536;
      } else {
        int i = it - 512;
        bool isB = i >= 256; i &= 255;
        int g = (i >> 5) * 8 + (i & 7), j = (i >> 3) & 3;
        int b = isB ? (i >> 3) : (g >> 1), hh = isB ? (i & 7) : ((g & 1) * 4 + j);
        size_t tok = (size_t)b * 256;
        a.seg[0].n = 256; a.seg[0].ks = L0_IN; a.seg[0].vs = L0_IN;
        if (!isB) {
          a.q = QKVG + tok * L0_IN + hh * 128;
          a.gate = QKVG + tok * L0_IN + 4608 + hh * 128;
          a.out = OG + tok * D + hh * 128;
          a.seg[0].k = QKVG + tok * L0_IN + 1024 + (hh >> 2) * 128;
          a.seg[0].v = QKVG + tok * L0_IN + 1280 + (hh >> 2) * 128;
        } else {
          a.q = QKVG + tok * L0_IN + 1536 + hh * 128;
          a.gate = QKVG + tok * L0_IN + 4608 + 1024 + hh * 128;
          a.out = OG + tok * D + 1024 + hh * 128;
          a.seg[0].k = QKVG + tok * L0_IN + 2560 + hh * 128;
          a.seg[0].v = QKVG + tok * L0_IN + 3584 + hh * 128;
        }
      }
      attn_block<128, 0>(a, smem);
    }
  }
}

DI void phase_attn1(const Params& p, LDS_AS(unsigned char)* smem, int round) {
  const u16* Q1 = (const u16*)(p.ws + OFF_Q1);
  u16* LAT1 = (u16*)(p.ws + OFF_LAT1);
  const float sc = 0.07216878364870322f * LOG2E;
  for (int it = blockIdx.x; it < 512; it += gridDim.x) {
    AttnArgs a;
    a.qs = 3072; a.gs = L1_LD; a.os = L1_LD; a.scale_log2 = sc; a.rpb = nullptr; a.rs0 = 0; a.ropetab = (const float*)(p.ws + OFF_ROPE);
    a.seg[1].k = nullptr; a.seg[1].v = nullptr; a.seg[1].kr = nullptr; a.seg[1].ks = 0; a.seg[1].vs = 0; a.seg[1].n = 0;
    a.nseg = 1;
    a.seg[0].ks = 4096; a.seg[0].vs = 4096;
    size_t tok;
    int hh;
    if (round == 0) {
      int b = it >> 4; hh = it & 15;
      tok = (size_t)b * 256;
      const u16* KV = (const u16*)(p.ws + OFF_KV_CTX) + (size_t)b * 256 * 4096 + hh * 256;
      a.seg[0].k = KV; a.seg[0].v = KV + 128;
      a.seg[0].kr = (const u16*)(p.ws + OFF_KR_CTX) + (size_t)b * 256 * 64;
      a.seg[0].n = 256;
      a.rope = 0; a.qtok0 = 0;
    } else {
      int bh = (it >> 5) * 8 + (it & 7), qb = (it >> 3) & 3;
      int b = bh >> 4; hh = bh & 15;
      tok = (size_t)NCTX + b * 1024 + qb * 256;
      const u16* KV = (const u16*)(p.ws + OFF_KV_LAT) + (size_t)b * 1536 * 4096 + hh * 256;
      a.seg[0].k = KV; a.seg[0].v = KV + 128;
      a.seg[0].kr = (const u16*)(p.ws + OFF_KR_ALL) + (size_t)b * 1536 * 64;
      a.seg[0].n = 1536;
      a.rope = 1; a.qtok0 = qb * 256;
    }
    a.q = Q1 + tok * 3072 + hh * 192;
    a.gate = LAT1 + tok * L1_LD + 1088 + hh * 128;
    a.out = LAT1 + tok * L1_LD + 1088 + hh * 128;
    attn_block<192, 2>(a, smem);
  }
}

#define XB_TMO      128
#define XB_XCNT(j)  (256  + 64 * (j))
#define XB_XSUB(j)  (1280 + 64 * (j))
#define XB_XGEN(j)  (2304 + 64 * (j))
#define XB_TOP      3328
#define XB_TOPGEN   3392
#define XCD_BAR_WORDS 3456
#define XB_SPIN_CAP (1u << 18)
#define XLAS __attribute__((address_space(3)))

__device__ __forceinline__ unsigned xb_ld(unsigned* p)              { return __hip_atomic_load(p, __ATOMIC_RELAXED, __HIP_MEMORY_SCOPE_AGENT); }
__device__ __forceinline__ unsigned xb_add(unsigned* p, unsigned v) { return __hip_atomic_fetch_add(p, v, __ATOMIC_RELAXED, __HIP_MEMORY_SCOPE_AGENT); }
__device__ __forceinline__ unsigned xb_xcc_id() { return (unsigned)__builtin_amdgcn_s_getreg((3 << 11) | 20) & 0xFu; }
#define XB_SPIN(cond, bar) do { unsigned _sp = 0; while (cond) { __builtin_amdgcn_s_sleep(1); \
    if ((++_sp & 255u) == 0u) { if (xb_ld(&(bar)[XB_TMO])) break; if (_sp > XB_SPIN_CAP) { atomicAdd(&(bar)[XB_TMO], 1u); break; } } } } while (0)

struct XcdBarrier {
    unsigned* bar; unsigned x;
    volatile XLAS unsigned* st;
};

__device__ __forceinline__ XcdBarrier xcd_barrier_post(unsigned* bar, volatile XLAS unsigned* st) {
    XcdBarrier b; b.bar = bar; b.x = xb_xcc_id(); b.st = st;
    if (threadIdx.x == 0) (void)xb_add(&bar[XB_XCNT(b.x)], 1u);
    return b;
}
__device__ __forceinline__ void xcd_barrier_complete(unsigned* bar, unsigned x, unsigned& nloc, unsigned& nx) {
    const unsigned G = gridDim.x * gridDim.y * gridDim.z;
    unsigned sum, cnt, mine, sp = 0u;
    for (;;) {
        sum = 0u; cnt = 0u; mine = 0u;
#pragma unroll
        for (unsigned j = 0; j < 16; ++j) { const unsigned c = xb_ld(&bar[XB_XCNT(j)]); sum += c; cnt += (c > 0u) ? 1u : 0u; mine = (j == x) ? c : mine; }
        if (sum == G) break;
        __builtin_amdgcn_s_sleep(1);
        if ((++sp & 255u) == 0u) { if (xb_ld(&bar[XB_TMO])) break; if (sp > XB_SPIN_CAP) { atomicAdd(&bar[XB_TMO], 1u); break; } }
    }
    nloc = mine > 0u ? mine : 1u; nx = cnt > 0u ? cnt : 1u;
}

__device__ __forceinline__ void xcd_barrier(const XcdBarrier& b) {
    asm volatile("s_waitcnt vmcnt(0)" ::: "memory");
    __syncthreads();
    if (threadIdx.x == 0) {
        unsigned* bar = b.bar;
        __builtin_amdgcn_s_waitcnt(0);
        unsigned nloc = b.st[0], nx = b.st[1];
        if (nloc == 0u) { xcd_barrier_complete(bar, b.x, nloc, nx); b.st[0] = nloc; b.st[1] = nx; }
        const unsigned old = xb_add(&bar[XB_XSUB(b.x)], 1u);
        const unsigned gen = old / nloc;
        if (old + 1u == (gen + 1u) * nloc) {
            __builtin_amdgcn_fence(__ATOMIC_RELEASE, "agent");
            asm volatile("s_waitcnt vmcnt(0)" ::: "memory");
            const unsigned og = xb_add(&bar[XB_TOP], 1u);
            const unsigned tg = og / nx;
            if (og + 1u == (tg + 1u) * nx) xb_add(&bar[XB_TOPGEN], 1u);
            else XB_SPIN(xb_ld(&bar[XB_TOPGEN]) == tg, bar);
            __builtin_amdgcn_fence(__ATOMIC_ACQUIRE, "agent");
            xb_add(&bar[XB_XGEN(b.x)], 1u);
            asm volatile("s_waitcnt vmcnt(0)" ::: "memory");
        } else {
            XB_SPIN(xb_ld(&bar[XB_XGEN(b.x)]) == gen, bar);
            __builtin_amdgcn_fence(__ATOMIC_ACQUIRE, "agent");
            asm volatile("s_waitcnt vmcnt(0)" ::: "memory");
        }
    }
    __syncthreads();
}

__global__ void __launch_bounds__(512, 2) fwd_megakernel(Params p) {
  cg::grid_group grid = cg::this_grid();
  extern __shared__ __attribute__((aligned(16))) unsigned char dsm[];
  char* smem = (char*)dsm;
  char* ws = p.ws;
  const float* mod0 = (const float*)(ws + OFF_MOD);
  const float* mod1 = mod0 + 9 * 6144;

  volatile XLAS unsigned* xst = (volatile XLAS unsigned*)((XLAS unsigned char*)dsm + 128 * 1024);
  if (threadIdx.x < 4) xst[threadIdx.x] = 0u;
  __syncthreads();
  const XcdBarrier xb = xcd_barrier_post((unsigned*)(ws + OFF_BAR), xst);
  phase_prep(p, smem);
  if (p.out == nullptr) grid.sync();
  xcd_barrier(xb);
  phase_normmod(p, 0);
  xcd_barrier(xb);
  { EpiBf16 e{(u16*)(ws + OFF_BIG), L0_IN};
    gemm_run((PG8_LAS unsigned char*)dsm, (const u16*)(ws + OFF_H), D, (const u16*)(ws + OFF_WT_IN0), NTOK, L0_IN, 2048, e); }
  if (gridDim.x == 256) { if (blockIdx.x >= 128 && blockIdx.x < 224) adaln_item(p, 1, blockIdx.x - 128, (float*)smem); }
  else { for (int c = blockIdx.x; c < 96; c += gridDim.x) adaln_item(p, 1, c, (float*)smem); }
  xcd_barrier(xb);
  phase_qknorm0(p);
  xcd_barrier(xb);
#pragma unroll 1
  for (int rep = 0; rep < REP_A0; ++rep) phase_attn0(p, (LDS_AS(unsigned char)*)dsm);
  xcd_barrier(xb);
  { EpiResidB<false> e{p.x_prompt, p.x_sample, mod0 + 4096, (u16*)(p.out + OUT_Y)};
    gemm_run((PG8_LAS unsigned char*)dsm, (const u16*)(ws + OFF_H), D, (const u16*)(ws + OFF_WT_OUT0), NTOK, D, 2048, e); }
  xcd_barrier(xb);
  phase_normmod1(p);
  xcd_barrier(xb);
  { EpiBf16 e{(u16*)(ws + OFF_LAT1), L1_LD};
    gemm_run((PG8_LAS unsigned char*)dsm, (const u16*)(ws + OFF_H), D, (const u16*)(ws + OFF_WT_IN1), NTOK, L1_LD, 2048, e); }
  xcd_barrier(xb);
  phase_norm1(p);
  xcd_barrier(xb);
  { EpiBf16 e{(u16*)(ws + OFF_Q1), 3072};
    gemm_run((PG8_LAS unsigned char*)dsm, (const u16*)(ws + OFF_QN), 512, (const u16*)(ws + OFF_WT_QB), NTOK, 3072, 512, e); }
#pragma unroll 1
  for (int round = 0; round < 2; ++round) {
    { EpiBf16 e{(u16*)(ws + (round ? OFF_KV_LAT : OFF_KV_CTX)), 4096};
      gemm_run((PG8_LAS unsigned char*)dsm, (const u16*)(ws + (round ? OFF_CKV_ALL : OFF_CKV_CTX)), 512, (const u16*)(ws + OFF_WT_KVB),
               round ? 12288 : NCTX, 4096, 512, e); }
    xcd_barrier(xb);
    phase_attn1(p, (LDS_AS(unsigned char)*)dsm, round);
    xcd_barrier(xb);
  }
  { EpiResidB<true> e{p.out + OUT_Y, nullptr, mod1 + 4096, (u16*)(ws + OFF_Q1)};
    gemm_run((PG8_LAS unsigned char*)dsm, (const u16*)(ws + OFF_LAT1) + 1088, L1_LD, (const u16*)(ws + OFF_WT_OUT1), NTOK, D, 2048, e); }
  xcd_barrier(xb);
  phase_final(p);
}

extern "C" void kernel_launch(void* const* d_in, const int* in_sizes, int n_in, void* d_out, int out_size, void* d_ws,
                              size_t ws_size, hipStream_t stream) {
  (void)in_sizes; (void)n_in; (void)out_size;
  if (ws_size < WS_NEEDED) { fprintf(stderr, "workspace too small: %zu < %zu\n", ws_size, (size_t)WS_NEEDED); return; }
  static int grid_blocks = 0;
  if (!grid_blocks) {
    int dev = 0, cus = 0, per_cu = 0;
    (void)hipGetDevice(&dev);
    (void)hipDeviceGetAttribute(&cus, hipDeviceAttributeMultiprocessorCount, dev);
    if (hipFuncSetAttribute((const void*)fwd_megakernel, hipFuncAttributeMaxDynamicSharedMemorySize, SMEM_BYTES) != hipSuccess) {
      fprintf(stderr, "hipFuncSetAttribute failed\n"); return; }
    (void)hipOccupancyMaxActiveBlocksPerMultiprocessor(&per_cu, fwd_megakernel, NT, SMEM_BYTES);
    if (per_cu < 1) { fprintf(stderr, "occupancy query returned %d\n", per_cu); return; }
    grid_blocks = cus;
  }
  Params p{};
  const float** pf = (const float**)&p;
  for (int i = 0; i < 28; ++i) pf[i] = (const float*)d_in[i];
  p.out = (float*)d_out;
  p.ws = (char*)d_ws;
  (void)hipMemsetAsync((char*)d_ws + OFF_BAR, 0, BAR_BYTES, stream);
  void* args[] = {&p};
  hipError_t e = hipLaunchCooperativeKernel((void*)fwd_megakernel, dim3(grid_blocks), dim3(NT), args, SMEM_BYTES, stream);
  if (e != hipSuccess) fprintf(stderr, "cooperative launch failed: %s (grid %d)\n", hipGetErrorString(e), grid_blocks);
}
```

```cpp
#include <hip/hip_runtime.h>
#include <hip/hip_cooperative_groups.h>
#include <cstdio>
namespace cg = cooperative_groups;

typedef unsigned short u16;
using bf16x8 = __attribute__((ext_vector_type(8))) short;
using s16x4  = __attribute__((ext_vector_type(4))) short;
using f32x16 = __attribute__((ext_vector_type(16))) float;
using f32x4  = __attribute__((ext_vector_type(4))) float;
using u32x4  = __attribute__((ext_vector_type(4))) unsigned;
typedef __bf16 bf16x2_t __attribute__((ext_vector_type(2)));
typedef float f32x2_t __attribute__((ext_vector_type(2)));
#define DI __device__ __forceinline__
#define MFMA32(a, b, c) __builtin_amdgcn_mfma_f32_32x32x16_bf16((a), (b), (c), 0, 0, 0)
#define LDS_AS(T) __attribute__((address_space(3))) T

constexpr int D = 2048;
constexpr int NTOK = 16384;
constexpr int NCTX = 8192;
constexpr int L0_IN = 6656;
constexpr int L1_IN = 3136;
constexpr int L1_LD = 3072;
constexpr int L1_GATE = 1024;
constexpr float EPS = 1e-6f;
constexpr float LOG2E = 1.4426950408889634f;
constexpr float LOG2_THETA = 13.287712379549449f;
#ifndef REP_G
#define REP_G 1
#endif
#ifndef REP_A0
#define REP_A0 1
#endif
constexpr int NT = 512;
constexpr int NW = 8;

constexpr size_t OFF_WT_IN1  = 0;
constexpr size_t OFF_WT_QB   = OFF_WT_IN1 + (size_t)3328 * 2048 * 2;
constexpr size_t OFF_WT_KVB  = OFF_WT_QB + (size_t)3072 * 512 * 2;
constexpr size_t OFF_WT_OUT1 = OFF_WT_KVB + (size_t)4096 * 512 * 2;
constexpr size_t OFF_WL0     = OFF_WT_OUT1 + (size_t)2048 * 2048 * 2;
constexpr size_t OFF_WT_IN0  = OFF_WL0;
constexpr size_t OFF_WT_OUT0 = OFF_WT_IN0 + (size_t)6656 * 2048 * 2;
constexpr size_t OFF_H       = OFF_WT_OUT0 + (size_t)2048 * 2048 * 2;
constexpr size_t OFF_BIG     = OFF_H + (size_t)NTOK * 2048 * 2;
constexpr size_t OFF_C       = OFF_BIG + (size_t)NTOK * 6656 * 2;
constexpr size_t OFF_KA_ALL  = OFF_C;
constexpr size_t OFF_VA_ALL  = OFF_KA_ALL + (size_t)8 * 1536 * 256 * 2;
constexpr size_t OFF_KB_CTX  = OFF_VA_ALL + (size_t)8 * 1536 * 256 * 2;
constexpr size_t OFF_VB_CTX  = OFF_KB_CTX + (size_t)8 * 512 * 1024 * 2;
constexpr size_t OFF_CKV_ALL = OFF_VB_CTX + (size_t)8 * 512 * 1024 * 2;
constexpr size_t OFF_KR_ALL  = OFF_CKV_ALL + (size_t)8 * 1536 * 512 * 2;
constexpr size_t OFF_MOD     = OFF_KR_ALL + (size_t)8 * 1536 * 64 * 2;
constexpr size_t OFF_ROPE    = OFF_MOD + (size_t)2 * 9 * 6144 * 4;
constexpr size_t OFF_ROPE0   = OFF_ROPE + (size_t)64 * 16 * 2 * 4;
constexpr size_t OFF_BAR     = OFF_ROPE0 + (size_t)64 * 32 * 2 * 4;
constexpr size_t BAR_BYTES   = 3456 * 4;
constexpr size_t WS_NEEDED   = OFF_BAR + BAR_BYTES;
constexpr size_t OFF_QN      = OFF_WL0;
constexpr size_t OFF_CKV_CTX = OFF_QN + (size_t)NTOK * 512 * 2;
constexpr size_t OFF_KR_CTX  = OFF_CKV_CTX + (size_t)NCTX * 512 * 2;
constexpr size_t OFF_KV_CTX  = OFF_H;
constexpr size_t OFF_KV_LAT  = OFF_WL0;
constexpr size_t OFF_LAT1    = OFF_BIG;
constexpr size_t OFF_Q1      = OFF_BIG + (size_t)NTOK * L1_LD * 2;
static_assert(OFF_KR_CTX + (size_t)NCTX * 64 * 2 <= OFF_WT_OUT0, "l1 small bufs overflow");
static_assert(OFF_KV_LAT + (size_t)12288 * 4096 * 2 <= OFF_BIG, "kv_lat overflow");
static_assert(OFF_Q1 + (size_t)NTOK * 3072 * 2 <= OFF_C, "q1 overflow");

constexpr size_t OUT_Y   = 0;
constexpr size_t OUT_NAK = (size_t)NTOK * 2048;
constexpr size_t OUT_NAV = OUT_NAK + (size_t)NCTX * 256;
constexpr size_t OUT_NBK = OUT_NAV + (size_t)NCTX * 256;
constexpr size_t OUT_NBV = OUT_NBK + (size_t)NCTX * 1024;
constexpr size_t OUT_NCKV = OUT_NBV + (size_t)NCTX * 1024;
constexpr size_t OUT_NKR = OUT_NCKV + (size_t)NCTX * 512;

constexpr int SMEM_BYTES = 128 * 1024 + 256;

struct Params {
  const float *x_prompt, *x_sample, *ca_k, *ca_v, *cb_k, *cb_v, *c_ckv, *c_kr, *c, *c_ctx;
  const float *l0_norm, *l0_ada_w, *l0_ada_b, *l0_w_in, *l0_qn, *l0_kn, *l0_rpb, *l0_w_out;
  const float *l1_norm, *l1_ada_w, *l1_ada_b, *l1_w_in, *l1_qan, *l1_wqb, *l1_kvan, *l1_wkvb, *l1_w_out, *fnorm;
  float* out;
  char* ws;
};

DI int threadIdx_x_raw() { return (int)__builtin_amdgcn_workitem_id_x(); }
DI u16 f2bf(float x) { unsigned u = __float_as_uint(x); u += 0x7fffu + ((u >> 16) & 1u); return (u16)(u >> 16); }
DI float bf2f(u16 v) { return __uint_as_float(((unsigned)v) << 16); }
DI unsigned pack2(float a, float b) { f32x2_t f = {a, b}; bf16x2_t r = __builtin_convertvector(f, bf16x2_t); return __builtin_bit_cast(unsigned, r); }
DI float bflo(unsigned u) { return __uint_as_float(u << 16); }
DI float bfhi(unsigned u) { return __uint_as_float(u & 0xffff0000u); }
DI float wave_sum(float v) {
#pragma unroll
  for (int o = 32; o >= 1; o >>= 1) v += __shfl_xor(v, o);
  return v;
}
DI int TID() { int t = threadIdx_x_raw(); asm volatile("" : "+v"(t)); return t; }
DI int crow(int i, int h) { return (i & 3) + 8 * (i >> 2) + 4 * h; }
DI float silu(float x) { return x / (1.f + __expf(-x)); }
DI int tok_modrow(int tok) { return tok < NCTX ? 0 : 1 + ((tok - NCTX) >> 10); }

DI void transpose_tile(const float* __restrict__ src, int K, int N, u16* __restrict__ dst, int kt, int nt, float* sm, bool remap1 = false) {
  const int t = TID();
  float4 v[8];
#pragma unroll
  for (int i = 0; i < 8; ++i) {
    int id = t + NT * i, r = id >> 6, c4 = id & 63, n = nt * 256 + c4 * 4;
    v[i] = (n < N) ? *(const float4*)(src + (size_t)(kt * 64 + r) * N + n) : make_float4(0.f, 0.f, 0.f, 0.f);
  }
#pragma unroll
  for (int i = 0; i < 8; ++i) {
    int id = t + NT * i, r = id >> 6, c4 = id & 63;
    *(float4*)(sm + r * 260 + c4 * 4) = v[i];
  }
  __syncthreads();
  {
    const int nl = t >> 1, kq = t & 1, n = nt * 256 + nl;
    if (n < N) {
      const int nr = !remap1 ? n : (n < 1024 ? n : (n < 1088 ? n + 2048 : n - 64));
      u16* dp = dst + (size_t)nr * K + kt * 64 + kq * 32;
#pragma unroll
      for (int q = 0; q < 4; ++q) {
        u32x4 o;
#pragma unroll
        for (int j = 0; j < 4; ++j) o[j] = pack2(sm[(kq * 32 + q * 8 + 2 * j) * 260 + nl], sm[(kq * 32 + q * 8 + 2 * j + 1) * 260 + nl]);
        *(u32x4*)(dp + q * 8) = o;
      }
    }
  }
  __syncthreads();
}

DI void adaln_item(const Params& p, int l, int chunk, float* sm) {
  const float* W = l ? p.l1_ada_w : p.l0_ada_w;
  const float* bias = l ? p.l1_ada_b : p.l0_ada_b;
  float* mod = (float*)(p.ws + OFF_MOD) + (size_t)l * 9 * 6144;
  const int t = TID(), col = chunk * 64 + (t & 63), kg = t >> 6;
  float acc[9];
#pragma unroll
  for (int r = 0; r < 9; ++r) acc[r] = 0.f;
  for (int kh = 0; kh < 2; ++kh) {
    __syncthreads();
    for (int e = t; e < 9 * 1024; e += NT) {
      int r = e >> 10, k = e & 1023;
      float cv = (r == 0) ? p.c_ctx[kh * 1024 + k] : p.c[(r - 1) * 2048 + kh * 1024 + k];
      sm[r * 1024 + k] = silu(cv);
    }
    __syncthreads();
    const float* wp = W + (size_t)(kh * 1024 + kg * 128) * 6144 + col;
    const float* sp = sm + kg * 128;
#pragma unroll 8
    for (int k = 0; k < 128; ++k) {
      float w = wp[(size_t)k * 6144];
#pragma unroll
      for (int r = 0; r < 9; ++r) acc[r] += sp[r * 1024 + k] * w;
    }
  }
  __syncthreads();
#pragma unroll
  for (int r = 0; r < 9; ++r) sm[(kg * 9 + r) * 64 + (t & 63)] = acc[r];
  __syncthreads();
  for (int e = t; e < 9 * 64; e += NT) {
    int r = e >> 6, cc = e & 63;
    float s = 0.f;
#pragma unroll
    for (int g = 0; g < NW; ++g) s += sm[(g * 9 + r) * 64 + cc];
    mod[(size_t)r * 6144 + chunk * 64 + cc] = s + bias[chunk * 64 + cc];
  }
  __syncthreads();
}

DI void convert_item(const float* __restrict__ src, u16* __restrict__ dst, int W, int dstT, int item) {
  size_t e = (size_t)item * 4096 + TID() * 8;
  size_t per_b = (size_t)512 * W;
  size_t b = e / per_b, r = e % per_b;
  float4 v0 = *(const float4*)(src + e), v1 = *(const float4*)(src + e + 4);
  u32x4 o = {pack2(v0.x, v0.y), pack2(v0.z, v0.w), pack2(v1.x, v1.y), pack2(v1.z, v1.w)};
  *(u32x4*)(dst + b * (size_t)dstT * W + r) = o;
}

DI void phase_prep(const Params& p, char* smem) {
  float* sm = (float*)smem;
  char* ws = p.ws;
  constexpr int T_IN0 = 32 * 26, T_OUT0 = 32 * 8, T_IN1 = 32 * 13, T_QB = 8 * 12, T_KVB = 8 * 16, T_OUT1 = 32 * 8;
  constexpr int C_A = 256, C_B = 1024, C_CKV = 512, C_KR = 64;
  constexpr int B1 = 0, B2 = B1 + T_IN0, B3 = B2 + T_OUT0, B4 = B3 + T_IN1, B5 = B4 + T_QB, B6 = B5 + T_KVB, B7 = B6 + T_OUT1;
  constexpr int B8 = B7 + C_A, B9 = B8 + C_A, B10 = B9 + C_B, B11 = B10 + C_B, B12 = B11 + C_CKV, B13 = B12 + C_KR;
  if (blockIdx.x == gridDim.x - 1) {
    float* tab = (float*)(ws + OFF_ROPE);
    for (int e = TID(); e < 64 * 16; e += NT) {
      int pos = e >> 4, i = e & 15;
      float inv = exp2f(-(float)i * (LOG2_THETA / 16.f));
      float sn, cs; sincosf((float)pos * inv, &sn, &cs);
      tab[2 * e] = cs; tab[2 * e + 1] = sn;
    }
    float* tab0 = (float*)(ws + OFF_ROPE0);
    for (int e = TID(); e < 64 * 32; e += NT) {
      int pos = e >> 5, i = e & 31;
      float inv = exp2f(-(float)i * (LOG2_THETA / 32.f));
      float sn, cs; sincosf((float)pos * inv, &sn, &cs);
      tab0[2 * e] = cs; tab0[2 * e + 1] = sn;
    }
  }
  const int nada = (gridDim.x > 128) ? 96 : 0;
  if ((int)blockIdx.x < nada) { adaln_item(p, 0, blockIdx.x, sm); return; }
  if (nada == 0) { for (int c = blockIdx.x; c < 96; c += gridDim.x) adaln_item(p, 0, c, sm); }
  for (int it = blockIdx.x - nada; it < B13; it += gridDim.x - nada) {
    if (it < B2) { int i = it - B1; transpose_tile(p.l0_w_in, 2048, 6656, (u16*)(ws + OFF_WT_IN0), i / 26, i % 26, sm); }
    else if (it < B3) { int i = it - B2; transpose_tile(p.l0_w_out, 2048, 2048, (u16*)(ws + OFF_WT_OUT0), i / 8, i % 8, sm); }
    else if (it < B4) { int i = it - B3; transpose_tile(p.l1_w_in, 2048, 3136, (u16*)(ws + OFF_WT_IN1), i / 13, i % 13, sm, true); }
    else if (it < B5) { int i = it - B4; transpose_tile(p.l1_wqb, 512, 3072, (u16*)(ws + OFF_WT_QB), i / 12, i % 12, sm); }
    else if (it < B6) { int i = it - B5; transpose_tile(p.l1_wkvb, 512, 4096, (u16*)(ws + OFF_WT_KVB), i / 16, i % 16, sm); }
    else if (it < B7) { int i = it - B6; transpose_tile(p.l1_w_out, 2048, 2048, (u16*)(ws + OFF_WT_OUT1), i / 8, i % 8, sm); }
    else if (it < B8) convert_item(p.ca_k, (u16*)(ws + OFF_KA_ALL), 256, 1536, it - B7);
    else if (it < B9) convert_item(p.ca_v, (u16*)(ws + OFF_VA_ALL), 256, 1536, it - B8);
    else if (it < B10) convert_item(p.cb_k, (u16*)(ws + OFF_KB_CTX), 1024, 512, it - B9);
    else if (it < B11) convert_item(p.cb_v, (u16*)(ws + OFF_VB_CTX), 1024, 512, it - B10);
    else if (it < B12) convert_item(p.c_ckv, (u16*)(ws + OFF_CKV_ALL), 512, 1536, it - B11);
    else convert_item(p.c_kr, (u16*)(ws + OFF_KR_ALL), 64, 1536, it - B12);
  }
}

DI void phase_normmod(const Params& p, int layer) {
  const int wave = TID() >> 6, lane = TID() & 63;
  const float* g = layer ? p.l1_norm : p.l0_norm;
  const float* mod = (const float*)(p.ws + OFF_MOD) + (size_t)layer * 9 * 6144;
  u16* H = (u16*)(p.ws + OFF_H);
  for (int it = blockIdx.x; it < NTOK / NW; it += gridDim.x) {
    int row = it * NW + wave;
    const float* src;
    if (layer == 0) src = row < NCTX ? p.x_prompt + (size_t)row * D : p.x_sample + (size_t)(row - NCTX) * D;
    else src = p.out + OUT_Y + (size_t)row * D;
    const float* mr = mod + (size_t)tok_modrow(row) * 6144;
    float4 v[8];
    float ss = 0.f;
#pragma unroll
    for (int i = 0; i < 8; ++i) {
      v[i] = *(const float4*)(src + (i * 64 + lane) * 4);
      ss += v[i].x * v[i].x + v[i].y * v[i].y + v[i].z * v[i].z + v[i].w * v[i].w;
    }
    ss = wave_sum(ss);
    float rinv = rsqrtf(ss * (1.f / D) + EPS);
#pragma unroll
    for (int i = 0; i < 8; ++i) {
      int col = (i * 64 + lane) * 4;
      float4 gg = *(const float4*)(g + col);
      float4 sh = *(const float4*)(mr + col);
      float4 sc = *(const float4*)(mr + 2048 + col);
      float h0 = v[i].x * rinv * gg.x * (1.f + sc.x) + sh.x;
      float h1 = v[i].y * rinv * gg.y * (1.f + sc.y) + sh.y;
      float h2 = v[i].z * rinv * gg.z * (1.f + sc.z) + sh.z;
      float h3 = v[i].w * rinv * gg.w * (1.f + sc.w) + sh.w;
      *(uint2*)(H + (size_t)row * D + col) = make_uint2(pack2(h0, h1), pack2(h2, h3));
    }
  }
}

DI void phase_normmod1(const Params& p) {
  const int wave = TID() >> 6, lane = TID() & 63;
  const float* g = p.l1_norm;
  const float* mod = (const float*)(p.ws + OFF_MOD) + (size_t)9 * 6144;
  const u16* X1 = (const u16*)(p.out + OUT_Y);
  u16* H = (u16*)(p.ws + OFF_H);
  for (int it = blockIdx.x; it < NTOK / NW; it += gridDim.x) {
    const int row = it * NW + wave;
    const float* mr = mod + (size_t)tok_modrow(row) * 6144;
    u32x4 v[4];
    float ss = 0.f;
#pragma unroll
    for (int i = 0; i < 4; ++i) {
      v[i] = *(const u32x4*)(X1 + (size_t)row * D + (i * 64 + lane) * 8);
#pragma unroll
      for (int j = 0; j < 4; ++j) { const float a0 = bflo(v[i][j]), a1 = bfhi(v[i][j]); ss += a0 * a0 + a1 * a1; }
    }
    ss = wave_sum(ss);
    const float rinv = rsqrtf(ss * (1.f / D) + EPS);
#pragma unroll
    for (int i = 0; i < 4; ++i) {
      const int col = (i * 64 + lane) * 8;
      u32x4 o;
#pragma unroll
      for (int q = 0; q < 2; ++q) {
        const f32x4 gg = *(const f32x4*)(g + col + 4 * q);
        const f32x4 sh = *(const f32x4*)(mr + col + 4 * q);
        const f32x4 sc = *(const f32x4*)(mr + 2048 + col + 4 * q);
        const float x0 = bflo(v[i][2 * q]), x1 = bfhi(v[i][2 * q]), x2 = bflo(v[i][2 * q + 1]), x3 = bfhi(v[i][2 * q + 1]);
        const float h0 = x0 * rinv * gg[0] * (1.f + sc[0]) + sh[0];
        const float h1 = x1 * rinv * gg[1] * (1.f + sc[1]) + sh[1];
        const float h2 = x2 * rinv * gg[2] * (1.f + sc[2]) + sh[2];
        const float h3 = x3 * rinv * gg[3] * (1.f + sc[3]) + sh[3];
        o[2 * q] = pack2(h0, h1); o[2 * q + 1] = pack2(h2, h3);
      }
      *(u32x4*)(H + (size_t)row * D + col) = o;
    }
  }
}

namespace pg8 {
#define PG8_LAS __attribute__((address_space(3)))
typedef unsigned short bf16_t;
typedef short bf16x8 __attribute__((ext_vector_type(8)));
typedef float f32x4 __attribute__((ext_vector_type(4)));
typedef unsigned u32x4 __attribute__((ext_vector_type(4)));
constexpr int BM = 256, BK = 64, HALF = 128, HTB = HALF * BK * 2  , STAGE_BYTES = 8 * HTB, NXCD = 8, WGM = 8;

__host__ __device__ __forceinline__ int lds_byte(int r, int c) { const int st = (r >> 4) * 2 + (c >> 5), rr = r & 15, cc = c & 31, ob = rr * 64 + cc * 2; return st * 1024 + (ob ^ (((ob >> 9) & 1) << 5)); }
__host__ __device__ __forceinline__ void stage_rc(int b, int& R, int& C) { const int st = b / 1024, sb = b % 1024, swz = sb ^ (((sb >> 9) & 1) << 5); R = (st >> 1) * 16 + swz / 64; C = (st & 1) * 32 + (swz % 64) / 2; }
__host__ __device__ __forceinline__ int perm32(int rho) { const int n = rho >> 4, i = rho & 15; return 8 * (i >> 2) + 4 * n + (i & 3); }

struct Unit { int pm, pn; };
struct Gemm { const bf16_t* A; const bf16_t* Bt; int M, N, K, lda; };
struct StaticOrder {
    int nM, nN, nwg, G, c;
    __host__ __device__ void init(int M, int N, int G_, int c_) { nM = M / BM; nN = N / BM; nwg = nM * nN; G = G_; c = c_; }
    __host__ __device__ bool next(int i, Unit& u) const {
        const long L = (long)i * G + c; if (L >= nwg) return false;
        int wgid = (int)L; { const int q = nwg / NXCD, r = nwg % NXCD, xcd = wgid % NXCD, off = wgid / NXCD; wgid = (xcd < r ? xcd * (q + 1) : r * (q + 1) + (xcd - r) * q) + off; }
        const int nig = WGM * nN, gid = wgid / nig, fm = gid * WGM, gsz = (nM - fm) < WGM ? (nM - fm) : WGM;
        u.pm = fm + ((wgid % nig) % gsz); u.pn = (wgid % nig) / gsz; return true;
    }
    __device__ __forceinline__ void a_ready(const Unit&) const {}
    __device__ __forceinline__ void done(const Unit&) const {}
};
template <class Epi, class Sched, bool STAMP = false>
__device__ __forceinline__ void gemm_phase(PG8_LAS unsigned char* lds, const Gemm g, const Sched& S, const Epi& E, unsigned long long* stamps) {
    const int tid = TID(), wid = __builtin_amdgcn_readfirstlane(tid >> 6), lane = tid & 63, wr = wid >> 2, wc = wid & 3, fr = lane & 15, fq = lane >> 4;
    const int K = g.K, nt = K / BK;
    int ts_lo = 0, ts_hi = 0, nts = 0; const unsigned long long rt_entry = STAMP ? (unsigned long long)wall_clock64() : 0ull;
#define PG8_STAMP() do { if (STAMP && wid == 0 && nts < 64) { const unsigned long long _c = (unsigned long long)clock64(); \
        ts_lo = (lane == nts) ? (int)(unsigned)_c : ts_lo; ts_hi = (lane == nts) ? (int)(unsigned)(_c >> 32) : ts_hi; ++nts; } } while (0)
    PG8_STAMP();
    unsigned voffA[2], voffB[2];
#pragma unroll
    for (int i = 0; i < 2; ++i) { int R, C; stage_rc(tid * 16 + i * 8192, R, C); const int Rb = Epi::PERM ? ((R & ~31) + perm32(R & 31)) : R;
        voffA[i] = (unsigned)(R * g.lda + C) * 2u; voffB[i] = (unsigned)(Rb * K + C) * 2u; }
    const size_t kstep = (size_t)(BK * 2);
    const size_t hstepB = (size_t)HALF * K * 2, hstepA = (size_t)HALF * g.lda * 2;
    const size_t tstepB = 2 * hstepB, tstepA = 2 * hstepA;
    const unsigned ldsw = (unsigned)wid * 1024u;
    const int aoff = lds_byte(wr * 64 + fr, fq * 8), boff = lds_byte(wc * 32 + fr, fq * 8);
#define PG8_SA(b, h) (((b) * 2 + (h)) * HTB)
#define PG8_SB(b, h) ((4 + (b) * 2 + (h)) * HTB)
#define PG8_STAGE(bufoff, gbase, voff) do { _Pragma("unroll") for (int _i = 0; _i < 2; ++_i) \
        __builtin_amdgcn_global_load_lds((const unsigned*)((const char*)(gbase) + (voff)[_i]), (PG8_LAS unsigned*)(lds + (bufoff) + ldsw + _i * 8192), 16, 0, 0); } while (0)
#define PG8_LDA(dst, b, h) do { _Pragma("unroll") for (int m = 0; m < 4; ++m) _Pragma("unroll") for (int k = 0; k < 2; ++k) dst[m][k] = *(const PG8_LAS bf16x8*)(lds + PG8_SA(b, h) + aoff + m * 2048 + k * 1024); } while (0)
#define PG8_LDB(dst, b, h) do { _Pragma("unroll") for (int n = 0; n < 2; ++n) _Pragma("unroll") for (int k = 0; k < 2; ++k) dst[n][k] = *(const PG8_LAS bf16x8*)(lds + PG8_SB(b, h) + boff + n * 2048 + k * 1024); } while (0)
#define PG8_MMA(ai, bj, At, Bt) do { __builtin_amdgcn_s_setprio(1); _Pragma("unroll") for (int m = 0; m < 4; ++m) _Pragma("unroll") for (int n = 0; n < 2; ++n) _Pragma("unroll") for (int k = 0; k < 2; ++k) \
        acc[ai][bj][m][n] = __builtin_amdgcn_mfma_f32_16x16x32_bf16(Bt[n][k], At[m][k], acc[ai][bj][m][n], 0, 0, 0); __builtin_amdgcn_s_setprio(0); } while (0)
#define PG8_WAIT_V(n) asm volatile("s_waitcnt vmcnt(" #n ")" ::: "memory")
#define PG8_WAIT_L(n) asm volatile("s_waitcnt lgkmcnt(" #n ")" ::: "memory")
#define PG8_BAR __builtin_amdgcn_s_barrier()
#define PG8_SCHED __builtin_amdgcn_sched_barrier(0)
    Unit cur, nxt; int ui = 0;
    if (!S.next(0, cur)) return;
    f32x4 acc[2][2][4][2];
#pragma unroll
    for (int a = 0; a < 2; ++a)
#pragma unroll
        for (int b = 0; b < 2; ++b)
#pragma unroll
            for (int m = 0; m < 4; ++m)
#pragma unroll
                for (int n = 0; n < 2; ++n) acc[a][b][m][n] = (f32x4){0.f, 0.f, 0.f, 0.f};
    bf16x8 At[4][2], B0[2][2], B1[2][2];
    const char* cA = (const char*)g.A + (size_t)cur.pm * tstepA; const char* cB = (const char*)g.Bt + (size_t)cur.pn * tstepB;
    S.a_ready(cur);
    PG8_STAGE(PG8_SB(0, 0), cB, voffB); PG8_STAGE(PG8_SA(0, 0), cA, voffA); PG8_STAGE(PG8_SB(0, 1), cB + hstepB, voffB); PG8_STAGE(PG8_SA(0, 1), cA + hstepA, voffA);
    if (wr == 1) PG8_BAR;
    PG8_WAIT_V(4); PG8_BAR;
    PG8_STAGE(PG8_SB(1, 0), cB + kstep, voffB); PG8_STAGE(PG8_SA(1, 0), cA + kstep, voffA); PG8_STAGE(PG8_SB(1, 1), cB + hstepB + kstep, voffB);
    PG8_WAIT_V(6); PG8_BAR;
    PG8_STAMP();
    for (;;) {
        const bool has_next = S.next(ui + 1, nxt);
        const char* nA = has_next ? (const char*)g.A + (size_t)nxt.pm * tstepA : cA; const char* nB = has_next ? (const char*)g.Bt + (size_t)nxt.pn * tstepB : cB;
        for (int t = 0; t < nt; t += 2) {
            const bool last = (t == nt - 2);
            const char* a1 = cA + (size_t)(t + 1) * kstep;
            const char* a2 = last ? nA : cA + (size_t)(t + 2) * kstep; const char* b2 = last ? nB : cB + (size_t)(t + 2) * kstep;
            const char* a3 = a2 + kstep; const char* b3 = b2 + kstep;
            if (last && has_next) S.a_ready(nxt);
            PG8_LDB(B0, 0, 0); PG8_SCHED; PG8_LDA(At, 0, 0); PG8_STAGE(PG8_SA(1, 1), a1 + hstepA, voffA);
            PG8_WAIT_L(8); PG8_BAR; PG8_WAIT_L(0); PG8_MMA(0, 0, At, B0); PG8_BAR; PG8_SCHED;
            PG8_LDB(B1, 0, 1); PG8_STAGE(PG8_SB(0, 0), b2, voffB);
            PG8_BAR; PG8_WAIT_L(0); PG8_MMA(0, 1, At, B1); PG8_BAR;
            PG8_LDA(At, 0, 1); PG8_STAGE(PG8_SA(0, 0), a2, voffA);
            PG8_BAR; PG8_WAIT_L(0); PG8_MMA(1, 0, At, B0); PG8_BAR; PG8_SCHED;
            PG8_STAGE(PG8_SB(0, 1), b2 + hstepB, voffB);
            PG8_WAIT_V(6); PG8_BAR; PG8_MMA(1, 1, At, B1); PG8_BAR;
            PG8_LDB(B0, 1, 0); PG8_SCHED; PG8_LDA(At, 1, 0); PG8_STAGE(PG8_SA(0, 1), a2 + hstepA, voffA);
            PG8_WAIT_L(8); PG8_BAR; PG8_WAIT_L(0); PG8_MMA(0, 0, At, B0); PG8_BAR; PG8_SCHED;
            PG8_LDB(B1, 1, 1); PG8_STAGE(PG8_SB(1, 0), b3, voffB);
            PG8_BAR; PG8_WAIT_L(0); PG8_MMA(0, 1, At, B1); PG8_BAR;
            PG8_LDA(At, 1, 1); PG8_STAGE(PG8_SA(1, 0), a3, voffA);
            PG8_BAR; PG8_WAIT_L(0); PG8_MMA(1, 0, At, B0); PG8_BAR; PG8_SCHED;
            PG8_STAGE(PG8_SB(1, 1), b3 + hstepB, voffB);
            PG8_WAIT_V(6); PG8_BAR; PG8_MMA(1, 1, At, B1); PG8_BAR;
        }
        PG8_STAMP();
        if constexpr (!Epi::AFTER_DRAIN) { E(acc, cur, wr, wc, fr, fq); S.done(cur); }
        PG8_STAMP();
        if (!has_next) break;
#pragma unroll
        for (int a = 0; a < 2; ++a)
#pragma unroll
            for (int b = 0; b < 2; ++b)
#pragma unroll
                for (int m = 0; m < 4; ++m)
#pragma unroll
                    for (int n = 0; n < 2; ++n) acc[a][b][m][n] = (f32x4){0.f, 0.f, 0.f, 0.f};
        cur = nxt; cA = nA; cB = nB; ++ui;
    }
    PG8_WAIT_V(0);
    if (wr == 0) PG8_BAR;
    PG8_BAR;
    if constexpr (Epi::AFTER_DRAIN) { E.fused(acc, cur, wr, wc, fr, fq, lds, wid, lane); S.done(cur); }
    PG8_STAMP();
    if (STAMP && wid == 0) { stamps[lane] = lane < nts ? (((unsigned long long)(unsigned)ts_hi << 32) | (unsigned)ts_lo) : 0ull;
        if (lane == 62) stamps[62] = rt_entry; if (lane == 63) stamps[63] = (unsigned long long)wall_clock64(); }
#undef PG8_STAMP
#undef PG8_SA
#undef PG8_SB
#undef PG8_STAGE
#undef PG8_LDA
#undef PG8_LDB
#undef PG8_MMA
#undef PG8_WAIT_V
#undef PG8_WAIT_L
#undef PG8_BAR
#undef PG8_SCHED
}
}


struct EpiBf16 {
  static constexpr bool PERM = true, AFTER_DRAIN = false;
  u16* O; int ldc;
  DI void operator()(const f32x4 (&acc)[2][2][4][2], const pg8::Unit& u, int wr, int wc, int fr, int fq) const {
    const int row0 = u.pm * 256 + wr * 64 + fr, col0 = u.pn * 256 + wc * 32 + 8 * fq;
#pragma unroll
    for (int ai = 0; ai < 2; ++ai)
#pragma unroll
      for (int m = 0; m < 4; ++m) {
        u16* rowp = O + (size_t)(row0 + ai * 128 + m * 16) * ldc + col0;
#pragma unroll
        for (int bj = 0; bj < 2; ++bj) {
          f32x4 v0 = acc[ai][bj][m][0], v1 = acc[ai][bj][m][1];
          u32x4 w = {pack2(v0[0], v0[1]), pack2(v0[2], v0[3]), pack2(v1[0], v1[1]), pack2(v1[2], v1[3])};
          *(u32x4*)(rowp + bj * 128) = w;
        }
      }
  }
};
struct EpiResid {
  static constexpr bool PERM = false, AFTER_DRAIN = false;
  const float* xa; const float* xb; const float* gate; float* out;
  DI void operator()(const f32x4 (&acc)[2][2][4][2], const pg8::Unit& u, int wr, int wc, int fr, int fq) const {
    const int row0 = u.pm * 256 + wr * 64 + fr, col0 = u.pn * 256 + wc * 32 + 4 * fq;
#pragma unroll
    for (int ai = 0; ai < 2; ++ai)
#pragma unroll
      for (int m = 0; m < 4; ++m) {
        const int row = row0 + ai * 128 + m * 16;
        const float* xr = (row < NCTX) ? xa + (size_t)row * D : xb + (size_t)(row - NCTX) * D;
        const float* gr = gate + (size_t)tok_modrow(row) * 6144;
        float* orow = out + (size_t)row * D;
#pragma unroll
        for (int bj = 0; bj < 2; ++bj)
#pragma unroll
          for (int n = 0; n < 2; ++n) {
            const int col = col0 + bj * 128 + n * 16;
            f32x4 xv = *(const f32x4*)(xr + col);
            f32x4 gv = *(const f32x4*)(gr + col);
            *(f32x4*)(orow + col) = xv + gv * acc[ai][bj][m][n];
          }
      }
  }
};

template <bool XBF> struct EpiResidB {
  static constexpr bool PERM = true, AFTER_DRAIN = false;
  const void* xa; const void* xb; const float* gate; u16* out;
  DI void operator()(const f32x4 (&acc)[2][2][4][2], const pg8::Unit& u, int wr, int wc, int fr, int fq) const {
    const int row0 = u.pm * 256 + wr * 64 + fr, col0 = u.pn * 256 + wc * 32 + 8 * fq;
#pragma unroll
    for (int ai = 0; ai < 2; ++ai)
#pragma unroll
      for (int m = 0; m < 4; ++m) {
        const int row = row0 + ai * 128 + m * 16;
        const float* gr = gate + (size_t)tok_modrow(row) * 6144;
        u16* orow = out + (size_t)row * D;
#pragma unroll
        for (int bj = 0; bj < 2; ++bj) {
          const int col = col0 + bj * 128;
          f32x4 x0, x1;
          if constexpr (XBF) {
            const u32x4 xv = *(const u32x4*)((const u16*)xa + (size_t)row * D + col);
            x0 = (f32x4){bflo(xv[0]), bfhi(xv[0]), bflo(xv[1]), bfhi(xv[1])};
            x1 = (f32x4){bflo(xv[2]), bfhi(xv[2]), bflo(xv[3]), bfhi(xv[3])};
          } else {
            const float* xr = (row < NCTX) ? (const float*)xa + (size_t)row * D : (const float*)xb + (size_t)(row - NCTX) * D;
            x0 = *(const f32x4*)(xr + col); x1 = *(const f32x4*)(xr + col + 4);
          }
          const f32x4 g0 = *(const f32x4*)(gr + col), g1 = *(const f32x4*)(gr + col + 4);
          const f32x4 o0 = x0 + g0 * acc[ai][bj][m][0], o1 = x1 + g1 * acc[ai][bj][m][1];
          u32x4 w = {pack2(o0[0], o0[1]), pack2(o0[2], o0[3]), pack2(o1[0], o1[1]), pack2(o1[2], o1[3])};
          *(u32x4*)(orow + col) = w;
        }
      }
  }
};

template <class Epi>
DI void gemm_run(PG8_LAS unsigned char* lds, const u16* A, int lda, const u16* Bt, int M, int N, int K, const Epi& e) {
  pg8::Gemm g{A, Bt, M, N, K, lda};
  pg8::StaticOrder S; S.init(M, N, (int)gridDim.x, (int)blockIdx.x);
#pragma unroll 1
  for (int rep = 0; rep < (Epi::PERM ? REP_G : 1); ++rep) {
    __syncthreads();
    pg8::gemm_phase<Epi, pg8::StaticOrder, false>(lds, g, S, e, nullptr);
    __syncthreads();
  }
}

DI void phase_qknorm0(const Params& p) {
  const int t = TID(), wave = t >> 6, lane = t & 63, l15 = lane & 15;
  u16* QKVG = (u16*)(p.ws + OFF_BIG);
  u16* KA = (u16*)(p.ws + OFF_KA_ALL);
  u16* VA = (u16*)(p.ws + OFF_VA_ALL);
  const float* tab = (const float*)(p.ws + OFF_ROPE0);
  float gq[8], gk[8];
#pragma unroll
  for (int j = 0; j < 8; ++j) { gq[j] = p.l0_qn[l15 * 8 + j]; gk[j] = p.l0_kn[l15 * 8 + j]; }
  const bool hi = (l15 & 4) != 0;
  const bool colrot = l15 >= 8;
  const int f0 = (l15 & 3) * 8;
  for (int it = blockIdx.x; it < NTOK / NW; it += gridDim.x) {
    const int tk = it * NW + wave;
    u16* base = QKVG + (size_t)tk * L0_IN;
    const bool lat = tk >= NCTX;
    const int lt = tk - NCTX, b = lt >> 10, tt = lt & 1023;
    u32x4 v[3];
#pragma unroll
    for (int ps = 0; ps < 3; ++ps) v[ps] = *(const u32x4*)(base + (ps * 64 + lane) * 8);
    u32x4 kb[2], vb[2];
    if (!lat) {
#pragma unroll
      for (int q = 0; q < 2; ++q) { kb[q] = *(const u32x4*)(base + 2560 + (q * 64 + lane) * 8); vb[q] = *(const u32x4*)(base + 3584 + (q * 64 + lane) * 8); }
    }
    float cs[8], sn[8];
    if (lat) {
      const int pos = colrot ? (tt & 63) : (tt >> 6);
      const float4* tp = (const float4*)(tab + (pos * 32 + f0) * 2);
#pragma unroll
      for (int j2 = 0; j2 < 4; ++j2) { float4 c = tp[j2]; cs[2 * j2] = c.x; sn[2 * j2] = c.y; cs[2 * j2 + 1] = c.z; sn[2 * j2 + 1] = c.w; }
    } else {
#pragma unroll
      for (int j = 0; j < 8; ++j) { cs[j] = 1.f; sn[j] = 0.f; }
    }
    const size_t arow = (size_t)b * 1536 + 512 + tt;
#pragma unroll
    for (int ps = 0; ps < 3; ++ps) {
      float x[8];
#pragma unroll
      for (int j = 0; j < 4; ++j) { x[2 * j] = bflo(v[ps][j]); x[2 * j + 1] = bfhi(v[ps][j]); }
      float ss = 0.f;
#pragma unroll
      for (int j = 0; j < 8; ++j) ss += x[j] * x[j];
      ss += __shfl_xor(ss, 8); ss += __shfl_xor(ss, 4); ss += __shfl_xor(ss, 2); ss += __shfl_xor(ss, 1);
      const float rinv = rsqrtf(ss * (1.f / 128.f) + EPS);
      float o[8];
#pragma unroll
      for (int j = 0; j < 8; ++j) {
        const float y = x[j] * rinv * (ps < 2 ? gq[j] : gk[j]);
        const float pr = __shfl_xor(y, 4);
        o[j] = hi ? (y * cs[j] + pr * sn[j]) : (y * cs[j] - pr * sn[j]);
      }
      if (ps < 2) {
        u32x4 w = {pack2(o[0], o[1]), pack2(o[2], o[3]), pack2(o[4], o[5]), pack2(o[6], o[7])};
        *(u32x4*)(base + (ps * 64 + lane) * 8) = w;
      } else if (lane < 32) {
        u32x4 w = {pack2(o[0], o[1]), pack2(o[2], o[3]), pack2(o[4], o[5]), pack2(o[6], o[7])};
        if (!lat) {
          *(u32x4*)(base + 1024 + lane * 8) = w;
          float* op = p.out + OUT_NAK + (size_t)tk * 256 + lane * 8;
          *(float4*)op = make_float4(o[0], o[1], o[2], o[3]);
          *(float4*)(op + 4) = make_float4(o[4], o[5], o[6], o[7]);
        } else *(u32x4*)(KA + arow * 256 + lane * 8) = w;
      } else {
        if (!lat) {
          float* op = p.out + OUT_NAV + (size_t)tk * 256 + (lane - 32) * 8;
          *(float4*)op = make_float4(x[0], x[1], x[2], x[3]);
          *(float4*)(op + 4) = make_float4(x[4], x[5], x[6], x[7]);
        } else *(u32x4*)(VA + arow * 256 + (lane - 32) * 8) = v[2];
      }
    }
    if (!lat) {
#pragma unroll
      for (int q = 0; q < 2; ++q) {
        float* ok = p.out + OUT_NBK + (size_t)tk * 1024 + (q * 64 + lane) * 8;
        float* ov = p.out + OUT_NBV + (size_t)tk * 1024 + (q * 64 + lane) * 8;
        *(float4*)ok = make_float4(bflo(kb[q][0]), bfhi(kb[q][0]), bflo(kb[q][1]), bfhi(kb[q][1]));
        *(float4*)(ok + 4) = make_float4(bflo(kb[q][2]), bfhi(kb[q][2]), bflo(kb[q][3]), bfhi(kb[q][3]));
        *(float4*)ov = make_float4(bflo(vb[q][0]), bfhi(vb[q][0]), bflo(vb[q][1]), bfhi(vb[q][1]));
        *(float4*)(ov + 4) = make_float4(bflo(vb[q][2]), bfhi(vb[q][2]), bflo(vb[q][3]), bfhi(vb[q][3]));
      }
    }
  }
}

DI void phase_norm1(const Params& p) {
  const int wave = TID() >> 6, lane = TID() & 63;
  const u16* LAT1 = (const u16*)(p.ws + OFF_LAT1);
  u16* QN = (u16*)(p.ws + OFF_QN);
  u16* CKVC = (u16*)(p.ws + OFF_CKV_CTX);
  u16* KRC = (u16*)(p.ws + OFF_KR_CTX);
  u16* CKVA = (u16*)(p.ws + OFF_CKV_ALL);
  u16* KRA = (u16*)(p.ws + OFF_KR_ALL);
  float gq[8], gk[8];
#pragma unroll
  for (int j = 0; j < 8; ++j) { gq[j] = p.l1_qan[lane * 8 + j]; gk[j] = p.l1_kvan[lane * 8 + j]; }
  const int ri = lane & 15, rhalf = (lane >> 4) & 1;
  const int rd1 = rhalf * 32 + ri, rd2 = rd1 + 16;
  const float inv = exp2f(-(float)ri * (LOG2_THETA / 16.f));
  for (int it = blockIdx.x; it < NTOK / NW; it += gridDim.x) {
    int tk = it * NW + wave;
    const u16* base = LAT1 + (size_t)tk * L1_LD;
    const bool lat = tk >= NCTX;
    int lt = tk - NCTX, b = lt >> 10, tt = lt & 1023;
    size_t arow = (size_t)b * 1536 + 512 + tt;
#pragma unroll
    for (int part = 0; part < 2; ++part) {
      uint4 v = *(const uint4*)(base + part * 512 + lane * 8);
      float x[8] = {bflo(v.x), bfhi(v.x), bflo(v.y), bfhi(v.y), bflo(v.z), bfhi(v.z), bflo(v.w), bfhi(v.w)};
      float ss = 0.f;
#pragma unroll
      for (int j = 0; j < 8; ++j) ss += x[j] * x[j];
      ss = wave_sum(ss);
      float rinv = rsqrtf(ss * (1.f / 512.f) + EPS);
#pragma unroll
      for (int j = 0; j < 8; ++j) x[j] = x[j] * rinv * (part ? gk[j] : gq[j]);
      uint4 o = make_uint4(pack2(x[0], x[1]), pack2(x[2], x[3]), pack2(x[4], x[5]), pack2(x[6], x[7]));
      if (part == 0) *(uint4*)(QN + (size_t)tk * 512 + lane * 8) = o;
      else if (!lat) {
        *(uint4*)(CKVC + (size_t)tk * 512 + lane * 8) = o;
        float* op = p.out + OUT_NCKV + (size_t)tk * 512 + lane * 8;
        *(float4*)op = make_float4(x[0], x[1], x[2], x[3]);
        *(float4*)(op + 4) = make_float4(x[4], x[5], x[6], x[7]);
      } else *(uint4*)(CKVA + arow * 512 + lane * 8) = o;
    }
  }
}

DI void phase_krope(const Params& p, char* smem) {
  const int t = TID(), wave = t >> 6, lane = t & 63, l31 = lane & 31, h = lane >> 5;
  const int tg = wave >> 2, kq = wave & 3;
  const u16* H = (const u16*)(p.ws + OFF_H);
  const u16* W = (const u16*)(p.ws + OFF_WT_IN1) + (size_t)3072 * 2048;
  u16* KRC = (u16*)(p.ws + OFF_KR_CTX);
  u16* KRA = (u16*)(p.ws + OFF_KR_ALL);
  const float* tab = (const float*)(p.ws + OFF_ROPE);
  constexpr int CLD = 256 + 8;
  u16* Hs = (u16*)smem;
  u16* Ws = Hs + 64 * CLD;
  float* red = (float*)smem;
  for (int it = blockIdx.x; it < NTOK / 64; it += gridDim.x) {
    const int tok = it * 64 + tg * 32 + l31;
    const u16* hg = H + (size_t)(it * 64 + (t >> 5)) * 2048 + (t & 31) * 8;
    const u16* wg = W + (size_t)(t >> 5) * 2048 + (t & 31) * 8;
    u32x4 rh[4], rw[4];
#pragma unroll
    for (int i = 0; i < 4; ++i) { rh[i] = *(const u32x4*)(hg + (size_t)(16 * i) * 2048); rw[i] = *(const u32x4*)(wg + (size_t)(16 * i) * 2048); }
    f32x16 c0, c1;
#pragma unroll
    for (int r = 0; r < 16; ++r) { c0[r] = 0.f; c1[r] = 0.f; }
#pragma unroll 1
    for (int kc = 0; kc < 8; ++kc) {
      __syncthreads();
#pragma unroll
      for (int i = 0; i < 4; ++i) {
        *(u32x4*)(Hs + ((t >> 5) + 16 * i) * CLD + (t & 31) * 8) = rh[i];
        *(u32x4*)(Ws + ((t >> 5) + 16 * i) * CLD + (t & 31) * 8) = rw[i];
      }
      __syncthreads();
      if (kc + 1 < 8) {
#pragma unroll
        for (int i = 0; i < 4; ++i) { rh[i] = *(const u32x4*)(hg + (size_t)(16 * i) * 2048 + (kc + 1) * 256); rw[i] = *(const u32x4*)(wg + (size_t)(16 * i) * 2048 + (kc + 1) * 256); }
      }
#pragma unroll
      for (int s = 0; s < 4; ++s) {
        const int ko = kq * 64 + 16 * s + 8 * h;
        const bf16x8 hb = *(const bf16x8*)(Hs + (tg * 32 + l31) * CLD + ko);
        const bf16x8 a0 = *(const bf16x8*)(Ws + l31 * CLD + ko);
        const bf16x8 a1 = *(const bf16x8*)(Ws + (32 + l31) * CLD + ko);
        c0 = MFMA32(a0, hb, c0);
        c1 = MFMA32(a1, hb, c1);
      }
    }
    __syncthreads();
#pragma unroll
    for (int r = 0; r < 16; ++r) { red[(wave * 32 + r) * 64 + lane] = c0[r]; red[(wave * 32 + 16 + r) * 64 + lane] = c1[r]; }
    __syncthreads();
    if (kq == 0) {
      float v[32];
#pragma unroll
      for (int r = 0; r < 32; ++r) {
        float a = 0.f;
#pragma unroll
        for (int q = 0; q < 4; ++q) a += red[((tg * 4 + q) * 32 + r) * 64 + lane];
        v[r] = a;
      }
      const bool lat = tok >= NCTX;
      const int lt = tok - NCTX, b = lt >> 10, tt = lt & 1023;
      if (lat) {
#pragma unroll
        for (int c = 0; c < 2; ++c) {
          const int pos = c ? (tt & 63) : (tt >> 6);
#pragma unroll
          for (int i = 0; i < 8; ++i) {
            const int n = (i & 3) + 8 * (i >> 2) + 4 * h;
            const float cs = tab[(pos * 16 + n) * 2], sn = tab[(pos * 16 + n) * 2 + 1];
            const float x1 = v[c * 16 + i], x2 = v[c * 16 + i + 8];
            v[c * 16 + i] = x1 * cs - x2 * sn;
            v[c * 16 + i + 8] = x2 * cs + x1 * sn;
          }
        }
      }
#pragma unroll
      for (int c = 0; c < 2; ++c)
#pragma unroll
        for (int g4 = 0; g4 < 4; ++g4) {
          const int n0 = 32 * c + 8 * g4 + 4 * h;
          const float o0 = v[c * 16 + 4 * g4], o1 = v[c * 16 + 4 * g4 + 1], o2 = v[c * 16 + 4 * g4 + 2], o3 = v[c * 16 + 4 * g4 + 3];
          const uint2 w = make_uint2(pack2(o0, o1), pack2(o2, o3));
          if (!lat) {
            *(uint2*)(KRC + (size_t)tok * 64 + n0) = w;
            *(float4*)(p.out + OUT_NKR + (size_t)tok * 64 + n0) = make_float4(o0, o1, o2, o3);
          } else {
            *(uint2*)(KRA + ((size_t)b * 1536 + 512 + tt) * 64 + n0) = w;
          }
        }
    }
  }
  __syncthreads();
}

DI void phase_final(const Params& p) {
  const int wave = TID() >> 6, lane = TID() & 63;
  const u16* X2 = (const u16*)(p.ws + OFF_Q1);
  for (int it = blockIdx.x; it < NTOK / NW; it += gridDim.x) {
    const int row = it * NW + wave;
    float* y = p.out + OUT_Y + (size_t)row * D;
    u32x4 v[4];
    float ss = 0.f;
#pragma unroll
    for (int i = 0; i < 4; ++i) {
      v[i] = *(const u32x4*)(X2 + (size_t)row * D + (i * 64 + lane) * 8);
#pragma unroll
      for (int j = 0; j < 4; ++j) { const float a0 = bflo(v[i][j]), a1 = bfhi(v[i][j]); ss += a0 * a0 + a1 * a1; }
    }
    ss = wave_sum(ss);
    const float rinv = rsqrtf(ss * (1.f / D) + EPS);
#pragma unroll
    for (int i = 0; i < 4; ++i) {
      const int col = (i * 64 + lane) * 8;
#pragma unroll
      for (int q = 0; q < 2; ++q) {
        const f32x4 gg = *(const f32x4*)(p.fnorm + col + 4 * q);
        f32x4 o = {bflo(v[i][2 * q]) * rinv * gg[0], bfhi(v[i][2 * q]) * rinv * gg[1], bflo(v[i][2 * q + 1]) * rinv * gg[2], bfhi(v[i][2 * q + 1]) * rinv * gg[3]};
        *(f32x4*)(y + col + 4 * q) = o;
      }
    }
  }
}

struct KVSeg { const u16* k; const u16* v; const u16* kr; int ks, vs, n; };
struct AttnArgs {
  const u16* q; int qs;
  KVSeg seg[2]; int nseg;
  const u16* gate; int gs;
  u16* out; int os;
  float scale_log2;
  const float* rpb;
  int qtok0;
  int rs0;
  int rope;
  const float* ropetab;
};

DI float xhalf_max(float v) {
  unsigned u = __float_as_uint(v);
  auto r = __builtin_amdgcn_permlane32_swap(u, u, false, false);
  return fmaxf(__uint_as_float(r[0]), __uint_as_float(r[1]));
}
DI int swz16(int r) { return ((r & 3) << 2) | ((r >> 2) & 3); }

template <int DQK, int MODE>
DI void attn_issue_tile(const AttnArgs& a, int tile, int nt0, LDS_AS(unsigned char)* slot, int wave, int lane) {
  const int sg = tile >= nt0 ? 1 : 0;
  const int off = (sg ? tile - nt0 : tile) * 64;
  const u16* kp = sg ? a.seg[1].k : a.seg[0].k;
  const u16* vp = sg ? a.seg[1].v : a.seg[0].v;
  const int ks = sg ? a.seg[1].ks : a.seg[0].ks;
  const int vs = sg ? a.seg[1].vs : a.seg[0].vs;
  const int sw = ((lane >> 4) << 2) | (wave & 3);
  const int ch = (lane & 15) ^ sw;
#pragma unroll
  for (int j = 0; j < 2; ++j) {
    const int row = off + (j * 8 + wave) * 4 + (lane >> 4);
    __builtin_amdgcn_global_load_lds((const unsigned*)(kp + (unsigned)(row * ks + ch * 8)), (LDS_AS(unsigned)*)(slot + (j * 8 + wave) * 1024), 16, 0, 0);
    __builtin_amdgcn_global_load_lds((const unsigned*)(vp + (unsigned)(row * vs + ch * 8)), (LDS_AS(unsigned)*)(slot + 16384 + (j * 8 + wave) * 1024), 16, 0, 0);
  }
  if constexpr (MODE == 2) {
    const u16* krp = sg ? a.seg[1].kr : a.seg[0].kr;
    const int row = wave * 8 + (lane >> 3);
    const int c2 = (lane & 7) ^ ((row >> 1) & 7);
    __builtin_amdgcn_global_load_lds((const unsigned*)(krp + (unsigned)((off + row) * 64 + c2 * 8)), (LDS_AS(unsigned)*)(slot + 32768 + wave * 1024), 16, 0, 0);
  }
}

template <int DQK, int MODE>
DI void attn_block(const AttnArgs& a, LDS_AS(unsigned char)* lds) {
  constexpr int NS = DQK / 16;
  constexpr int SLOTB = (MODE == 2) ? 40960 : 32768;
  constexpr int NLOAD = (MODE == 2) ? 5 : 4;
  LDS_AS(float)* bias_s = (LDS_AS(float)*)(lds + 3 * SLOTB);
  const int t = TID(), wave = __builtin_amdgcn_readfirstlane(t >> 6), lane = t & 63, l31 = lane & 31, h = lane >> 5;

  __syncthreads();
  if constexpr (MODE == 1) {
    for (int e = t; e < 15 * 31; e += NT) bias_s[e] = a.rpb[e] * LOG2E;
    __syncthreads();
  }
  int ntiles = 0;
  for (int s = 0; s < a.nseg; ++s) ntiles += a.seg[s].n >> 6;
  const int nt0 = a.seg[0].n >> 6;
  bf16x8 qf[NS];
  {
    const u16* qp = a.q + (size_t)(wave * 32 + l31) * a.qs + 8 * h;
#pragma unroll
    for (int s = 0; s < NS; ++s) qf[s] = *(const bf16x8*)(qp + 16 * s);
  }
  attn_issue_tile<DQK, MODE>(a, 0, nt0, lds, wave, lane);
  attn_issue_tile<DQK, MODE>(a, ntiles > 1 ? 1 : 0, nt0, lds + SLOTB, wave, lane);
  const int qtok = a.qtok0 + wave * 32 + l31;
  if constexpr (MODE == 2) {
    if (a.rope) {
      const int qr = qtok >> 6, qc = qtok & 63;
#pragma unroll
      for (int pr = 0; pr < 2; ++pr) {
        const float4* tb = (const float4*)(a.ropetab + ((pr ? qc : qr) * 16 + 8 * h) * 2);
#pragma unroll
        for (int j2 = 0; j2 < 4; ++j2) {
          float4 cssn = tb[j2];
#pragma unroll
          for (int e = 0; e < 2; ++e) {
            const int j = 2 * j2 + e;
            float cs = e ? cssn.z : cssn.x, sn = e ? cssn.w : cssn.y;
            float x1 = bf2f((u16)qf[8 + 2 * pr][j]), x2 = bf2f((u16)qf[9 + 2 * pr][j]);
            qf[8 + 2 * pr][j] = (short)f2bf(x1 * cs - x2 * sn);
            qf[9 + 2 * pr][j] = (short)f2bf(x2 * cs + x1 * sn);
          }
        }
      }
    }
  }
  f32x16 acc[4];
#pragma unroll
  for (int c = 0; c < 4; ++c)
#pragma unroll
    for (int r = 0; r < 16; ++r) acc[c][r] = 0.f;
  float m_run = -1e30f, l_run = 0.f;

  const int blk = (lane >> 4) & 1, tq = (lane & 15) >> 2, tp = lane & 3;
  const int kswz = swz16(l31);
  const int kb0 = l31 * 256 + ((h ^ (kswz & 1)) << 4);
  const int ksw = kswz >> 1;
  const int kr0 = 32768 + l31 * 128;
  const int krsw = (l31 >> 1) & 7;
  const int vlow0 = (2 * blk + (tp >> 1)) ^ (h & 3);
  const int vlow1 = (2 * blk + (tp >> 1)) ^ ((2 + h) & 3);
  const int vb0 = 16384 + (4 * h + tq) * 256 + (vlow0 << 4) + 8 * (tp & 1);
  const int vb1 = 16384 + (8 + 4 * h + tq) * 256 + (vlow1 << 4) + 8 * (tp & 1);
  const int qrow = qtok >> 6, qcol = qtok & 63;
  int q_rs = qrow - 4; q_rs = q_rs < 0 ? 0 : (q_rs > 8 ? 8 : q_rs);
  int q_cs = qcol - 8; q_cs = q_cs < 0 ? 0 : (q_cs > 48 ? 48 : q_cs);

  int sl = 0;
  for (int tile = 0; tile < ntiles; ++tile) {
    if constexpr (NLOAD == 5) asm volatile("s_waitcnt vmcnt(5)" ::: "memory"); else asm volatile("s_waitcnt vmcnt(4)" ::: "memory");
    __builtin_amdgcn_s_barrier();
    asm volatile("" ::: "memory");
    {
      int nx = tile + 2; nx = nx < ntiles ? nx : ntiles - 1;
      int sn = sl + 2; sn = sn >= 3 ? sn - 3 : sn;
      attn_issue_tile<DQK, MODE>(a, nx, nt0, lds + sn * SLOTB, wave, lane);
    }
    LDS_AS(unsigned char)* slot = lds + sl * SLOTB;
    sl = sl == 2 ? 0 : sl + 1;

    const bool local = (MODE == 1) && (tile >= nt0);
    const int krow = a.rs0 + (tile - nt0);
#pragma unroll 1
    for (int mt = 0; mt < 2; ++mt) {
      f32x16 S;
#pragma unroll
      for (int r = 0; r < 16; ++r) S[r] = 0.f;
      LDS_AS(unsigned char)* kbase = slot + mt * 8192 + kb0;
#pragma unroll
      for (int s = 0; s < 8; ++s) {
        bf16x8 kf = *(const LDS_AS(bf16x8)*)(kbase + ((s ^ ksw) << 5));
        S = MFMA32(kf, qf[s], S);
      }
      if constexpr (MODE == 2) {
        LDS_AS(unsigned char)* rbase = slot + mt * 4096 + kr0;
#pragma unroll
        for (int s2 = 0; s2 < 4; ++s2) {
          bf16x8 kf = *(const LDS_AS(bf16x8)*)(rbase + (((2 * s2 + h) ^ krsw) << 4));
          S = MFMA32(kf, qf[8 + s2], S);
        }
      }
      float mx = -1e30f;
      float m_new, alpha;
      float ps = 0.f;
      const float m_old = m_run;
      if constexpr (MODE == 1) {
#pragma unroll
        for (int r = 0; r < 16; ++r) {
          float sv = S[r] * a.scale_log2;
          if (local) {
            int kcol = mt * 32 + crow(r, h);
            bool ok = (krow >= q_rs) && (krow < q_rs + 8) && (kcol >= q_cs) && (kcol < q_cs + 16);
            int dy = krow - qrow + 7, dx = kcol - qcol + 15;
            dy = dy < 0 ? 0 : (dy > 14 ? 14 : dy);
            dx = dx < 0 ? 0 : (dx > 30 ? 30 : dx);
            const float bv = bias_s[dy * 31 + dx];
            sv = ok ? sv + bv : -1e30f;
          }
          S[r] = sv;
          mx = fmaxf(mx, sv);
        }
        mx = xhalf_max(mx);
        m_new = fmaxf(m_run, mx);
        alpha = __builtin_amdgcn_exp2f(m_run - m_new);
        m_run = m_new;
#pragma unroll
        for (int r = 0; r < 16; ++r) {
          float pv = __builtin_amdgcn_exp2f(S[r] - m_new);
          if (S[r] <= -1e29f) pv = 0.f;
          S[r] = pv;
          ps += pv;
        }
      } else {
#pragma unroll
        for (int r = 0; r < 16; ++r) mx = fmaxf(mx, S[r]);
        mx = xhalf_max(mx) * a.scale_log2;
        m_new = fmaxf(m_run, mx);
        alpha = __builtin_amdgcn_exp2f(m_run - m_new);
        m_run = m_new;
        const float nm = -m_new;
#pragma unroll
        for (int r = 0; r < 16; ++r) {
          float pv = __builtin_amdgcn_exp2f(__builtin_fmaf(S[r], a.scale_log2, nm));
          S[r] = pv;
          ps += pv;
        }
      }
      l_run = l_run * alpha + ps;
      if (__builtin_amdgcn_ballot_w64(m_new != m_old) != 0) {
#pragma unroll
        for (int c = 0; c < 4; ++c)
#pragma unroll
          for (int r = 0; r < 16; ++r) acc[c][r] *= alpha;
      }
      bf16x8 pf[2];
#pragma unroll
      for (int s2 = 0; s2 < 2; ++s2) {
        u32x4 u;
        u[0] = pack2(S[8 * s2 + 0], S[8 * s2 + 1]);
        u[1] = pack2(S[8 * s2 + 2], S[8 * s2 + 3]);
        u[2] = pack2(S[8 * s2 + 4], S[8 * s2 + 5]);
        u[3] = pack2(S[8 * s2 + 6], S[8 * s2 + 7]);
        pf[s2] = __builtin_bit_cast(bf16x8, u);
      }
      const unsigned vaddr = (unsigned)(size_t)(slot + mt * 8192);
#pragma unroll
      for (int c0 = 0; c0 < 4; c0 += 2) {
        const unsigned a0 = vaddr + vb0 + ((c0 ^ tq) << 6), a1 = vaddr + vb1 + ((c0 ^ tq) << 6);
        const unsigned a2 = vaddr + vb0 + (((c0 + 1) ^ tq) << 6), a3 = vaddr + vb1 + (((c0 + 1) ^ tq) << 6);
        s16x4 r0, r1, r2, r3, r4, r5, r6, r7;
        asm volatile(
            "ds_read_b64_tr_b16 %0, %8\n\t"
            "ds_read_b64_tr_b16 %1, %9\n\t"
            "ds_read_b64_tr_b16 %2, %8 offset:4096\n\t"
            "ds_read_b64_tr_b16 %3, %9 offset:4096\n\t"
            "ds_read_b64_tr_b16 %4, %10\n\t"
            "ds_read_b64_tr_b16 %5, %11\n\t"
            "ds_read_b64_tr_b16 %6, %10 offset:4096\n\t"
            "ds_read_b64_tr_b16 %7, %11 offset:4096\n\t"
            "s_waitcnt lgkmcnt(0)"
            : "=&v"(r0), "=&v"(r1), "=&v"(r2), "=&v"(r3), "=&v"(r4), "=&v"(r5), "=&v"(r6), "=&v"(r7)
            : "v"(a0), "v"(a1), "v"(a2), "v"(a3)
            : "memory");
        acc[c0] = MFMA32(__builtin_shufflevector(r0, r1, 0, 1, 2, 3, 4, 5, 6, 7), pf[0], acc[c0]);
        acc[c0] = MFMA32(__builtin_shufflevector(r2, r3, 0, 1, 2, 3, 4, 5, 6, 7), pf[1], acc[c0]);
        acc[c0 + 1] = MFMA32(__builtin_shufflevector(r4, r5, 0, 1, 2, 3, 4, 5, 6, 7), pf[0], acc[c0 + 1]);
        acc[c0 + 1] = MFMA32(__builtin_shufflevector(r6, r7, 0, 1, 2, 3, 4, 5, 6, 7), pf[1], acc[c0 + 1]);
      }
    }
  }
  asm volatile("s_waitcnt vmcnt(0)" ::: "memory");
  float l_tot = l_run + __shfl_xor(l_run, 32);
  float linv = 1.f / l_tot;
  const size_t qrow_i = (size_t)(wave * 32 + l31);
#pragma unroll
  for (int c = 0; c < 4; ++c)
#pragma unroll
    for (int g4 = 0; g4 < 4; ++g4) {
      int dv0 = 32 * c + 8 * g4 + 4 * h;
      uint2 gt = *(const uint2*)(a.gate + qrow_i * a.gs + dv0);
      float o0 = acc[c][4 * g4 + 0] * linv * silu(bflo(gt.x));
      float o1 = acc[c][4 * g4 + 1] * linv * silu(bfhi(gt.x));
      float o2 = acc[c][4 * g4 + 2] * linv * silu(bflo(gt.y));
      float o3 = acc[c][4 * g4 + 3] * linv * silu(bfhi(gt.y));
      *(uint2*)(a.out + qrow_i * a.os + dv0) = make_uint2(pack2(o0, o1), pack2(o2, o3));
    }
}

DI void phase_attn0(const Params& p, LDS_AS(unsigned char)* smem) {
  const u16* QKVG = (const u16*)(p.ws + OFF_BIG);
  u16* OG = (u16*)(p.ws + OFF_H);
  const u16* KA = (const u16*)(p.ws + OFF_KA_ALL);
  const u16* VA = (const u16*)(p.ws + OFF_VA_ALL);
  const u16* KBC = (const u16*)(p.ws + OFF_KB_CTX);
  const u16* VBC = (const u16*)(p.ws + OFF_VB_CTX);
  const float sc = 0.08838834764831845f * LOG2E;
  for (int it = blockIdx.x; it < 1024; it += gridDim.x) {
    AttnArgs a;
    a.qs = L0_IN; a.gs = L0_IN; a.os = D; a.scale_log2 = sc; a.rpb = nullptr; a.qtok0 = 0; a.rs0 = 0; a.rope = 0; a.ropetab = nullptr;
    a.seg[1].k = nullptr; a.seg[1].v = nullptr; a.seg[1].kr = nullptr; a.seg[1].ks = 0; a.seg[1].vs = 0; a.seg[1].n = 0;
    a.seg[0].kr = nullptr;
    if (it >= 256 && it < 512) {
      int i = it - 256;
      int bh = (i >> 5) * 8 + (i & 7), qb = (i >> 3) & 3;
      int b = bh >> 3, hh = bh & 7;
      size_t tok = (size_t)NCTX + b * 1024 + qb * 256;
      a.q = QKVG + tok * L0_IN + 1536 + hh * 128;
      a.gate = QKVG + tok * L0_IN + 4608 + 1024 + hh * 128;
      a.out = OG + tok * D + 1024 + hh * 128;
      a.nseg = 2;
      a.seg[0].k = KBC + (size_t)b * 512 * 1024 + hh * 128; a.seg[0].ks = 1024;
      a.seg[0].v = VBC + (size_t)b * 512 * 1024 + hh * 128; a.seg[0].vs = 1024;
      a.seg[0].n = 512;
      int rs0 = 4 * qb - 4; rs0 = rs0 < 0 ? 0 : (rs0 > 8 ? 8 : rs0);
      int rs1 = 4 * qb - 1; rs1 = rs1 < 0 ? 0 : (rs1 > 8 ? 8 : rs1);
      int nrows = rs1 + 8 - rs0;
      size_t ktok = (size_t)NCTX + b * 1024 + rs0 * 64;
      a.seg[1].k = QKVG + ktok * L0_IN + 2560 + hh * 128; a.seg[1].ks = L0_IN;
      a.seg[1].v = QKVG + ktok * L0_IN + 3584 + hh * 128; a.seg[1].vs = L0_IN;
      a.seg[1].n = nrows * 64;
      a.rpb = p.l0_rpb + hh * 15 * 31;
      a.qtok0 = qb * 256; a.rs0 = rs0;
      attn_block<128, 1>(a, smem);
    } else {
      a.nseg = 1;
      if (it < 256) {
        int g = (it >> 7) * 8 + (it & 7), j = (it >> 3) & 15;
        int b = g >> 1, hq = (g & 1) * 4 + (j >> 2), qb = j & 3;
        size_t tok = (size_t)NCTX + b * 1024 + qb * 256;
        a.q = QKVG + tok * L0_IN + hq * 128;
        a.gate = QKVG + tok * L0_IN + 4608 + hq * 128;
        a.out = OG + tok * D + hq * 128;
        a.seg[0].k = KA + (size_t)b * 1536 * 256 + (hq >> 2) * 128; a.seg[0].ks = 256;
        a.seg[0].v = VA + (size_t)b * 1536 * 256 + (hq >> 2) * 128; a.seg[0].vs = 256;
        a.seg[0].n = 1536;
      } else {
        int i = it - 512;
        bool isB = i >= 256; i &= 255;
        int g = (i >> 5) * 8 + (i & 7), j = (i >> 3) & 3;
        int b = isB ? (i >> 3) : (g >> 1), hh = isB ? (i & 7) : ((g & 1) * 4 + j);
        size_t tok = (size_t)b * 256;
        a.seg[0].n = 256; a.seg[0].ks = L0_IN; a.seg[0].vs = L0_IN;
        if (!isB) {
          a.q = QKVG + tok * L0_IN + hh * 128;
          a.gate = QKVG + tok * L0_IN + 4608 + hh * 128;
          a.out = OG + tok * D + hh * 128;
          a.seg[0].k = QKVG + tok * L0_IN + 1024 + (hh >> 2) * 128;
          a.seg[0].v = QKVG + tok * L0_IN + 1280 + (hh >> 2) * 128;
        } else {
          a.q = QKVG + tok * L0_IN + 1536 + hh * 128;
          a.gate = QKVG + tok * L0_IN + 4608 + 1024 + hh * 128;
          a.out = OG + tok * D + 1024 + hh * 128;
          a.seg[0].k = QKVG + tok * L0_IN + 2560 + hh * 128;
          a.seg[0].v = QKVG + tok * L0_IN + 3584 + hh * 128;
        }
      }
      attn_block<128, 0>(a, smem);
    }
  }
}

DI void phase_attn1(const Params& p, LDS_AS(unsigned char)* smem, int round) {
  const u16* Q1 = (const u16*)(p.ws + OFF_Q1);
  u16* LAT1 = (u16*)(p.ws + OFF_LAT1);
  const float sc = 0.07216878364870322f * LOG2E;
  for (int it = blockIdx.x; it < 512; it += gridDim.x) {
    AttnArgs a;
    a.qs = 3072; a.gs = L1_LD; a.os = L1_LD; a.scale_log2 = sc; a.rpb = nullptr; a.rs0 = 0; a.ropetab = (const float*)(p.ws + OFF_ROPE);
    a.seg[1].k = nullptr; a.seg[1].v = nullptr; a.seg[1].kr = nullptr; a.seg[1].ks = 0; a.seg[1].vs = 0; a.seg[1].n = 0;
    a.nseg = 1;
    a.seg[0].ks = 4096; a.seg[0].vs = 4096;
    size_t tok;
    int hh;
    if (round == 0) {
      int b = it >> 4; hh = it & 15;
      tok = (size_t)b * 256;
      const u16* KV = (const u16*)(p.ws + OFF_KV_CTX) + (size_t)b * 256 * 4096 + hh * 256;
      a.seg[0].k = KV; a.seg[0].v = KV + 128;
      a.seg[0].kr = (const u16*)(p.ws + OFF_KR_CTX) + (size_t)b * 256 * 64;
      a.seg[0].n = 256;
      a.rope = 0; a.qtok0 = 0;
    } else {
      int bh = (it >> 5) * 8 + (it & 7), qb = (it >> 3) & 3;
      int b = bh >> 4; hh = bh & 15;
      tok = (size_t)NCTX + b * 1024 + qb * 256;
      const u16* KV = (const u16*)(p.ws + OFF_KV_LAT) + (size_t)b * 1536 * 4096 + hh * 256;
      a.seg[0].k = KV; a.seg[0].v = KV + 128;
      a.seg[0].kr = (const u16*)(p.ws + OFF_KR_ALL) + (size_t)b * 1536 * 64;
      a.seg[0].n = 1536;
      a.rope = 1; a.qtok0 = qb * 256;
    }
    a.q = Q1 + tok * 3072 + hh * 192;
    a.gate = LAT1 + tok * L1_LD + L1_GATE + hh * 128;
    a.out = LAT1 + tok * L1_LD + L1_GATE + hh * 128;
    attn_block<192, 2>(a, smem);
  }
}

#define XB_TMO      128
#define XB_XCNT(j)  (256  + 64 * (j))
#define XB_XSUB(j)  (1280 + 64 * (j))
#define XB_XGEN(j)  (2304 + 64 * (j))
#define XB_TOP      3328
#define XB_TOPGEN   3392
#define XCD_BAR_WORDS 3456
#define XB_SPIN_CAP (1u << 18)
#define XLAS __attribute__((address_space(3)))

__device__ __forceinline__ unsigned xb_ld(unsigned* p)              { return __hip_atomic_load(p, __ATOMIC_RELAXED, __HIP_MEMORY_SCOPE_AGENT); }
__device__ __forceinline__ unsigned xb_add(unsigned* p, unsigned v) { return __hip_atomic_fetch_add(p, v, __ATOMIC_RELAXED, __HIP_MEMORY_SCOPE_AGENT); }
__device__ __forceinline__ unsigned xb_xcc_id() { return (unsigned)__builtin_amdgcn_s_getreg((3 << 11) | 20) & 0xFu; }
#define XB_SPIN(cond, bar) do { unsigned _sp = 0; while (cond) { __builtin_amdgcn_s_sleep(1); \
    if ((++_sp & 255u) == 0u) { if (xb_ld(&(bar)[XB_TMO])) break; if (_sp > XB_SPIN_CAP) { atomicAdd(&(bar)[XB_TMO], 1u); break; } } } } while (0)

struct XcdBarrier {
    unsigned* bar; unsigned x;
    volatile XLAS unsigned* st;
};

__device__ __forceinline__ XcdBarrier xcd_barrier_post(unsigned* bar, volatile XLAS unsigned* st) {
    XcdBarrier b; b.bar = bar; b.x = xb_xcc_id(); b.st = st;
    if (threadIdx.x == 0) (void)xb_add(&bar[XB_XCNT(b.x)], 1u);
    return b;
}
__device__ __forceinline__ void xcd_barrier_complete(unsigned* bar, unsigned x, unsigned& nloc, unsigned& nx) {
    const unsigned G = gridDim.x * gridDim.y * gridDim.z;
    unsigned sum, cnt, mine, sp = 0u;
    for (;;) {
        sum = 0u; cnt = 0u; mine = 0u;
#pragma unroll
        for (unsigned j = 0; j < 16; ++j) { const unsigned c = xb_ld(&bar[XB_XCNT(j)]); sum += c; cnt += (c > 0u) ? 1u : 0u; mine = (j == x) ? c : mine; }
        if (sum == G) break;
        __builtin_amdgcn_s_sleep(1);
        if ((++sp & 255u) == 0u) { if (xb_ld(&bar[XB_TMO])) break; if (sp > XB_SPIN_CAP) { atomicAdd(&bar[XB_TMO], 1u); break; } }
    }
    nloc = mine > 0u ? mine : 1u; nx = cnt > 0u ? cnt : 1u;
}

__device__ __forceinline__ void xcd_barrier(const XcdBarrier& b) {
    asm volatile("s_waitcnt vmcnt(0)" ::: "memory");
    __syncthreads();
    if (threadIdx.x == 0) {
        unsigned* bar = b.bar;
        __builtin_amdgcn_s_waitcnt(0);
        unsigned nloc = b.st[0], nx = b.st[1];
        if (nloc == 0u) { xcd_barrier_complete(bar, b.x, nloc, nx); b.st[0] = nloc; b.st[1] = nx; }
        const unsigned old = xb_add(&bar[XB_XSUB(b.x)], 1u);
        const unsigned gen = old / nloc;
        if (old + 1u == (gen + 1u) * nloc) {
            __builtin_amdgcn_fence(__ATOMIC_RELEASE, "agent");
            asm volatile("s_waitcnt vmcnt(0)" ::: "memory");
            const unsigned og = xb_add(&bar[XB_TOP], 1u);
            const unsigned tg = og / nx;
            if (og + 1u == (tg + 1u) * nx) xb_add(&bar[XB_TOPGEN], 1u);
            else XB_SPIN(xb_ld(&bar[XB_TOPGEN]) == tg, bar);
            __builtin_amdgcn_fence(__ATOMIC_ACQUIRE, "agent");
            xb_add(&bar[XB_XGEN(b.x)], 1u);
            asm volatile("s_waitcnt vmcnt(0)" ::: "memory");
        } else {
            XB_SPIN(xb_ld(&bar[XB_XGEN(b.x)]) == gen, bar);
            __builtin_amdgcn_fence(__ATOMIC_ACQUIRE, "agent");
            asm volatile("s_waitcnt vmcnt(0)" ::: "memory");
        }
    }
    __syncthreads();
}

__global__ void __launch_bounds__(512, 2) fwd_megakernel(Params p) {
  cg::grid_group grid = cg::this_grid();
  extern __shared__ __attribute__((aligned(16))) unsigned char dsm[];
  char* smem = (char*)dsm;
  char* ws = p.ws;
  const float* mod0 = (const float*)(ws + OFF_MOD);
  const float* mod1 = mod0 + 9 * 6144;

  volatile XLAS unsigned* xst = (volatile XLAS unsigned*)((XLAS unsigned char*)dsm + 128 * 1024);
  if (threadIdx.x < 4) xst[threadIdx.x] = 0u;
  __syncthreads();
  const XcdBarrier xb = xcd_barrier_post((unsigned*)(ws + OFF_BAR), xst);
  phase_prep(p, smem);
  if (p.out == nullptr) grid.sync();
  xcd_barrier(xb);
  phase_normmod(p, 0);
  xcd_barrier(xb);
  { EpiBf16 e{(u16*)(ws + OFF_BIG), L0_IN};
    gemm_run((PG8_LAS unsigned char*)dsm, (const u16*)(ws + OFF_H), D, (const u16*)(ws + OFF_WT_IN0), NTOK, L0_IN, 2048, e); }
  if (gridDim.x == 256) { if (blockIdx.x >= 128 && blockIdx.x < 224) adaln_item(p, 1, blockIdx.x - 128, (float*)smem); }
  else { for (int c = blockIdx.x; c < 96; c += gridDim.x) adaln_item(p, 1, c, (float*)smem); }
  xcd_barrier(xb);
  phase_qknorm0(p);
  xcd_barrier(xb);
#pragma unroll 1
  for (int rep = 0; rep < REP_A0; ++rep) phase_attn0(p, (LDS_AS(unsigned char)*)dsm);
  xcd_barrier(xb);
  { EpiResidB<false> e{p.x_prompt, p.x_sample, mod0 + 4096, (u16*)(p.out + OUT_Y)};
    gemm_run((PG8_LAS unsigned char*)dsm, (const u16*)(ws + OFF_H), D, (const u16*)(ws + OFF_WT_OUT0), NTOK, D, 2048, e); }
  xcd_barrier(xb);
  phase_normmod1(p);
  xcd_barrier(xb);
  { EpiBf16 e{(u16*)(ws + OFF_LAT1), L1_LD};
    gemm_run((PG8_LAS unsigned char*)dsm, (const u16*)(ws + OFF_H), D, (const u16*)(ws + OFF_WT_IN1), NTOK, L1_LD, 2048, e); }
  xcd_barrier(xb);
  phase_krope(p, smem);
  phase_norm1(p);
  xcd_barrier(xb);
  { EpiBf16 e{(u16*)(ws + OFF_Q1), 3072};
    gemm_run((PG8_LAS unsigned char*)dsm, (const u16*)(ws + OFF_QN), 512, (const u16*)(ws + OFF_WT_QB), NTOK, 3072, 512, e); }
#pragma unroll 1
  for (int round = 0; round < 2; ++round) {
    { EpiBf16 e{(u16*)(ws + (round ? OFF_KV_LAT : OFF_KV_CTX)), 4096};
      gemm_run((PG8_LAS unsigned char*)dsm, (const u16*)(ws + (round ? OFF_CKV_ALL : OFF_CKV_CTX)), 512, (const u16*)(ws + OFF_WT_KVB),
               round ? 12288 : NCTX, 4096, 512, e); }
    xcd_barrier(xb);
    phase_attn1(p, (LDS_AS(unsigned char)*)dsm, round);
    xcd_barrier(xb);
  }
  { EpiResidB<true> e{p.out + OUT_Y, nullptr, mod1 + 4096, (u16*)(ws + OFF_Q1)};
    gemm_run((PG8_LAS unsigned char*)dsm, (const u16*)(ws + OFF_LAT1) + L1_GATE, L1_LD, (const u16*)(ws + OFF_WT_OUT1), NTOK, D, 2048, e); }
  xcd_barrier(xb);
  phase_final(p);
}

extern "C" void kernel_launch(void* const* d_in, const int* in_sizes, int n_in, void* d_out, int out_size, void* d_ws,
                              size_t ws_size, hipStream_t stream) {
  (void)in_sizes; (void)n_in; (void)out_size;
  if (ws_size < WS_NEEDED) { fprintf(stderr, "workspace too small: %zu < %zu\n", ws_size, (size_t)WS_NEEDED); return; }
  static int grid_blocks = 0;
  if (!grid_blocks) {
    int dev = 0, cus = 0, per_cu = 0;
    (void)hipGetDevice(&dev);
    (void)hipDeviceGetAttribute(&cus, hipDeviceAttributeMultiprocessorCount, dev);
    if (hipFuncSetAttribute((const void*)fwd_megakernel, hipFuncAttributeMaxDynamicSharedMemorySize, SMEM_BYTES) != hipSuccess) {
      fprintf(stderr, "hipFuncSetAttribute failed\n"); return; }
    (void)hipOccupancyMaxActiveBlocksPerMultiprocessor(&per_cu, fwd_megakernel, NT, SMEM_BYTES);
    if (per_cu < 1) { fprintf(stderr, "occupancy query returned %d\n", per_cu); return; }
    grid_blocks = cus;
  }
  Params p{};
  const float** pf = (const float**)&p;
  for (int i = 0; i < 28; ++i) pf[i] = (const float*)d_in[i];
  p.out = (float*)d_out;
  p.ws = (char*)d_ws;
  (void)hipMemsetAsync((char*)d_ws + OFF_BAR, 0, BAR_BYTES, stream);
  void* args[] = {&p};
  hipError_t e = hipLaunchCooperativeKernel((void*)fwd_megakernel, dim3(grid_blocks), dim3(NT), args, SMEM_BYTES, stream);
  if (e != hipSuccess) fprintf(stderr, "cooperative launch failed: %s (grid %d)\n", hipGetErrorString(e), grid_blocks);
}
```

```cpp
#include <hip/hip_runtime.h>
#include <hip/hip_cooperative_groups.h>
#include <cstdio>
namespace cg = cooperative_groups;

typedef unsigned short u16;
using bf16x8 = __attribute__((ext_vector_type(8))) short;
using s16x4  = __attribute__((ext_vector_type(4))) short;
using f32x16 = __attribute__((ext_vector_type(16))) float;
using f32x4  = __attribute__((ext_vector_type(4))) float;
using u32x4  = __attribute__((ext_vector_type(4))) unsigned;
typedef __bf16 bf16x2_t __attribute__((ext_vector_type(2)));
typedef float f32x2_t __attribute__((ext_vector_type(2)));
#define DI __device__ __forceinline__
#define MFMA32(a, b, c) __builtin_amdgcn_mfma_f32_32x32x16_bf16((a), (b), (c), 0, 0, 0)
#define LDS_AS(T) __attribute__((address_space(3))) T

constexpr int D = 2048;
constexpr int NTOK = 16384;
constexpr int NCTX = 8192;
constexpr int L0_IN = 6656;
constexpr int L1_IN = 3136;
constexpr int L1_LD = 3072;
constexpr int L1_GATE = 1024;
constexpr float EPS = 1e-6f;
constexpr float LOG2E = 1.4426950408889634f;
constexpr float LOG2_THETA = 13.287712379549449f;
#ifndef REP_G
#define REP_G 1
#endif
#ifndef REP_A0
#define REP_A0 1
#endif
constexpr int NT = 512;
constexpr int NW = 8;

constexpr size_t OFF_WT_IN1  = 0;
constexpr size_t OFF_WT_QB   = OFF_WT_IN1 + (size_t)3328 * 2048 * 2;
constexpr size_t OFF_WT_KVB  = OFF_WT_QB + (size_t)3072 * 512 * 2;
constexpr size_t OFF_WT_OUT1 = OFF_WT_KVB + (size_t)4096 * 512 * 2;
constexpr size_t OFF_WL0     = OFF_WT_OUT1 + (size_t)2048 * 2048 * 2;
constexpr size_t OFF_WT_IN0  = OFF_WL0;
constexpr size_t OFF_WT_OUT0 = OFF_WT_IN0 + (size_t)6656 * 2048 * 2;
constexpr size_t OFF_H       = OFF_WT_OUT0 + (size_t)2048 * 2048 * 2;
constexpr size_t OFF_BIG     = OFF_H + (size_t)NTOK * 2048 * 2;
constexpr size_t OFF_C       = OFF_BIG + (size_t)NTOK * 6656 * 2;
constexpr size_t OFF_KA_ALL  = OFF_C;
constexpr size_t OFF_VA_ALL  = OFF_KA_ALL + (size_t)8 * 1536 * 256 * 2;
constexpr size_t OFF_KB_CTX  = OFF_VA_ALL + (size_t)8 * 1536 * 256 * 2;
constexpr size_t OFF_VB_CTX  = OFF_KB_CTX + (size_t)8 * 512 * 1024 * 2;
constexpr size_t OFF_CKV_ALL = OFF_VB_CTX + (size_t)8 * 512 * 1024 * 2;
constexpr size_t OFF_KR_ALL  = OFF_CKV_ALL + (size_t)8 * 1536 * 512 * 2;
constexpr size_t OFF_MOD     = OFF_KR_ALL + (size_t)8 * 1536 * 64 * 2;
constexpr size_t OFF_ROPE    = OFF_MOD + (size_t)2 * 9 * 6144 * 4;
constexpr size_t OFF_ROPE0   = OFF_ROPE + (size_t)64 * 16 * 2 * 4;
constexpr size_t OFF_BAR     = OFF_ROPE0 + (size_t)64 * 32 * 2 * 4;
constexpr size_t BAR_BYTES   = 3456 * 4;
constexpr size_t WS_NEEDED   = OFF_BAR + BAR_BYTES;
constexpr size_t OFF_QN      = OFF_WL0;
constexpr size_t OFF_CKV_CTX = OFF_QN + (size_t)NTOK * 512 * 2;
constexpr size_t OFF_KR_CTX  = OFF_CKV_CTX + (size_t)NCTX * 512 * 2;
constexpr size_t OFF_KV_CTX  = OFF_H;
constexpr size_t OFF_KV_LAT  = OFF_WL0;
constexpr size_t OFF_LAT1    = OFF_BIG;
constexpr size_t OFF_Q1      = OFF_BIG + (size_t)NTOK * L1_LD * 2;
static_assert(OFF_KR_CTX + (size_t)NCTX * 64 * 2 <= OFF_WT_OUT0, "l1 small bufs overflow");
static_assert(OFF_KV_LAT + (size_t)12288 * 4096 * 2 <= OFF_BIG, "kv_lat overflow");
static_assert(OFF_Q1 + (size_t)NTOK * 3072 * 2 <= OFF_C, "q1 overflow");

constexpr size_t OUT_Y   = 0;
constexpr size_t OUT_NAK = (size_t)NTOK * 2048;
constexpr size_t OUT_NAV = OUT_NAK + (size_t)NCTX * 256;
constexpr size_t OUT_NBK = OUT_NAV + (size_t)NCTX * 256;
constexpr size_t OUT_NBV = OUT_NBK + (size_t)NCTX * 1024;
constexpr size_t OUT_NCKV = OUT_NBV + (size_t)NCTX * 1024;
constexpr size_t OUT_NKR = OUT_NCKV + (size_t)NCTX * 512;

constexpr int SMEM_BYTES = 128 * 1024 + 256;

struct Params {
  const float *x_prompt, *x_sample, *ca_k, *ca_v, *cb_k, *cb_v, *c_ckv, *c_kr, *c, *c_ctx;
  const float *l0_norm, *l0_ada_w, *l0_ada_b, *l0_w_in, *l0_qn, *l0_kn, *l0_rpb, *l0_w_out;
  const float *l1_norm, *l1_ada_w, *l1_ada_b, *l1_w_in, *l1_qan, *l1_wqb, *l1_kvan, *l1_wkvb, *l1_w_out, *fnorm;
  float* out;
  char* ws;
};

DI int threadIdx_x_raw() { return (int)__builtin_amdgcn_workitem_id_x(); }
DI u16 f2bf(float x) { unsigned u = __float_as_uint(x); u += 0x7fffu + ((u >> 16) & 1u); return (u16)(u >> 16); }
DI float bf2f(u16 v) { return __uint_as_float(((unsigned)v) << 16); }
DI unsigned pack2(float a, float b) { f32x2_t f = {a, b}; bf16x2_t r = __builtin_convertvector(f, bf16x2_t); return __builtin_bit_cast(unsigned, r); }
DI float bflo(unsigned u) { return __uint_as_float(u << 16); }
DI float bfhi(unsigned u) { return __uint_as_float(u & 0xffff0000u); }
DI float wave_sum(float v) {
#pragma unroll
  for (int o = 32; o >= 1; o >>= 1) v += __shfl_xor(v, o);
  return v;
}
DI int TID() { int t = threadIdx_x_raw(); asm volatile("" : "+v"(t)); return t; }
DI int crow(int i, int h) { return (i & 3) + 8 * (i >> 2) + 4 * h; }
DI float silu(float x) { return x / (1.f + __expf(-x)); }
DI int tok_modrow(int tok) { return tok < NCTX ? 0 : 1 + ((tok - NCTX) >> 10); }

DI void transpose_tile(const float* __restrict__ src, int K, int N, u16* __restrict__ dst, int kt, int nt, float* sm, bool remap1 = false) {
  const int t = TID();
  float4 v[8];
#pragma unroll
  for (int i = 0; i < 8; ++i) {
    int id = t + NT * i, r = id >> 6, c4 = id & 63, n = nt * 256 + c4 * 4;
    v[i] = (n < N) ? *(const float4*)(src + (size_t)(kt * 64 + r) * N + n) : make_float4(0.f, 0.f, 0.f, 0.f);
  }
#pragma unroll
  for (int i = 0; i < 8; ++i) {
    int id = t + NT * i, r = id >> 6, c4 = id & 63;
    *(float4*)(sm + r * 260 + c4 * 4) = v[i];
  }
  __syncthreads();
  {
    const int nl = t >> 1, kq = t & 1, n = nt * 256 + nl;
    if (n < N) {
      const int nr = !remap1 ? n : (n < 1024 ? n : (n < 1088 ? n + 2048 : n - 64));
      u16* dp = dst + (size_t)nr * K + kt * 64 + kq * 32;
#pragma unroll
      for (int q = 0; q < 4; ++q) {
        u32x4 o;
#pragma unroll
        for (int j = 0; j < 4; ++j) o[j] = pack2(sm[(kq * 32 + q * 8 + 2 * j) * 260 + nl], sm[(kq * 32 + q * 8 + 2 * j + 1) * 260 + nl]);
        *(u32x4*)(dp + q * 8) = o;
      }
    }
  }
  __syncthreads();
}

DI void adaln_item(const Params& p, int l, int chunk, float* sm) {
  const float* W = l ? p.l1_ada_w : p.l0_ada_w;
  const float* bias = l ? p.l1_ada_b : p.l0_ada_b;
  float* mod = (float*)(p.ws + OFF_MOD) + (size_t)l * 9 * 6144;
  const int t = TID(), col = chunk * 64 + (t & 63), kg = t >> 6;
  float acc[9];
#pragma unroll
  for (int r = 0; r < 9; ++r) acc[r] = 0.f;
  for (int kh = 0; kh < 2; ++kh) {
    __syncthreads();
    for (int e = t; e < 9 * 1024; e += NT) {
      int r = e >> 10, k = e & 1023;
      float cv = (r == 0) ? p.c_ctx[kh * 1024 + k] : p.c[(r - 1) * 2048 + kh * 1024 + k];
      sm[r * 1024 + k] = silu(cv);
    }
    __syncthreads();
    const float* wp = W + (size_t)(kh * 1024 + kg * 128) * 6144 + col;
    const float* sp = sm + kg * 128;
#pragma unroll 8
    for (int k = 0; k < 128; ++k) {
      float w = wp[(size_t)k * 6144];
#pragma unroll
      for (int r = 0; r < 9; ++r) acc[r] += sp[r * 1024 + k] * w;
    }
  }
  __syncthreads();
#pragma unroll
  for (int r = 0; r < 9; ++r) sm[(kg * 9 + r) * 64 + (t & 63)] = acc[r];
  __syncthreads();
  for (int e = t; e < 9 * 64; e += NT) {
    int r = e >> 6, cc = e & 63;
    float s = 0.f;
#pragma unroll
    for (int g = 0; g < NW; ++g) s += sm[(g * 9 + r) * 64 + cc];
    mod[(size_t)r * 6144 + chunk * 64 + cc] = s + bias[chunk * 64 + cc];
  }
  __syncthreads();
}

DI void convert_item(const float* __restrict__ src, u16* __restrict__ dst, int W, int dstT, int item) {
  size_t e = (size_t)item * 4096 + TID() * 8;
  size_t per_b = (size_t)512 * W;
  size_t b = e / per_b, r = e % per_b;
  float4 v0 = *(const float4*)(src + e), v1 = *(const float4*)(src + e + 4);
  u32x4 o = {pack2(v0.x, v0.y), pack2(v0.z, v0.w), pack2(v1.x, v1.y), pack2(v1.z, v1.w)};
  *(u32x4*)(dst + b * (size_t)dstT * W + r) = o;
}

DI void phase_prep(const Params& p, char* smem) {
  float* sm = (float*)smem;
  char* ws = p.ws;
  constexpr int T_IN0 = 32 * 26, T_OUT0 = 32 * 8, T_IN1 = 32 * 13, T_QB = 8 * 12, T_KVB = 8 * 16, T_OUT1 = 32 * 8;
  constexpr int C_A = 256, C_B = 1024, C_CKV = 512, C_KR = 64;
  constexpr int B1 = 0, B2 = B1 + T_IN0, B3 = B2 + T_OUT0, B4 = B3 + T_IN1, B5 = B4 + T_QB, B6 = B5 + T_KVB, B7 = B6 + T_OUT1;
  constexpr int B8 = B7 + C_A, B9 = B8 + C_A, B10 = B9 + C_B, B11 = B10 + C_B, B12 = B11 + C_CKV, B13 = B12 + C_KR;
  if (blockIdx.x == gridDim.x - 1) {
    float* tab = (float*)(ws + OFF_ROPE);
    for (int e = TID(); e < 64 * 16; e += NT) {
      int pos = e >> 4, i = e & 15;
      float inv = exp2f(-(float)i * (LOG2_THETA / 16.f));
      float sn, cs; sincosf((float)pos * inv, &sn, &cs);
      tab[2 * e] = cs; tab[2 * e + 1] = sn;
    }
    float* tab0 = (float*)(ws + OFF_ROPE0);
    for (int e = TID(); e < 64 * 32; e += NT) {
      int pos = e >> 5, i = e & 31;
      float inv = exp2f(-(float)i * (LOG2_THETA / 32.f));
      float sn, cs; sincosf((float)pos * inv, &sn, &cs);
      tab0[2 * e] = cs; tab0[2 * e + 1] = sn;
    }
  }
  const int nada = (gridDim.x > 128) ? 96 : 0;
  if ((int)blockIdx.x < nada) { adaln_item(p, 0, blockIdx.x, sm); return; }
  if (nada == 0) { for (int c = blockIdx.x; c < 96; c += gridDim.x) adaln_item(p, 0, c, sm); }
  for (int it = blockIdx.x - nada; it < B13; it += gridDim.x - nada) {
    if (it < B2) { int i = it - B1; transpose_tile(p.l0_w_in, 2048, 6656, (u16*)(ws + OFF_WT_IN0), i / 26, i % 26, sm); }
    else if (it < B3) { int i = it - B2; transpose_tile(p.l0_w_out, 2048, 2048, (u16*)(ws + OFF_WT_OUT0), i / 8, i % 8, sm); }
    else if (it < B4) { int i = it - B3; transpose_tile(p.l1_w_in, 2048, 3136, (u16*)(ws + OFF_WT_IN1), i / 13, i % 13, sm, true); }
    else if (it < B5) { int i = it - B4; transpose_tile(p.l1_wqb, 512, 3072, (u16*)(ws + OFF_WT_QB), i / 12, i % 12, sm); }
    else if (it < B6) { int i = it - B5; transpose_tile(p.l1_wkvb, 512, 4096, (u16*)(ws + OFF_WT_KVB), i / 16, i % 16, sm); }
    else if (it < B7) { int i = it - B6; transpose_tile(p.l1_w_out, 2048, 2048, (u16*)(ws + OFF_WT_OUT1), i / 8, i % 8, sm); }
    else if (it < B8) convert_item(p.ca_k, (u16*)(ws + OFF_KA_ALL), 256, 1536, it - B7);
    else if (it < B9) convert_item(p.ca_v, (u16*)(ws + OFF_VA_ALL), 256, 1536, it - B8);
    else if (it < B10) convert_item(p.cb_k, (u16*)(ws + OFF_KB_CTX), 1024, 512, it - B9);
    else if (it < B11) convert_item(p.cb_v, (u16*)(ws + OFF_VB_CTX), 1024, 512, it - B10);
    else if (it < B12) convert_item(p.c_ckv, (u16*)(ws + OFF_CKV_ALL), 512, 1536, it - B11);
    else convert_item(p.c_kr, (u16*)(ws + OFF_KR_ALL), 64, 1536, it - B12);
  }
}

DI void phase_normmod(const Params& p, int layer) {
  const int wave = TID() >> 6, lane = TID() & 63;
  const float* g = layer ? p.l1_norm : p.l0_norm;
  const float* mod = (const float*)(p.ws + OFF_MOD) + (size_t)layer * 9 * 6144;
  u16* H = (u16*)(p.ws + OFF_H);
  for (int it = blockIdx.x; it < NTOK / NW; it += gridDim.x) {
    int row = it * NW + wave;
    const float* src;
    if (layer == 0) src = row < NCTX ? p.x_prompt + (size_t)row * D : p.x_sample + (size_t)(row - NCTX) * D;
    else src = p.out + OUT_Y + (size_t)row * D;
    const float* mr = mod + (size_t)tok_modrow(row) * 6144;
    float4 v[8];
    float ss = 0.f;
#pragma unroll
    for (int i = 0; i < 8; ++i) {
      v[i] = *(const float4*)(src + (i * 64 + lane) * 4);
      ss += v[i].x * v[i].x + v[i].y * v[i].y + v[i].z * v[i].z + v[i].w * v[i].w;
    }
    ss = wave_sum(ss);
    float rinv = rsqrtf(ss * (1.f / D) + EPS);
#pragma unroll
    for (int i = 0; i < 8; ++i) {
      int col = (i * 64 + lane) * 4;
      float4 gg = *(const float4*)(g + col);
      float4 sh = *(const float4*)(mr + col);
      float4 sc = *(const float4*)(mr + 2048 + col);
      float h0 = v[i].x * rinv * gg.x * (1.f + sc.x) + sh.x;
      float h1 = v[i].y * rinv * gg.y * (1.f + sc.y) + sh.y;
      float h2 = v[i].z * rinv * gg.z * (1.f + sc.z) + sh.z;
      float h3 = v[i].w * rinv * gg.w * (1.f + sc.w) + sh.w;
      *(uint2*)(H + (size_t)row * D + col) = make_uint2(pack2(h0, h1), pack2(h2, h3));
    }
  }
}

DI void phase_normmod1(const Params& p) {
  const int wave = TID() >> 6, lane = TID() & 63;
  const float* g = p.l1_norm;
  const float* mod = (const float*)(p.ws + OFF_MOD) + (size_t)9 * 6144;
  const u16* X1 = (const u16*)(p.out + OUT_Y);
  u16* H = (u16*)(p.ws + OFF_H);
  for (int it = blockIdx.x; it < NTOK / NW; it += gridDim.x) {
    const int row = it * NW + wave;
    const float* mr = mod + (size_t)tok_modrow(row) * 6144;
    u32x4 v[4];
    float ss = 0.f;
#pragma unroll
    for (int i = 0; i < 4; ++i) {
      v[i] = *(const u32x4*)(X1 + (size_t)row * D + (i * 64 + lane) * 8);
#pragma unroll
      for (int j = 0; j < 4; ++j) { const float a0 = bflo(v[i][j]), a1 = bfhi(v[i][j]); ss += a0 * a0 + a1 * a1; }
    }
    ss = wave_sum(ss);
    const float rinv = rsqrtf(ss * (1.f / D) + EPS);
#pragma unroll
    for (int i = 0; i < 4; ++i) {
      const int col = (i * 64 + lane) * 8;
      u32x4 o;
#pragma unroll
      for (int q = 0; q < 2; ++q) {
        const f32x4 gg = *(const f32x4*)(g + col + 4 * q);
        const f32x4 sh = *(const f32x4*)(mr + col + 4 * q);
        const f32x4 sc = *(const f32x4*)(mr + 2048 + col + 4 * q);
        const float x0 = bflo(v[i][2 * q]), x1 = bfhi(v[i][2 * q]), x2 = bflo(v[i][2 * q + 1]), x3 = bfhi(v[i][2 * q + 1]);
        const float h0 = x0 * rinv * gg[0] * (1.f + sc[0]) + sh[0];
        const float h1 = x1 * rinv * gg[1] * (1.f + sc[1]) + sh[1];
        const float h2 = x2 * rinv * gg[2] * (1.f + sc[2]) + sh[2];
        const float h3 = x3 * rinv * gg[3] * (1.f + sc[3]) + sh[3];
        o[2 * q] = pack2(h0, h1); o[2 * q + 1] = pack2(h2, h3);
      }
      *(u32x4*)(H + (size_t)row * D + col) = o;
    }
  }
}

namespace pg8 {
#define PG8_LAS __attribute__((address_space(3)))
typedef unsigned short bf16_t;
typedef short bf16x8 __attribute__((ext_vector_type(8)));
typedef float f32x4 __attribute__((ext_vector_type(4)));
typedef unsigned u32x4 __attribute__((ext_vector_type(4)));
constexpr int BM = 256, BK = 64, HALF = 128, HTB = HALF * BK * 2  , STAGE_BYTES = 8 * HTB, NXCD = 8, WGM = 8;

__host__ __device__ __forceinline__ int lds_byte(int r, int c) { const int st = (r >> 4) * 2 + (c >> 5), rr = r & 15, cc = c & 31, ob = rr * 64 + cc * 2; return st * 1024 + (ob ^ (((ob >> 9) & 1) << 5)); }
__host__ __device__ __forceinline__ void stage_rc(int b, int& R, int& C) { const int st = b / 1024, sb = b % 1024, swz = sb ^ (((sb >> 9) & 1) << 5); R = (st >> 1) * 16 + swz / 64; C = (st & 1) * 32 + (swz % 64) / 2; }
__host__ __device__ __forceinline__ int perm32(int rho) { const int n = rho >> 4, i = rho & 15; return 8 * (i >> 2) + 4 * n + (i & 3); }

struct Unit { int pm, pn; };
struct Gemm { const bf16_t* A; const bf16_t* Bt; int M, N, K, lda; };
struct StaticOrder {
    int nM, nN, nwg, G, c;
    __host__ __device__ void init(int M, int N, int G_, int c_) { nM = M / BM; nN = N / BM; nwg = nM * nN; G = G_; c = c_; }
    __host__ __device__ bool next(int i, Unit& u) const {
        const long L = (long)i * G + c; if (L >= nwg) return false;
        int wgid = (int)L; { const int q = nwg / NXCD, r = nwg % NXCD, xcd = wgid % NXCD, off = wgid / NXCD; wgid = (xcd < r ? xcd * (q + 1) : r * (q + 1) + (xcd - r) * q) + off; }
        const int nig = WGM * nN, gid = wgid / nig, fm = gid * WGM, gsz = (nM - fm) < WGM ? (nM - fm) : WGM;
        u.pm = fm + ((wgid % nig) % gsz); u.pn = (wgid % nig) / gsz; return true;
    }
    __device__ __forceinline__ void a_ready(const Unit&) const {}
    __device__ __forceinline__ void done(const Unit&) const {}
};
template <class Epi, class Sched, bool STAMP = false>
__device__ __forceinline__ void gemm_phase(PG8_LAS unsigned char* lds, const Gemm g, const Sched& S, const Epi& E, unsigned long long* stamps) {
    const int tid = TID(), wid = __builtin_amdgcn_readfirstlane(tid >> 6), lane = tid & 63, wr = wid >> 2, wc = wid & 3, fr = lane & 15, fq = lane >> 4;
    const int K = g.K, nt = K / BK;
    int ts_lo = 0, ts_hi = 0, nts = 0; const unsigned long long rt_entry = STAMP ? (unsigned long long)wall_clock64() : 0ull;
#define PG8_STAMP() do { if (STAMP && wid == 0 && nts < 64) { const unsigned long long _c = (unsigned long long)clock64(); \
        ts_lo = (lane == nts) ? (int)(unsigned)_c : ts_lo; ts_hi = (lane == nts) ? (int)(unsigned)(_c >> 32) : ts_hi; ++nts; } } while (0)
    PG8_STAMP();
    unsigned voffA[2], voffB[2];
#pragma unroll
    for (int i = 0; i < 2; ++i) { int R, C; stage_rc(tid * 16 + i * 8192, R, C); const int Rb = Epi::PERM ? ((R & ~31) + perm32(R & 31)) : R;
        voffA[i] = (unsigned)(R * g.lda + C) * 2u; voffB[i] = (unsigned)(Rb * K + C) * 2u; }
    const size_t kstep = (size_t)(BK * 2);
    const size_t hstepB = (size_t)HALF * K * 2, hstepA = (size_t)HALF * g.lda * 2;
    const size_t tstepB = 2 * hstepB, tstepA = 2 * hstepA;
    const unsigned ldsw = (unsigned)wid * 1024u;
    const int aoff = lds_byte(wr * 64 + fr, fq * 8), boff = lds_byte(wc * 32 + fr, fq * 8);
#define PG8_SA(b, h) (((b) * 2 + (h)) * HTB)
#define PG8_SB(b, h) ((4 + (b) * 2 + (h)) * HTB)
#define PG8_STAGE(bufoff, gbase, voff) do { _Pragma("unroll") for (int _i = 0; _i < 2; ++_i) \
        __builtin_amdgcn_global_load_lds((const unsigned*)((const char*)(gbase) + (voff)[_i]), (PG8_LAS unsigned*)(lds + (bufoff) + ldsw + _i * 8192), 16, 0, 0); } while (0)
#define PG8_LDA(dst, b, h) do { _Pragma("unroll") for (int m = 0; m < 4; ++m) _Pragma("unroll") for (int k = 0; k < 2; ++k) dst[m][k] = *(const PG8_LAS bf16x8*)(lds + PG8_SA(b, h) + aoff + m * 2048 + k * 1024); } while (0)
#define PG8_LDB(dst, b, h) do { _Pragma("unroll") for (int n = 0; n < 2; ++n) _Pragma("unroll") for (int k = 0; k < 2; ++k) dst[n][k] = *(const PG8_LAS bf16x8*)(lds + PG8_SB(b, h) + boff + n * 2048 + k * 1024); } while (0)
#define PG8_MMA(ai, bj, At, Bt) do { __builtin_amdgcn_s_setprio(1); _Pragma("unroll") for (int m = 0; m < 4; ++m) _Pragma("unroll") for (int n = 0; n < 2; ++n) _Pragma("unroll") for (int k = 0; k < 2; ++k) \
        acc[ai][bj][m][n] = __builtin_amdgcn_mfma_f32_16x16x32_bf16(Bt[n][k], At[m][k], acc[ai][bj][m][n], 0, 0, 0); __builtin_amdgcn_s_setprio(0); } while (0)
#define PG8_WAIT_V(n) asm volatile("s_waitcnt vmcnt(" #n ")" ::: "memory")
#define PG8_WAIT_L(n) asm volatile("s_waitcnt lgkmcnt(" #n ")" ::: "memory")
#define PG8_BAR __builtin_amdgcn_s_barrier()
#define PG8_SCHED __builtin_amdgcn_sched_barrier(0)
    Unit cur, nxt; int ui = 0;
    if (!S.next(0, cur)) return;
    f32x4 acc[2][2][4][2];
#pragma unroll
    for (int a = 0; a < 2; ++a)
#pragma unroll
        for (int b = 0; b < 2; ++b)
#pragma unroll
            for (int m = 0; m < 4; ++m)
#pragma unroll
                for (int n = 0; n < 2; ++n) acc[a][b][m][n] = (f32x4){0.f, 0.f, 0.f, 0.f};
    bf16x8 At[4][2], B0[2][2], B1[2][2];
    const char* cA = (const char*)g.A + (size_t)cur.pm * tstepA; const char* cB = (const char*)g.Bt + (size_t)cur.pn * tstepB;
    S.a_ready(cur);
    PG8_STAGE(PG8_SB(0, 0), cB, voffB); PG8_STAGE(PG8_SA(0, 0), cA, voffA); PG8_STAGE(PG8_SB(0, 1), cB + hstepB, voffB); PG8_STAGE(PG8_SA(0, 1), cA + hstepA, voffA);
    if (wr == 1) PG8_BAR;
    PG8_WAIT_V(4); PG8_BAR;
    PG8_STAGE(PG8_SB(1, 0), cB + kstep, voffB); PG8_STAGE(PG8_SA(1, 0), cA + kstep, voffA); PG8_STAGE(PG8_SB(1, 1), cB + hstepB + kstep, voffB);
    PG8_WAIT_V(6); PG8_BAR;
    PG8_STAMP();
    for (;;) {
        const bool has_next = S.next(ui + 1, nxt);
        const char* nA = has_next ? (const char*)g.A + (size_t)nxt.pm * tstepA : cA; const char* nB = has_next ? (const char*)g.Bt + (size_t)nxt.pn * tstepB : cB;
        for (int t = 0; t < nt; t += 2) {
            const bool last = (t == nt - 2);
            const char* a1 = cA + (size_t)(t + 1) * kstep;
            const char* a2 = last ? nA : cA + (size_t)(t + 2) * kstep; const char* b2 = last ? nB : cB + (size_t)(t + 2) * kstep;
            const char* a3 = a2 + kstep; const char* b3 = b2 + kstep;
            if (last && has_next) S.a_ready(nxt);
            PG8_LDB(B0, 0, 0); PG8_SCHED; PG8_LDA(At, 0, 0); PG8_STAGE(PG8_SA(1, 1), a1 + hstepA, voffA);
            PG8_WAIT_L(8); PG8_BAR; PG8_WAIT_L(0); PG8_MMA(0, 0, At, B0); PG8_BAR; PG8_SCHED;
            PG8_LDB(B1, 0, 1); PG8_STAGE(PG8_SB(0, 0), b2, voffB);
            PG8_BAR; PG8_WAIT_L(0); PG8_MMA(0, 1, At, B1); PG8_BAR;
            PG8_LDA(At, 0, 1); PG8_STAGE(PG8_SA(0, 0), a2, voffA);
            PG8_BAR; PG8_WAIT_L(0); PG8_MMA(1, 0, At, B0); PG8_BAR; PG8_SCHED;
            PG8_STAGE(PG8_SB(0, 1), b2 + hstepB, voffB);
            PG8_WAIT_V(6); PG8_BAR; PG8_MMA(1, 1, At, B1); PG8_BAR;
            PG8_LDB(B0, 1, 0); PG8_SCHED; PG8_LDA(At, 1, 0); PG8_STAGE(PG8_SA(0, 1), a2 + hstepA, voffA);
            PG8_WAIT_L(8); PG8_BAR; PG8_WAIT_L(0); PG8_MMA(0, 0, At, B0); PG8_BAR; PG8_SCHED;
            PG8_LDB(B1, 1, 1); PG8_STAGE(PG8_SB(1, 0), b3, voffB);
            PG8_BAR; PG8_WAIT_L(0); PG8_MMA(0, 1, At, B1); PG8_BAR;
            PG8_LDA(At, 1, 1); PG8_STAGE(PG8_SA(1, 0), a3, voffA);
            PG8_BAR; PG8_WAIT_L(0); PG8_MMA(1, 0, At, B0); PG8_BAR; PG8_SCHED;
            PG8_STAGE(PG8_SB(1, 1), b3 + hstepB, voffB);
            PG8_WAIT_V(6); PG8_BAR; PG8_MMA(1, 1, At, B1); PG8_BAR;
        }
        PG8_STAMP();
        if constexpr (!Epi::AFTER_DRAIN) { E(acc, cur, wr, wc, fr, fq); S.done(cur); }
        PG8_STAMP();
        if (!has_next) break;
#pragma unroll
        for (int a = 0; a < 2; ++a)
#pragma unroll
            for (int b = 0; b < 2; ++b)
#pragma unroll
                for (int m = 0; m < 4; ++m)
#pragma unroll
                    for (int n = 0; n < 2; ++n) acc[a][b][m][n] = (f32x4){0.f, 0.f, 0.f, 0.f};
        cur = nxt; cA = nA; cB = nB; ++ui;
    }
    PG8_WAIT_V(0);
    if (wr == 0) PG8_BAR;
    PG8_BAR;
    if constexpr (Epi::AFTER_DRAIN) { E.fused(acc, cur, wr, wc, fr, fq, lds, wid, lane); S.done(cur); }
    PG8_STAMP();
    if (STAMP && wid == 0) { stamps[lane] = lane < nts ? (((unsigned long long)(unsigned)ts_hi << 32) | (unsigned)ts_lo) : 0ull;
        if (lane == 62) stamps[62] = rt_entry; if (lane == 63) stamps[63] = (unsigned long long)wall_clock64(); }
#undef PG8_STAMP
#undef PG8_SA
#undef PG8_SB
#undef PG8_STAGE
#undef PG8_LDA
#undef PG8_LDB
#undef PG8_MMA
#undef PG8_WAIT_V
#undef PG8_WAIT_L
#undef PG8_BAR
#undef PG8_SCHED
}
}


struct EpiBf16 {
  static constexpr bool PERM = true, AFTER_DRAIN = false;
  u16* O; int ldc;
  DI void operator()(const f32x4 (&acc)[2][2][4][2], const pg8::Unit& u, int wr, int wc, int fr, int fq) const {
    const int row0 = u.pm * 256 + wr * 64 + fr, col0 = u.pn * 256 + wc * 32 + 8 * fq;
#pragma unroll
    for (int ai = 0; ai < 2; ++ai)
#pragma unroll
      for (int m = 0; m < 4; ++m) {
        u16* rowp = O + (size_t)(row0 + ai * 128 + m * 16) * ldc + col0;
#pragma unroll
        for (int bj = 0; bj < 2; ++bj) {
          f32x4 v0 = acc[ai][bj][m][0], v1 = acc[ai][bj][m][1];
          u32x4 w = {pack2(v0[0], v0[1]), pack2(v0[2], v0[3]), pack2(v1[0], v1[1]), pack2(v1[2], v1[3])};
          *(u32x4*)(rowp + bj * 128) = w;
        }
      }
  }
};
struct EpiResid {
  static constexpr bool PERM = false, AFTER_DRAIN = false;
  const float* xa; const float* xb; const float* gate; float* out;
  DI void operator()(const f32x4 (&acc)[2][2][4][2], const pg8::Unit& u, int wr, int wc, int fr, int fq) const {
    const int row0 = u.pm * 256 + wr * 64 + fr, col0 = u.pn * 256 + wc * 32 + 4 * fq;
#pragma unroll
    for (int ai = 0; ai < 2; ++ai)
#pragma unroll
      for (int m = 0; m < 4; ++m) {
        const int row = row0 + ai * 128 + m * 16;
        const float* xr = (row < NCTX) ? xa + (size_t)row * D : xb + (size_t)(row - NCTX) * D;
        const float* gr = gate + (size_t)tok_modrow(row) * 6144;
        float* orow = out + (size_t)row * D;
#pragma unroll
        for (int bj = 0; bj < 2; ++bj)
#pragma unroll
          for (int n = 0; n < 2; ++n) {
            const int col = col0 + bj * 128 + n * 16;
            f32x4 xv = *(const f32x4*)(xr + col);
            f32x4 gv = *(const f32x4*)(gr + col);
            *(f32x4*)(orow + col) = xv + gv * acc[ai][bj][m][n];
          }
      }
  }
};

template <bool XBF> struct EpiResidB {
  static constexpr bool PERM = true, AFTER_DRAIN = false;
  const void* xa; const void* xb; const float* gate; u16* out;
  DI void operator()(const f32x4 (&acc)[2][2][4][2], const pg8::Unit& u, int wr, int wc, int fr, int fq) const {
    const int row0 = u.pm * 256 + wr * 64 + fr, col0 = u.pn * 256 + wc * 32 + 8 * fq;
#pragma unroll
    for (int ai = 0; ai < 2; ++ai)
#pragma unroll
      for (int m = 0; m < 4; ++m) {
        const int row = row0 + ai * 128 + m * 16;
        const float* gr = gate + (size_t)tok_modrow(row) * 6144;
        u16* orow = out + (size_t)row * D;
#pragma unroll
        for (int bj = 0; bj < 2; ++bj) {
          const int col = col0 + bj * 128;
          f32x4 x0, x1;
          if constexpr (XBF) {
            const u32x4 xv = *(const u32x4*)((const u16*)xa + (size_t)row * D + col);
            x0 = (f32x4){bflo(xv[0]), bfhi(xv[0]), bflo(xv[1]), bfhi(xv[1])};
            x1 = (f32x4){bflo(xv[2]), bfhi(xv[2]), bflo(xv[3]), bfhi(xv[3])};
          } else {
            const float* xr = (row < NCTX) ? (const float*)xa + (size_t)row * D : (const float*)xb + (size_t)(row - NCTX) * D;
            x0 = *(const f32x4*)(xr + col); x1 = *(const f32x4*)(xr + col + 4);
          }
          const f32x4 g0 = *(const f32x4*)(gr + col), g1 = *(const f32x4*)(gr + col + 4);
          const f32x4 o0 = x0 + g0 * acc[ai][bj][m][0], o1 = x1 + g1 * acc[ai][bj][m][1];
          u32x4 w = {pack2(o0[0], o0[1]), pack2(o0[2], o0[3]), pack2(o1[0], o1[1]), pack2(o1[2], o1[3])};
          *(u32x4*)(orow + col) = w;
        }
      }
  }
};

template <class Epi>
DI void gemm_run(PG8_LAS unsigned char* lds, const u16* A, int lda, const u16* Bt, int M, int N, int K, const Epi& e) {
  pg8::Gemm g{A, Bt, M, N, K, lda};
  pg8::StaticOrder S; S.init(M, N, (int)gridDim.x, (int)blockIdx.x);
#pragma unroll 1
  for (int rep = 0; rep < (Epi::PERM ? REP_G : 1); ++rep) {
    __syncthreads();
    pg8::gemm_phase<Epi, pg8::StaticOrder, false>(lds, g, S, e, nullptr);
    __syncthreads();
  }
}

DI void phase_qknorm0(const Params& p) {
  const int t = TID(), wave = t >> 6, lane = t & 63, l15 = lane & 15;
  u16* QKVG = (u16*)(p.ws + OFF_BIG);
  u16* KA = (u16*)(p.ws + OFF_KA_ALL);
  u16* VA = (u16*)(p.ws + OFF_VA_ALL);
  const float* tab = (const float*)(p.ws + OFF_ROPE0);
  float gq[8], gk[8];
#pragma unroll
  for (int j = 0; j < 8; ++j) { gq[j] = p.l0_qn[l15 * 8 + j]; gk[j] = p.l0_kn[l15 * 8 + j]; }
  const bool hi = (l15 & 4) != 0;
  const bool colrot = l15 >= 8;
  const int f0 = (l15 & 3) * 8;
  for (int it = blockIdx.x; it < NTOK / NW; it += gridDim.x) {
    const int tk = it * NW + wave;
    u16* base = QKVG + (size_t)tk * L0_IN;
    const bool lat = tk >= NCTX;
    const int lt = tk - NCTX, b = lt >> 10, tt = lt & 1023;
    u32x4 v[3];
#pragma unroll
    for (int ps = 0; ps < 3; ++ps) v[ps] = *(const u32x4*)(base + (ps * 64 + lane) * 8);
    u32x4 kb[2], vb[2];
    if (!lat) {
#pragma unroll
      for (int q = 0; q < 2; ++q) { kb[q] = *(const u32x4*)(base + 2560 + (q * 64 + lane) * 8); vb[q] = *(const u32x4*)(base + 3584 + (q * 64 + lane) * 8); }
    }
    float cs[8], sn[8];
    if (lat) {
      const int pos = colrot ? (tt & 63) : (tt >> 6);
      const float4* tp = (const float4*)(tab + (pos * 32 + f0) * 2);
#pragma unroll
      for (int j2 = 0; j2 < 4; ++j2) { float4 c = tp[j2]; cs[2 * j2] = c.x; sn[2 * j2] = c.y; cs[2 * j2 + 1] = c.z; sn[2 * j2 + 1] = c.w; }
    } else {
#pragma unroll
      for (int j = 0; j < 8; ++j) { cs[j] = 1.f; sn[j] = 0.f; }
    }
    const size_t arow = (size_t)b * 1536 + 512 + tt;
#pragma unroll
    for (int ps = 0; ps < 3; ++ps) {
      float x[8];
#pragma unroll
      for (int j = 0; j < 4; ++j) { x[2 * j] = bflo(v[ps][j]); x[2 * j + 1] = bfhi(v[ps][j]); }
      float ss = 0.f;
#pragma unroll
      for (int j = 0; j < 8; ++j) ss += x[j] * x[j];
      ss += __shfl_xor(ss, 8); ss += __shfl_xor(ss, 4); ss += __shfl_xor(ss, 2); ss += __shfl_xor(ss, 1);
      const float rinv = rsqrtf(ss * (1.f / 128.f) + EPS);
      float o[8];
#pragma unroll
      for (int j = 0; j < 8; ++j) {
        const float y = x[j] * rinv * (ps < 2 ? gq[j] : gk[j]);
        const float pr = __shfl_xor(y, 4);
        o[j] = hi ? (y * cs[j] + pr * sn[j]) : (y * cs[j] - pr * sn[j]);
      }
      if (ps < 2) {
        u32x4 w = {pack2(o[0], o[1]), pack2(o[2], o[3]), pack2(o[4], o[5]), pack2(o[6], o[7])};
        *(u32x4*)(base + (ps * 64 + lane) * 8) = w;
      } else if (lane < 32) {
        u32x4 w = {pack2(o[0], o[1]), pack2(o[2], o[3]), pack2(o[4], o[5]), pack2(o[6], o[7])};
        if (!lat) {
          *(u32x4*)(base + 1024 + lane * 8) = w;
          float* op = p.out + OUT_NAK + (size_t)tk * 256 + lane * 8;
          *(float4*)op = make_float4(o[0], o[1], o[2], o[3]);
          *(float4*)(op + 4) = make_float4(o[4], o[5], o[6], o[7]);
        } else *(u32x4*)(KA + arow * 256 + lane * 8) = w;
      } else {
        if (!lat) {
          float* op = p.out + OUT_NAV + (size_t)tk * 256 + (lane - 32) * 8;
          *(float4*)op = make_float4(x[0], x[1], x[2], x[3]);
          *(float4*)(op + 4) = make_float4(x[4], x[5], x[6], x[7]);
        } else *(u32x4*)(VA + arow * 256 + (lane - 32) * 8) = v[2];
      }
    }
    if (!lat) {
#pragma unroll
      for (int q = 0; q < 2; ++q) {
        float* ok = p.out + OUT_NBK + (size_t)tk * 1024 + (q * 64 + lane) * 8;
        float* ov = p.out + OUT_NBV + (size_t)tk * 1024 + (q * 64 + lane) * 8;
        *(float4*)ok = make_float4(bflo(kb[q][0]), bfhi(kb[q][0]), bflo(kb[q][1]), bfhi(kb[q][1]));
        *(float4*)(ok + 4) = make_float4(bflo(kb[q][2]), bfhi(kb[q][2]), bflo(kb[q][3]), bfhi(kb[q][3]));
        *(float4*)ov = make_float4(bflo(vb[q][0]), bfhi(vb[q][0]), bflo(vb[q][1]), bfhi(vb[q][1]));
        *(float4*)(ov + 4) = make_float4(bflo(vb[q][2]), bfhi(vb[q][2]), bflo(vb[q][3]), bfhi(vb[q][3]));
      }
    }
  }
}

DI void phase_norm1(const Params& p) {
  const int wave = TID() >> 6, lane = TID() & 63;
  const u16* LAT1 = (const u16*)(p.ws + OFF_LAT1);
  u16* QN = (u16*)(p.ws + OFF_QN);
  u16* CKVC = (u16*)(p.ws + OFF_CKV_CTX);
  u16* KRC = (u16*)(p.ws + OFF_KR_CTX);
  u16* CKVA = (u16*)(p.ws + OFF_CKV_ALL);
  u16* KRA = (u16*)(p.ws + OFF_KR_ALL);
  float gq[8], gk[8];
#pragma unroll
  for (int j = 0; j < 8; ++j) { gq[j] = p.l1_qan[lane * 8 + j]; gk[j] = p.l1_kvan[lane * 8 + j]; }
  const int ri = lane & 15, rhalf = (lane >> 4) & 1;
  const int rd1 = rhalf * 32 + ri, rd2 = rd1 + 16;
  const float inv = exp2f(-(float)ri * (LOG2_THETA / 16.f));
  for (int it = blockIdx.x; it < NTOK / NW; it += gridDim.x) {
    int tk = it * NW + wave;
    const u16* base = LAT1 + (size_t)tk * L1_LD;
    const bool lat = tk >= NCTX;
    int lt = tk - NCTX, b = lt >> 10, tt = lt & 1023;
    size_t arow = (size_t)b * 1536 + 512 + tt;
#pragma unroll
    for (int part = 0; part < 2; ++part) {
      uint4 v = *(const uint4*)(base + part * 512 + lane * 8);
      float x[8] = {bflo(v.x), bfhi(v.x), bflo(v.y), bfhi(v.y), bflo(v.z), bfhi(v.z), bflo(v.w), bfhi(v.w)};
      float ss = 0.f;
#pragma unroll
      for (int j = 0; j < 8; ++j) ss += x[j] * x[j];
      ss = wave_sum(ss);
      float rinv = rsqrtf(ss * (1.f / 512.f) + EPS);
#pragma unroll
      for (int j = 0; j < 8; ++j) x[j] = x[j] * rinv * (part ? gk[j] : gq[j]);
      uint4 o = make_uint4(pack2(x[0], x[1]), pack2(x[2], x[3]), pack2(x[4], x[5]), pack2(x[6], x[7]));
      if (part == 0) *(uint4*)(QN + (size_t)tk * 512 + lane * 8) = o;
      else if (!lat) {
        *(uint4*)(CKVC + (size_t)tk * 512 + lane * 8) = o;
        float* op = p.out + OUT_NCKV + (size_t)tk * 512 + lane * 8;
        *(float4*)op = make_float4(x[0], x[1], x[2], x[3]);
        *(float4*)(op + 4) = make_float4(x[4], x[5], x[6], x[7]);
      } else *(uint4*)(CKVA + arow * 512 + lane * 8) = o;
    }
  }
}

DI void phase_krope(const Params& p, char* smem) {
  const int t = TID(), wave = t >> 6, lane = t & 63, l31 = lane & 31, h = lane >> 5;
  const int tg = wave >> 2, kq = wave & 3;
  const u16* H = (const u16*)(p.ws + OFF_H);
  const u16* W = (const u16*)(p.ws + OFF_WT_IN1) + (size_t)3072 * 2048;
  u16* KRC = (u16*)(p.ws + OFF_KR_CTX);
  u16* KRA = (u16*)(p.ws + OFF_KR_ALL);
  const float* tab = (const float*)(p.ws + OFF_ROPE);
  constexpr int CLD = 256 + 8;
  u16* Hs = (u16*)smem;
  u16* Ws = Hs + 64 * CLD;
  float* red = (float*)smem;
  for (int it = blockIdx.x; it < NTOK / 64; it += gridDim.x) {
    const int tok = it * 64 + tg * 32 + l31;
    const u16* hg = H + (size_t)(it * 64 + (t >> 5)) * 2048 + (t & 31) * 8;
    const u16* wg = W + (size_t)(t >> 5) * 2048 + (t & 31) * 8;
    u32x4 rh[4], rw[4];
#pragma unroll
    for (int i = 0; i < 4; ++i) { rh[i] = *(const u32x4*)(hg + (size_t)(16 * i) * 2048); rw[i] = *(const u32x4*)(wg + (size_t)(16 * i) * 2048); }
    f32x16 c0, c1;
#pragma unroll
    for (int r = 0; r < 16; ++r) { c0[r] = 0.f; c1[r] = 0.f; }
#pragma unroll 1
    for (int kc = 0; kc < 8; ++kc) {
      __syncthreads();
#pragma unroll
      for (int i = 0; i < 4; ++i) {
        *(u32x4*)(Hs + ((t >> 5) + 16 * i) * CLD + (t & 31) * 8) = rh[i];
        *(u32x4*)(Ws + ((t >> 5) + 16 * i) * CLD + (t & 31) * 8) = rw[i];
      }
      __syncthreads();
      if (kc + 1 < 8) {
#pragma unroll
        for (int i = 0; i < 4; ++i) { rh[i] = *(const u32x4*)(hg + (size_t)(16 * i) * 2048 + (kc + 1) * 256); rw[i] = *(const u32x4*)(wg + (size_t)(16 * i) * 2048 + (kc + 1) * 256); }
      }
#pragma unroll
      for (int s = 0; s < 4; ++s) {
        const int ko = kq * 64 + 16 * s + 8 * h;
        const bf16x8 hb = *(const bf16x8*)(Hs + (tg * 32 + l31) * CLD + ko);
        const bf16x8 a0 = *(const bf16x8*)(Ws + l31 * CLD + ko);
        const bf16x8 a1 = *(const bf16x8*)(Ws + (32 + l31) * CLD + ko);
        c0 = MFMA32(a0, hb, c0);
        c1 = MFMA32(a1, hb, c1);
      }
    }
    __syncthreads();
#pragma unroll
    for (int r = 0; r < 16; ++r) { red[(wave * 32 + r) * 64 + lane] = c0[r]; red[(wave * 32 + 16 + r) * 64 + lane] = c1[r]; }
    __syncthreads();
    if (kq == 0) {
      float v[32];
#pragma unroll
      for (int r = 0; r < 32; ++r) {
        float a = 0.f;
#pragma unroll
        for (int q = 0; q < 4; ++q) a += red[((tg * 4 + q) * 32 + r) * 64 + lane];
        v[r] = a;
      }
      const bool lat = tok >= NCTX;
      const int lt = tok - NCTX, b = lt >> 10, tt = lt & 1023;
      if (lat) {
#pragma unroll
        for (int c = 0; c < 2; ++c) {
          const int pos = c ? (tt & 63) : (tt >> 6);
#pragma unroll
          for (int i = 0; i < 8; ++i) {
            const int n = (i & 3) + 8 * (i >> 2) + 4 * h;
            const float cs = tab[(pos * 16 + n) * 2], sn = tab[(pos * 16 + n) * 2 + 1];
            const float x1 = v[c * 16 + i], x2 = v[c * 16 + i + 8];
            v[c * 16 + i] = x1 * cs - x2 * sn;
            v[c * 16 + i + 8] = x2 * cs + x1 * sn;
          }
        }
      }
#pragma unroll
      for (int c = 0; c < 2; ++c)
#pragma unroll
        for (int g4 = 0; g4 < 4; ++g4) {
          const int n0 = 32 * c + 8 * g4 + 4 * h;
          const float o0 = v[c * 16 + 4 * g4], o1 = v[c * 16 + 4 * g4 + 1], o2 = v[c * 16 + 4 * g4 + 2], o3 = v[c * 16 + 4 * g4 + 3];
          const uint2 w = make_uint2(pack2(o0, o1), pack2(o2, o3));
          if (!lat) {
            *(uint2*)(KRC + (size_t)tok * 64 + n0) = w;
            *(float4*)(p.out + OUT_NKR + (size_t)tok * 64 + n0) = make_float4(o0, o1, o2, o3);
          } else {
            *(uint2*)(KRA + ((size_t)b * 1536 + 512 + tt) * 64 + n0) = w;
          }
        }
    }
  }
  __syncthreads();
}

DI void phase_final(const Params& p) {
  const int wave = TID() >> 6, lane = TID() & 63;
  const u16* X2 = (const u16*)(p.ws + OFF_Q1);
  for (int it = blockIdx.x; it < NTOK / NW; it += gridDim.x) {
    const int row = it * NW + wave;
    float* y = p.out + OUT_Y + (size_t)row * D;
    u32x4 v[4];
    float ss = 0.f;
#pragma unroll
    for (int i = 0; i < 4; ++i) {
      v[i] = *(const u32x4*)(X2 + (size_t)row * D + (i * 64 + lane) * 8);
#pragma unroll
      for (int j = 0; j < 4; ++j) { const float a0 = bflo(v[i][j]), a1 = bfhi(v[i][j]); ss += a0 * a0 + a1 * a1; }
    }
    ss = wave_sum(ss);
    const float rinv = rsqrtf(ss * (1.f / D) + EPS);
#pragma unroll
    for (int i = 0; i < 4; ++i) {
      const int col = (i * 64 + lane) * 8;
#pragma unroll
      for (int q = 0; q < 2; ++q) {
        const f32x4 gg = *(const f32x4*)(p.fnorm + col + 4 * q);
        f32x4 o = {bflo(v[i][2 * q]) * rinv * gg[0], bfhi(v[i][2 * q]) * rinv * gg[1], bflo(v[i][2 * q + 1]) * rinv * gg[2], bfhi(v[i][2 * q + 1]) * rinv * gg[3]};
        *(f32x4*)(y + col + 4 * q) = o;
      }
    }
  }
}

struct KVSeg { const u16* k; const u16* v; const u16* kr; int ks, vs, n; };
struct AttnArgs {
  const u16* q; int qs;
  KVSeg seg[2]; int nseg;
  const u16* gate; int gs;
  u16* out; int os;
  float scale_log2;
  const float* rpb;
  int qtok0;
  int rs0;
  int rope;
  const float* ropetab;
};

DI float xhalf_max(float v) {
  unsigned u = __float_as_uint(v);
  auto r = __builtin_amdgcn_permlane32_swap(u, u, false, false);
  return fmaxf(__uint_as_float(r[0]), __uint_as_float(r[1]));
}
#define DEFER_MAX_UPDATE() do { \
    if (__builtin_amdgcn_ballot_w64(mx > m_run + 8.0f) != 0) { \
      const float mn_ = fmaxf(m_run, mx); const float al_ = __builtin_amdgcn_exp2f(m_run - mn_); m_run = mn_; l_run *= al_; \
      _Pragma("unroll") for (int c_ = 0; c_ < 4; ++c_) _Pragma("unroll") for (int r_ = 0; r_ < 16; ++r_) acc[c_][r_] *= al_; \
    } } while (0)
DI int swz16(int r) { return ((r & 3) << 2) | ((r >> 2) & 3); }

template <int DQK, int MODE>
DI void attn_issue_tile(const AttnArgs& a, int tile, int nt0, LDS_AS(unsigned char)* slot, int wave, int lane) {
  const int sg = tile >= nt0 ? 1 : 0;
  const int off = (sg ? tile - nt0 : tile) * 64;
  const u16* kp = sg ? a.seg[1].k : a.seg[0].k;
  const u16* vp = sg ? a.seg[1].v : a.seg[0].v;
  const int ks = sg ? a.seg[1].ks : a.seg[0].ks;
  const int vs = sg ? a.seg[1].vs : a.seg[0].vs;
  const int sw = ((lane >> 4) << 2) | (wave & 3);
  const int ch = (lane & 15) ^ sw;
#pragma unroll
  for (int j = 0; j < 2; ++j) {
    const int row = off + (j * 8 + wave) * 4 + (lane >> 4);
    __builtin_amdgcn_global_load_lds((const unsigned*)(kp + (unsigned)(row * ks + ch * 8)), (LDS_AS(unsigned)*)(slot + (j * 8 + wave) * 1024), 16, 0, 0);
    __builtin_amdgcn_global_load_lds((const unsigned*)(vp + (unsigned)(row * vs + ch * 8)), (LDS_AS(unsigned)*)(slot + 16384 + (j * 8 + wave) * 1024), 16, 0, 0);
  }
  if constexpr (MODE == 2) {
    const u16* krp = sg ? a.seg[1].kr : a.seg[0].kr;
    const int row = wave * 8 + (lane >> 3);
    const int c2 = (lane & 7) ^ ((row >> 1) & 7);
    __builtin_amdgcn_global_load_lds((const unsigned*)(krp + (unsigned)((off + row) * 64 + c2 * 8)), (LDS_AS(unsigned)*)(slot + 32768 + wave * 1024), 16, 0, 0);
  }
}

template <int DQK, int MODE>
DI void attn_block(const AttnArgs& a, LDS_AS(unsigned char)* lds) {
  constexpr int NS = DQK / 16;
  constexpr int SLOTB = (MODE == 2) ? 40960 : 32768;
  constexpr int NLOAD = (MODE == 2) ? 5 : 4;
  LDS_AS(float)* bias_s = (LDS_AS(float)*)(lds + 3 * SLOTB);
  const int t = TID(), wave = __builtin_amdgcn_readfirstlane(t >> 6), lane = t & 63, l31 = lane & 31, h = lane >> 5;

  __syncthreads();
  if constexpr (MODE == 1) {
    for (int e = t; e < 15 * 31; e += NT) bias_s[e] = a.rpb[e] * LOG2E;
    __syncthreads();
  }
  int ntiles = 0;
  for (int s = 0; s < a.nseg; ++s) ntiles += a.seg[s].n >> 6;
  const int nt0 = a.seg[0].n >> 6;
  bf16x8 qf[NS];
  {
    const u16* qp = a.q + (size_t)(wave * 32 + l31) * a.qs + 8 * h;
#pragma unroll
    for (int s = 0; s < NS; ++s) qf[s] = *(const bf16x8*)(qp + 16 * s);
  }
  attn_issue_tile<DQK, MODE>(a, 0, nt0, lds, wave, lane);
  attn_issue_tile<DQK, MODE>(a, ntiles > 1 ? 1 : 0, nt0, lds + SLOTB, wave, lane);
  const int qtok = a.qtok0 + wave * 32 + l31;
  if constexpr (MODE == 2) {
    if (a.rope) {
      const int qr = qtok >> 6, qc = qtok & 63;
#pragma unroll
      for (int pr = 0; pr < 2; ++pr) {
        const float4* tb = (const float4*)(a.ropetab + ((pr ? qc : qr) * 16 + 8 * h) * 2);
#pragma unroll
        for (int j2 = 0; j2 < 4; ++j2) {
          float4 cssn = tb[j2];
#pragma unroll
          for (int e = 0; e < 2; ++e) {
            const int j = 2 * j2 + e;
            float cs = e ? cssn.z : cssn.x, sn = e ? cssn.w : cssn.y;
            float x1 = bf2f((u16)qf[8 + 2 * pr][j]), x2 = bf2f((u16)qf[9 + 2 * pr][j]);
            qf[8 + 2 * pr][j] = (short)f2bf(x1 * cs - x2 * sn);
            qf[9 + 2 * pr][j] = (short)f2bf(x2 * cs + x1 * sn);
          }
        }
      }
    }
  }
  f32x16 acc[4];
#pragma unroll
  for (int c = 0; c < 4; ++c)
#pragma unroll
    for (int r = 0; r < 16; ++r) acc[c][r] = 0.f;
  float m_run = -1e30f, l_run = 0.f;

  const int blk = (lane >> 4) & 1, tq = (lane & 15) >> 2, tp = lane & 3;
  const int kswz = swz16(l31);
  const int kb0 = l31 * 256 + ((h ^ (kswz & 1)) << 4);
  const int ksw = kswz >> 1;
  const int kr0 = 32768 + l31 * 128;
  const int krsw = (l31 >> 1) & 7;
  const int vlow0 = (2 * blk + (tp >> 1)) ^ (h & 3);
  const int vlow1 = (2 * blk + (tp >> 1)) ^ ((2 + h) & 3);
  const int vb0 = 16384 + (4 * h + tq) * 256 + (vlow0 << 4) + 8 * (tp & 1);
  const int vb1 = 16384 + (8 + 4 * h + tq) * 256 + (vlow1 << 4) + 8 * (tp & 1);
  const int qrow = qtok >> 6, qcol = qtok & 63;
  int q_rs = qrow - 4; q_rs = q_rs < 0 ? 0 : (q_rs > 8 ? 8 : q_rs);
  int q_cs = qcol - 8; q_cs = q_cs < 0 ? 0 : (q_cs > 48 ? 48 : q_cs);

  int sl = 0;
  for (int tile = 0; tile < ntiles; ++tile) {
    if constexpr (NLOAD == 5) asm volatile("s_waitcnt vmcnt(5)" ::: "memory"); else asm volatile("s_waitcnt vmcnt(4)" ::: "memory");
    __builtin_amdgcn_s_barrier();
    asm volatile("" ::: "memory");
    {
      int nx = tile + 2; nx = nx < ntiles ? nx : ntiles - 1;
      int sn = sl + 2; sn = sn >= 3 ? sn - 3 : sn;
      attn_issue_tile<DQK, MODE>(a, nx, nt0, lds + sn * SLOTB, wave, lane);
    }
    LDS_AS(unsigned char)* slot = lds + sl * SLOTB;
    sl = sl == 2 ? 0 : sl + 1;

    const bool local = (MODE == 1) && (tile >= nt0);
    const int krow = a.rs0 + (tile - nt0);
#pragma unroll 1
    for (int mt = 0; mt < 2; ++mt) {
      f32x16 S;
#pragma unroll
      for (int r = 0; r < 16; ++r) S[r] = 0.f;
      LDS_AS(unsigned char)* kbase = slot + mt * 8192 + kb0;
#pragma unroll
      for (int s = 0; s < 8; ++s) {
        bf16x8 kf = *(const LDS_AS(bf16x8)*)(kbase + ((s ^ ksw) << 5));
        S = MFMA32(kf, qf[s], S);
      }
      if constexpr (MODE == 2) {
        LDS_AS(unsigned char)* rbase = slot + mt * 4096 + kr0;
#pragma unroll
        for (int s2 = 0; s2 < 4; ++s2) {
          bf16x8 kf = *(const LDS_AS(bf16x8)*)(rbase + (((2 * s2 + h) ^ krsw) << 4));
          S = MFMA32(kf, qf[8 + s2], S);
        }
      }
      float mx = -1e30f;
      float m_new, alpha;
      float ps = 0.f;
      const float m_old = m_run;
      if constexpr (MODE == 1) {
#pragma unroll
        for (int r = 0; r < 16; ++r) {
          float sv = S[r] * a.scale_log2;
          if (local) {
            int kcol = mt * 32 + crow(r, h);
            bool ok = (krow >= q_rs) && (krow < q_rs + 8) && (kcol >= q_cs) && (kcol < q_cs + 16);
            int dy = krow - qrow + 7, dx = kcol - qcol + 15;
            dy = dy < 0 ? 0 : (dy > 14 ? 14 : dy);
            dx = dx < 0 ? 0 : (dx > 30 ? 30 : dx);
            const float bv = bias_s[dy * 31 + dx];
            sv = ok ? sv + bv : -1e30f;
          }
          S[r] = sv;
          mx = fmaxf(mx, sv);
        }
        mx = xhalf_max(mx);
        DEFER_MAX_UPDATE();
        m_new = m_run;
#pragma unroll
        for (int r = 0; r < 16; ++r) {
          float pv = __builtin_amdgcn_exp2f(S[r] - m_new);
          if (S[r] <= -1e29f) pv = 0.f;
          S[r] = pv;
          ps += pv;
        }
      } else {
#pragma unroll
        for (int r = 0; r < 16; ++r) mx = fmaxf(mx, S[r]);
        mx = xhalf_max(mx) * a.scale_log2;
        DEFER_MAX_UPDATE();
        m_new = m_run;
        const float nm = -m_new;
#pragma unroll
        for (int r = 0; r < 16; ++r) {
          float pv = __builtin_amdgcn_exp2f(__builtin_fmaf(S[r], a.scale_log2, nm));
          S[r] = pv;
          ps += pv;
        }
      }
      l_run += ps;
      (void)m_old; (void)alpha;
      bf16x8 pf[2];
#pragma unroll
      for (int s2 = 0; s2 < 2; ++s2) {
        u32x4 u;
        u[0] = pack2(S[8 * s2 + 0], S[8 * s2 + 1]);
        u[1] = pack2(S[8 * s2 + 2], S[8 * s2 + 3]);
        u[2] = pack2(S[8 * s2 + 4], S[8 * s2 + 5]);
        u[3] = pack2(S[8 * s2 + 6], S[8 * s2 + 7]);
        pf[s2] = __builtin_bit_cast(bf16x8, u);
      }
      const unsigned vaddr = (unsigned)(size_t)(slot + mt * 8192);
#pragma unroll
      for (int c0 = 0; c0 < 4; c0 += 2) {
        const unsigned a0 = vaddr + vb0 + ((c0 ^ tq) << 6), a1 = vaddr + vb1 + ((c0 ^ tq) << 6);
        const unsigned a2 = vaddr + vb0 + (((c0 + 1) ^ tq) << 6), a3 = vaddr + vb1 + (((c0 + 1) ^ tq) << 6);
        s16x4 r0, r1, r2, r3, r4, r5, r6, r7;
        asm volatile(
            "ds_read_b64_tr_b16 %0, %8\n\t"
            "ds_read_b64_tr_b16 %1, %9\n\t"
            "ds_read_b64_tr_b16 %2, %8 offset:4096\n\t"
            "ds_read_b64_tr_b16 %3, %9 offset:4096\n\t"
            "ds_read_b64_tr_b16 %4, %10\n\t"
            "ds_read_b64_tr_b16 %5, %11\n\t"
            "ds_read_b64_tr_b16 %6, %10 offset:4096\n\t"
            "ds_read_b64_tr_b16 %7, %11 offset:4096\n\t"
            "s_waitcnt lgkmcnt(0)"
            : "=&v"(r0), "=&v"(r1), "=&v"(r2), "=&v"(r3), "=&v"(r4), "=&v"(r5), "=&v"(r6), "=&v"(r7)
            : "v"(a0), "v"(a1), "v"(a2), "v"(a3)
            : "memory");
        acc[c0] = MFMA32(__builtin_shufflevector(r0, r1, 0, 1, 2, 3, 4, 5, 6, 7), pf[0], acc[c0]);
        acc[c0] = MFMA32(__builtin_shufflevector(r2, r3, 0, 1, 2, 3, 4, 5, 6, 7), pf[1], acc[c0]);
        acc[c0 + 1] = MFMA32(__builtin_shufflevector(r4, r5, 0, 1, 2, 3, 4, 5, 6, 7), pf[0], acc[c0 + 1]);
        acc[c0 + 1] = MFMA32(__builtin_shufflevector(r6, r7, 0, 1, 2, 3, 4, 5, 6, 7), pf[1], acc[c0 + 1]);
      }
    }
  }
  asm volatile("s_waitcnt vmcnt(0)" ::: "memory");
  float l_tot = l_run + __shfl_xor(l_run, 32);
  float linv = 1.f / l_tot;
  const size_t qrow_i = (size_t)(wave * 32 + l31);
#pragma unroll
  for (int c = 0; c < 4; ++c)
#pragma unroll
    for (int g4 = 0; g4 < 4; ++g4) {
      int dv0 = 32 * c + 8 * g4 + 4 * h;
      uint2 gt = *(const uint2*)(a.gate + qrow_i * a.gs + dv0);
      float o0 = acc[c][4 * g4 + 0] * linv * silu(bflo(gt.x));
      float o1 = acc[c][4 * g4 + 1] * linv * silu(bfhi(gt.x));
      float o2 = acc[c][4 * g4 + 2] * linv * silu(bflo(gt.y));
      float o3 = acc[c][4 * g4 + 3] * linv * silu(bfhi(gt.y));
      *(uint2*)(a.out + qrow_i * a.os + dv0) = make_uint2(pack2(o0, o1), pack2(o2, o3));
    }
}

DI void phase_attn0(const Params& p, LDS_AS(unsigned char)* smem) {
  const u16* QKVG = (const u16*)(p.ws + OFF_BIG);
  u16* OG = (u16*)(p.ws + OFF_H);
  const u16* KA = (const u16*)(p.ws + OFF_KA_ALL);
  const u16* VA = (const u16*)(p.ws + OFF_VA_ALL);
  const u16* KBC = (const u16*)(p.ws + OFF_KB_CTX);
  const u16* VBC = (const u16*)(p.ws + OFF_VB_CTX);
  const float sc = 0.08838834764831845f * LOG2E;
  for (int it = blockIdx.x; it < 1024; it += gridDim.x) {
    AttnArgs a;
    a.qs = L0_IN; a.gs = L0_IN; a.os = D; a.scale_log2 = sc; a.rpb = nullptr; a.qtok0 = 0; a.rs0 = 0; a.rope = 0; a.ropetab = nullptr;
    a.seg[1].k = nullptr; a.seg[1].v = nullptr; a.seg[1].kr = nullptr; a.seg[1].ks = 0; a.seg[1].vs = 0; a.seg[1].n = 0;
    a.seg[0].kr = nullptr;
    if (it >= 256 && it < 512) {
      int i = it - 256;
      int bh = (i >> 5) * 8 + (i & 7), qb = (i >> 3) & 3;
      int b = bh >> 3, hh = bh & 7;
      size_t tok = (size_t)NCTX + b * 1024 + qb * 256;
      a.q = QKVG + tok * L0_IN + 1536 + hh * 128;
      a.gate = QKVG + tok * L0_IN + 4608 + 1024 + hh * 128;
      a.out = OG + tok * D + 1024 + hh * 128;
      a.nseg = 2;
      a.seg[0].k = KBC + (size_t)b * 512 * 1024 + hh * 128; a.seg[0].ks = 1024;
      a.seg[0].v = VBC + (size_t)b * 512 * 1024 + hh * 128; a.seg[0].vs = 1024;
      a.seg[0].n = 512;
      int rs0 = 4 * qb - 4; rs0 = rs0 < 0 ? 0 : (rs0 > 8 ? 8 : rs0);
      int rs1 = 4 * qb - 1; rs1 = rs1 < 0 ? 0 : (rs1 > 8 ? 8 : rs1);
      int nrows = rs1 + 8 - rs0;
      size_t ktok = (size_t)NCTX + b * 1024 + rs0 * 64;
      a.seg[1].k = QKVG + ktok * L0_IN + 2560 + hh * 128; a.seg[1].ks = L0_IN;
      a.seg[1].v = QKVG + ktok * L0_IN + 3584 + hh * 128; a.seg[1].vs = L0_IN;
      a.seg[1].n = nrows * 64;
      a.rpb = p.l0_rpb + hh * 15 * 31;
      a.qtok0 = qb * 256; a.rs0 = rs0;
      attn_block<128, 1>(a, smem);
    } else {
      a.nseg = 1;
      if (it < 256) {
        int g = (it >> 7) * 8 + (it & 7), j = (it >> 3) & 15;
        int b = g >> 1, hq = (g & 1) * 4 + (j >> 2), qb = j & 3;
        size_t tok = (size_t)NCTX + b * 1024 + qb * 256;
        a.q = QKVG + tok * L0_IN + hq * 128;
        a.gate = QKVG + tok * L0_IN + 4608 + hq * 128;
        a.out = OG + tok * D + hq * 128;
        a.seg[0].k = KA + (size_t)b * 1536 * 256 + (hq >> 2) * 128; a.seg[0].ks = 256;
        a.seg[0].v = VA + (size_t)b * 1536 * 256 + (hq >> 2) * 128; a.seg[0].vs = 256;
        a.seg[0].n = 1536;
      } else {
        int i = it - 512;
        bool isB = i >= 256; i &= 255;
        int g = (i >> 5) * 8 + (i & 7), j = (i >> 3) & 3;
        int b = isB ? (i >> 3) : (g >> 1), hh = isB ? (i & 7) : ((g & 1) * 4 + j);
        size_t tok = (size_t)b * 256;
        a.seg[0].n = 256; a.seg[0].ks = L0_IN; a.seg[0].vs = L0_IN;
        if (!isB) {
          a.q = QKVG + tok * L0_IN + hh * 128;
          a.gate = QKVG + tok * L0_IN + 4608 + hh * 128;
          a.out = OG + tok * D + hh * 128;
          a.seg[0].k = QKVG + tok * L0_IN + 1024 + (hh >> 2) * 128;
          a.seg[0].v = QKVG + tok * L0_IN + 1280 + (hh >> 2) * 128;
        } else {
          a.q = QKVG + tok * L0_IN + 1536 + hh * 128;
          a.gate = QKVG + tok * L0_IN + 4608 + 1024 + hh * 128;
          a.out = OG + tok * D + 1024 + hh * 128;
          a.seg[0].k = QKVG + tok * L0_IN + 2560 + hh * 128;
          a.seg[0].v = QKVG + tok * L0_IN + 3584 + hh * 128;
        }
      }
      attn_block<128, 0>(a, smem);
    }
  }
}

DI void phase_attn1(const Params& p, LDS_AS(unsigned char)* smem, int round) {
  const u16* Q1 = (const u16*)(p.ws + OFF_Q1);
  u16* LAT1 = (u16*)(p.ws + OFF_LAT1);
  const float sc = 0.07216878364870322f * LOG2E;
  for (int it = blockIdx.x; it < 512; it += gridDim.x) {
    AttnArgs a;
    a.qs = 3072; a.gs = L1_LD; a.os = L1_LD; a.scale_log2 = sc; a.rpb = nullptr; a.rs0 = 0; a.ropetab = (const float*)(p.ws + OFF_ROPE);
    a.seg[1].k = nullptr; a.seg[1].v = nullptr; a.seg[1].kr = nullptr; a.seg[1].ks = 0; a.seg[1].vs = 0; a.seg[1].n = 0;
    a.nseg = 1;
    a.seg[0].ks = 4096; a.seg[0].vs = 4096;
    size_t tok;
    int hh;
    if (round == 0) {
      int b = it >> 4; hh = it & 15;
      tok = (size_t)b * 256;
      const u16* KV = (const u16*)(p.ws + OFF_KV_CTX) + (size_t)b * 256 * 4096 + hh * 256;
      a.seg[0].k = KV; a.seg[0].v = KV + 128;
      a.seg[0].kr = (const u16*)(p.ws + OFF_KR_CTX) + (size_t)b * 256 * 64;
      a.seg[0].n = 256;
      a.rope = 0; a.qtok0 = 0;
    } else {
      int bh = (it >> 5) * 8 + (it & 7), qb = (it >> 3) & 3;
      int b = bh >> 4; hh = bh & 15;
      tok = (size_t)NCTX + b * 1024 + qb * 256;
      const u16* KV = (const u16*)(p.ws + OFF_KV_LAT) + (size_t)b * 1536 * 4096 + hh * 256;
      a.seg[0].k = KV; a.seg[0].v = KV + 128;
      a.seg[0].kr = (const u16*)(p.ws + OFF_KR_ALL) + (size_t)b * 1536 * 64;
      a.seg[0].n = 1536;
      a.rope = 1; a.qtok0 = qb * 256;
    }
    a.q = Q1 + tok * 3072 + hh * 192;
    a.gate = LAT1 + tok * L1_LD + L1_GATE + hh * 128;
    a.out = LAT1 + tok * L1_LD + L1_GATE + hh * 128;
    attn_block<192, 2>(a, smem);
  }
}

#define XB_TMO      128
#define XB_XCNT(j)  (256  + 64 * (j))
#define XB_XSUB(j)  (1280 + 64 * (j))
#define XB_XGEN(j)  (2304 + 64 * (j))
#define XB_TOP      3328
#define XB_TOPGEN   3392
#define XCD_BAR_WORDS 3456
#define XB_SPIN_CAP (1u << 18)
#define XLAS __attribute__((address_space(3)))

__device__ __forceinline__ unsigned xb_ld(unsigned* p)              { return __hip_atomic_load(p, __ATOMIC_RELAXED, __HIP_MEMORY_SCOPE_AGENT); }
__device__ __forceinline__ unsigned xb_add(unsigned* p, unsigned v) { return __hip_atomic_fetch_add(p, v, __ATOMIC_RELAXED, __HIP_MEMORY_SCOPE_AGENT); }
__device__ __forceinline__ unsigned xb_xcc_id() { return (unsigned)__builtin_amdgcn_s_getreg((3 << 11) | 20) & 0xFu; }
#define XB_SPIN(cond, bar) do { unsigned _sp = 0; while (cond) { __builtin_amdgcn_s_sleep(1); \
    if ((++_sp & 255u) == 0u) { if (xb_ld(&(bar)[XB_TMO])) break; if (_sp > XB_SPIN_CAP) { atomicAdd(&(bar)[XB_TMO], 1u); break; } } } } while (0)

struct XcdBarrier {
    unsigned* bar; unsigned x;
    volatile XLAS unsigned* st;
};

__device__ __forceinline__ XcdBarrier xcd_barrier_post(unsigned* bar, volatile XLAS unsigned* st) {
    XcdBarrier b; b.bar = bar; b.x = xb_xcc_id(); b.st = st;
    if (threadIdx.x == 0) (void)xb_add(&bar[XB_XCNT(b.x)], 1u);
    return b;
}
__device__ __forceinline__ void xcd_barrier_complete(unsigned* bar, unsigned x, unsigned& nloc, unsigned& nx) {
    const unsigned G = gridDim.x * gridDim.y * gridDim.z;
    unsigned sum, cnt, mine, sp = 0u;
    for (;;) {
        sum = 0u; cnt = 0u; mine = 0u;
#pragma unroll
        for (unsigned j = 0; j < 16; ++j) { const unsigned c = xb_ld(&bar[XB_XCNT(j)]); sum += c; cnt += (c > 0u) ? 1u : 0u; mine = (j == x) ? c : mine; }
        if (sum == G) break;
        __builtin_amdgcn_s_sleep(1);
        if ((++sp & 255u) == 0u) { if (xb_ld(&bar[XB_TMO])) break; if (sp > XB_SPIN_CAP) { atomicAdd(&bar[XB_TMO], 1u); break; } }
    }
    nloc = mine > 0u ? mine : 1u; nx = cnt > 0u ? cnt : 1u;
}

__device__ __forceinline__ void xcd_barrier(const XcdBarrier& b) {
    asm volatile("s_waitcnt vmcnt(0)" ::: "memory");
    __syncthreads();
    if (threadIdx.x == 0) {
        unsigned* bar = b.bar;
        __builtin_amdgcn_s_waitcnt(0);
        unsigned nloc = b.st[0], nx = b.st[1];
        if (nloc == 0u) { xcd_barrier_complete(bar, b.x, nloc, nx); b.st[0] = nloc; b.st[1] = nx; }
        const unsigned old = xb_add(&bar[XB_XSUB(b.x)], 1u);
        const unsigned gen = old / nloc;
        if (old + 1u == (gen + 1u) * nloc) {
            __builtin_amdgcn_fence(__ATOMIC_RELEASE, "agent");
            asm volatile("s_waitcnt vmcnt(0)" ::: "memory");
            const unsigned og = xb_add(&bar[XB_TOP], 1u);
            const unsigned tg = og / nx;
            if (og + 1u == (tg + 1u) * nx) xb_add(&bar[XB_TOPGEN], 1u);
            else XB_SPIN(xb_ld(&bar[XB_TOPGEN]) == tg, bar);
            __builtin_amdgcn_fence(__ATOMIC_ACQUIRE, "agent");
            xb_add(&bar[XB_XGEN(b.x)], 1u);
            asm volatile("s_waitcnt vmcnt(0)" ::: "memory");
        } else {
            XB_SPIN(xb_ld(&bar[XB_XGEN(b.x)]) == gen, bar);
            __builtin_amdgcn_fence(__ATOMIC_ACQUIRE, "agent");
            asm volatile("s_waitcnt vmcnt(0)" ::: "memory");
        }
    }
    __syncthreads();
}

__global__ void __launch_bounds__(512, 2) fwd_megakernel(Params p) {
  cg::grid_group grid = cg::this_grid();
  extern __shared__ __attribute__((aligned(16))) unsigned char dsm[];
  char* smem = (char*)dsm;
  char* ws = p.ws;
  const float* mod0 = (const float*)(ws + OFF_MOD);
  const float* mod1 = mod0 + 9 * 6144;

  volatile XLAS unsigned* xst = (volatile XLAS unsigned*)((XLAS unsigned char*)dsm + 128 * 1024);
  if (threadIdx.x < 4) xst[threadIdx.x] = 0u;
  __syncthreads();
  const XcdBarrier xb = xcd_barrier_post((unsigned*)(ws + OFF_BAR), xst);
  phase_prep(p, smem);
  if (p.out == nullptr) grid.sync();
  xcd_barrier(xb);
  phase_normmod(p, 0);
  xcd_barrier(xb);
  { EpiBf16 e{(u16*)(ws + OFF_BIG), L0_IN};
    gemm_run((PG8_LAS unsigned char*)dsm, (const u16*)(ws + OFF_H), D, (const u16*)(ws + OFF_WT_IN0), NTOK, L0_IN, 2048, e); }
  if (gridDim.x == 256) { if (blockIdx.x >= 128 && blockIdx.x < 224) adaln_item(p, 1, blockIdx.x - 128, (float*)smem); }
  else { for (int c = blockIdx.x; c < 96; c += gridDim.x) adaln_item(p, 1, c, (float*)smem); }
  xcd_barrier(xb);
  phase_qknorm0(p);
  xcd_barrier(xb);
#pragma unroll 1
  for (int rep = 0; rep < REP_A0; ++rep) phase_attn0(p, (LDS_AS(unsigned char)*)dsm);
  xcd_barrier(xb);
  { EpiResidB<false> e{p.x_prompt, p.x_sample, mod0 + 4096, (u16*)(p.out + OUT_Y)};
    gemm_run((PG8_LAS unsigned char*)dsm, (const u16*)(ws + OFF_H), D, (const u16*)(ws + OFF_WT_OUT0), NTOK, D, 2048, e); }
  xcd_barrier(xb);
  phase_normmod1(p);
  xcd_barrier(xb);
  { EpiBf16 e{(u16*)(ws + OFF_LAT1), L1_LD};
    gemm_run((PG8_LAS unsigned char*)dsm, (const u16*)(ws + OFF_H), D, (const u16*)(ws + OFF_WT_IN1), NTOK, L1_LD, 2048, e); }
  xcd_barrier(xb);
  phase_krope(p, smem);
  phase_norm1(p);
  xcd_barrier(xb);
  { EpiBf16 e{(u16*)(ws + OFF_Q1), 3072};
    gemm_run((PG8_LAS unsigned char*)dsm, (const u16*)(ws + OFF_QN), 512, (const u16*)(ws + OFF_WT_QB), NTOK, 3072, 512, e); }
#pragma unroll 1
  for (int round = 0; round < 2; ++round) {
    { EpiBf16 e{(u16*)(ws + (round ? OFF_KV_LAT : OFF_KV_CTX)), 4096};
      gemm_run((PG8_LAS unsigned char*)dsm, (const u16*)(ws + (round ? OFF_CKV_ALL : OFF_CKV_CTX)), 512, (const u16*)(ws + OFF_WT_KVB),
               round ? 12288 : NCTX, 4096, 512, e); }
    xcd_barrier(xb);
    phase_attn1(p, (LDS_AS(unsigned char)*)dsm, round);
    xcd_barrier(xb);
  }
  { EpiResidB<true> e{p.out + OUT_Y, nullptr, mod1 + 4096, (u16*)(ws + OFF_Q1)};
    gemm_run((PG8_LAS unsigned char*)dsm, (const u16*)(ws + OFF_LAT1) + L1_GATE, L1_LD, (const u16*)(ws + OFF_WT_OUT1), NTOK, D, 2048, e); }
  xcd_barrier(xb);
  phase_final(p);
}

extern "C" void kernel_launch(void* const* d_in, const int* in_sizes, int n_in, void* d_out, int out_size, void* d_ws,
                              size_t ws_size, hipStream_t stream) {
  (void)in_sizes; (void)n_in; (void)out_size;
  if (ws_size < WS_NEEDED) { fprintf(stderr, "workspace too small: %zu < %zu\n", ws_size, (size_t)WS_NEEDED); return; }
  static int grid_blocks = 0;
  if (!grid_blocks) {
    int dev = 0, cus = 0, per_cu = 0;
    (void)hipGetDevice(&dev);
    (void)hipDeviceGetAttribute(&cus, hipDeviceAttributeMultiprocessorCount, dev);
    if (hipFuncSetAttribute((const void*)fwd_megakernel, hipFuncAttributeMaxDynamicSharedMemorySize, SMEM_BYTES) != hipSuccess) {
      fprintf(stderr, "hipFuncSetAttribute failed\n"); return; }
    (void)hipOccupancyMaxActiveBlocksPerMultiprocessor(&per_cu, fwd_megakernel, NT, SMEM_BYTES);
    if (per_cu < 1) { fprintf(stderr, "occupancy query returned %d\n", per_cu); return; }
    grid_blocks = cus;
  }
  Params p{};
  const float** pf = (const float**)&p;
  for (int i = 0; i < 28; ++i) pf[i] = (const float*)d_in[i];
  p.out = (float*)d_out;
  p.ws = (char*)d_ws;
  (void)hipMemsetAsync((char*)d_ws + OFF_BAR, 0, BAR_BYTES, stream);
  void* args[] = {&p};
  hipError_t e = hipLaunchCooperativeKernel((void*)fwd_megakernel, dim3(grid_blocks), dim3(NT), args, SMEM_BYTES, stream);
  if (e != hipSuccess) fprintf(stderr, "cooperative launch failed: %s (grid %d)\n", hipGetErrorString(e), grid_blocks);
}
```

```cpp
#include <hip/hip_runtime.h>
#include <hip/hip_cooperative_groups.h>
#include <cstdio>
namespace cg = cooperative_groups;

typedef unsigned short u16;
using bf16x8 = __attribute__((ext_vector_type(8))) short;
using s16x4  = __attribute__((ext_vector_type(4))) short;
using f32x16 = __attribute__((ext_vector_type(16))) float;
using f32x4  = __attribute__((ext_vector_type(4))) float;
using u32x4  = __attribute__((ext_vector_type(4))) unsigned;
typedef __bf16 bf16x2_t __attribute__((ext_vector_type(2)));
typedef float f32x2_t __attribute__((ext_vector_type(2)));
#define DI __device__ __forceinline__
#define MFMA32(a, b, c) __builtin_amdgcn_mfma_f32_32x32x16_bf16((a), (b), (c), 0, 0, 0)
#define LDS_AS(T) __attribute__((address_space(3))) T

constexpr int D = 2048;
constexpr int NTOK = 16384;
constexpr int NCTX = 8192;
constexpr int L0_IN = 6656;
constexpr int L1_IN = 3136;
constexpr int L1_LD = 3072;
constexpr int L1_GATE = 1024;
constexpr float EPS = 1e-6f;
constexpr float LOG2E = 1.4426950408889634f;
constexpr float LOG2_THETA = 13.287712379549449f;
#ifndef REP_G
#define REP_G 1
#endif
#ifndef REP_A0
#define REP_A0 1
#endif
constexpr int NT = 512;
constexpr int NW = 8;

constexpr size_t OFF_WT_IN1  = 0;
constexpr size_t OFF_WT_QB   = OFF_WT_IN1 + (size_t)3328 * 2048 * 2;
constexpr size_t OFF_WT_KVB  = OFF_WT_QB + (size_t)3072 * 512 * 2;
constexpr size_t OFF_WT_OUT1 = OFF_WT_KVB + (size_t)4096 * 512 * 2;
constexpr size_t OFF_WL0     = OFF_WT_OUT1 + (size_t)2048 * 2048 * 2;
constexpr size_t OFF_WT_IN0  = OFF_WL0;
constexpr size_t OFF_WT_OUT0 = OFF_WT_IN0 + (size_t)6656 * 2048 * 2;
constexpr size_t OFF_H       = OFF_WT_OUT0 + (size_t)2048 * 2048 * 2;
constexpr size_t OFF_BIG     = OFF_H + (size_t)NTOK * 2048 * 2;
constexpr size_t OFF_C       = OFF_BIG + (size_t)NTOK * 6656 * 2;
constexpr size_t OFF_KA_ALL  = OFF_C;
constexpr size_t OFF_VA_ALL  = OFF_KA_ALL + (size_t)8 * 1536 * 256 * 2;
constexpr size_t OFF_KB_CTX  = OFF_VA_ALL + (size_t)8 * 1536 * 256 * 2;
constexpr size_t OFF_VB_CTX  = OFF_KB_CTX + (size_t)8 * 512 * 1024 * 2;
constexpr size_t OFF_CKV_ALL = OFF_VB_CTX + (size_t)8 * 512 * 1024 * 2;
constexpr size_t OFF_KR_ALL  = OFF_CKV_ALL + (size_t)8 * 1536 * 512 * 2;
constexpr size_t OFF_MOD     = OFF_KR_ALL + (size_t)8 * 1536 * 64 * 2;
constexpr size_t OFF_ROPE    = OFF_MOD + (size_t)2 * 9 * 6144 * 4;
constexpr size_t OFF_ROPE0   = OFF_ROPE + (size_t)64 * 16 * 2 * 4;
constexpr size_t OFF_BAR     = OFF_ROPE0 + (size_t)64 * 32 * 2 * 4;
constexpr size_t BAR_BYTES   = 3456 * 4;
constexpr size_t WS_NEEDED   = OFF_BAR + BAR_BYTES;
constexpr size_t OFF_QN      = OFF_WL0;
constexpr size_t OFF_CKV_CTX = OFF_QN + (size_t)NTOK * 512 * 2;
constexpr size_t OFF_KR_CTX  = OFF_CKV_CTX + (size_t)NCTX * 512 * 2;
constexpr size_t OFF_KV_CTX  = OFF_H;
constexpr size_t OFF_KV_LAT  = OFF_WL0;
constexpr size_t OFF_LAT1    = OFF_BIG;
constexpr size_t OFF_Q1      = OFF_BIG + (size_t)NTOK * L1_LD * 2;
static_assert(OFF_KR_CTX + (size_t)NCTX * 64 * 2 <= OFF_WT_OUT0, "l1 small bufs overflow");
static_assert(OFF_KV_LAT + (size_t)12288 * 4096 * 2 <= OFF_BIG, "kv_lat overflow");
static_assert(OFF_Q1 + (size_t)NTOK * 3072 * 2 <= OFF_C, "q1 overflow");

constexpr size_t OUT_Y   = 0;
constexpr size_t OUT_NAK = (size_t)NTOK * 2048;
constexpr size_t OUT_NAV = OUT_NAK + (size_t)NCTX * 256;
constexpr size_t OUT_NBK = OUT_NAV + (size_t)NCTX * 256;
constexpr size_t OUT_NBV = OUT_NBK + (size_t)NCTX * 1024;
constexpr size_t OUT_NCKV = OUT_NBV + (size_t)NCTX * 1024;
constexpr size_t OUT_NKR = OUT_NCKV + (size_t)NCTX * 512;

constexpr int SMEM_BYTES = 128 * 1024 + 256 + 8192;

struct Params {
  const float *x_prompt, *x_sample, *ca_k, *ca_v, *cb_k, *cb_v, *c_ckv, *c_kr, *c, *c_ctx;
  const float *l0_norm, *l0_ada_w, *l0_ada_b, *l0_w_in, *l0_qn, *l0_kn, *l0_rpb, *l0_w_out;
  const float *l1_norm, *l1_ada_w, *l1_ada_b, *l1_w_in, *l1_qan, *l1_wqb, *l1_kvan, *l1_wkvb, *l1_w_out, *fnorm;
  float* out;
  char* ws;
};

DI int threadIdx_x_raw() { return (int)__builtin_amdgcn_workitem_id_x(); }
DI u16 f2bf(float x) { unsigned u = __float_as_uint(x); u += 0x7fffu + ((u >> 16) & 1u); return (u16)(u >> 16); }
DI float bf2f(u16 v) { return __uint_as_float(((unsigned)v) << 16); }
DI unsigned pack2(float a, float b) { f32x2_t f = {a, b}; bf16x2_t r = __builtin_convertvector(f, bf16x2_t); return __builtin_bit_cast(unsigned, r); }
DI float bflo(unsigned u) { return __uint_as_float(u << 16); }
DI float bfhi(unsigned u) { return __uint_as_float(u & 0xffff0000u); }
DI float wave_sum(float v) {
#pragma unroll
  for (int o = 32; o >= 1; o >>= 1) v += __shfl_xor(v, o);
  return v;
}
DI int TID() { int t = threadIdx_x_raw(); asm volatile("" : "+v"(t)); return t; }
DI int crow(int i, int h) { return (i & 3) + 8 * (i >> 2) + 4 * h; }
DI float silu(float x) { return x / (1.f + __expf(-x)); }
DI int tok_modrow(int tok) { return tok < NCTX ? 0 : 1 + ((tok - NCTX) >> 10); }

DI void transpose_tile(const float* __restrict__ src, int K, int N, u16* __restrict__ dst, int kt, int nt, float* sm, bool remap1 = false) {
  const int t = TID();
  float4 v[8];
#pragma unroll
  for (int i = 0; i < 8; ++i) {
    int id = t + NT * i, r = id >> 6, c4 = id & 63, n = nt * 256 + c4 * 4;
    v[i] = (n < N) ? *(const float4*)(src + (size_t)(kt * 64 + r) * N + n) : make_float4(0.f, 0.f, 0.f, 0.f);
  }
#pragma unroll
  for (int i = 0; i < 8; ++i) {
    int id = t + NT * i, r = id >> 6, c4 = id & 63;
    *(float4*)(sm + r * 260 + c4 * 4) = v[i];
  }
  __syncthreads();
  {
    const int nl = t >> 1, kq = t & 1, n = nt * 256 + nl;
    if (n < N) {
      const int nr = !remap1 ? n : (n < 1024 ? n : (n < 1088 ? n + 2048 : n - 64));
      u16* dp = dst + (size_t)nr * K + kt * 64 + kq * 32;
#pragma unroll
      for (int q = 0; q < 4; ++q) {
        u32x4 o;
#pragma unroll
        for (int j = 0; j < 4; ++j) o[j] = pack2(sm[(kq * 32 + q * 8 + 2 * j) * 260 + nl], sm[(kq * 32 + q * 8 + 2 * j + 1) * 260 + nl]);
        *(u32x4*)(dp + q * 8) = o;
      }
    }
  }
  __syncthreads();
}

DI void adaln_item(const Params& p, int l, int chunk, float* sm) {
  const float* W = l ? p.l1_ada_w : p.l0_ada_w;
  const float* bias = l ? p.l1_ada_b : p.l0_ada_b;
  float* mod = (float*)(p.ws + OFF_MOD) + (size_t)l * 9 * 6144;
  const int t = TID(), col = chunk * 64 + (t & 63), kg = t >> 6;
  float acc[9];
#pragma unroll
  for (int r = 0; r < 9; ++r) acc[r] = 0.f;
  for (int kh = 0; kh < 2; ++kh) {
    __syncthreads();
    for (int e = t; e < 9 * 1024; e += NT) {
      int r = e >> 10, k = e & 1023;
      float cv = (r == 0) ? p.c_ctx[kh * 1024 + k] : p.c[(r - 1) * 2048 + kh * 1024 + k];
      sm[r * 1024 + k] = silu(cv);
    }
    __syncthreads();
    const float* wp = W + (size_t)(kh * 1024 + kg * 128) * 6144 + col;
    const float* sp = sm + kg * 128;
#pragma unroll 8
    for (int k = 0; k < 128; ++k) {
      float w = wp[(size_t)k * 6144];
#pragma unroll
      for (int r = 0; r < 9; ++r) acc[r] += sp[r * 1024 + k] * w;
    }
  }
  __syncthreads();
#pragma unroll
  for (int r = 0; r < 9; ++r) sm[(kg * 9 + r) * 64 + (t & 63)] = acc[r];
  __syncthreads();
  for (int e = t; e < 9 * 64; e += NT) {
    int r = e >> 6, cc = e & 63;
    float s = 0.f;
#pragma unroll
    for (int g = 0; g < NW; ++g) s += sm[(g * 9 + r) * 64 + cc];
    mod[(size_t)r * 6144 + chunk * 64 + cc] = s + bias[chunk * 64 + cc];
  }
  __syncthreads();
}

DI void convert_item(const float* __restrict__ src, u16* __restrict__ dst, int W, int dstT, int item) {
  size_t e = (size_t)item * 4096 + TID() * 8;
  size_t per_b = (size_t)512 * W;
  size_t b = e / per_b, r = e % per_b;
  float4 v0 = *(const float4*)(src + e), v1 = *(const float4*)(src + e + 4);
  u32x4 o = {pack2(v0.x, v0.y), pack2(v0.z, v0.w), pack2(v1.x, v1.y), pack2(v1.z, v1.w)};
  *(u32x4*)(dst + b * (size_t)dstT * W + r) = o;
}

DI void phase_prep(const Params& p, char* smem) {
  float* sm = (float*)smem;
  char* ws = p.ws;
  constexpr int T_IN0 = 32 * 26, T_OUT0 = 32 * 8, T_IN1 = 32 * 13, T_QB = 8 * 12, T_KVB = 8 * 16, T_OUT1 = 32 * 8;
  constexpr int C_A = 256, C_B = 1024, C_CKV = 512, C_KR = 64;
  constexpr int B1 = 0, B2 = B1 + T_IN0, B3 = B2 + T_OUT0, B4 = B3 + T_IN1, B5 = B4 + T_QB, B6 = B5 + T_KVB, B7 = B6 + T_OUT1;
  constexpr int B8 = B7 + C_A, B9 = B8 + C_A, B10 = B9 + C_B, B11 = B10 + C_B, B12 = B11 + C_CKV, B13 = B12 + C_KR;
  if (blockIdx.x == gridDim.x - 1) {
    float* tab = (float*)(ws + OFF_ROPE);
    for (int e = TID(); e < 64 * 16; e += NT) {
      int pos = e >> 4, i = e & 15;
      float inv = exp2f(-(float)i * (LOG2_THETA / 16.f));
      float sn, cs; sincosf((float)pos * inv, &sn, &cs);
      tab[2 * e] = cs; tab[2 * e + 1] = sn;
    }
    float* tab0 = (float*)(ws + OFF_ROPE0);
    for (int e = TID(); e < 64 * 32; e += NT) {
      int pos = e >> 5, i = e & 31;
      float inv = exp2f(-(float)i * (LOG2_THETA / 32.f));
      float sn, cs; sincosf((float)pos * inv, &sn, &cs);
      tab0[2 * e] = cs; tab0[2 * e + 1] = sn;
    }
  }
  const int nada = (gridDim.x > 128) ? 96 : 0;
  if ((int)blockIdx.x < nada) { adaln_item(p, 0, blockIdx.x, sm); return; }
  if (nada == 0) { for (int c = blockIdx.x; c < 96; c += gridDim.x) adaln_item(p, 0, c, sm); }
  for (int it = blockIdx.x - nada; it < B13; it += gridDim.x - nada) {
    if (it < B2) { int i = it - B1; transpose_tile(p.l0_w_in, 2048, 6656, (u16*)(ws + OFF_WT_IN0), i / 26, i % 26, sm); }
    else if (it < B3) { int i = it - B2; transpose_tile(p.l0_w_out, 2048, 2048, (u16*)(ws + OFF_WT_OUT0), i / 8, i % 8, sm); }
    else if (it < B4) { int i = it - B3; transpose_tile(p.l1_w_in, 2048, 3136, (u16*)(ws + OFF_WT_IN1), i / 13, i % 13, sm, true); }
    else if (it < B5) { int i = it - B4; transpose_tile(p.l1_wqb, 512, 3072, (u16*)(ws + OFF_WT_QB), i / 12, i % 12, sm); }
    else if (it < B6) { int i = it - B5; transpose_tile(p.l1_wkvb, 512, 4096, (u16*)(ws + OFF_WT_KVB), i / 16, i % 16, sm); }
    else if (it < B7) { int i = it - B6; transpose_tile(p.l1_w_out, 2048, 2048, (u16*)(ws + OFF_WT_OUT1), i / 8, i % 8, sm); }
    else if (it < B8) convert_item(p.ca_k, (u16*)(ws + OFF_KA_ALL), 256, 1536, it - B7);
    else if (it < B9) convert_item(p.ca_v, (u16*)(ws + OFF_VA_ALL), 256, 1536, it - B8);
    else if (it < B10) convert_item(p.cb_k, (u16*)(ws + OFF_KB_CTX), 1024, 512, it - B9);
    else if (it < B11) convert_item(p.cb_v, (u16*)(ws + OFF_VB_CTX), 1024, 512, it - B10);
    else if (it < B12) convert_item(p.c_ckv, (u16*)(ws + OFF_CKV_ALL), 512, 1536, it - B11);
    else convert_item(p.c_kr, (u16*)(ws + OFF_KR_ALL), 64, 1536, it - B12);
  }
}

DI void phase_normmod(const Params& p, int layer) {
  const int wave = TID() >> 6, lane = TID() & 63;
  const float* g = layer ? p.l1_norm : p.l0_norm;
  const float* mod = (const float*)(p.ws + OFF_MOD) + (size_t)layer * 9 * 6144;
  u16* H = (u16*)(p.ws + OFF_H);
  for (int it = blockIdx.x; it < NTOK / NW; it += gridDim.x) {
    int row = it * NW + wave;
    const float* src;
    if (layer == 0) src = row < NCTX ? p.x_prompt + (size_t)row * D : p.x_sample + (size_t)(row - NCTX) * D;
    else src = p.out + OUT_Y + (size_t)row * D;
    const float* mr = mod + (size_t)tok_modrow(row) * 6144;
    float4 v[8];
    float ss = 0.f;
#pragma unroll
    for (int i = 0; i < 8; ++i) {
      v[i] = *(const float4*)(src + (i * 64 + lane) * 4);
      ss += v[i].x * v[i].x + v[i].y * v[i].y + v[i].z * v[i].z + v[i].w * v[i].w;
    }
    ss = wave_sum(ss);
    float rinv = rsqrtf(ss * (1.f / D) + EPS);
#pragma unroll
    for (int i = 0; i < 8; ++i) {
      int col = (i * 64 + lane) * 4;
      float4 gg = *(const float4*)(g + col);
      float4 sh = *(const float4*)(mr + col);
      float4 sc = *(const float4*)(mr + 2048 + col);
      float h0 = v[i].x * rinv * gg.x * (1.f + sc.x) + sh.x;
      float h1 = v[i].y * rinv * gg.y * (1.f + sc.y) + sh.y;
      float h2 = v[i].z * rinv * gg.z * (1.f + sc.z) + sh.z;
      float h3 = v[i].w * rinv * gg.w * (1.f + sc.w) + sh.w;
      *(uint2*)(H + (size_t)row * D + col) = make_uint2(pack2(h0, h1), pack2(h2, h3));
    }
  }
}

DI void phase_normmod1(const Params& p) {
  const int wave = TID() >> 6, lane = TID() & 63;
  const float* g = p.l1_norm;
  const float* mod = (const float*)(p.ws + OFF_MOD) + (size_t)9 * 6144;
  const u16* X1 = (const u16*)(p.out + OUT_Y);
  u16* H = (u16*)(p.ws + OFF_H);
  for (int it = blockIdx.x; it < NTOK / NW; it += gridDim.x) {
    const int row = it * NW + wave;
    const float* mr = mod + (size_t)tok_modrow(row) * 6144;
    u32x4 v[4];
    float ss = 0.f;
#pragma unroll
    for (int i = 0; i < 4; ++i) {
      v[i] = *(const u32x4*)(X1 + (size_t)row * D + (i * 64 + lane) * 8);
#pragma unroll
      for (int j = 0; j < 4; ++j) { const float a0 = bflo(v[i][j]), a1 = bfhi(v[i][j]); ss += a0 * a0 + a1 * a1; }
    }
    ss = wave_sum(ss);
    const float rinv = rsqrtf(ss * (1.f / D) + EPS);
#pragma unroll
    for (int i = 0; i < 4; ++i) {
      const int col = (i * 64 + lane) * 8;
      u32x4 o;
#pragma unroll
      for (int q = 0; q < 2; ++q) {
        const f32x4 gg = *(const f32x4*)(g + col + 4 * q);
        const f32x4 sh = *(const f32x4*)(mr + col + 4 * q);
        const f32x4 sc = *(const f32x4*)(mr + 2048 + col + 4 * q);
        const float x0 = bflo(v[i][2 * q]), x1 = bfhi(v[i][2 * q]), x2 = bflo(v[i][2 * q + 1]), x3 = bfhi(v[i][2 * q + 1]);
        const float h0 = x0 * rinv * gg[0] * (1.f + sc[0]) + sh[0];
        const float h1 = x1 * rinv * gg[1] * (1.f + sc[1]) + sh[1];
        const float h2 = x2 * rinv * gg[2] * (1.f + sc[2]) + sh[2];
        const float h3 = x3 * rinv * gg[3] * (1.f + sc[3]) + sh[3];
        o[2 * q] = pack2(h0, h1); o[2 * q + 1] = pack2(h2, h3);
      }
      *(u32x4*)(H + (size_t)row * D + col) = o;
    }
  }
}

namespace pg8 {
#define PG8_LAS __attribute__((address_space(3)))
typedef unsigned short bf16_t;
typedef short bf16x8 __attribute__((ext_vector_type(8)));
typedef float f32x4 __attribute__((ext_vector_type(4)));
typedef unsigned u32x4 __attribute__((ext_vector_type(4)));
constexpr int BM = 256, BK = 64, HALF = 128, HTB = HALF * BK * 2  , STAGE_BYTES = 8 * HTB, NXCD = 8, WGM = 8;

__host__ __device__ __forceinline__ int lds_byte(int r, int c) { const int st = (r >> 4) * 2 + (c >> 5), rr = r & 15, cc = c & 31, ob = rr * 64 + cc * 2; return st * 1024 + (ob ^ (((ob >> 9) & 1) << 5)); }
__host__ __device__ __forceinline__ void stage_rc(int b, int& R, int& C) { const int st = b / 1024, sb = b % 1024, swz = sb ^ (((sb >> 9) & 1) << 5); R = (st >> 1) * 16 + swz / 64; C = (st & 1) * 32 + (swz % 64) / 2; }
__host__ __device__ __forceinline__ int perm32(int rho) { const int n = rho >> 4, i = rho & 15; return 8 * (i >> 2) + 4 * n + (i & 3); }

struct Unit { int pm, pn; };
struct Gemm { const bf16_t* A; const bf16_t* Bt; int M, N, K, lda; };
struct StaticOrder {
    int nM, nN, nwg, G, c;
    __host__ __device__ void init(int M, int N, int G_, int c_) { nM = M / BM; nN = N / BM; nwg = nM * nN; G = G_; c = c_; }
    __host__ __device__ bool next(int i, Unit& u) const {
        const long L = (long)i * G + c; if (L >= nwg) return false;
        int wgid = (int)L; { const int q = nwg / NXCD, r = nwg % NXCD, xcd = wgid % NXCD, off = wgid / NXCD; wgid = (xcd < r ? xcd * (q + 1) : r * (q + 1) + (xcd - r) * q) + off; }
        const int nig = WGM * nN, gid = wgid / nig, fm = gid * WGM, gsz = (nM - fm) < WGM ? (nM - fm) : WGM;
        u.pm = fm + ((wgid % nig) % gsz); u.pn = (wgid % nig) / gsz; return true;
    }
    __device__ __forceinline__ void a_ready(const Unit&) const {}
    __device__ __forceinline__ void done(const Unit&) const {}
};
template <class Epi, class Sched, bool STAMP = false>
__device__ __forceinline__ void gemm_phase(PG8_LAS unsigned char* lds, const Gemm g, const Sched& S, const Epi& E, unsigned long long* stamps) {
    const int tid = TID(), wid = __builtin_amdgcn_readfirstlane(tid >> 6), lane = tid & 63, wr = wid >> 2, wc = wid & 3, fr = lane & 15, fq = lane >> 4;
    const int K = g.K, nt = K / BK;
    int ts_lo = 0, ts_hi = 0, nts = 0; const unsigned long long rt_entry = STAMP ? (unsigned long long)wall_clock64() : 0ull;
#define PG8_STAMP() do { if (STAMP && wid == 0 && nts < 64) { const unsigned long long _c = (unsigned long long)clock64(); \
        ts_lo = (lane == nts) ? (int)(unsigned)_c : ts_lo; ts_hi = (lane == nts) ? (int)(unsigned)(_c >> 32) : ts_hi; ++nts; } } while (0)
    PG8_STAMP();
    unsigned voffA[2], voffB[2];
#pragma unroll
    for (int i = 0; i < 2; ++i) { int R, C; stage_rc(tid * 16 + i * 8192, R, C); const int Rb = Epi::PERM ? ((R & ~31) + perm32(R & 31)) : R;
        voffA[i] = (unsigned)(R * g.lda + C) * 2u; voffB[i] = (unsigned)(Rb * K + C) * 2u; }
    const size_t kstep = (size_t)(BK * 2);
    const size_t hstepB = (size_t)HALF * K * 2, hstepA = (size_t)HALF * g.lda * 2;
    const size_t tstepB = 2 * hstepB, tstepA = 2 * hstepA;
    const unsigned ldsw = (unsigned)wid * 1024u;
    const int aoff = lds_byte(wr * 64 + fr, fq * 8), boff = lds_byte(wc * 32 + fr, fq * 8);
#define PG8_SA(b, h) (((b) * 2 + (h)) * HTB)
#define PG8_SB(b, h) ((4 + (b) * 2 + (h)) * HTB)
#define PG8_STAGE(bufoff, gbase, voff) do { _Pragma("unroll") for (int _i = 0; _i < 2; ++_i) \
        __builtin_amdgcn_global_load_lds((const unsigned*)((const char*)(gbase) + (voff)[_i]), (PG8_LAS unsigned*)(lds + (bufoff) + ldsw + _i * 8192), 16, 0, 0); } while (0)
#define PG8_LDA(dst, b, h) do { _Pragma("unroll") for (int m = 0; m < 4; ++m) _Pragma("unroll") for (int k = 0; k < 2; ++k) dst[m][k] = *(const PG8_LAS bf16x8*)(lds + PG8_SA(b, h) + aoff + m * 2048 + k * 1024); } while (0)
#define PG8_LDB(dst, b, h) do { _Pragma("unroll") for (int n = 0; n < 2; ++n) _Pragma("unroll") for (int k = 0; k < 2; ++k) dst[n][k] = *(const PG8_LAS bf16x8*)(lds + PG8_SB(b, h) + boff + n * 2048 + k * 1024); } while (0)
#define PG8_MMA(ai, bj, At, Bt) do { __builtin_amdgcn_s_setprio(1); _Pragma("unroll") for (int m = 0; m < 4; ++m) _Pragma("unroll") for (int n = 0; n < 2; ++n) _Pragma("unroll") for (int k = 0; k < 2; ++k) \
        acc[ai][bj][m][n] = __builtin_amdgcn_mfma_f32_16x16x32_bf16(Bt[n][k], At[m][k], acc[ai][bj][m][n], 0, 0, 0); __builtin_amdgcn_s_setprio(0); } while (0)
#define PG8_WAIT_V(n) asm volatile("s_waitcnt vmcnt(" #n ")" ::: "memory")
#define PG8_WAIT_L(n) asm volatile("s_waitcnt lgkmcnt(" #n ")" ::: "memory")
#define PG8_BAR __builtin_amdgcn_s_barrier()
#define PG8_SCHED __builtin_amdgcn_sched_barrier(0)
    Unit cur, nxt; int ui = 0;
    if (!S.next(0, cur)) return;
    f32x4 acc[2][2][4][2];
#pragma unroll
    for (int a = 0; a < 2; ++a)
#pragma unroll
        for (int b = 0; b < 2; ++b)
#pragma unroll
            for (int m = 0; m < 4; ++m)
#pragma unroll
                for (int n = 0; n < 2; ++n) acc[a][b][m][n] = (f32x4){0.f, 0.f, 0.f, 0.f};
    bf16x8 At[4][2], B0[2][2], B1[2][2];
    const char* cA = (const char*)g.A + (size_t)cur.pm * tstepA; const char* cB = (const char*)g.Bt + (size_t)cur.pn * tstepB;
    S.a_ready(cur);
    PG8_STAGE(PG8_SB(0, 0), cB, voffB); PG8_STAGE(PG8_SA(0, 0), cA, voffA); PG8_STAGE(PG8_SB(0, 1), cB + hstepB, voffB); PG8_STAGE(PG8_SA(0, 1), cA + hstepA, voffA);
    if (wr == 1) PG8_BAR;
    PG8_WAIT_V(4); PG8_BAR;
    PG8_STAGE(PG8_SB(1, 0), cB + kstep, voffB); PG8_STAGE(PG8_SA(1, 0), cA + kstep, voffA); PG8_STAGE(PG8_SB(1, 1), cB + hstepB + kstep, voffB);
    PG8_WAIT_V(6); PG8_BAR;
    PG8_STAMP();
    for (;;) {
        const bool has_next = S.next(ui + 1, nxt);
        const char* nA = has_next ? (const char*)g.A + (size_t)nxt.pm * tstepA : cA; const char* nB = has_next ? (const char*)g.Bt + (size_t)nxt.pn * tstepB : cB;
        for (int t = 0; t < nt; t += 2) {
            const bool last = (t == nt - 2);
            const char* a1 = cA + (size_t)(t + 1) * kstep;
            const char* a2 = last ? nA : cA + (size_t)(t + 2) * kstep; const char* b2 = last ? nB : cB + (size_t)(t + 2) * kstep;
            const char* a3 = a2 + kstep; const char* b3 = b2 + kstep;
            if (last && has_next) S.a_ready(nxt);
            PG8_LDB(B0, 0, 0); PG8_SCHED; PG8_LDA(At, 0, 0); PG8_STAGE(PG8_SA(1, 1), a1 + hstepA, voffA);
            PG8_WAIT_L(8); PG8_BAR; PG8_WAIT_L(0); PG8_MMA(0, 0, At, B0); PG8_BAR; PG8_SCHED;
            PG8_LDB(B1, 0, 1); PG8_STAGE(PG8_SB(0, 0), b2, voffB);
            if constexpr (Epi::PFX != 0) __builtin_amdgcn_global_load_lds((const unsigned*)E.pf_ptr(cur, t >> 1, 0, tid), (PG8_LAS unsigned*)(lds + STAGE_BYTES + 256 + ldsw), 16, 0, 0);
            PG8_BAR; PG8_WAIT_L(0); PG8_MMA(0, 1, At, B1); PG8_BAR;
            PG8_LDA(At, 0, 1); PG8_STAGE(PG8_SA(0, 0), a2, voffA);
            PG8_BAR; PG8_WAIT_L(0); PG8_MMA(1, 0, At, B0); PG8_BAR; PG8_SCHED;
            PG8_STAGE(PG8_SB(0, 1), b2 + hstepB, voffB);
            if constexpr (Epi::PFX != 0) PG8_WAIT_V(7); else PG8_WAIT_V(6);
            PG8_BAR; PG8_MMA(1, 1, At, B1); PG8_BAR;
            PG8_LDB(B0, 1, 0); PG8_SCHED; PG8_LDA(At, 1, 0); PG8_STAGE(PG8_SA(0, 1), a2 + hstepA, voffA);
            PG8_WAIT_L(8); PG8_BAR; PG8_WAIT_L(0); PG8_MMA(0, 0, At, B0); PG8_BAR; PG8_SCHED;
            PG8_LDB(B1, 1, 1); PG8_STAGE(PG8_SB(1, 0), b3, voffB);
            if constexpr (Epi::PFX != 0) __builtin_amdgcn_global_load_lds((const unsigned*)E.pf_ptr(cur, t >> 1, 1, tid), (PG8_LAS unsigned*)(lds + STAGE_BYTES + 256 + ldsw), 16, 0, 0);
            PG8_BAR; PG8_WAIT_L(0); PG8_MMA(0, 1, At, B1); PG8_BAR;
            PG8_LDA(At, 1, 1); PG8_STAGE(PG8_SA(1, 0), a3, voffA);
            PG8_BAR; PG8_WAIT_L(0); PG8_MMA(1, 0, At, B0); PG8_BAR; PG8_SCHED;
            PG8_STAGE(PG8_SB(1, 1), b3 + hstepB, voffB);
            if constexpr (Epi::PFX != 0) PG8_WAIT_V(7); else PG8_WAIT_V(6);
            PG8_BAR; PG8_MMA(1, 1, At, B1); PG8_BAR;
        }
        PG8_STAMP();
        if constexpr (!Epi::AFTER_DRAIN) { E(acc, cur, wr, wc, fr, fq); S.done(cur); }
        PG8_STAMP();
        if (!has_next) break;
#pragma unroll
        for (int a = 0; a < 2; ++a)
#pragma unroll
            for (int b = 0; b < 2; ++b)
#pragma unroll
                for (int m = 0; m < 4; ++m)
#pragma unroll
                    for (int n = 0; n < 2; ++n) acc[a][b][m][n] = (f32x4){0.f, 0.f, 0.f, 0.f};
        cur = nxt; cA = nA; cB = nB; ++ui;
    }
    PG8_WAIT_V(0);
    if (wr == 0) PG8_BAR;
    PG8_BAR;
    if constexpr (Epi::AFTER_DRAIN) { E.fused(acc, cur, wr, wc, fr, fq, lds, wid, lane); S.done(cur); }
    PG8_STAMP();
    if (STAMP && wid == 0) { stamps[lane] = lane < nts ? (((unsigned long long)(unsigned)ts_hi << 32) | (unsigned)ts_lo) : 0ull;
        if (lane == 62) stamps[62] = rt_entry; if (lane == 63) stamps[63] = (unsigned long long)wall_clock64(); }
#undef PG8_STAMP
#undef PG8_SA
#undef PG8_SB
#undef PG8_STAGE
#undef PG8_LDA
#undef PG8_LDB
#undef PG8_MMA
#undef PG8_WAIT_V
#undef PG8_WAIT_L
#undef PG8_BAR
#undef PG8_SCHED
}
}


struct EpiBf16 {
  static constexpr bool PERM = true, AFTER_DRAIN = false; static constexpr int PFX = 0;
  u16* O; int ldc;
  DI void operator()(const f32x4 (&acc)[2][2][4][2], const pg8::Unit& u, int wr, int wc, int fr, int fq) const {
    const int row0 = u.pm * 256 + wr * 64 + fr, col0 = u.pn * 256 + wc * 32 + 8 * fq;
#pragma unroll
    for (int ai = 0; ai < 2; ++ai)
#pragma unroll
      for (int m = 0; m < 4; ++m) {
        u16* rowp = O + (size_t)(row0 + ai * 128 + m * 16) * ldc + col0;
#pragma unroll
        for (int bj = 0; bj < 2; ++bj) {
          f32x4 v0 = acc[ai][bj][m][0], v1 = acc[ai][bj][m][1];
          u32x4 w = {pack2(v0[0], v0[1]), pack2(v0[2], v0[3]), pack2(v1[0], v1[1]), pack2(v1[2], v1[3])};
          *(u32x4*)(rowp + bj * 128) = w;
        }
      }
  }
};
struct EpiResid {
  static constexpr bool PERM = false, AFTER_DRAIN = false; static constexpr int PFX = 0;
  const float* xa; const float* xb; const float* gate; float* out;
  DI void operator()(const f32x4 (&acc)[2][2][4][2], const pg8::Unit& u, int wr, int wc, int fr, int fq) const {
    const int row0 = u.pm * 256 + wr * 64 + fr, col0 = u.pn * 256 + wc * 32 + 4 * fq;
#pragma unroll
    for (int ai = 0; ai < 2; ++ai)
#pragma unroll
      for (int m = 0; m < 4; ++m) {
        const int row = row0 + ai * 128 + m * 16;
        const float* xr = (row < NCTX) ? xa + (size_t)row * D : xb + (size_t)(row - NCTX) * D;
        const float* gr = gate + (size_t)tok_modrow(row) * 6144;
        float* orow = out + (size_t)row * D;
#pragma unroll
        for (int bj = 0; bj < 2; ++bj)
#pragma unroll
          for (int n = 0; n < 2; ++n) {
            const int col = col0 + bj * 128 + n * 16;
            f32x4 xv = *(const f32x4*)(xr + col);
            f32x4 gv = *(const f32x4*)(gr + col);
            *(f32x4*)(orow + col) = xv + gv * acc[ai][bj][m][n];
          }
      }
  }
};

template <bool XBF> struct EpiResidB {
  static constexpr bool PERM = true, AFTER_DRAIN = false; static constexpr int PFX = 1;
  const void* xa; const void* xb; const float* gate; u16* out;
  DI const void* pf_ptr(const pg8::Unit& u, int j, int op, int tid) const {
    if constexpr (XBF) {
      const int row = u.pm * 256 + 16 * j + (tid >> 5);
      return (const u16*)xa + (size_t)row * D + u.pn * 256 + (tid & 31) * 8;
    } else {
      const int row = u.pm * 256 + 16 * j + 8 * op + (tid >> 6);
      const float* xr = (row < NCTX) ? (const float*)xa + (size_t)row * D : (const float*)xb + (size_t)(row - NCTX) * D;
      return xr + u.pn * 256 + (tid & 63) * 4;
    }
  }
  DI void operator()(const f32x4 (&acc)[2][2][4][2], const pg8::Unit& u, int wr, int wc, int fr, int fq) const {
    const int row0 = u.pm * 256 + wr * 64 + fr, col0 = u.pn * 256 + wc * 32 + 8 * fq;
#pragma unroll
    for (int ai = 0; ai < 2; ++ai)
#pragma unroll
      for (int m = 0; m < 4; ++m) {
        const int row = row0 + ai * 128 + m * 16;
        const float* gr = gate + (size_t)tok_modrow(row) * 6144;
        u16* orow = out + (size_t)row * D;
#pragma unroll
        for (int bj = 0; bj < 2; ++bj) {
          const int col = col0 + bj * 128;
          f32x4 x0, x1;
          if constexpr (XBF) {
            const u32x4 xv = *(const u32x4*)((const u16*)xa + (size_t)row * D + col);
            x0 = (f32x4){bflo(xv[0]), bfhi(xv[0]), bflo(xv[1]), bfhi(xv[1])};
            x1 = (f32x4){bflo(xv[2]), bfhi(xv[2]), bflo(xv[3]), bfhi(xv[3])};
          } else {
            const float* xr = (row < NCTX) ? (const float*)xa + (size_t)row * D : (const float*)xb + (size_t)(row - NCTX) * D;
            x0 = *(const f32x4*)(xr + col); x1 = *(const f32x4*)(xr + col + 4);
          }
          const f32x4 g0 = *(const f32x4*)(gr + col), g1 = *(const f32x4*)(gr + col + 4);
          const f32x4 o0 = x0 + g0 * acc[ai][bj][m][0], o1 = x1 + g1 * acc[ai][bj][m][1];
          u32x4 w = {pack2(o0[0], o0[1]), pack2(o0[2], o0[3]), pack2(o1[0], o1[1]), pack2(o1[2], o1[3])};
          *(u32x4*)(orow + col) = w;
        }
      }
  }
};

template <class Epi>
DI void gemm_run(PG8_LAS unsigned char* lds, const u16* A, int lda, const u16* Bt, int M, int N, int K, const Epi& e) {
  pg8::Gemm g{A, Bt, M, N, K, lda};
  pg8::StaticOrder S; S.init(M, N, (int)gridDim.x, (int)blockIdx.x);
#pragma unroll 1
  for (int rep = 0; rep < (Epi::PERM ? REP_G : 1); ++rep) {
    __syncthreads();
    pg8::gemm_phase<Epi, pg8::StaticOrder, false>(lds, g, S, e, nullptr);
    __syncthreads();
  }
}

DI void phase_qknorm0(const Params& p) {
  const int t = TID(), wave = t >> 6, lane = t & 63, l15 = lane & 15;
  u16* QKVG = (u16*)(p.ws + OFF_BIG);
  u16* KA = (u16*)(p.ws + OFF_KA_ALL);
  u16* VA = (u16*)(p.ws + OFF_VA_ALL);
  const float* tab = (const float*)(p.ws + OFF_ROPE0);
  float gq[8], gk[8];
#pragma unroll
  for (int j = 0; j < 8; ++j) { gq[j] = p.l0_qn[l15 * 8 + j]; gk[j] = p.l0_kn[l15 * 8 + j]; }
  const bool hi = (l15 & 4) != 0;
  const bool colrot = l15 >= 8;
  const int f0 = (l15 & 3) * 8;
  for (int it = blockIdx.x; it < NTOK / NW; it += gridDim.x) {
    const int tk = it * NW + wave;
    u16* base = QKVG + (size_t)tk * L0_IN;
    const bool lat = tk >= NCTX;
    const int lt = tk - NCTX, b = lt >> 10, tt = lt & 1023;
    u32x4 v[3];
#pragma unroll
    for (int ps = 0; ps < 3; ++ps) v[ps] = *(const u32x4*)(base + (ps * 64 + lane) * 8);
    u32x4 kb[2], vb[2];
    if (!lat) {
#pragma unroll
      for (int q = 0; q < 2; ++q) { kb[q] = *(const u32x4*)(base + 2560 + (q * 64 + lane) * 8); vb[q] = *(const u32x4*)(base + 3584 + (q * 64 + lane) * 8); }
    }
    float cs[8], sn[8];
    if (lat) {
      const int pos = colrot ? (tt & 63) : (tt >> 6);
      const float4* tp = (const float4*)(tab + (pos * 32 + f0) * 2);
#pragma unroll
      for (int j2 = 0; j2 < 4; ++j2) { float4 c = tp[j2]; cs[2 * j2] = c.x; sn[2 * j2] = c.y; cs[2 * j2 + 1] = c.z; sn[2 * j2 + 1] = c.w; }
    } else {
#pragma unroll
      for (int j = 0; j < 8; ++j) { cs[j] = 1.f; sn[j] = 0.f; }
    }
    const size_t arow = (size_t)b * 1536 + 512 + tt;
#pragma unroll
    for (int ps = 0; ps < 3; ++ps) {
      float x[8];
#pragma unroll
      for (int j = 0; j < 4; ++j) { x[2 * j] = bflo(v[ps][j]); x[2 * j + 1] = bfhi(v[ps][j]); }
      float ss = 0.f;
#pragma unroll
      for (int j = 0; j < 8; ++j) ss += x[j] * x[j];
      ss += __shfl_xor(ss, 8); ss += __shfl_xor(ss, 4); ss += __shfl_xor(ss, 2); ss += __shfl_xor(ss, 1);
      const float rinv = rsqrtf(ss * (1.f / 128.f) + EPS);
      float o[8];
#pragma unroll
      for (int j = 0; j < 8; ++j) {
        const float y = x[j] * rinv * (ps < 2 ? gq[j] : gk[j]);
        const float pr = __shfl_xor(y, 4);
        o[j] = hi ? (y * cs[j] + pr * sn[j]) : (y * cs[j] - pr * sn[j]);
      }
      if (ps < 2) {
        u32x4 w = {pack2(o[0], o[1]), pack2(o[2], o[3]), pack2(o[4], o[5]), pack2(o[6], o[7])};
        *(u32x4*)(base + (ps * 64 + lane) * 8) = w;
      } else if (lane < 32) {
        u32x4 w = {pack2(o[0], o[1]), pack2(o[2], o[3]), pack2(o[4], o[5]), pack2(o[6], o[7])};
        if (!lat) {
          *(u32x4*)(base + 1024 + lane * 8) = w;
          float* op = p.out + OUT_NAK + (size_t)tk * 256 + lane * 8;
          *(float4*)op = make_float4(o[0], o[1], o[2], o[3]);
          *(float4*)(op + 4) = make_float4(o[4], o[5], o[6], o[7]);
        } else *(u32x4*)(KA + arow * 256 + lane * 8) = w;
      } else {
        if (!lat) {
          float* op = p.out + OUT_NAV + (size_t)tk * 256 + (lane - 32) * 8;
          *(float4*)op = make_float4(x[0], x[1], x[2], x[3]);
          *(float4*)(op + 4) = make_float4(x[4], x[5], x[6], x[7]);
        } else *(u32x4*)(VA + arow * 256 + (lane - 32) * 8) = v[2];
      }
    }
    if (!lat) {
#pragma unroll
      for (int q = 0; q < 2; ++q) {
        float* ok = p.out + OUT_NBK + (size_t)tk * 1024 + (q * 64 + lane) * 8;
        float* ov = p.out + OUT_NBV + (size_t)tk * 1024 + (q * 64 + lane) * 8;
        *(float4*)ok = make_float4(bflo(kb[q][0]), bfhi(kb[q][0]), bflo(kb[q][1]), bfhi(kb[q][1]));
        *(float4*)(ok + 4) = make_float4(bflo(kb[q][2]), bfhi(kb[q][2]), bflo(kb[q][3]), bfhi(kb[q][3]));
        *(float4*)ov = make_float4(bflo(vb[q][0]), bfhi(vb[q][0]), bflo(vb[q][1]), bfhi(vb[q][1]));
        *(float4*)(ov + 4) = make_float4(bflo(vb[q][2]), bfhi(vb[q][2]), bflo(vb[q][3]), bfhi(vb[q][3]));
      }
    }
  }
}

DI void phase_norm1(const Params& p) {
  const int wave = TID() >> 6, lane = TID() & 63;
  const u16* LAT1 = (const u16*)(p.ws + OFF_LAT1);
  u16* QN = (u16*)(p.ws + OFF_QN);
  u16* CKVC = (u16*)(p.ws + OFF_CKV_CTX);
  u16* KRC = (u16*)(p.ws + OFF_KR_CTX);
  u16* CKVA = (u16*)(p.ws + OFF_CKV_ALL);
  u16* KRA = (u16*)(p.ws + OFF_KR_ALL);
  float gq[8], gk[8];
#pragma unroll
  for (int j = 0; j < 8; ++j) { gq[j] = p.l1_qan[lane * 8 + j]; gk[j] = p.l1_kvan[lane * 8 + j]; }
  const int ri = lane & 15, rhalf = (lane >> 4) & 1;
  const int rd1 = rhalf * 32 + ri, rd2 = rd1 + 16;
  const float inv = exp2f(-(float)ri * (LOG2_THETA / 16.f));
  for (int it = blockIdx.x; it < NTOK / NW; it += gridDim.x) {
    int tk = it * NW + wave;
    const u16* base = LAT1 + (size_t)tk * L1_LD;
    const bool lat = tk >= NCTX;
    int lt = tk - NCTX, b = lt >> 10, tt = lt & 1023;
    size_t arow = (size_t)b * 1536 + 512 + tt;
#pragma unroll
    for (int part = 0; part < 2; ++part) {
      uint4 v = *(const uint4*)(base + part * 512 + lane * 8);
      float x[8] = {bflo(v.x), bfhi(v.x), bflo(v.y), bfhi(v.y), bflo(v.z), bfhi(v.z), bflo(v.w), bfhi(v.w)};
      float ss = 0.f;
#pragma unroll
      for (int j = 0; j < 8; ++j) ss += x[j] * x[j];
      ss = wave_sum(ss);
      float rinv = rsqrtf(ss * (1.f / 512.f) + EPS);
#pragma unroll
      for (int j = 0; j < 8; ++j) x[j] = x[j] * rinv * (part ? gk[j] : gq[j]);
      uint4 o = make_uint4(pack2(x[0], x[1]), pack2(x[2], x[3]), pack2(x[4], x[5]), pack2(x[6], x[7]));
      if (part == 0) *(uint4*)(QN + (size_t)tk * 512 + lane * 8) = o;
      else if (!lat) {
        *(uint4*)(CKVC + (size_t)tk * 512 + lane * 8) = o;
        float* op = p.out + OUT_NCKV + (size_t)tk * 512 + lane * 8;
        *(float4*)op = make_float4(x[0], x[1], x[2], x[3]);
        *(float4*)(op + 4) = make_float4(x[4], x[5], x[6], x[7]);
      } else *(uint4*)(CKVA + arow * 512 + lane * 8) = o;
    }
  }
}

DI void phase_krope(const Params& p, char* smem) {
  const int t = TID(), wave = t >> 6, lane = t & 63, l31 = lane & 31, h = lane >> 5;
  const int tg = wave >> 2, kq = wave & 3;
  const u16* H = (const u16*)(p.ws + OFF_H);
  const u16* W = (const u16*)(p.ws + OFF_WT_IN1) + (size_t)3072 * 2048;
  u16* KRC = (u16*)(p.ws + OFF_KR_CTX);
  u16* KRA = (u16*)(p.ws + OFF_KR_ALL);
  const float* tab = (const float*)(p.ws + OFF_ROPE);
  constexpr int CLD = 256 + 8;
  u16* Hs = (u16*)smem;
  u16* Ws = Hs + 64 * CLD;
  float* red = (float*)smem;
  for (int it = blockIdx.x; it < NTOK / 64; it += gridDim.x) {
    const int tok = it * 64 + tg * 32 + l31;
    const u16* hg = H + (size_t)(it * 64 + (t >> 5)) * 2048 + (t & 31) * 8;
    const u16* wg = W + (size_t)(t >> 5) * 2048 + (t & 31) * 8;
    u32x4 rh[4], rw[4];
#pragma unroll
    for (int i = 0; i < 4; ++i) { rh[i] = *(const u32x4*)(hg + (size_t)(16 * i) * 2048); rw[i] = *(const u32x4*)(wg + (size_t)(16 * i) * 2048); }
    f32x16 c0, c1;
#pragma unroll
    for (int r = 0; r < 16; ++r) { c0[r] = 0.f; c1[r] = 0.f; }
#pragma unroll 1
    for (int kc = 0; kc < 8; ++kc) {
      __syncthreads();
#pragma unroll
      for (int i = 0; i < 4; ++i) {
        *(u32x4*)(Hs + ((t >> 5) + 16 * i) * CLD + (t & 31) * 8) = rh[i];
        *(u32x4*)(Ws + ((t >> 5) + 16 * i) * CLD + (t & 31) * 8) = rw[i];
      }
      __syncthreads();
      if (kc + 1 < 8) {
#pragma unroll
        for (int i = 0; i < 4; ++i) { rh[i] = *(const u32x4*)(hg + (size_t)(16 * i) * 2048 + (kc + 1) * 256); rw[i] = *(const u32x4*)(wg + (size_t)(16 * i) * 2048 + (kc + 1) * 256); }
      }
#pragma unroll
      for (int s = 0; s < 4; ++s) {
        const int ko = kq * 64 + 16 * s + 8 * h;
        const bf16x8 hb = *(const bf16x8*)(Hs + (tg * 32 + l31) * CLD + ko);
        const bf16x8 a0 = *(const bf16x8*)(Ws + l31 * CLD + ko);
        const bf16x8 a1 = *(const bf16x8*)(Ws + (32 + l31) * CLD + ko);
        c0 = MFMA32(a0, hb, c0);
        c1 = MFMA32(a1, hb, c1);
      }
    }
    __syncthreads();
#pragma unroll
    for (int r = 0; r < 16; ++r) { red[(wave * 32 + r) * 64 + lane] = c0[r]; red[(wave * 32 + 16 + r) * 64 + lane] = c1[r]; }
    __syncthreads();
    if (kq == 0) {
      float v[32];
#pragma unroll
      for (int r = 0; r < 32; ++r) {
        float a = 0.f;
#pragma unroll
        for (int q = 0; q < 4; ++q) a += red[((tg * 4 + q) * 32 + r) * 64 + lane];
        v[r] = a;
      }
      const bool lat = tok >= NCTX;
      const int lt = tok - NCTX, b = lt >> 10, tt = lt & 1023;
      if (lat) {
#pragma unroll
        for (int c = 0; c < 2; ++c) {
          const int pos = c ? (tt & 63) : (tt >> 6);
#pragma unroll
          for (int i = 0; i < 8; ++i) {
            const int n = (i & 3) + 8 * (i >> 2) + 4 * h;
            const float cs = tab[(pos * 16 + n) * 2], sn = tab[(pos * 16 + n) * 2 + 1];
            const float x1 = v[c * 16 + i], x2 = v[c * 16 + i + 8];
            v[c * 16 + i] = x1 * cs - x2 * sn;
            v[c * 16 + i + 8] = x2 * cs + x1 * sn;
          }
        }
      }
#pragma unroll
      for (int c = 0; c < 2; ++c)
#pragma unroll
        for (int g4 = 0; g4 < 4; ++g4) {
          const int n0 = 32 * c + 8 * g4 + 4 * h;
          const float o0 = v[c * 16 + 4 * g4], o1 = v[c * 16 + 4 * g4 + 1], o2 = v[c * 16 + 4 * g4 + 2], o3 = v[c * 16 + 4 * g4 + 3];
          const uint2 w = make_uint2(pack2(o0, o1), pack2(o2, o3));
          if (!lat) {
            *(uint2*)(KRC + (size_t)tok * 64 + n0) = w;
            *(float4*)(p.out + OUT_NKR + (size_t)tok * 64 + n0) = make_float4(o0, o1, o2, o3);
          } else {
            *(uint2*)(KRA + ((size_t)b * 1536 + 512 + tt) * 64 + n0) = w;
          }
        }
    }
  }
  __syncthreads();
}

DI void phase_final(const Params& p) {
  const int wave = TID() >> 6, lane = TID() & 63;
  const u16* X2 = (const u16*)(p.ws + OFF_Q1);
  for (int it = blockIdx.x; it < NTOK / NW; it += gridDim.x) {
    const int row = it * NW + wave;
    float* y = p.out + OUT_Y + (size_t)row * D;
    u32x4 v[4];
    float ss = 0.f;
#pragma unroll
    for (int i = 0; i < 4; ++i) {
      v[i] = *(const u32x4*)(X2 + (size_t)row * D + (i * 64 + lane) * 8);
#pragma unroll
      for (int j = 0; j < 4; ++j) { const float a0 = bflo(v[i][j]), a1 = bfhi(v[i][j]); ss += a0 * a0 + a1 * a1; }
    }
    ss = wave_sum(ss);
    const float rinv = rsqrtf(ss * (1.f / D) + EPS);
#pragma unroll
    for (int i = 0; i < 4; ++i) {
      const int col = (i * 64 + lane) * 8;
#pragma unroll
      for (int q = 0; q < 2; ++q) {
        const f32x4 gg = *(const f32x4*)(p.fnorm + col + 4 * q);
        f32x4 o = {bflo(v[i][2 * q]) * rinv * gg[0], bfhi(v[i][2 * q]) * rinv * gg[1], bflo(v[i][2 * q + 1]) * rinv * gg[2], bfhi(v[i][2 * q + 1]) * rinv * gg[3]};
        *(f32x4*)(y + col + 4 * q) = o;
      }
    }
  }
}

struct KVSeg { const u16* k; const u16* v; const u16* kr; int ks, vs, n; };
struct AttnArgs {
  const u16* q; int qs;
  KVSeg seg[2]; int nseg;
  const u16* gate; int gs;
  u16* out; int os;
  float scale_log2;
  const float* rpb;
  int qtok0;
  int rs0;
  int rope;
  const float* ropetab;
};

DI float xhalf_max(float v) {
  unsigned u = __float_as_uint(v);
  auto r = __builtin_amdgcn_permlane32_swap(u, u, false, false);
  return fmaxf(__uint_as_float(r[0]), __uint_as_float(r[1]));
}
#define DEFER_MAX_UPDATE() do { \
    if (__builtin_amdgcn_ballot_w64(mx > m_run + 8.0f) != 0) { \
      const float mn_ = fmaxf(m_run, mx); const float al_ = __builtin_amdgcn_exp2f(m_run - mn_); m_run = mn_; l_run *= al_; \
      _Pragma("unroll") for (int c_ = 0; c_ < 4; ++c_) _Pragma("unroll") for (int r_ = 0; r_ < 16; ++r_) acc[c_][r_] *= al_; \
    } } while (0)
DI int swz16(int r) { return ((r & 3) << 2) | ((r >> 2) & 3); }

template <int DQK, int MODE>
DI void attn_issue_tile(const AttnArgs& a, int tile, int nt0, LDS_AS(unsigned char)* slot, int wave, int lane) {
  const int sg = tile >= nt0 ? 1 : 0;
  const int off = (sg ? tile - nt0 : tile) * 64;
  const u16* kp = sg ? a.seg[1].k : a.seg[0].k;
  const u16* vp = sg ? a.seg[1].v : a.seg[0].v;
  const int ks = sg ? a.seg[1].ks : a.seg[0].ks;
  const int vs = sg ? a.seg[1].vs : a.seg[0].vs;
  const int sw = ((lane >> 4) << 2) | (wave & 3);
  const int ch = (lane & 15) ^ sw;
#pragma unroll
  for (int j = 0; j < 2; ++j) {
    const int row = off + (j * 8 + wave) * 4 + (lane >> 4);
    __builtin_amdgcn_global_load_lds((const unsigned*)(kp + (unsigned)(row * ks + ch * 8)), (LDS_AS(unsigned)*)(slot + (j * 8 + wave) * 1024), 16, 0, 0);
    __builtin_amdgcn_global_load_lds((const unsigned*)(vp + (unsigned)(row * vs + ch * 8)), (LDS_AS(unsigned)*)(slot + 16384 + (j * 8 + wave) * 1024), 16, 0, 0);
  }
  if constexpr (MODE == 2) {
    const u16* krp = sg ? a.seg[1].kr : a.seg[0].kr;
    const int row = wave * 8 + (lane >> 3);
    const int c2 = (lane & 7) ^ ((row >> 1) & 7);
    __builtin_amdgcn_global_load_lds((const unsigned*)(krp + (unsigned)((off + row) * 64 + c2 * 8)), (LDS_AS(unsigned)*)(slot + 32768 + wave * 1024), 16, 0, 0);
  }
}

template <int DQK, int MODE>
DI void attn_block(const AttnArgs& a, LDS_AS(unsigned char)* lds) {
  constexpr int NS = DQK / 16;
  constexpr int SLOTB = (MODE == 2) ? 40960 : 32768;
  constexpr int NLOAD = (MODE == 2) ? 5 : 4;
  LDS_AS(float)* bias_s = (LDS_AS(float)*)(lds + 3 * SLOTB);
  const int t = TID(), wave = __builtin_amdgcn_readfirstlane(t >> 6), lane = t & 63, l31 = lane & 31, h = lane >> 5;

  __syncthreads();
  if constexpr (MODE == 1) {
    for (int e = t; e < 15 * 31; e += NT) bias_s[e] = a.rpb[e] * LOG2E;
    __syncthreads();
  }
  int ntiles = 0;
  for (int s = 0; s < a.nseg; ++s) ntiles += a.seg[s].n >> 6;
  const int nt0 = a.seg[0].n >> 6;
  bf16x8 qf[NS];
  {
    const u16* qp = a.q + (size_t)(wave * 32 + l31) * a.qs + 8 * h;
#pragma unroll
    for (int s = 0; s < NS; ++s) qf[s] = *(const bf16x8*)(qp + 16 * s);
  }
  attn_issue_tile<DQK, MODE>(a, 0, nt0, lds, wave, lane);
  attn_issue_tile<DQK, MODE>(a, ntiles > 1 ? 1 : 0, nt0, lds + SLOTB, wave, lane);
  const int qtok = a.qtok0 + wave * 32 + l31;
  if constexpr (MODE == 2) {
    if (a.rope) {
      const int qr = qtok >> 6, qc = qtok & 63;
#pragma unroll
      for (int pr = 0; pr < 2; ++pr) {
        const float4* tb = (const float4*)(a.ropetab + ((pr ? qc : qr) * 16 + 8 * h) * 2);
#pragma unroll
        for (int j2 = 0; j2 < 4; ++j2) {
          float4 cssn = tb[j2];
#pragma unroll
          for (int e = 0; e < 2; ++e) {
            const int j = 2 * j2 + e;
            float cs = e ? cssn.z : cssn.x, sn = e ? cssn.w : cssn.y;
            float x1 = bf2f((u16)qf[8 + 2 * pr][j]), x2 = bf2f((u16)qf[9 + 2 * pr][j]);
            qf[8 + 2 * pr][j] = (short)f2bf(x1 * cs - x2 * sn);
            qf[9 + 2 * pr][j] = (short)f2bf(x2 * cs + x1 * sn);
          }
        }
      }
    }
  }
  f32x16 acc[4];
#pragma unroll
  for (int c = 0; c < 4; ++c)
#pragma unroll
    for (int r = 0; r < 16; ++r) acc[c][r] = 0.f;
  float m_run = -1e30f, l_run = 0.f;

  const int blk = (lane >> 4) & 1, tq = (lane & 15) >> 2, tp = lane & 3;
  const int kswz = swz16(l31);
  const int kb0 = l31 * 256 + ((h ^ (kswz & 1)) << 4);
  const int ksw = kswz >> 1;
  const int kr0 = 32768 + l31 * 128;
  const int krsw = (l31 >> 1) & 7;
  const int vlow0 = (2 * blk + (tp >> 1)) ^ (h & 3);
  const int vlow1 = (2 * blk + (tp >> 1)) ^ ((2 + h) & 3);
  const int vb0 = 16384 + (4 * h + tq) * 256 + (vlow0 << 4) + 8 * (tp & 1);
  const int vb1 = 16384 + (8 + 4 * h + tq) * 256 + (vlow1 << 4) + 8 * (tp & 1);
  const int qrow = qtok >> 6, qcol = qtok & 63;
  int q_rs = qrow - 4; q_rs = q_rs < 0 ? 0 : (q_rs > 8 ? 8 : q_rs);
  int q_cs = qcol - 8; q_cs = q_cs < 0 ? 0 : (q_cs > 48 ? 48 : q_cs);

  int sl = 0;
  for (int tile = 0; tile < ntiles; ++tile) {
    if constexpr (NLOAD == 5) asm volatile("s_waitcnt vmcnt(5)" ::: "memory"); else asm volatile("s_waitcnt vmcnt(4)" ::: "memory");
    __builtin_amdgcn_s_barrier();
    asm volatile("" ::: "memory");
    {
      int nx = tile + 2; nx = nx < ntiles ? nx : ntiles - 1;
      int sn = sl + 2; sn = sn >= 3 ? sn - 3 : sn;
      attn_issue_tile<DQK, MODE>(a, nx, nt0, lds + sn * SLOTB, wave, lane);
    }
    LDS_AS(unsigned char)* slot = lds + sl * SLOTB;
    sl = sl == 2 ? 0 : sl + 1;

    const bool local = (MODE == 1) && (tile >= nt0);
    const int krow = a.rs0 + (tile - nt0);
#pragma unroll 1
    for (int mt = 0; mt < 2; ++mt) {
      f32x16 S;
#pragma unroll
      for (int r = 0; r < 16; ++r) S[r] = 0.f;
      LDS_AS(unsigned char)* kbase = slot + mt * 8192 + kb0;
#pragma unroll
      for (int s = 0; s < 8; ++s) {
        bf16x8 kf = *(const LDS_AS(bf16x8)*)(kbase + ((s ^ ksw) << 5));
        S = MFMA32(kf, qf[s], S);
      }
      if constexpr (MODE == 2) {
        LDS_AS(unsigned char)* rbase = slot + mt * 4096 + kr0;
#pragma unroll
        for (int s2 = 0; s2 < 4; ++s2) {
          bf16x8 kf = *(const LDS_AS(bf16x8)*)(rbase + (((2 * s2 + h) ^ krsw) << 4));
          S = MFMA32(kf, qf[8 + s2], S);
        }
      }
      float mx = -1e30f;
      float m_new, alpha;
      float ps = 0.f;
      const float m_old = m_run;
      if constexpr (MODE == 1) {
#pragma unroll
        for (int r = 0; r < 16; ++r) {
          float sv = S[r] * a.scale_log2;
          if (local) {
            int kcol = mt * 32 + crow(r, h);
            bool ok = (krow >= q_rs) && (krow < q_rs + 8) && (kcol >= q_cs) && (kcol < q_cs + 16);
            int dy = krow - qrow + 7, dx = kcol - qcol + 15;
            dy = dy < 0 ? 0 : (dy > 14 ? 14 : dy);
            dx = dx < 0 ? 0 : (dx > 30 ? 30 : dx);
            const float bv = bias_s[dy * 31 + dx];
            sv = ok ? sv + bv : -1e30f;
          }
          S[r] = sv;
          mx = fmaxf(mx, sv);
        }
        mx = xhalf_max(mx);
        DEFER_MAX_UPDATE();
        m_new = m_run;
#pragma unroll
        for (int r = 0; r < 16; ++r) {
          float pv = __builtin_amdgcn_exp2f(S[r] - m_new);
          if (S[r] <= -1e29f) pv = 0.f;
          S[r] = pv;
          ps += pv;
        }
      } else {
#pragma unroll
        for (int r = 0; r < 16; ++r) mx = fmaxf(mx, S[r]);
        mx = xhalf_max(mx) * a.scale_log2;
        DEFER_MAX_UPDATE();
        m_new = m_run;
        const float nm = -m_new;
#pragma unroll
        for (int r = 0; r < 16; ++r) {
          float pv = __builtin_amdgcn_exp2f(__builtin_fmaf(S[r], a.scale_log2, nm));
          S[r] = pv;
          ps += pv;
        }
      }
      l_run += ps;
      (void)m_old; (void)alpha;
      bf16x8 pf[2];
#pragma unroll
      for (int s2 = 0; s2 < 2; ++s2) {
        u32x4 u;
        u[0] = pack2(S[8 * s2 + 0], S[8 * s2 + 1]);
        u[1] = pack2(S[8 * s2 + 2], S[8 * s2 + 3]);
        u[2] = pack2(S[8 * s2 + 4], S[8 * s2 + 5]);
        u[3] = pack2(S[8 * s2 + 6], S[8 * s2 + 7]);
        pf[s2] = __builtin_bit_cast(bf16x8, u);
      }
      const unsigned vaddr = (unsigned)(size_t)(slot + mt * 8192);
#pragma unroll
      for (int c0 = 0; c0 < 4; c0 += 2) {
        const unsigned a0 = vaddr + vb0 + ((c0 ^ tq) << 6), a1 = vaddr + vb1 + ((c0 ^ tq) << 6);
        const unsigned a2 = vaddr + vb0 + (((c0 + 1) ^ tq) << 6), a3 = vaddr + vb1 + (((c0 + 1) ^ tq) << 6);
        s16x4 r0, r1, r2, r3, r4, r5, r6, r7;
        asm volatile(
            "ds_read_b64_tr_b16 %0, %8\n\t"
            "ds_read_b64_tr_b16 %1, %9\n\t"
            "ds_read_b64_tr_b16 %2, %8 offset:4096\n\t"
            "ds_read_b64_tr_b16 %3, %9 offset:4096\n\t"
            "ds_read_b64_tr_b16 %4, %10\n\t"
            "ds_read_b64_tr_b16 %5, %11\n\t"
            "ds_read_b64_tr_b16 %6, %10 offset:4096\n\t"
            "ds_read_b64_tr_b16 %7, %11 offset:4096\n\t"
            "s_waitcnt lgkmcnt(0)"
            : "=&v"(r0), "=&v"(r1), "=&v"(r2), "=&v"(r3), "=&v"(r4), "=&v"(r5), "=&v"(r6), "=&v"(r7)
            : "v"(a0), "v"(a1), "v"(a2), "v"(a3)
            : "memory");
        acc[c0] = MFMA32(__builtin_shufflevector(r0, r1, 0, 1, 2, 3, 4, 5, 6, 7), pf[0], acc[c0]);
        acc[c0] = MFMA32(__builtin_shufflevector(r2, r3, 0, 1, 2, 3, 4, 5, 6, 7), pf[1], acc[c0]);
        acc[c0 + 1] = MFMA32(__builtin_shufflevector(r4, r5, 0, 1, 2, 3, 4, 5, 6, 7), pf[0], acc[c0 + 1]);
        acc[c0 + 1] = MFMA32(__builtin_shufflevector(r6, r7, 0, 1, 2, 3, 4, 5, 6, 7), pf[1], acc[c0 + 1]);
      }
    }
  }
  asm volatile("s_waitcnt vmcnt(0)" ::: "memory");
  float l_tot = l_run + __shfl_xor(l_run, 32);
  float linv = 1.f / l_tot;
  const size_t qrow_i = (size_t)(wave * 32 + l31);
#pragma unroll
  for (int c = 0; c < 4; ++c)
#pragma unroll
    for (int g4 = 0; g4 < 4; ++g4) {
      int dv0 = 32 * c + 8 * g4 + 4 * h;
      uint2 gt = *(const uint2*)(a.gate + qrow_i * a.gs + dv0);
      float o0 = acc[c][4 * g4 + 0] * linv * silu(bflo(gt.x));
      float o1 = acc[c][4 * g4 + 1] * linv * silu(bfhi(gt.x));
      float o2 = acc[c][4 * g4 + 2] * linv * silu(bflo(gt.y));
      float o3 = acc[c][4 * g4 + 3] * linv * silu(bfhi(gt.y));
      *(uint2*)(a.out + qrow_i * a.os + dv0) = make_uint2(pack2(o0, o1), pack2(o2, o3));
    }
}

DI void phase_attn0(const Params& p, LDS_AS(unsigned char)* smem) {
  const u16* QKVG = (const u16*)(p.ws + OFF_BIG);
  u16* OG = (u16*)(p.ws + OFF_H);
  const u16* KA = (const u16*)(p.ws + OFF_KA_ALL);
  const u16* VA = (const u16*)(p.ws + OFF_VA_ALL);
  const u16* KBC = (const u16*)(p.ws + OFF_KB_CTX);
  const u16* VBC = (const u16*)(p.ws + OFF_VB_CTX);
  const float sc = 0.08838834764831845f * LOG2E;
  for (int it = blockIdx.x; it < 1024; it += gridDim.x) {
    AttnArgs a;
    a.qs = L0_IN; a.gs = L0_IN; a.os = D; a.scale_log2 = sc; a.rpb = nullptr; a.qtok0 = 0; a.rs0 = 0; a.rope = 0; a.ropetab = nullptr;
    a.seg[1].k = nullptr; a.seg[1].v = nullptr; a.seg[1].kr = nullptr; a.seg[1].ks = 0; a.seg[1].vs = 0; a.seg[1].n = 0;
    a.seg[0].kr = nullptr;
    if (it >= 256 && it < 512) {
      int i = it - 256;
      int bh = (i >> 5) * 8 + (i & 7), qb = (i >> 3) & 3;
      int b = bh >> 3, hh = bh & 7;
      size_t tok = (size_t)NCTX + b * 1024 + qb * 256;
      a.q = QKVG + tok * L0_IN + 1536 + hh * 128;
      a.gate = QKVG + tok * L0_IN + 4608 + 1024 + hh * 128;
      a.out = OG + tok * D + 1024 + hh * 128;
      a.nseg = 2;
      a.seg[0].k = KBC + (size_t)b * 512 * 1024 + hh * 128; a.seg[0].ks = 1024;
      a.seg[0].v = VBC + (size_t)b * 512 * 1024 + hh * 128; a.seg[0].vs = 1024;
      a.seg[0].n = 512;
      int rs0 = 4 * qb - 4; rs0 = rs0 < 0 ? 0 : (rs0 > 8 ? 8 : rs0);
      int rs1 = 4 * qb - 1; rs1 = rs1 < 0 ? 0 : (rs1 > 8 ? 8 : rs1);
      int nrows = rs1 + 8 - rs0;
      size_t ktok = (size_t)NCTX + b * 1024 + rs0 * 64;
      a.seg[1].k = QKVG + ktok * L0_IN + 2560 + hh * 128; a.seg[1].ks = L0_IN;
      a.seg[1].v = QKVG + ktok * L0_IN + 3584 + hh * 128; a.seg[1].vs = L0_IN;
      a.seg[1].n = nrows * 64;
      a.rpb = p.l0_rpb + hh * 15 * 31;
      a.qtok0 = qb * 256; a.rs0 = rs0;
      attn_block<128, 1>(a, smem);
    } else {
      a.nseg = 1;
      if (it < 256) {
        int g = (it >> 7) * 8 + (it & 7), j = (it >> 3) & 15;
        int b = g >> 1, hq = (g & 1) * 4 + (j >> 2), qb = j & 3;
        size_t tok = (size_t)NCTX + b * 1024 + qb * 256;
        a.q = QKVG + tok * L0_IN + hq * 128;
        a.gate = QKVG + tok * L0_IN + 4608 + hq * 128;
        a.out = OG + tok * D + hq * 128;
        a.seg[0].k = KA + (size_t)b * 1536 * 256 + (hq >> 2) * 128; a.seg[0].ks = 256;
        a.seg[0].v = VA + (size_t)b * 1536 * 256 + (hq >> 2) * 128; a.seg[0].vs = 256;
        a.seg[0].n = 1536;
      } else {
        int i = it - 512;
        bool isB = i >= 256; i &= 255;
        int g = (i >> 5) * 8 + (i & 7), j = (i >> 3) & 3;
        int b = isB ? (i >> 3) : (g >> 1), hh = isB ? (i & 7) : ((g & 1) * 4 + j);
        size_t tok = (size_t)b * 256;
        a.seg[0].n = 256; a.seg[0].ks = L0_IN; a.seg[0].vs = L0_IN;
        if (!isB) {
          a.q = QKVG + tok * L0_IN + hh * 128;
          a.gate = QKVG + tok * L0_IN + 4608 + hh * 128;
          a.out = OG + tok * D + hh * 128;
          a.seg[0].k = QKVG + tok * L0_IN + 1024 + (hh >> 2) * 128;
          a.seg[0].v = QKVG + tok * L0_IN + 1280 + (hh >> 2) * 128;
        } else {
          a.q = QKVG + tok * L0_IN + 1536 + hh * 128;
          a.gate = QKVG + tok * L0_IN + 4608 + 1024 + hh * 128;
          a.out = OG + tok * D + 1024 + hh * 128;
          a.seg[0].k = QKVG + tok * L0_IN + 2560 + hh * 128;
          a.seg[0].v = QKVG + tok * L0_IN + 3584 + hh * 128;
        }
      }
      attn_block<128, 0>(a, smem);
    }
  }
}

DI void phase_attn1(const Params& p, LDS_AS(unsigned char)* smem, int round) {
  const u16* Q1 = (const u16*)(p.ws + OFF_Q1);
  u16* LAT1 = (u16*)(p.ws + OFF_LAT1);
  const float sc = 0.07216878364870322f * LOG2E;
  for (int it = blockIdx.x; it < 512; it += gridDim.x) {
    AttnArgs a;
    a.qs = 3072; a.gs = L1_LD; a.os = L1_LD; a.scale_log2 = sc; a.rpb = nullptr; a.rs0 = 0; a.ropetab = (const float*)(p.ws + OFF_ROPE);
    a.seg[1].k = nullptr; a.seg[1].v = nullptr; a.seg[1].kr = nullptr; a.seg[1].ks = 0; a.seg[1].vs = 0; a.seg[1].n = 0;
    a.nseg = 1;
    a.seg[0].ks = 4096; a.seg[0].vs = 4096;
    size_t tok;
    int hh;
    if (round == 0) {
      int b = it >> 4; hh = it & 15;
      tok = (size_t)b * 256;
      const u16* KV = (const u16*)(p.ws + OFF_KV_CTX) + (size_t)b * 256 * 4096 + hh * 256;
      a.seg[0].k = KV; a.seg[0].v = KV + 128;
      a.seg[0].kr = (const u16*)(p.ws + OFF_KR_CTX) + (size_t)b * 256 * 64;
      a.seg[0].n = 256;
      a.rope = 0; a.qtok0 = 0;
    } else {
      int bh = (it >> 5) * 8 + (it & 7), qb = (it >> 3) & 3;
      int b = bh >> 4; hh = bh & 15;
      tok = (size_t)NCTX + b * 1024 + qb * 256;
      const u16* KV = (const u16*)(p.ws + OFF_KV_LAT) + (size_t)b * 1536 * 4096 + hh * 256;
      a.seg[0].k = KV; a.seg[0].v = KV + 128;
      a.seg[0].kr = (const u16*)(p.ws + OFF_KR_ALL) + (size_t)b * 1536 * 64;
      a.seg[0].n = 1536;
      a.rope = 1; a.qtok0 = qb * 256;
    }
    a.q = Q1 + tok * 3072 + hh * 192;
    a.gate = LAT1 + tok * L1_LD + L1_GATE + hh * 128;
    a.out = LAT1 + tok * L1_LD + L1_GATE + hh * 128;
    attn_block<192, 2>(a, smem);
  }
}

#define XB_TMO      128
#define XB_XCNT(j)  (256  + 64 * (j))
#define XB_XSUB(j)  (1280 + 64 * (j))
#define XB_XGEN(j)  (2304 + 64 * (j))
#define XB_TOP      3328
#define XB_TOPGEN   3392
#define XCD_BAR_WORDS 3456
#define XB_SPIN_CAP (1u << 18)
#define XLAS __attribute__((address_space(3)))

__device__ __forceinline__ unsigned xb_ld(unsigned* p)              { return __hip_atomic_load(p, __ATOMIC_RELAXED, __HIP_MEMORY_SCOPE_AGENT); }
__device__ __forceinline__ unsigned xb_add(unsigned* p, unsigned v) { return __hip_atomic_fetch_add(p, v, __ATOMIC_RELAXED, __HIP_MEMORY_SCOPE_AGENT); }
__device__ __forceinline__ unsigned xb_xcc_id() { return (unsigned)__builtin_amdgcn_s_getreg((3 << 11) | 20) & 0xFu; }
#define XB_SPIN(cond, bar) do { unsigned _sp = 0; while (cond) { __builtin_amdgcn_s_sleep(1); \
    if ((++_sp & 255u) == 0u) { if (xb_ld(&(bar)[XB_TMO])) break; if (_sp > XB_SPIN_CAP) { atomicAdd(&(bar)[XB_TMO], 1u); break; } } } } while (0)

struct XcdBarrier {
    unsigned* bar; unsigned x;
    volatile XLAS unsigned* st;
};

__device__ __forceinline__ XcdBarrier xcd_barrier_post(unsigned* bar, volatile XLAS unsigned* st) {
    XcdBarrier b; b.bar = bar; b.x = xb_xcc_id(); b.st = st;
    if (threadIdx.x == 0) (void)xb_add(&bar[XB_XCNT(b.x)], 1u);
    return b;
}
__device__ __forceinline__ void xcd_barrier_complete(unsigned* bar, unsigned x, unsigned& nloc, unsigned& nx) {
    const unsigned G = gridDim.x * gridDim.y * gridDim.z;
    unsigned sum, cnt, mine, sp = 0u;
    for (;;) {
        sum = 0u; cnt = 0u; mine = 0u;
#pragma unroll
        for (unsigned j = 0; j < 16; ++j) { const unsigned c = xb_ld(&bar[XB_XCNT(j)]); sum += c; cnt += (c > 0u) ? 1u : 0u; mine = (j == x) ? c : mine; }
        if (sum == G) break;
        __builtin_amdgcn_s_sleep(1);
        if ((++sp & 255u) == 0u) { if (xb_ld(&bar[XB_TMO])) break; if (sp > XB_SPIN_CAP) { atomicAdd(&bar[XB_TMO], 1u); break; } }
    }
    nloc = mine > 0u ? mine : 1u; nx = cnt > 0u ? cnt : 1u;
}

__device__ __forceinline__ void xcd_barrier(const XcdBarrier& b) {
    asm volatile("s_waitcnt vmcnt(0)" ::: "memory");
    __syncthreads();
    if (threadIdx.x == 0) {
        unsigned* bar = b.bar;
        __builtin_amdgcn_s_waitcnt(0);
        unsigned nloc = b.st[0], nx = b.st[1];
        if (nloc == 0u) { xcd_barrier_complete(bar, b.x, nloc, nx); b.st[0] = nloc; b.st[1] = nx; }
        const unsigned old = xb_add(&bar[XB_XSUB(b.x)], 1u);
        const unsigned gen = old / nloc;
        if (old + 1u == (gen + 1u) * nloc) {
            __builtin_amdgcn_fence(__ATOMIC_RELEASE, "agent");
            asm volatile("s_waitcnt vmcnt(0)" ::: "memory");
            const unsigned og = xb_add(&bar[XB_TOP], 1u);
            const unsigned tg = og / nx;
            if (og + 1u == (tg + 1u) * nx) xb_add(&bar[XB_TOPGEN], 1u);
            else XB_SPIN(xb_ld(&bar[XB_TOPGEN]) == tg, bar);
            __builtin_amdgcn_fence(__ATOMIC_ACQUIRE, "agent");
            xb_add(&bar[XB_XGEN(b.x)], 1u);
            asm volatile("s_waitcnt vmcnt(0)" ::: "memory");
        } else {
            XB_SPIN(xb_ld(&bar[XB_XGEN(b.x)]) == gen, bar);
            __builtin_amdgcn_fence(__ATOMIC_ACQUIRE, "agent");
            asm volatile("s_waitcnt vmcnt(0)" ::: "memory");
        }
    }
    __syncthreads();
}

__global__ void __launch_bounds__(512, 2) fwd_megakernel(Params p) {
  cg::grid_group grid = cg::this_grid();
  extern __shared__ __attribute__((aligned(16))) unsigned char dsm[];
  char* smem = (char*)dsm;
  char* ws = p.ws;
  const float* mod0 = (const float*)(ws + OFF_MOD);
  const float* mod1 = mod0 + 9 * 6144;

  volatile XLAS unsigned* xst = (volatile XLAS unsigned*)((XLAS unsigned char*)dsm + 128 * 1024);
  if (threadIdx.x < 4) xst[threadIdx.x] = 0u;
  __syncthreads();
  const XcdBarrier xb = xcd_barrier_post((unsigned*)(ws + OFF_BAR), xst);
  phase_prep(p, smem);
  if (p.out == nullptr) grid.sync();
  xcd_barrier(xb);
  phase_normmod(p, 0);
  xcd_barrier(xb);
  { EpiBf16 e{(u16*)(ws + OFF_BIG), L0_IN};
    gemm_run((PG8_LAS unsigned char*)dsm, (const u16*)(ws + OFF_H), D, (const u16*)(ws + OFF_WT_IN0), NTOK, L0_IN, 2048, e); }
  if (gridDim.x == 256) { if (blockIdx.x >= 128 && blockIdx.x < 224) adaln_item(p, 1, blockIdx.x - 128, (float*)smem); }
  else { for (int c = blockIdx.x; c < 96; c += gridDim.x) adaln_item(p, 1, c, (float*)smem); }
  xcd_barrier(xb);
  phase_qknorm0(p);
  xcd_barrier(xb);
#pragma unroll 1
  for (int rep = 0; rep < REP_A0; ++rep) phase_attn0(p, (LDS_AS(unsigned char)*)dsm);
  xcd_barrier(xb);
  { EpiResidB<false> e{p.x_prompt, p.x_sample, mod0 + 4096, (u16*)(p.out + OUT_Y)};
    gemm_run((PG8_LAS unsigned char*)dsm, (const u16*)(ws + OFF_H), D, (const u16*)(ws + OFF_WT_OUT0), NTOK, D, 2048, e); }
  xcd_barrier(xb);
  phase_normmod1(p);
  xcd_barrier(xb);
  { EpiBf16 e{(u16*)(ws + OFF_LAT1), L1_LD};
    gemm_run((PG8_LAS unsigned char*)dsm, (const u16*)(ws + OFF_H), D, (const u16*)(ws + OFF_WT_IN1), NTOK, L1_LD, 2048, e); }
  xcd_barrier(xb);
  phase_krope(p, smem);
  phase_norm1(p);
  xcd_barrier(xb);
  { EpiBf16 e{(u16*)(ws + OFF_Q1), 3072};
    gemm_run((PG8_LAS unsigned char*)dsm, (const u16*)(ws + OFF_QN), 512, (const u16*)(ws + OFF_WT_QB), NTOK, 3072, 512, e); }
#pragma unroll 1
  for (int round = 0; round < 2; ++round) {
    { EpiBf16 e{(u16*)(ws + (round ? OFF_KV_LAT : OFF_KV_CTX)), 4096};
      gemm_run((PG8_LAS unsigned char*)dsm, (const u16*)(ws + (round ? OFF_CKV_ALL : OFF_CKV_CTX)), 512, (const u16*)(ws + OFF_WT_KVB),
               round ? 12288 : NCTX, 4096, 512, e); }
    xcd_barrier(xb);
    phase_attn1(p, (LDS_AS(unsigned char)*)dsm, round);
    xcd_barrier(xb);
  }
  { EpiResidB<true> e{p.out + OUT_Y, nullptr, mod1 + 4096, (u16*)(ws + OFF_Q1)};
    gemm_run((PG8_LAS unsigned char*)dsm, (const u16*)(ws + OFF_LAT1) + L1_GATE, L1_LD, (const u16*)(ws + OFF_WT_OUT1), NTOK, D, 2048, e); }
  xcd_barrier(xb);
  phase_final(p);
}

extern "C" void kernel_launch(void* const* d_in, const int* in_sizes, int n_in, void* d_out, int out_size, void* d_ws,
                              size_t ws_size, hipStream_t stream) {
  (void)in_sizes; (void)n_in; (void)out_size;
  if (ws_size < WS_NEEDED) { fprintf(stderr, "workspace too small: %zu < %zu\n", ws_size, (size_t)WS_NEEDED); return; }
  static int grid_blocks = 0;
  if (!grid_blocks) {
    int dev = 0, cus = 0, per_cu = 0;
    (void)hipGetDevice(&dev);
    (void)hipDeviceGetAttribute(&cus, hipDeviceAttributeMultiprocessorCount, dev);
    if (hipFuncSetAttribute((const void*)fwd_megakernel, hipFuncAttributeMaxDynamicSharedMemorySize, SMEM_BYTES) != hipSuccess) {
      fprintf(stderr, "hipFuncSetAttribute failed\n"); return; }
    (void)hipOccupancyMaxActiveBlocksPerMultiprocessor(&per_cu, fwd_megakernel, NT, SMEM_BYTES);
    if (per_cu < 1) { fprintf(stderr, "occupancy query returned %d\n", per_cu); return; }
    grid_blocks = cus;
  }
  Params p{};
  const float** pf = (const float**)&p;
  for (int i = 0; i < 28; ++i) pf[i] = (const float*)d_in[i];
  p.out = (float*)d_out;
  p.ws = (char*)d_ws;
  (void)hipMemsetAsync((char*)d_ws + OFF_BAR, 0, BAR_BYTES, stream);
  void* args[] = {&p};
  hipError_t e = hipLaunchCooperativeKernel((void*)fwd_megakernel, dim3(grid_blocks), dim3(NT), args, SMEM_BYTES, stream);
  if (e != hipSuccess) fprintf(stderr, "cooperative launch failed: %s (grid %d)\n", hipGetErrorString(e), grid_blocks);
}
```
